# Optimizing an MI355X kernel written in HIP

```python
import math
import jax, jax.numpy as jnp
from jax import lax
import numpy as np

D_MODEL = 2048
BATCH = 2
SEQ = 4096
DEPTH = 2

CHUNK = 64
QBLOCK = 128
N_EVEN = (DEPTH + 1) // 2
N_ODD = DEPTH // 2
EPS = 1e-6

H_A = 8
DH_A = 128
H_B = 4
DK_B = 128
DV_B = 2 * DK_B
NUM_BUCKETS = 32
MAX_DISTANCE = 128
H_C = 4
DK_C = 128
DV_C = 2 * DK_C
ROPE_BASE = 10000.0
D_D = 1024
G_D = 4
SGU_LEN = 128
D_FF = 5632
CONV_WIDTH = 3

AB_IN = 3 * H_A * DH_A + 2 * H_B * 2 * DK_B + H_B * DV_B
AB_WIDTH = H_A * DH_A + H_B * DV_B
CD_IN = 2 * H_C * DK_C + 2 * H_C * DV_C + 2 * D_D
CD_WIDTH = H_C * DV_C + D_D

kernel_name = "hybrid_stickbreak_diffattn_retention_sgu_convffn"


def _rmsnorm(x, g):
    x32 = x.astype(jnp.float32)
    y = x32 * lax.rsqrt(jnp.mean(x32 * x32, axis=-1, keepdims=True) + EPS)
    return (y * g.astype(jnp.float32)).astype(x.dtype)


def _layernorm(x, g, b):
    x32 = x.astype(jnp.float32)
    mu = jnp.mean(x32, axis=-1, keepdims=True)
    var = jnp.mean(jnp.square(x32 - mu), axis=-1, keepdims=True)
    y = (x32 - mu) * lax.rsqrt(var + EPS)
    return (y * g.astype(jnp.float32) + b.astype(jnp.float32)).astype(x.dtype)


def _heads(t, n_heads, dh):
    b, s, _ = t.shape
    return t.reshape(b, s, n_heads, dh).transpose(0, 2, 1, 3)


def _merge_heads(t):
    b, h, s, d = t.shape
    return t.transpose(0, 2, 1, 3).reshape(b, s, h * d)


def _rel_bucket(rel):
    nb = NUM_BUCKETS // 2
    max_exact = nb // 2
    ret = jnp.where(rel > 0, nb, 0)
    n = jnp.abs(rel)
    n_f = jnp.maximum(n, 1).astype(jnp.float32)
    large = max_exact + (jnp.log(n_f / max_exact) / math.log(MAX_DISTANCE / max_exact)
                         * (nb - max_exact)).astype(jnp.int32)
    large = jnp.minimum(large, nb - 1)
    return ret + jnp.where(n < max_exact, n, large)


def _stick_breaking(q, k, v):
    b, h, s, dh = q.shape
    scale = dh ** -0.5
    kpos = jnp.arange(s)

    def block(i):
        start = i * QBLOCK
        qpos = start + jnp.arange(QBLOCK)
        q_blk = lax.dynamic_slice_in_dim(q, start, QBLOCK, axis=2)
        z = jnp.einsum('bhqd,bhkd->bhqk', q_blk, k).astype(jnp.float32) * scale
        earlier = kpos[None, :] < qpos[:, None]
        log_1m = jnp.where(earlier, jax.nn.log_sigmoid(-z), 0.0)
        after = lax.cumsum(log_1m, axis=3, reverse=True) - log_1m
        w = jnp.where(earlier, jnp.exp(jax.nn.log_sigmoid(z) + after), 0.0)
        return jnp.einsum('bhqk,bhkd->bhqd', w.astype(v.dtype), v)

    out = lax.map(block, jnp.arange(s // QBLOCK))
    return out.transpose(1, 2, 0, 3, 4).reshape(b, h, s, dh)


def _diff_attention(q1, q2, k1, k2, v, rel_bias, lam):
    b, h, s, dk = q1.shape
    dv = v.shape[-1]
    scale = dk ** -0.5
    kpos = jnp.arange(s)

    def block(i):
        start = i * QBLOCK
        qpos = start + jnp.arange(QBLOCK)
        bucket = _rel_bucket(kpos[None, :] - qpos[:, None])
        bias = jnp.transpose(rel_bias[bucket], (2, 0, 1)).astype(jnp.float32)
        allowed = (kpos[None, :] // CHUNK) <= (qpos[:, None] // CHUNK)

        def probs(qq, kk):
            q_blk = lax.dynamic_slice_in_dim(qq, start, QBLOCK, axis=2)
            logits = jnp.einsum('bhqd,bhkd->bhqk', q_blk, kk).astype(jnp.float32) * scale + bias
            return jax.nn.softmax(jnp.where(allowed, logits, -jnp.inf), axis=-1)

        a = probs(q1, k1) - lam * probs(q2, k2)
        return jnp.einsum('bhqk,bhkd->bhqd', a.astype(v.dtype), v)

    out = lax.map(block, jnp.arange(s // QBLOCK))
    return out.transpose(1, 2, 0, 3, 4).reshape(b, h, s, dv)


def _rotary(t):
    s, d = t.shape[2], t.shape[3]
    inv_freq = ROPE_BASE ** (-jnp.arange(0, d, 2, dtype=jnp.float32) / d)
    ang = jnp.arange(s, dtype=jnp.float32)[:, None] * inv_freq[None, :]
    cos = jnp.concatenate([jnp.cos(ang), jnp.cos(ang)], axis=-1)
    sin = jnp.concatenate([jnp.sin(ang), jnp.sin(ang)], axis=-1)
    t1, t2 = jnp.split(t, 2, axis=-1)
    return t * cos + jnp.concatenate([-t2, t1], axis=-1) * sin


def _retention(q, k, v):
    b, h, s, dk = q.shape
    dv = v.shape[-1]
    n = s // CHUNK
    log_g = jnp.log(1.0 - 2.0 ** (-5.0 - jnp.arange(h, dtype=jnp.float32)))
    idx = jnp.arange(CHUNK, dtype=jnp.float32)
    intra_decay = jnp.exp(log_g[:, None, None] * jnp.abs(idx[:, None] - idx[None, :]))
    q_decay = jnp.exp(log_g[:, None] * (idx + 1.0))
    k_decay = jnp.exp(log_g[:, None] * (CHUNK - 1.0 - idx))
    chunk_decay = jnp.exp(log_g * CHUNK)

    qc = q.reshape(b, h, n, CHUNK, dk)
    kc = k.reshape(b, h, n, CHUNK, dk)
    vc = v.reshape(b, h, n, CHUNK, dv)
    scores = jnp.einsum('bhncd,bhnmd->bhncm', qc, kc) * intra_decay[None, :, None]
    intra = jnp.einsum('bhncm,bhnme->bhnce', scores, vc)
    kv = jnp.einsum('bhncd,bhnce->bhnde', kc * k_decay[None, :, None, :, None], vc)

    def step(state, kv_n):
        return chunk_decay[None, :, None, None] * state + kv_n, state

    _, prev = lax.scan(step, jnp.zeros((b, h, dk, dv), jnp.float32),
                       kv.transpose(2, 0, 1, 3, 4))
    cross = jnp.einsum('bhncd,nbhde->bhnce', qc, prev) * q_decay[None, :, None, :, None]
    return (intra + cross).reshape(b, h, s, dv)


def _spatial_gate(v, w_s, b_s):
    b, s, _ = v.shape
    vg = v.reshape(b, s // SGU_LEN, SGU_LEN, G_D, D_D // G_D)
    pos = jnp.arange(SGU_LEN)
    mask = (pos[None, :] // CHUNK) <= (pos[:, None] // CHUNK)
    w = jnp.where(mask[None], w_s, 0.0)
    out = jnp.einsum('gij,bnjgc->bnigc', w, vg) + b_s.T[None, None, :, :, None]
    return out.reshape(b, s, D_D)


def _mixer_ab(h, w_in, w_out, rel_bias, lam_vecs, subln_g, lam_init):
    b, s, _ = h.shape
    p = h @ w_in
    sa = H_A * DH_A
    sbq = H_B * 2 * DK_B
    qa, ka, va, qb, kb, vb = jnp.split(
        p, np.cumsum([sa, sa, sa, sbq, sbq])[:5].tolist(), axis=-1)
    o_a = _stick_breaking(_heads(qa, H_A, DH_A), _heads(ka, H_A, DH_A), _heads(va, H_A, DH_A))
    qb = qb.reshape(b, s, H_B, 2, DK_B).transpose(0, 2, 3, 1, 4)
    kb = kb.reshape(b, s, H_B, 2, DK_B).transpose(0, 2, 3, 1, 4)
    lv = lam_vecs.astype(jnp.float32)
    lam = jnp.exp(jnp.sum(lv[0] * lv[1])) - jnp.exp(jnp.sum(lv[2] * lv[3])) + lam_init
    o_b = _diff_attention(qb[:, :, 0], qb[:, :, 1], kb[:, :, 0], kb[:, :, 1],
                          _heads(vb, H_B, DV_B), rel_bias, lam)
    o_b = _rmsnorm(o_b, subln_g) * (1.0 - lam_init)
    return jnp.concatenate([_merge_heads(o_a), _merge_heads(o_b)], axis=-1) @ w_out


def _mixer_cd(h, w_in, w_out, ret_norm_g, ln_g, ln_b, sgu_w, sgu_b):
    sq = H_C * DK_C
    sv = H_C * DV_C
    qc, kc, vc, gc, zd = jnp.split(
        h @ w_in, np.cumsum([sq, sq, sv, sv])[:4].tolist(), axis=-1)
    q = _rotary(_heads(qc, H_C, DK_C).astype(jnp.float32)) * (DK_C ** -0.5)
    k = _rotary(_heads(kc, H_C, DK_C).astype(jnp.float32))
    y = _retention(q, k, _heads(vc, H_C, DV_C).astype(jnp.float32))
    y = _rmsnorm(y, ret_norm_g).astype(h.dtype)
    o_c = jax.nn.silu(gc) * _merge_heads(y)
    u, v = jnp.split(jax.nn.gelu(zd), 2, axis=-1)
    o_d = u * _spatial_gate(_layernorm(v, ln_g, ln_b), sgu_w, sgu_b)
    return jnp.concatenate([o_c, o_d], axis=-1) @ w_out


def _conv_ffn(h, w_up, conv_w, conv_b, w_down):
    s = h.shape[1]
    up = h @ w_up
    padded = jnp.pad(up, ((0, 0), (CONV_WIDTH - 1, 0), (0, 0)))
    c = conv_b + sum(conv_w[j] * padded[:, j:j + s] for j in range(CONV_WIDTH))
    a, g = jnp.split(c, 2, axis=-1)
    return (jax.nn.silu(g) * a) @ w_down


def setup_inputs(seed: int = 0) -> dict:
    key = jax.random.key(seed)
    ks = jax.random.split(key, 20)
    nrm = jax.random.normal
    f32 = jnp.float32
    return {
        "x": nrm(ks[0], (BATCH, SEQ, D_MODEL), f32),
        "norm_mix_g": 1.0 + 0.02 * nrm(ks[1], (DEPTH, D_MODEL), f32),
        "norm_ffn_g": 1.0 + 0.02 * nrm(ks[2], (DEPTH, D_MODEL), f32),
        "final_norm_g": 1.0 + 0.02 * nrm(ks[3], (D_MODEL,), f32),
        "rel_bias": 0.2 * nrm(ks[4], (NUM_BUCKETS, H_B), f32),
        "ab_w_in": nrm(ks[5], (N_EVEN, D_MODEL, AB_IN), f32) * D_MODEL ** -0.5,
        "ab_w_out": nrm(ks[6], (N_EVEN, AB_WIDTH, D_MODEL), f32) * AB_WIDTH ** -0.5,
        "diff_lambda": 0.1 * nrm(ks[7], (N_EVEN, 4, DK_B), f32),
        "diff_subln_g": 1.0 + 0.02 * nrm(ks[8], (N_EVEN, DV_B), f32),
        "cd_w_in": nrm(ks[9], (N_ODD, D_MODEL, CD_IN), f32) * D_MODEL ** -0.5,
        "cd_w_out": nrm(ks[10], (N_ODD, CD_WIDTH, D_MODEL), f32) * CD_WIDTH ** -0.5,
        "ret_norm_g": 1.0 + 0.02 * nrm(ks[11], (N_ODD, DV_C), f32),
        "sgu_ln_g": 1.0 + 0.02 * nrm(ks[12], (N_ODD, D_D), f32),
        "sgu_ln_b": 0.02 * nrm(ks[13], (N_ODD, D_D), f32),
        "sgu_w": nrm(ks[14], (N_ODD, G_D, SGU_LEN, SGU_LEN), f32) * SGU_LEN ** -0.5,
        "sgu_b": 1.0 + 0.02 * nrm(ks[15], (N_ODD, G_D, SGU_LEN), f32),
        "ffn_w_up": nrm(ks[16], (DEPTH, D_MODEL, 2 * D_FF), f32) * D_MODEL ** -0.5,
        "ffn_conv_w": nrm(ks[17], (DEPTH, CONV_WIDTH, 2 * D_FF), f32) * CONV_WIDTH ** -0.5,
        "ffn_conv_b": 0.02 * nrm(ks[18], (DEPTH, 2 * D_FF), f32),
        "ffn_w_down": nrm(ks[19], (DEPTH, D_FF, D_MODEL), f32) * D_FF ** -0.5,
    }


def reference(x, norm_mix_g, norm_ffn_g, final_norm_g, rel_bias, ab_w_in, ab_w_out,
              diff_lambda, diff_subln_g, cd_w_in, cd_w_out, ret_norm_g, sgu_ln_g,
              sgu_ln_b, sgu_w, sgu_b, ffn_w_up, ffn_conv_w, ffn_conv_b, ffn_w_down):
    for layer in range(DEPTH):
        h = _rmsnorm(x, norm_mix_g[layer])
        j = layer // 2
        if layer % 2 == 0:
            lam_init = 0.8 - 0.6 * math.exp(-0.3 * layer)
            x = x + _mixer_ab(h, ab_w_in[j], ab_w_out[j], rel_bias, diff_lambda[j],
                              diff_subln_g[j], lam_init)
        else:
            x = x + _mixer_cd(h, cd_w_in[j], cd_w_out[j], ret_norm_g[j], sgu_ln_g[j],
                              sgu_ln_b[j], sgu_w[j], sgu_b[j])
        h = _rmsnorm(x, norm_ffn_g[layer])
        x = x + _conv_ffn(h, ffn_w_up[layer], ffn_conv_w[layer], ffn_conv_b[layer],
                          ffn_w_down[layer])
    return _rmsnorm(x, final_norm_g)
```

```cpp
#include <hip/hip_runtime.h>
#include <hip/hip_bf16.h>
#include <cstdio>
#include <cstdint>

#ifndef PROBE_PHASE
#define PROBE_PHASE -1
#endif
#ifndef PROBE_SEL
#define PROBE_SEL 0
#endif
#ifndef PROBE_NPH
#define PROBE_NPH 1
#endif
#ifndef MK_PER_PHASE
#define MK_PER_PHASE 0
#endif

namespace pg8 {
#define PG8_LAS __attribute__((address_space(3)))
typedef unsigned short bf16_t;
typedef short bf16x8 __attribute__((ext_vector_type(8)));
typedef float f32x4 __attribute__((ext_vector_type(4)));
typedef unsigned u32x4 __attribute__((ext_vector_type(4)));
constexpr int BM = 256, BK = 64, HALF = 128, HTB = HALF * BK * 2, STAGE_BYTES = 8 * HTB, NXCD = 8, WGM = 8;

__host__ __device__ __forceinline__ int lds_byte(int r, int c) { const int st = (r >> 4) * 2 + (c >> 5), rr = r & 15, cc = c & 31, ob = rr * 64 + cc * 2; return st * 1024 + (ob ^ (((ob >> 9) & 1) << 5)); }
__host__ __device__ __forceinline__ void stage_rc(int b, int& R, int& C) { const int st = b / 1024, sb = b % 1024, swz = sb ^ (((sb >> 9) & 1) << 5); R = (st >> 1) * 16 + swz / 64; C = (st & 1) * 32 + (swz % 64) / 2; }
__host__ __device__ __forceinline__ int perm32(int rho) { const int n = rho >> 4, i = rho & 15; return 8 * (i >> 2) + 4 * n + (i & 3); }

struct Unit { int pm, pn; };
struct Gemm { const bf16_t* A; const bf16_t* Bt; int M, N, K; };

struct StaticOrder {
    int nM, nN, nwg, G, c;
    __host__ __device__ void init(int M, int N, int G_, int c_) { nM = M / BM; nN = N / BM; nwg = nM * nN; G = G_; c = c_; }
    __host__ __device__ bool next(int i, Unit& u) const {
        const long L = (long)i * G + c; if (L >= nwg) return false;
        int wgid = (int)L; { const int q = nwg / NXCD, r = nwg % NXCD, xcd = wgid % NXCD, off = wgid / NXCD; wgid = (xcd < r ? xcd * (q + 1) : r * (q + 1) + (xcd - r) * q) + off; }
        const int nig = WGM * nN, gid = wgid / nig, fm = gid * WGM, gsz = (nM - fm) < WGM ? (nM - fm) : WGM;
        u.pm = fm + ((wgid % nig) % gsz); u.pn = (wgid % nig) / gsz; return true;
    }
    __device__ __forceinline__ void a_ready(const Unit&) const {}
    __device__ __forceinline__ void done(const Unit&) const {}
};

__device__ __forceinline__ unsigned cvt_pk_bf16(float lo, float hi) { unsigned r; asm volatile("v_cvt_pk_bf16_f32 %0, %1, %2" : "=v"(r) : "v"(lo), "v"(hi)); return r; }

__device__ __forceinline__ float gelu_tanh_e(float x) { const float u = 0.7978845608028654f * (x + 0.044715f * x * x * x); const float t = 1.f - 2.f / (__expf(2.f * u) + 1.f); return 0.5f * x * (1.f + t); }
struct EpiBf16 {
    static constexpr bool PERM = true, AFTER_DRAIN = false;
    bf16_t* O; int ldc; const unsigned long long* ss; unsigned long long* lnsum; int ln_pn0, ln_pn1;
    __device__ __forceinline__ void operator()(const f32x4 (&acc)[2][2][4][2], const Unit& u, int wr, int wc, int fr, int fq) const {
        const int row0 = u.pm * BM + wr * 64 + fr; const int col0 = u.pn * BM + wc * 32 + 8 * fq;
        const bool do_ln = lnsum != nullptr && u.pn >= ln_pn0 && u.pn < ln_pn1;
#pragma unroll
        for (int ai = 0; ai < 2; ++ai)
#pragma unroll
            for (int m = 0; m < 4; ++m) { const int row = row0 + ai * HALF + m * 16; bf16_t* rowp = O + (size_t)row * ldc + col0;
                const float sc = ss ? __builtin_amdgcn_rsqf((float)__hip_atomic_load(ss + row, __ATOMIC_RELAXED, __HIP_MEMORY_SCOPE_AGENT) * (1.f / 16777216.f / 2048.f) + 1e-6f) : 1.f;
                float s1 = 0.f, s2 = 0.f;
#pragma unroll
                for (int bj = 0; bj < 2; ++bj) { const f32x4 v0 = acc[ai][bj][m][0] * sc, v1 = acc[ai][bj][m][1] * sc;
                    u32x4 w; w.x = cvt_pk_bf16(v0[0], v0[1]); w.y = cvt_pk_bf16(v0[2], v0[3]); w.z = cvt_pk_bf16(v1[0], v1[1]); w.w = cvt_pk_bf16(v1[2], v1[3]);
                    *(u32x4*)(rowp + bj * HALF) = w;
                    if (do_ln) {
#pragma unroll
                        for (int q = 0; q < 4; ++q) { const float a = gelu_tanh_e(v0[q]), b = gelu_tanh_e(v1[q]); s1 += a + b; s2 += a * a + b * b; } } }
                if (do_ln) { s1 += __shfl_xor(s1, 16); s1 += __shfl_xor(s1, 32); s2 += __shfl_xor(s2, 16); s2 += __shfl_xor(s2, 32);
                    if (fq == 0) { atomicAdd(lnsum + 2 * row, (unsigned long long)(long long)(s1 * 16777216.f)); atomicAdd(lnsum + 2 * row + 1, (unsigned long long)(long long)(s2 * 16777216.f)); } } }
    }
};
struct EpiRes {
    static constexpr bool PERM = true, AFTER_DRAIN = false;
    const float* basef; bf16_t* xb; int ldc; unsigned long long* ss;
    __device__ __forceinline__ void operator()(const f32x4 (&acc)[2][2][4][2], const Unit& u, int wr, int wc, int fr, int fq) const {
        const int row0 = u.pm * BM + wr * 64 + fr; const int col0 = u.pn * BM + wc * 32 + 8 * fq;
#pragma unroll
        for (int ai = 0; ai < 2; ++ai)
#pragma unroll
            for (int m = 0; m < 4; ++m) { const int row = row0 + ai * HALF + m * 16; const size_t off = (size_t)row * ldc + col0; float sq = 0.f;
#pragma unroll
                for (int bj = 0; bj < 2; ++bj) { f32x4 b0, b1;
                    if (basef) { b0 = *(const f32x4*)(basef + off + bj * HALF); b1 = *(const f32x4*)(basef + off + bj * HALF + 4); }
                    else { const u32x4 w = *(const u32x4*)(xb + off + bj * HALF);
                        b0 = (f32x4){__builtin_bit_cast(float, w.x << 16), __builtin_bit_cast(float, w.x & 0xffff0000u), __builtin_bit_cast(float, w.y << 16), __builtin_bit_cast(float, w.y & 0xffff0000u)};
                        b1 = (f32x4){__builtin_bit_cast(float, w.z << 16), __builtin_bit_cast(float, w.z & 0xffff0000u), __builtin_bit_cast(float, w.w << 16), __builtin_bit_cast(float, w.w & 0xffff0000u)}; }
                    const f32x4 o0 = b0 + acc[ai][bj][m][0], o1 = b1 + acc[ai][bj][m][1];
                    u32x4 w; w.x = cvt_pk_bf16(o0[0], o0[1]); w.y = cvt_pk_bf16(o0[2], o0[3]); w.z = cvt_pk_bf16(o1[0], o1[1]); w.w = cvt_pk_bf16(o1[2], o1[3]);
                    *(u32x4*)(xb + off + bj * HALF) = w;
#pragma unroll
                    for (int q = 0; q < 4; ++q) { const unsigned ww = q == 0 ? w.x : q == 1 ? w.y : q == 2 ? w.z : w.w; const float lo = __builtin_bit_cast(float, ww << 16), hi = __builtin_bit_cast(float, ww & 0xffff0000u); sq += lo * lo + hi * hi; } }
                sq += __shfl_xor(sq, 16); sq += __shfl_xor(sq, 32);
                if (fq == 0) atomicAdd(ss + row, (unsigned long long)(sq * 16777216.f)); }
    }
};

struct EpiConv {
    static constexpr bool PERM = true, AFTER_DRAIN = false;
    bf16_t* act; const unsigned long long* ss; const float* cw; const float* cb; bf16_t* halo; PG8_LAS unsigned char* lds0;
    static constexpr int NFF = 5632, NFF2 = 11264;
    static constexpr int HX = STAGE_BYTES + 1024, CPAR = HX + 4096;
    __device__ __forceinline__ static int hxi(int wr, int ai, int rs, int bj, int wc, int fq) { return ((((((wr * 2 + ai) * 2 + rs) * 2 + bj) * 4 + wc) * 4 + fq) * 16); }
    __device__ __forceinline__ static u32x4 bperm4(int addr, u32x4 v) {
        u32x4 r; r.x = (unsigned)__builtin_amdgcn_ds_bpermute(addr, (int)v.x); r.y = (unsigned)__builtin_amdgcn_ds_bpermute(addr, (int)v.y);
        r.z = (unsigned)__builtin_amdgcn_ds_bpermute(addr, (int)v.z); r.w = (unsigned)__builtin_amdgcn_ds_bpermute(addr, (int)v.w); return r; }
    __device__ __forceinline__ void operator()(const f32x4 (&acc)[2][2][4][2], const Unit& u, int wr, int wc, int fr, int fq) const {
        asm volatile("" : "+v"(fr), "+v"(fq));
        typedef float f32x2 __attribute__((ext_vector_type(2)));
        const int lane = fq * 16 + fr, tid = (wr * 4 + wc) * 64 + lane;
        { PG8_LAS float* cp = (PG8_LAS float*)(lds0 + CPAR);
#pragma unroll
          for (int e = 0; e < 2; ++e) { const int idx = tid * 2 + e, bj = idx >> 9, j = (idx >> 7) & 3, c = idx & 127; const int gcol = bj * NFF + u.pn * 128 + c;
              cp[idx] = j < 3 ? cw[(size_t)j * NFF2 + gcol] : cb[gcol]; } }
        u32x4 pk[2][2][4];
#pragma unroll
        for (int ai = 0; ai < 2; ++ai)
#pragma unroll
            for (int m = 0; m < 4; ++m) { const int row = u.pm * BM + ai * HALF + wr * 64 + m * 16 + fr;
                const float sc = __builtin_amdgcn_rsqf((float)__hip_atomic_load(ss + row, __ATOMIC_RELAXED, __HIP_MEMORY_SCOPE_AGENT) * (1.f / 16777216.f / 2048.f) + 1e-6f);
#pragma unroll
                for (int bj = 0; bj < 2; ++bj) { const f32x4 v0 = acc[ai][bj][m][0] * sc, v1 = acc[ai][bj][m][1] * sc;
                    pk[ai][bj][m] = (u32x4){cvt_pk_bf16(v0[0], v0[1]), cvt_pk_bf16(v0[2], v0[3]), cvt_pk_bf16(v1[0], v1[1]), cvt_pk_bf16(v1[2], v1[3])}; } }
        const int pcol = u.pn * 256 + wc * 32 + 8 * fq;
        if (fr >= 14) {
#pragma unroll
            for (int ai = 0; ai < 2; ++ai)
#pragma unroll
                for (int bj = 0; bj < 2; ++bj) *(PG8_LAS u32x4*)(lds0 + HX + hxi(wr, ai, fr - 14, bj, wc, fq)) = pk[ai][bj][3];
            if (wr == 1) {
#pragma unroll
                for (int bj = 0; bj < 2; ++bj) *(u32x4*)(halo + ((size_t)u.pm * 4 + 2 + (fr - 14)) * NFF2 + pcol + bj * HALF) = pk[1][bj][3]; } }
        if (wr == 0 && fr < 2) {
#pragma unroll
            for (int bj = 0; bj < 2; ++bj) *(u32x4*)(halo + ((size_t)u.pm * 4 + fr) * NFF2 + pcol + bj * HALF) = pk[0][bj][0]; }
        asm volatile("s_waitcnt lgkmcnt(0)" ::: "memory"); __builtin_amdgcn_s_barrier(); asm volatile("" ::: "memory");
        const int i1 = ((lane & 48) | ((fr + 15) & 15)) * 4, i2 = ((lane & 48) | ((fr + 14) & 15)) * 4;
        const int ca = u.pn * 128 + wc * 32 + 8 * fq;
        const PG8_LAS float* cpl = (const PG8_LAS float*)(lds0 + CPAR) + wc * 32 + 8 * fq;
#define PG8_BLO(w_) __builtin_bit_cast(float, (w_) << 16)
#define PG8_BHI(w_) __builtin_bit_cast(float, (w_) & 0xffff0000u)
#define PG8_W(v_, q_) ((q_) == 0 ? (v_).x : (q_) == 1 ? (v_).y : (q_) == 2 ? (v_).z : (v_).w)
#define PG8_X2(v_, q_) ((f32x2){PG8_BLO(PG8_W(v_, q_)), PG8_BHI(PG8_W(v_, q_))})
#pragma unroll
        for (int ai = 0; ai < 2; ++ai) {
            const bool top = (wr == 0 && ai == 0);
            u32x4 q1[2], q2[2];
            if (top) { q1[0] = (u32x4){0u, 0u, 0u, 0u}; q1[1] = q1[0]; q2[0] = q1[0]; q2[1] = q1[0]; }
            else { const int swr = wr == 1 ? 0 : 1, sai = wr == 1 ? ai : 0;
#pragma unroll
                for (int bj = 0; bj < 2; ++bj) { const u32x4 h14 = *(const PG8_LAS u32x4*)(lds0 + HX + hxi(swr, sai, 0, bj, wc, fq)), h15 = *(const PG8_LAS u32x4*)(lds0 + HX + hxi(swr, sai, 1, bj, wc, fq));
                    q1[bj] = h15; q2[bj] = fr == 0 ? h14 : h15; } }
#pragma unroll
            for (int m = 0; m < 4; ++m) {
                const PG8_LAS float* cpb = cpl; asm volatile("" : "+v"(cpb));
                f32x2 cv[2][4];
#pragma unroll
                for (int bj = 0; bj < 2; ++bj) { const u32x4 cur = pk[ai][bj][m];
                    const u32x4 s1 = bperm4(i1, cur), s2 = bperm4(i2, cur);
                    const u32x4 p1 = fr == 0 ? q1[bj] : s1, p2 = fr < 2 ? q2[bj] : s2;
                    q1[bj] = s1; q2[bj] = s2;
#pragma unroll
                    for (int q = 0; q < 4; ++q) { const f32x2 w0 = *(const PG8_LAS f32x2*)(cpb + bj * 512 + 2 * q), w1 = *(const PG8_LAS f32x2*)(cpb + bj * 512 + 128 + 2 * q), w2 = *(const PG8_LAS f32x2*)(cpb + bj * 512 + 256 + 2 * q), bb = *(const PG8_LAS f32x2*)(cpb + bj * 512 + 384 + 2 * q);
                        cv[bj][q] = bb + w0 * PG8_X2(p2, q) + w1 * PG8_X2(p1, q) + w2 * PG8_X2(cur, q); } }
                float o[8];
#pragma unroll
                for (int q = 0; q < 4; ++q) { const f32x2 gv = cv[1][q]; const f32x2 sg = {__builtin_amdgcn_rcpf(1.f + __expf(-gv.x)), __builtin_amdgcn_rcpf(1.f + __expf(-gv.y))};
                    const f32x2 ov = cv[0][q] * gv * sg; o[2 * q] = ov.x; o[2 * q + 1] = ov.y; }
                u32x4 out; out.x = cvt_pk_bf16(o[0], o[1]); out.y = cvt_pk_bf16(o[2], o[3]); out.z = cvt_pk_bf16(o[4], o[5]); out.w = cvt_pk_bf16(o[6], o[7]);
                const int row = u.pm * BM + ai * HALF + wr * 64 + m * 16 + fr;
                if (!(top && m == 0 && fr < 2)) *(u32x4*)(act + (size_t)row * NFF + ca) = out;
                __builtin_amdgcn_sched_barrier(0); } }
#undef PG8_BLO
#undef PG8_BHI
#undef PG8_W
#undef PG8_X2
    }
};

struct EpiFinal {
    static constexpr bool PERM = true, AFTER_DRAIN = true;
    const bf16_t* xb; int ldc; unsigned long long* ss; unsigned* cnt; const float* g; float* out;
    __device__ __forceinline__ void fused(f32x4 (&acc)[2][2][4][2], const Unit& u, int wr, int wc, int fr, int fq, PG8_LAS unsigned char* lds, int wid, int lane) const {
        const int row0 = u.pm * BM + wr * 64 + fr; const int col0 = u.pn * BM + wc * 32 + 8 * fq;
        unsigned long long keep = 0ull;
#pragma unroll
        for (int ai = 0; ai < 2; ++ai)
#pragma unroll
            for (int m = 0; m < 4; ++m) { const int row = row0 + ai * HALF + m * 16; const size_t off = (size_t)row * ldc + col0; float sq = 0.f;
#pragma unroll
                for (int bj = 0; bj < 2; ++bj) { const u32x4 w = *(const u32x4*)(xb + off + bj * HALF);
                    const f32x4 b0 = {__builtin_bit_cast(float, w.x << 16), __builtin_bit_cast(float, w.x & 0xffff0000u), __builtin_bit_cast(float, w.y << 16), __builtin_bit_cast(float, w.y & 0xffff0000u)};
                    const f32x4 b1 = {__builtin_bit_cast(float, w.z << 16), __builtin_bit_cast(float, w.z & 0xffff0000u), __builtin_bit_cast(float, w.w << 16), __builtin_bit_cast(float, w.w & 0xffff0000u)};
                    const f32x4 o0 = b0 + acc[ai][bj][m][0], o1 = b1 + acc[ai][bj][m][1]; acc[ai][bj][m][0] = o0; acc[ai][bj][m][1] = o1;
                    sq += (o0[0] * o0[0] + o0[1] * o0[1]) + (o0[2] * o0[2] + o0[3] * o0[3]) + (o1[0] * o1[0] + o1[1] * o1[1]) + (o1[2] * o1[2] + o1[3] * o1[3]); }
                sq += __shfl_xor(sq, 16); sq += __shfl_xor(sq, 32);
                if (fq == 0) keep += atomicAdd(ss + row, (unsigned long long)(sq * 16777216.f)); }
        asm volatile("s_waitcnt vmcnt(0)" :: "v"((unsigned)keep), "v"((unsigned)(keep >> 32)) : "memory");
        if (lane == 0) __hip_atomic_fetch_add(cnt + 64 * u.pm, 1u, __ATOMIC_RELAXED, __HIP_MEMORY_SCOPE_AGENT);
        if (wid == 0) { unsigned sp = 0;
            while ((unsigned)__builtin_amdgcn_readfirstlane(__hip_atomic_load(cnt + 64 * u.pm, __ATOMIC_RELAXED, __HIP_MEMORY_SCOPE_AGENT)) < 64u) { __builtin_amdgcn_s_sleep(2); if (++sp > (1u << 22)) break; } }
        asm volatile("s_waitcnt vmcnt(0) lgkmcnt(0)" ::: "memory"); __builtin_amdgcn_s_barrier(); asm volatile("" ::: "memory");
#pragma unroll
        for (int ai = 0; ai < 2; ++ai)
#pragma unroll
            for (int m = 0; m < 4; ++m) { const int row = row0 + ai * HALF + m * 16; const size_t off = (size_t)row * ldc + col0;
                const float rstd = __builtin_amdgcn_rsqf((float)__hip_atomic_load(ss + row, __ATOMIC_RELAXED, __HIP_MEMORY_SCOPE_AGENT) * (1.f / 16777216.f / 2048.f) + 1e-6f);
#pragma unroll
                for (int bj = 0; bj < 2; ++bj) { const f32x4 g0 = *(const f32x4*)(g + col0 + bj * HALF), g1 = *(const f32x4*)(g + col0 + bj * HALF + 4);
                    *(f32x4*)(out + off + bj * HALF) = acc[ai][bj][m][0] * rstd * g0; *(f32x4*)(out + off + bj * HALF + 4) = acc[ai][bj][m][1] * rstd * g1; } }
    }
};

template <class Epi, class Sched, bool ALIGN_EPI = false, bool SP2 = false>
__device__ __forceinline__ void gemm_phase(PG8_LAS unsigned char* lds, const Gemm g, const Sched& S, const Epi& E, const int tid) {
    const int wid = __builtin_amdgcn_readfirstlane(tid >> 6), lane = tid & 63, wr = wid >> 2, wc = wid & 3, fr = lane & 15, fq = lane >> 4;
    const int K = g.K, nt = K / BK;
    unsigned voffA[2], voffB[2];
#pragma unroll
    for (int i = 0; i < 2; ++i) { int R, C; stage_rc(tid * 16 + i * 8192, R, C); const int Rb = Epi::PERM ? ((R & ~31) + perm32(R & 31)) : R;
        voffA[i] = (unsigned)(R * K + C) * 2u; voffB[i] = (unsigned)(Rb * K + C) * 2u; }
    const size_t kstep = (size_t)(BK * 2);
    const size_t hstep = (size_t)HALF * K * 2;
    const size_t tstep = 2 * hstep;
    const unsigned ldsw = (unsigned)wid * 1024u;
    const int aoff = lds_byte(wr * 64 + fr, fq * 8), boff = lds_byte(wc * 32 + fr, fq * 8);
#define PG8_SA(b, h) (((b) * 2 + (h)) * HTB)
#define PG8_SB(b, h) ((4 + (b) * 2 + (h)) * HTB)
#define PG8_STAGE(bufoff, gbase, voff) do { _Pragma("unroll") for (int _i = 0; _i < 2; ++_i) \
        __builtin_amdgcn_global_load_lds((const unsigned*)((const char*)(gbase) + (voff)[_i]), (PG8_LAS unsigned*)(lds + (bufoff) + ldsw + _i * 8192), 16, 0, 0); } while (0)
#define PG8_LDA(dst, b, h) do { _Pragma("unroll") for (int m = 0; m < 4; ++m) _Pragma("unroll") for (int k = 0; k < 2; ++k) dst[m][k] = *(const PG8_LAS bf16x8*)(lds + PG8_SA(b, h) + aoff + m * 2048 + k * 1024); } while (0)
#define PG8_LDB(dst, b, h) do { _Pragma("unroll") for (int n = 0; n < 2; ++n) _Pragma("unroll") for (int k = 0; k < 2; ++k) dst[n][k] = *(const PG8_LAS bf16x8*)(lds + PG8_SB(b, h) + boff + n * 2048 + k * 1024); } while (0)
#define PG8_MMA(ai, bj, At, Bt) do { __builtin_amdgcn_s_setprio(1); _Pragma("unroll") for (int m = 0; m < 4; ++m) _Pragma("unroll") for (int n = 0; n < 2; ++n) _Pragma("unroll") for (int k = 0; k < 2; ++k) \
        acc[ai][bj][m][n] = __builtin_amdgcn_mfma_f32_16x16x32_bf16(Bt[n][k], At[m][k], acc[ai][bj][m][n], 0, 0, 0); __builtin_amdgcn_s_setprio(0); } while (0)
#define PG8_WAIT_V(n) asm volatile("s_waitcnt vmcnt(" #n ")" ::: "memory")
#define PG8_WAIT_L(n) asm volatile("s_waitcnt lgkmcnt(" #n ")" ::: "memory")
#define PG8_BAR __builtin_amdgcn_s_barrier()
#define PG8_SCHED __builtin_amdgcn_sched_barrier(0)
    Unit cur, nxt; int ui = 0;
    if (!S.next(0, cur)) return;
    f32x4 acc[2][2][4][2];
#pragma unroll
    for (int a = 0; a < 2; ++a)
#pragma unroll
        for (int b = 0; b < 2; ++b)
#pragma unroll
            for (int m = 0; m < 4; ++m)
#pragma unroll
                for (int n = 0; n < 2; ++n) acc[a][b][m][n] = (f32x4){0.f, 0.f, 0.f, 0.f};
    bf16x8 At[4][2], B0[2][2], B1[2][2];
    const char* cA = (const char*)g.A + (size_t)cur.pm * tstep; const char* cB = (const char*)g.Bt + (size_t)cur.pn * tstep;
    S.a_ready(cur);
    if constexpr (SP2) {
        PG8_STAGE(PG8_SB(0, 0), cB, voffB); PG8_STAGE(PG8_SB(0, 1), cB + hstep, voffB); PG8_STAGE(PG8_SA(0, 0), cA, voffA); PG8_STAGE(PG8_SA(0, 1), cA + hstep, voffA);
        if (wr == 1) PG8_BAR;
        PG8_WAIT_V(2); PG8_BAR;
        PG8_STAGE(PG8_SB(1, 0), cB + kstep, voffB); PG8_STAGE(PG8_SA(1, 0), cA + kstep, voffA); PG8_STAGE(PG8_SB(1, 1), cB + hstep + kstep, voffB);
        PG8_WAIT_V(6); PG8_BAR;
    } else {
        PG8_STAGE(PG8_SB(0, 0), cB, voffB); PG8_STAGE(PG8_SA(0, 0), cA, voffA); PG8_STAGE(PG8_SB(0, 1), cB + hstep, voffB); PG8_STAGE(PG8_SA(0, 1), cA + hstep, voffA);
        if (wr == 1) PG8_BAR;
        PG8_WAIT_V(4); PG8_BAR;
        PG8_STAGE(PG8_SB(1, 0), cB + kstep, voffB); PG8_STAGE(PG8_SA(1, 0), cA + kstep, voffA); PG8_STAGE(PG8_SB(1, 1), cB + hstep + kstep, voffB);
        PG8_WAIT_V(6); PG8_BAR;
    }
    for (;;) {
        const bool has_next = S.next(ui + 1, nxt);
        const char* nA = has_next ? (const char*)g.A + (size_t)nxt.pm * tstep : cA; const char* nB = has_next ? (const char*)g.Bt + (size_t)nxt.pn * tstep : cB;
        for (int t = 0; t < nt; t += 2) {
            const bool last = (t == nt - 2);
            const char* a1 = cA + (size_t)(t + 1) * kstep;
            const char* a2 = last ? nA : cA + (size_t)(t + 2) * kstep; const char* b2 = last ? nB : cB + (size_t)(t + 2) * kstep;
            const char* a3 = a2 + kstep; const char* b3 = b2 + kstep;
            if (last && has_next) S.a_ready(nxt);
            if constexpr (SP2) {
            PG8_LDB(B0, 0, 0); PG8_LDB(B1, 0, 1); PG8_SCHED; PG8_LDA(At, 0, 0); PG8_STAGE(PG8_SA(1, 1), a1 + hstep, voffA);
            PG8_WAIT_V(8); PG8_WAIT_L(0); PG8_BAR; PG8_MMA(0, 0, At, B0); PG8_MMA(0, 1, At, B1); PG8_BAR; PG8_SCHED;
            PG8_LDA(At, 0, 1); PG8_STAGE(PG8_SB(0, 0), b2, voffB); PG8_STAGE(PG8_SB(0, 1), b2 + hstep, voffB); PG8_STAGE(PG8_SA(0, 0), a2, voffA);
            PG8_WAIT_V(8); PG8_WAIT_L(0); PG8_BAR; PG8_MMA(1, 0, At, B0); PG8_MMA(1, 1, At, B1); PG8_BAR; PG8_SCHED;
            PG8_LDB(B0, 1, 0); PG8_LDB(B1, 1, 1); PG8_SCHED; PG8_LDA(At, 1, 0); PG8_STAGE(PG8_SA(0, 1), a2 + hstep, voffA);
            PG8_WAIT_V(8); PG8_WAIT_L(0); PG8_BAR; PG8_MMA(0, 0, At, B0); PG8_MMA(0, 1, At, B1); PG8_BAR; PG8_SCHED;
            PG8_LDA(At, 1, 1); PG8_STAGE(PG8_SB(1, 0), b3, voffB); PG8_STAGE(PG8_SB(1, 1), b3 + hstep, voffB); PG8_STAGE(PG8_SA(1, 0), a3, voffA);
            PG8_WAIT_V(8); PG8_WAIT_L(0); PG8_BAR; PG8_MMA(1, 0, At, B0); PG8_MMA(1, 1, At, B1); PG8_BAR; PG8_SCHED;
            } else {
            PG8_LDB(B0, 0, 0); PG8_SCHED; PG8_LDA(At, 0, 0); PG8_STAGE(PG8_SA(1, 1), a1 + hstep, voffA);
            PG8_WAIT_L(8); PG8_BAR; PG8_WAIT_L(0); PG8_MMA(0, 0, At, B0); PG8_BAR; PG8_SCHED;
            PG8_LDB(B1, 0, 1); PG8_STAGE(PG8_SB(0, 0), b2, voffB);
            PG8_BAR; PG8_WAIT_L(0); PG8_MMA(0, 1, At, B1); PG8_BAR;
            PG8_LDA(At, 0, 1); PG8_STAGE(PG8_SA(0, 0), a2, voffA);
            PG8_BAR; PG8_WAIT_L(0); PG8_MMA(1, 0, At, B0); PG8_BAR; PG8_SCHED;
            PG8_STAGE(PG8_SB(0, 1), b2 + hstep, voffB);
            PG8_WAIT_V(6); PG8_BAR; PG8_MMA(1, 1, At, B1); PG8_BAR;
            PG8_LDB(B0, 1, 0); PG8_SCHED; PG8_LDA(At, 1, 0); PG8_STAGE(PG8_SA(0, 1), a2 + hstep, voffA);
            PG8_WAIT_L(8); PG8_BAR; PG8_WAIT_L(0); PG8_MMA(0, 0, At, B0); PG8_BAR; PG8_SCHED;
            PG8_LDB(B1, 1, 1); PG8_STAGE(PG8_SB(1, 0), b3, voffB);
            PG8_BAR; PG8_WAIT_L(0); PG8_MMA(0, 1, At, B1); PG8_BAR;
            PG8_LDA(At, 1, 1); PG8_STAGE(PG8_SA(1, 0), a3, voffA);
            PG8_BAR; PG8_WAIT_L(0); PG8_MMA(1, 0, At, B0); PG8_BAR; PG8_SCHED;
            PG8_STAGE(PG8_SB(1, 1), b3 + hstep, voffB);
            PG8_WAIT_V(6); PG8_BAR; PG8_MMA(1, 1, At, B1); PG8_BAR;
            }
        }
        if constexpr (ALIGN_EPI) { if (wr == 0) PG8_BAR; }
        if constexpr (!Epi::AFTER_DRAIN) { E(acc, cur, wr, wc, fr, fq); S.done(cur); }
        if (!has_next) break;
#pragma unroll
        for (int a = 0; a < 2; ++a)
#pragma unroll
            for (int b = 0; b < 2; ++b)
#pragma unroll
                for (int m = 0; m < 4; ++m)
#pragma unroll
                    for (int n = 0; n < 2; ++n) acc[a][b][m][n] = (f32x4){0.f, 0.f, 0.f, 0.f};
        cur = nxt; cA = nA; cB = nB; ++ui;
        if constexpr (ALIGN_EPI) { if (wr == 1) PG8_BAR; }
    }
    PG8_WAIT_V(0);
    if constexpr (!ALIGN_EPI) { if (wr == 0) PG8_BAR; }
    PG8_BAR;
    if constexpr (Epi::AFTER_DRAIN) { E.fused(acc, cur, wr, wc, fr, fq, lds, wid, lane); }
#undef PG8_SA
#undef PG8_SB
#undef PG8_STAGE
#undef PG8_LDA
#undef PG8_LDB
#undef PG8_MMA
#undef PG8_WAIT_V
#undef PG8_WAIT_L
#undef PG8_BAR
#undef PG8_SCHED
}
}

constexpr int DM = 2048, BATCH = 2, SEQ = 4096, MTOK = BATCH * SEQ;
constexpr int AB_IN = 6144, CD_IN = 5120, DFF = 5632, DFF2 = 11264;
constexpr float EPS = 1e-6f;
constexpr int NWAVES = 8;

#define GAS __attribute__((address_space(1)))
#define LAS __attribute__((address_space(3)))
typedef unsigned short bf16;
typedef unsigned v4u __attribute__((ext_vector_type(4)));
typedef unsigned v2u __attribute__((ext_vector_type(2)));
typedef float f32x4 __attribute__((ext_vector_type(4)));
typedef float f32x16 __attribute__((ext_vector_type(16)));
typedef short bf16x8 __attribute__((ext_vector_type(8)));
typedef short s16x4 __attribute__((ext_vector_type(4)));
typedef GAS unsigned gu32;
#define RLX_AGENT __ATOMIC_RELAXED, __HIP_MEMORY_SCOPE_AGENT
#define LDS_WAIT() asm volatile("s_waitcnt lgkmcnt(0)" ::: "memory")
#define VM_WAIT() asm volatile("s_waitcnt vmcnt(0)" ::: "memory")
__device__ __forceinline__ unsigned f2bf(float f) { unsigned u = __builtin_bit_cast(unsigned, f); return (u + 0x7fffu + ((u >> 16) & 1u)) >> 16; }
__device__ __forceinline__ unsigned pk2(float lo, float hi) { return f2bf(lo) | (f2bf(hi) << 16); }
__device__ __forceinline__ float bf2f(unsigned u16) { return __builtin_bit_cast(float, u16 << 16); }
__device__ __forceinline__ float bflo(unsigned w) { return __builtin_bit_cast(float, w << 16); }
__device__ __forceinline__ float bfhi(unsigned w) { return __builtin_bit_cast(float, w & 0xffff0000u); }
__device__ __forceinline__ float wave_sum(float v) {
#pragma unroll
    for (int o = 1; o < 64; o <<= 1) v += __shfl_xor(v, o);
    return v;
}
__device__ __forceinline__ float gelu_tanh(float x) {
    const float u = 0.7978845608028654f * (x + 0.044715f * x * x * x);
    const float t = 1.f - 2.f / (__expf(2.f * u) + 1.f);
    return 0.5f * x * (1.f + t);
}
__device__ __forceinline__ float silu_f(float x) { return x / (1.f + __expf(-x)); }

constexpr size_t MiB = 1u << 20;
constexpr size_t WS_CTL = 0, CTL_ZERO_BYTES = 1 * MiB;
constexpr size_t WS_SS = 128 * 1024;
constexpr size_t WS_LNS = 512 * 1024;
constexpr size_t WS_CNT = 768 * 1024;
constexpr size_t WS_SCAL = 1 * MiB;
constexpr size_t WS_ROPE = 2 * MiB;
constexpr size_t WS_W_ABIN = 4 * MiB;
constexpr size_t WS_W_ABOUT = WS_W_ABIN + 24 * MiB;
constexpr size_t WS_W_CDIN = WS_W_ABOUT + 8 * MiB;
constexpr size_t WS_W_CDOUT = WS_W_CDIN + 20 * MiB;
constexpr size_t WS_W_UP0 = WS_W_CDOUT + 8 * MiB;
constexpr size_t WS_W_UP1 = WS_W_UP0 + 44 * MiB;
constexpr size_t WS_W_DN0 = WS_W_UP1 + 44 * MiB;
constexpr size_t WS_W_DN1 = WS_W_DN0 + 22 * MiB;
constexpr size_t WS_XN = WS_W_DN1 + 22 * MiB;
constexpr size_t WS_O = WS_XN + 32 * MiB;
constexpr size_t WS_X = WS_O + 32 * MiB;
constexpr size_t WS_ACT = WS_X + 64 * MiB;
constexpr size_t WS_R1 = WS_ACT + 88 * MiB;
constexpr size_t WS_P = WS_R1;
constexpr size_t WS_OB = WS_R1 + 96 * MiB;
constexpr size_t WS_KV = WS_R1 + 96 * MiB;
constexpr size_t WS_PREV = WS_KV + 64 * MiB;
constexpr size_t WS_UP = WS_R1;
constexpr size_t WS_HALO = WS_R1 + 192 * MiB;
constexpr size_t WS_SCR = WS_HALO + 4 * MiB;
constexpr size_t WS_END = WS_SCR + 32 * MiB;

constexpr int RING_BYTES = 131072;
constexpr int LDSCTL_OFF = RING_BYTES, MISC_OFF = LDSCTL_OFF + 320;
constexpr int LDS_BYTES = 147456;

#define XB_TMO      128
#define XB_XCNT(j)  (256  + 64 * (j))
#define XB_XSUB(j)  (1280 + 64 * (j))
#define XB_XGEN(j)  (2304 + 64 * (j))
#define XB_TOP      3328
#define XB_TOPGEN   3392
#define XCD_BAR_WORDS 3456
#define XB_SPIN_CAP (1u << 20)
__device__ __forceinline__ unsigned xb_ld(unsigned* p)              { return __hip_atomic_load(p, __ATOMIC_RELAXED, __HIP_MEMORY_SCOPE_AGENT); }
__device__ __forceinline__ unsigned xb_add(unsigned* p, unsigned v) { return __hip_atomic_fetch_add(p, v, __ATOMIC_RELAXED, __HIP_MEMORY_SCOPE_AGENT); }
__device__ __forceinline__ unsigned xb_xcc_id() { return (unsigned)__builtin_amdgcn_s_getreg((3 << 11) | 20) & 0xFu; }
#define XB_SPIN(cond, bar) do { unsigned _sp = 0; while (cond) { __builtin_amdgcn_s_sleep(1); \
    if ((++_sp & 255u) == 0u) { if (xb_ld(&(bar)[XB_TMO])) break; if (_sp > XB_SPIN_CAP) { atomicAdd(&(bar)[XB_TMO], 1u); break; } } } } while (0)
struct XcdBarrier { unsigned* bar; unsigned x; volatile LAS unsigned* st; };
__device__ __forceinline__ XcdBarrier xcd_barrier_post(unsigned* bar, volatile LAS unsigned* st) {
    XcdBarrier b; b.bar = bar; b.x = xb_xcc_id(); b.st = st;
    if (threadIdx.x == 0) (void)xb_add(&bar[XB_XCNT(b.x)], 1u);
    return b;
}
__device__ __forceinline__ void xcd_barrier_complete(unsigned* bar, unsigned x, unsigned& nloc, unsigned& nx) {
    const unsigned G = gridDim.x * gridDim.y * gridDim.z;
    unsigned sum, cnt, mine, sp = 0u;
    for (;;) {
        sum = 0u; cnt = 0u; mine = 0u;
#pragma unroll
        for (unsigned j = 0; j < 16; ++j) { const unsigned c = xb_ld(&bar[XB_XCNT(j)]); sum += c; cnt += (c > 0u) ? 1u : 0u; mine = (j == x) ? c : mine; }
        if (sum == G) break;
        __builtin_amdgcn_s_sleep(1);
        if ((++sp & 255u) == 0u) { if (xb_ld(&bar[XB_TMO])) break; if (sp > XB_SPIN_CAP) { atomicAdd(&bar[XB_TMO], 1u); break; } }
    }
    nloc = mine > 0u ? mine : 1u; nx = cnt > 0u ? cnt : 1u;
}
__device__ __forceinline__ void xcd_barrier(const XcdBarrier& b) {
    asm volatile("s_waitcnt vmcnt(0)" ::: "memory");
    __syncthreads();
    if (threadIdx.x == 0) {
        unsigned* bar = b.bar;
        __builtin_amdgcn_s_waitcnt(0);
        unsigned nloc = b.st[0], nx = b.st[1];
        if (nloc == 0u) { xcd_barrier_complete(bar, b.x, nloc, nx); b.st[0] = nloc; b.st[1] = nx; }
        const unsigned old = xb_add(&bar[XB_XSUB(b.x)], 1u);
        const unsigned gen = old / nloc;
        if (old + 1u == (gen + 1u) * nloc) {
            __builtin_amdgcn_fence(__ATOMIC_RELEASE, "agent");
            asm volatile("s_waitcnt vmcnt(0)" ::: "memory");
            const unsigned og = xb_add(&bar[XB_TOP], 1u);
            const unsigned tg = og / nx;
            if (og + 1u == (tg + 1u) * nx) xb_add(&bar[XB_TOPGEN], 1u);
            else XB_SPIN(xb_ld(&bar[XB_TOPGEN]) == tg, bar);
            __builtin_amdgcn_fence(__ATOMIC_ACQUIRE, "agent");
            xb_add(&bar[XB_XGEN(b.x)], 1u);
            asm volatile("s_waitcnt vmcnt(0)" ::: "memory");
        } else {
            XB_SPIN(xb_ld(&bar[XB_XGEN(b.x)]) == gen, bar);
            __builtin_amdgcn_fence(__ATOMIC_ACQUIRE, "agent");
            asm volatile("s_waitcnt vmcnt(0)" ::: "memory");
        }
    }
    __syncthreads();
}

#ifndef ATT_SDEPTH
#define ATT_SDEPTH 1
#endif
namespace att {
constexpr int D = 128, QBLK = 32, KVBLK = 64;
constexpr float SCALE = 0.088388347648318440f;
constexpr float THR = 8.f;
constexpr int SHM_V = KVBLK * D * 2, SHM_K = KVBLK * D * 2;
constexpr int OFF_WS = 2 * SHM_V + 2 * SHM_K;
constexpr int OFF_TB = OFF_WS + 8 * 64 * 4;
constexpr int OFF_FLG = OFF_TB + 448 * 4;
#define KSWZ(row, colB) ((row) * 256 + ((colB) ^ (((row) & 7) << 4)))
#define SBAR() __builtin_amdgcn_sched_barrier(0)
__device__ __forceinline__ int crow(int r, int hi) { return (r & 3) + 8 * (r >> 2) + 4 * hi; }
__device__ __forceinline__ unsigned cvtpk(float lo, float hi) { unsigned r; asm volatile("v_cvt_pk_bf16_f32 %0, %1, %2" : "=v"(r) : "v"(lo), "v"(hi)); return r; }

__device__ __forceinline__ void partialSM(f32x16& p0, f32x16& p1, float& m_reg, float& mn, float& alpha) {
  constexpr float C = SCALE * 1.4426950408889634f;
  float pmax = p0[0];
#pragma unroll
  for (int r = 1; r < 16; ++r) pmax = fmaxf(pmax, p0[r]);
#pragma unroll
  for (int r = 0; r < 16; ++r) pmax = fmaxf(pmax, p1[r]);
  { auto rr = __builtin_amdgcn_permlane32_swap(__float_as_uint(pmax), __float_as_uint(pmax), false, false);
    pmax = fmaxf(__uint_as_float(rr[0]), __uint_as_float(rr[1])); }
  if (__builtin_expect(__all(pmax - m_reg <= THR / SCALE), 1)) { mn = m_reg; alpha = 1.f; }
  else { mn = fmaxf(m_reg, pmax); alpha = __builtin_amdgcn_exp2f((m_reg - mn) * C); m_reg = mn; }
  float mnC = -mn * C;
#pragma unroll
  for (int r = 0; r < 16; ++r) p0[r] = fmaf(p0[r], C, mnC);
#pragma unroll
  for (int r = 0; r < 16; ++r) p1[r] = fmaf(p1[r], C, mnC);
#pragma unroll
  for (int r = 0; r < 16; ++r) p0[r] = __builtin_amdgcn_exp2f(p0[r]);
}
#define PK4(P, BASE, OUT) do { unsigned a0 = cvtpk(P[BASE + 0], P[BASE + 1]), a1 = cvtpk(P[BASE + 2], P[BASE + 3]);   \
    unsigned b0 = cvtpk(P[BASE + 4], P[BASE + 5]), b1 = cvtpk(P[BASE + 6], P[BASE + 7]);                              \
    auto r0 = __builtin_amdgcn_permlane32_swap(a0, b0, false, false); auto r1 = __builtin_amdgcn_permlane32_swap(a1, b1, false, false); \
    v4u w = {r0[0], r1[0], r0[1], r1[1]}; OUT = *reinterpret_cast<bf16x8*>(&w); } while (0)
__device__ __forceinline__ void finishSM(f32x16& p0, f32x16& p1, float alpha, float& l_reg, bf16x8& pa0, bf16x8& pa1, bf16x8& pa2, bf16x8& pa3) {
#pragma unroll
  for (int r = 0; r < 16; ++r) p1[r] = __builtin_amdgcn_exp2f(p1[r]);
  float ps = 0;
#pragma unroll
  for (int r = 0; r < 16; ++r) ps += p0[r];
#pragma unroll
  for (int r = 0; r < 16; ++r) ps += p1[r];
  { auto rr = __builtin_amdgcn_permlane32_swap(__float_as_uint(ps), __float_as_uint(ps), false, false);
    ps = __uint_as_float(rr[0]) + __uint_as_float(rr[1]); }
  l_reg = l_reg * alpha + ps;
  PK4(p0, 0, pa0); PK4(p0, 8, pa1); PK4(p1, 0, pa2); PK4(p1, 8, pa3);
}
__device__ __forceinline__ void packP(const f32x16& p0, const f32x16& p1, bf16x8& pa0, bf16x8& pa1, bf16x8& pa2, bf16x8& pa3) {
  PK4(p0, 0, pa0); PK4(p0, 8, pa1); PK4(p1, 0, pa2); PK4(p1, 8, pa3);
}
__device__ __forceinline__ void qkt(f32x16& p0, f32x16& p1, const char* Ks, const bf16x8* qr, int r32, int hi) {
  p0 = f32x16{}; p1 = f32x16{};
#pragma unroll
  for (int d0 = 0; d0 < 8; ++d0) { int cb = (d0 * 16 + hi * 8) * 2;
    bf16x8 b0 = *reinterpret_cast<const bf16x8*>(Ks + KSWZ(r32, cb));
    bf16x8 b1 = *reinterpret_cast<const bf16x8*>(Ks + KSWZ(32 + r32, cb));
    p0 = __builtin_amdgcn_mfma_f32_32x32x16_bf16(b0, qr[d0], p0, 0, 0, 0);
    p1 = __builtin_amdgcn_mfma_f32_32x32x16_bf16(b1, qr[d0], p1, 0, 0, 0); }
}
__device__ __forceinline__ int v_st(int k, int c) { const int kk = (k & ~0xC) | ((k & 4) << 1) | ((k & 8) >> 1); return ((kk >> 3) * 4 + (c >> 5)) * 512 + ((kk & 7) * 32 + (c & 31)) * 2; }
__device__ __forceinline__ int v_rd_base(int lane) { return ((lane & 3) << 3) | (((lane >> 2) & 3) << 6) | (((lane >> 4) & 1) << 5) | (((lane >> 5) & 1) << 8); }
constexpr int v_rd_off(int d0, int ks, int half) { return d0 * 512 + ks * 4096 + half * 2048; }
template <int OFF> __device__ __forceinline__ s16x4 tr_read(int vb) {
  s16x4 r; asm volatile("ds_read_b64_tr_b16 %0, %1 offset:%2" : "=&v"(r) : "v"(vb), "i"(OFF) : "memory"); return r;
}
template <int D0> __device__ __forceinline__ void pv_one(f32x16& od, int vb, bf16x8 pa0, bf16x8 pa1, bf16x8 pa2, bf16x8 pa3) {
  const s16x4 l0 = tr_read<v_rd_off(D0, 0, 0)>(vb), h0 = tr_read<v_rd_off(D0, 0, 1)>(vb), l1 = tr_read<v_rd_off(D0, 1, 0)>(vb), h1 = tr_read<v_rd_off(D0, 1, 1)>(vb);
  const s16x4 l2 = tr_read<v_rd_off(D0, 2, 0)>(vb), h2 = tr_read<v_rd_off(D0, 2, 1)>(vb), l3 = tr_read<v_rd_off(D0, 3, 0)>(vb), h3 = tr_read<v_rd_off(D0, 3, 1)>(vb);
  asm volatile("s_waitcnt lgkmcnt(0)" ::: "memory"); SBAR();
#define PKV(L, H) (bf16x8){L[0], L[1], L[2], L[3], H[0], H[1], H[2], H[3]}
  od = __builtin_amdgcn_mfma_f32_32x32x16_bf16(pa0, PKV(l0, h0), od, 0, 0, 0);
  od = __builtin_amdgcn_mfma_f32_32x32x16_bf16(pa1, PKV(l1, h1), od, 0, 0, 0);
  od = __builtin_amdgcn_mfma_f32_32x32x16_bf16(pa2, PKV(l2, h2), od, 0, 0, 0);
  od = __builtin_amdgcn_mfma_f32_32x32x16_bf16(pa3, PKV(l3, h3), od, 0, 0, 0);
#undef PKV
}
__device__ __forceinline__ void pv_d0(f32x16* o, int vb, bf16x8 pa0, bf16x8 pa1, bf16x8 pa2, bf16x8 pa3) {
  pv_one<0>(o[0], vb, pa0, pa1, pa2, pa3); pv_one<1>(o[1], vb, pa0, pa1, pa2, pa3); pv_one<2>(o[2], vb, pa0, pa1, pa2, pa3); pv_one<3>(o[3], vb, pa0, pa1, pa2, pa3);
}

__device__ __forceinline__ void* uniform_ptr(const void* p) { const unsigned long long v = (unsigned long long)p;
  const unsigned lo = (unsigned)__builtin_amdgcn_readfirstlane((int)(unsigned)v), hi = (unsigned)__builtin_amdgcn_readfirstlane((int)(unsigned)(v >> 32)); return (void*)(((unsigned long long)hi << 32) | lo); }
__device__ __forceinline__ bf16x8 mk8a(s16x4 l, s16x4 h) { return (bf16x8){l[0], l[1], l[2], l[3], h[0], h[1], h[2], h[3]}; }
__device__ __forceinline__ bf16x8 bload16(__amdgpu_buffer_rsrc_t rs, int voff, int soff) {
  const v4u w = __builtin_amdgcn_raw_buffer_load_b128(rs, voff, soff, 0); return __builtin_bit_cast(bf16x8, w); }
template <int LDP, int LDO>
__device__ __forceinline__ void attnB_unit(const bf16* __restrict__ Qb, const bf16* Pbase, int koff, int voff, float* __restrict__ Ob, int qb, char* lds) {
  const __amdgpu_buffer_rsrc_t rs = __builtin_amdgcn_make_buffer_rsrc(uniform_ptr(Pbase), 0, SEQ * LDP * 2, 0x00020000);
  int tid = threadIdx.x; asm volatile("" : "+v"(tid));
  const int wid = tid >> 6, lane = tid & 63, r32 = lane & 31, hi = lane >> 5;
  char* V_lds = lds; char* K_lds = lds + 2 * SHM_V;
  float* ws = (float*)(lds + OFF_WS) + wid * 64; float* li_l = ws; float* al_l = ws + 32;
  const float* tb = (const float*)(lds + OFF_TB);
  float m_reg = -1e30f, l_reg = 0; f32x16 o[4] = {}; bf16x8 qr[8];
  const bf16* Qw = Qb + (long)(wid * QBLK + r32) * LDP + hi * 8;
#pragma unroll
  for (int d0 = 0; d0 < 8; ++d0) qr[d0] = *reinterpret_cast<const bf16x8*>(Qw + d0 * 16);
  const int sr = tid >> 4, sc = (tid & 15) * 8, vst0 = v_st(sr, sc), vst1 = v_st(32 + sr, sc);
  const int vb0 = (int)(uintptr_t)V_lds + v_rd_base(lane);
  constexpr int SDEPTH = ATT_SDEPTH;
  struct { bf16x8 vs0, vs1, ks0, ks1; } sr_[SDEPTH];
  const int vo0 = (sr * LDP + sc) * 2, vo1 = vo0 + 32 * LDP * 2;
#define SLOAD(i, k0) do { const int sV_ = (voff + (k0) * LDP) * 2, sK_ = (koff + (k0) * LDP) * 2; \
    sr_[i].vs0 = bload16(rs, vo0, sV_); sr_[i].vs1 = bload16(rs, vo1, sV_); sr_[i].ks0 = bload16(rs, vo0, sK_); sr_[i].ks1 = bload16(rs, vo1, sK_); } while (0)
#define SWRITE(b, i) do { *(bf16x8*)(V_lds + (b) * SHM_V + vst0) = sr_[i].vs0;          \
    *(bf16x8*)(V_lds + (b) * SHM_V + vst1) = sr_[i].vs1; int kc = sc * 2;               \
    *(bf16x8*)(K_lds + (b) * SHM_K + KSWZ(sr, kc)) = sr_[i].ks0;                       \
    *(bf16x8*)(K_lds + (b) * SHM_K + KSWZ(32 + sr, kc)) = sr_[i].ks1; } while (0)
#define SWAIT() do { if constexpr (SDEPTH == 2) asm volatile("s_waitcnt vmcnt(4)" ::: "memory"); else asm volatile("s_waitcnt vmcnt(0)" ::: "memory"); } while (0)
#define RESC(a) do { if (__any((a) < 1.f)) { if (hi == 0) al_l[r32] = (a); asm volatile("s_waitcnt lgkmcnt(0)" ::: "memory"); \
    _Pragma("unroll") for (int d = 0; d < 4; ++d) _Pragma("unroll") for (int r = 0; r < 16; ++r) o[d][r] *= al_l[crow(r, hi)]; } } while (0)
  const int NT = 4 * qb + 4, chunk_w = 4 * qb + (wid >> 1);
  const int ib0 = 4 * hi - 256 * qb - 32 * wid - r32 + 127 + 256;
#ifdef NO_FIX
#define FIX(P0, P1, j) do {} while (0)
#else
#define FIX(P0, P1, j) do { if ((j) > chunk_w) { _Pragma("unroll") for (int r = 0; r < 16; ++r) { P0[r] = -1e30f; P1[r] = -1e30f; } } \
    else if ((j) >= NT - 6) { const float* tbj = tb + (ib0 + 64 * (j)); \
      _Pragma("unroll") for (int r = 0; r < 16; ++r) { P0[r] += tbj[(r & 3) + 8 * (r >> 2)]; P1[r] += tbj[32 + (r & 3) + 8 * (r >> 2)]; } } } while (0)
#endif
  f32x16 pA0, pA1, pB0, pB1; float mnA, mnB, alA, alB; bf16x8 pa0, pa1, pa2, pa3;
  constexpr int SE = 0, SO = SDEPTH - 1;
  SLOAD(SE, 0); asm volatile("s_waitcnt vmcnt(0)" ::: "memory"); SWRITE(0, SE); __syncthreads();
  qkt(pA0, pA1, K_lds, qr, r32, hi); FIX(pA0, pA1, 0); partialSM(pA0, pA1, m_reg, mnA, alA);
  SLOAD(SO, KVBLK); if constexpr (SDEPTH == 2) { if (2 < NT) SLOAD(SE, 2 * KVBLK); }
  SWAIT(); SWRITE(1, SO); __syncthreads();
  for (int j = 1; j + 1 < NT; j += 2) {
    SBAR(); qkt(pB0, pB1, K_lds + SHM_K, qr, r32, hi);
    finishSM(pA0, pA1, alA, l_reg, pa0, pa1, pa2, pa3); SBAR();
    SLOAD(SO, (j + SDEPTH) * KVBLK); SBAR();
    pv_d0(o, vb0, pa0, pa1, pa2, pa3); FIX(pB0, pB1, j); partialSM(pB0, pB1, m_reg, mnB, alB);
    __syncthreads(); SWAIT(); SWRITE(0, SE);
    RESC(alB); __syncthreads();
    SBAR(); qkt(pA0, pA1, K_lds, qr, r32, hi);
    finishSM(pB0, pB1, alB, l_reg, pa0, pa1, pa2, pa3); SBAR();
    if (SDEPTH == 1 || j + 3 < NT) SLOAD(SE, (j + 1 + SDEPTH) * KVBLK); SBAR();
    pv_d0(o, vb0 + SHM_V, pa0, pa1, pa2, pa3); FIX(pA0, pA1, j + 1); partialSM(pA0, pA1, m_reg, mnA, alA);
    __syncthreads(); SWAIT(); SWRITE(1, SO);
    RESC(alA); __syncthreads();
  }
  SBAR(); qkt(pB0, pB1, K_lds + SHM_K, qr, r32, hi);
  finishSM(pA0, pA1, alA, l_reg, pa0, pa1, pa2, pa3); SBAR();
  pv_d0(o, vb0, pa0, pa1, pa2, pa3); FIX(pB0, pB1, NT - 1); partialSM(pB0, pB1, m_reg, mnB, alB);
  __syncthreads(); RESC(alB);
  finishSM(pB0, pB1, alB, l_reg, pa0, pa1, pa2, pa3); SBAR();
  pv_d0(o, vb0 + SHM_V, pa0, pa1, pa2, pa3);
  if (hi == 0) li_l[r32] = l_reg; asm volatile("s_waitcnt lgkmcnt(0)" ::: "memory");
  float rli[16];
#pragma unroll
  for (int r = 0; r < 16; ++r) rli[r] = __builtin_amdgcn_rcpf(li_l[crow(r, hi)]);
  float* Ow = Ob + (long)(wid * QBLK) * LDO;
#pragma unroll
  for (int r = 0; r < 16; ++r) { int orow = crow(r, hi);
#pragma unroll
    for (int d0 = 0; d0 < 4; ++d0) Ow[(long)orow * LDO + d0 * 32 + r32] = o[d0][r] * rli[r]; }
  __syncthreads();
#undef SLOAD
#undef SWRITE
#undef SWAIT
#undef RESC
#undef FIX
}

#define PV8_RD(S, VB, D0) do { S##l0 = tr_read<v_rd_off(D0, 0, 0)>(VB); S##h0 = tr_read<v_rd_off(D0, 0, 1)>(VB); S##l1 = tr_read<v_rd_off(D0, 1, 0)>(VB); S##h1 = tr_read<v_rd_off(D0, 1, 1)>(VB); \
    S##l2 = tr_read<v_rd_off(D0, 2, 0)>(VB); S##h2 = tr_read<v_rd_off(D0, 2, 1)>(VB); S##l3 = tr_read<v_rd_off(D0, 3, 0)>(VB); S##h3 = tr_read<v_rd_off(D0, 3, 1)>(VB); } while (0)
#define PV8_MF(S, OD) do { OD = __builtin_amdgcn_mfma_f32_32x32x16_bf16(pa0, mk8a(S##l0, S##h0), OD, 0, 0, 0); OD = __builtin_amdgcn_mfma_f32_32x32x16_bf16(pa1, mk8a(S##l1, S##h1), OD, 0, 0, 0); \
    OD = __builtin_amdgcn_mfma_f32_32x32x16_bf16(pa2, mk8a(S##l2, S##h2), OD, 0, 0, 0); OD = __builtin_amdgcn_mfma_f32_32x32x16_bf16(pa3, mk8a(S##l3, S##h3), OD, 0, 0, 0); } while (0)
#define PV8_W8() do { asm volatile("s_waitcnt lgkmcnt(8)" ::: "memory"); SBAR(); } while (0)
__device__ __forceinline__ void pv8(f32x16* o, int vbA, int vbB, bf16x8 pa0, bf16x8 pa1, bf16x8 pa2, bf16x8 pa3) {
  s16x4 Al0, Ah0, Al1, Ah1, Al2, Ah2, Al3, Ah3, Bl0, Bh0, Bl1, Bh1, Bl2, Bh2, Bl3, Bh3;
  SBAR();
  PV8_RD(A, vbA, 0);
  PV8_RD(B, vbA, 1); PV8_W8(); PV8_MF(A, o[0]);
  PV8_RD(A, vbA, 2); PV8_W8(); PV8_MF(B, o[1]);
  PV8_RD(B, vbA, 3); PV8_W8(); PV8_MF(A, o[2]);
  PV8_RD(A, vbB, 0); PV8_W8(); PV8_MF(B, o[3]);
  PV8_RD(B, vbB, 1); PV8_W8(); PV8_MF(A, o[4]);
  PV8_RD(A, vbB, 2); PV8_W8(); PV8_MF(B, o[5]);
  PV8_RD(B, vbB, 3); PV8_W8(); PV8_MF(A, o[6]);
  asm volatile("s_waitcnt lgkmcnt(0)" ::: "memory"); SBAR(); PV8_MF(B, o[7]);
}
#undef PV8_RD
#undef PV8_MF
#undef PV8_W8
__device__ __forceinline__ void glds16_asm(const void* gsrc, unsigned lds_dst) { unsigned keep;
  asm volatile("s_mov_b32 %0, m0\n\ts_mov_b32 m0, %2\n\ts_nop 0\n\tglobal_load_lds_dwordx4 %1, off\n\ts_mov_b32 m0, %0" : "=&s"(keep) : "v"(gsrc), "s"(lds_dst) : "memory"); }
constexpr int B2_K = 0, B2_V = 2 * SHM_K, B2_P = B2_V + 4 * SHM_V, B2_X = 131072 + 1024;
constexpr int B2_AL = B2_X, B2_FL = B2_AL + 1024, B2_LI = B2_FL + 64, B2_TB = B2_LI + 512;
template <int LDP, int LDO>
__device__ __forceinline__ void attnB2_unit(const bf16* __restrict__ Qb, const bf16* Pbase, int koff, int voff, float* __restrict__ Ob, int q128, char* lds, int sel = 0) {
  int tid = threadIdx.x; asm volatile("" : "+v"(tid));
  const int wid = __builtin_amdgcn_readfirstlane(tid >> 6), lane = tid & 63, r32 = lane & 31, hi = lane >> 5, pw = wid & 3;
  const int NT = 2 * q128 + 2;
  const unsigned lbase = (unsigned)__builtin_amdgcn_readfirstlane((int)(uintptr_t)lds);
  const bf16* Ksrc; const bf16* Vsrc[4];
  { const int row0 = 8 * wid + (lane >> 4), row1 = row0 + 4;
    Ksrc = Pbase + koff + (size_t)row0 * LDP + (((lane & 15) ^ (row0 & 7)) << 3);
    (void)row1; }
  const int kx1 = (int)((((lane & 15) ^ ((8 * wid + (lane >> 4) + 4) & 7)) << 3)) - (int)((((lane & 15) ^ ((8 * wid + (lane >> 4)) & 7)) << 3));
#pragma unroll
  for (int q = 0; q < 4; ++q) { const int ci = wid * 4 + q, vt = ci >> 4, cs = ci & 15, st = cs * 2 + (lane >> 5);
    const int kk = (st >> 2) * 8 + ((lane >> 2) & 7), k = (kk & ~0xC) | ((kk & 4) << 1) | ((kk & 8) >> 1), c = vt * 128 + (st & 3) * 32 + (lane & 3) * 8;
    Vsrc[q] = Pbase + voff + (size_t)k * LDP + c; }
#define B2DMA_K(t_, b_) do { const bf16* ks_ = Ksrc + (size_t)(t_) * KVBLK * LDP; const unsigned kd_ = (unsigned)__builtin_amdgcn_readfirstlane((int)(lbase + B2_K + (b_) * SHM_K + wid * 2048)); \
    glds16_asm(ks_, kd_); glds16_asm(ks_ + 4 * LDP + kx1, kd_ + 1024); } while (0)
#define B2DMA_V(t_, b_) do { _Pragma("unroll") for (int q = 0; q < 4; ++q) { const int ci_ = wid * 4 + q; \
      glds16_asm(Vsrc[q] + (size_t)(t_) * KVBLK * LDP, (unsigned)__builtin_amdgcn_readfirstlane((int)(lbase + B2_V + (b_) * 2 * SHM_V + (ci_ >> 4) * SHM_V + (ci_ & 15) * 1024))); } } while (0)
#define B2SYNC() do { asm volatile("s_waitcnt vmcnt(0)" ::: "memory"); __syncthreads(); } while (0)
  typedef __attribute__((address_space(3))) float lds_f32; typedef __attribute__((address_space(3))) int lds_i32;
  lds_f32* al_s = (lds_f32*)(uintptr_t)(lbase + B2_AL); lds_i32* fl_s = (lds_i32*)(uintptr_t)(lbase + B2_FL); lds_f32* li_s = (lds_f32*)(uintptr_t)(lbase + B2_LI);
  B2DMA_K(0, 0); B2DMA_V(0, 0); B2DMA_K(1, 1);
  if (wid < 4) {
    const float* tb = (const float*)(lds + B2_TB);
    const int chunk_w = 2 * q128 + (pw >> 1);
    const int ib0 = 4 * hi - 128 * q128 - 32 * pw - r32 + 127 + 256;
    float m_reg = -1e30f, l_reg = 0.f; bf16x8 qr[8];
    { const bf16* Qw = Qb + (long)(pw * QBLK + r32) * LDP + hi * 8;
#pragma unroll
      for (int d0 = 0; d0 < 8; ++d0) qr[d0] = *reinterpret_cast<const bf16x8*>(Qw + d0 * 16); }
    B2SYNC();
#define B2PROD(t_) do { f32x16 p0, p1; qkt(p0, p1, lds + B2_K + ((t_) & 1) * SHM_K, qr, r32, hi); \
      if ((t_) > chunk_w) { _Pragma("unroll") for (int r = 0; r < 16; ++r) { p0[r] = -1e30f; p1[r] = -1e30f; } } \
      else if ((t_) >= NT - 4) { const float* tbj = tb + (ib0 + 64 * (t_)); \
        _Pragma("unroll") for (int r = 0; r < 16; ++r) { p0[r] += tbj[(r & 3) + 8 * (r >> 2)]; p1[r] += tbj[32 + (r & 3) + 8 * (r >> 2)]; } } \
      float mn_, al_; partialSM(p0, p1, m_reg, mn_, al_); bf16x8 pa0, pa1, pa2, pa3; finishSM(p0, p1, al_, l_reg, pa0, pa1, pa2, pa3); \
      char* pb_ = lds + B2_P + ((((t_) & 1) * 4 + pw) * 4) * 1024 + lane * 16; \
      *(bf16x8*)(pb_) = pa0; *(bf16x8*)(pb_ + 1024) = pa1; *(bf16x8*)(pb_ + 2048) = pa2; *(bf16x8*)(pb_ + 3072) = pa3; \
      if (hi == 0) al_s[(((t_) & 1) * 4 + pw) * 32 + r32] = al_; \
      const int any_ = __any(al_ < 1.f) ? 1 : 0; if (lane == 0) fl_s[((t_) & 1) * 4 + pw] = any_; } while (0)
    B2PROD(0);
    B2SYNC();
    for (int j = 0; j < NT; ++j) {
      if (j + 2 < NT) B2DMA_K(j + 2, j & 1);
      if (j + 1 < NT) B2DMA_V(j + 1, (j + 1) & 1);
      if (j + 1 < NT && !(sel & 4)) B2PROD(j + 1);
      B2SYNC();
    }
    if (hi == 0) li_s[pw * 32 + r32] = __builtin_amdgcn_rcpf(l_reg);
    __syncthreads();
#undef B2PROD
  } else {
    f32x16 o[8] = {};
    const int vb0 = (int)(uintptr_t)(lds + B2_V) + v_rd_base(lane);
    B2SYNC();
    B2SYNC();
    for (int j = 0; j < NT; ++j) {
      if (j + 2 < NT) B2DMA_K(j + 2, j & 1);
      if (j + 1 < NT) B2DMA_V(j + 1, (j + 1) & 1);
      if (!(sel & 8)) { const int bsel = j & 1;
        if (fl_s[bsel * 4 + pw]) { const lds_f32* ap = al_s + (bsel * 4 + pw) * 32;
#pragma unroll
          for (int d = 0; d < 8; ++d)
#pragma unroll
            for (int r = 0; r < 16; ++r) o[d][r] *= ap[crow(r, hi)]; }
        const char* pb_ = lds + B2_P + ((bsel * 4 + pw) * 4) * 1024 + lane * 16;
        const bf16x8 pa0 = *(const bf16x8*)(pb_), pa1 = *(const bf16x8*)(pb_ + 1024), pa2 = *(const bf16x8*)(pb_ + 2048), pa3 = *(const bf16x8*)(pb_ + 3072);
        pv8(o, vb0 + bsel * 2 * SHM_V, vb0 + bsel * 2 * SHM_V + SHM_V, pa0, pa1, pa2, pa3); }
      B2SYNC();
    }
    __syncthreads();
    float rli[16];
#pragma unroll
    for (int r = 0; r < 16; ++r) rli[r] = li_s[pw * 32 + crow(r, hi)];
    float* Ow = Ob + (long)(pw * QBLK) * LDO;
#pragma unroll
    for (int r = 0; r < 16; ++r) { const int orow = crow(r, hi);
#pragma unroll
      for (int d = 0; d < 8; ++d) Ow[(long)orow * LDO + d * 32 + r32] = o[d][r] * rli[r]; }
  }
  __syncthreads();
#undef B2DMA_K
#undef B2DMA_V
#undef B2SYNC
}

template <int LDP, int LDO>
__device__ __forceinline__ void attnA_unit(const bf16* __restrict__ Qb, const bf16* Pbase, int koff, int voff, bf16* __restrict__ Ob, int qb, char* lds) {
  const __amdgpu_buffer_rsrc_t rs = __builtin_amdgcn_make_buffer_rsrc(uniform_ptr(Pbase), 0, SEQ * LDP * 2, 0x00020000);
  int tid = threadIdx.x; asm volatile("" : "+v"(tid));
  const int wid = __builtin_amdgcn_readfirstlane(tid >> 6), lane = tid & 63, r32 = lane & 31, hi = lane >> 5;
  char* K_lds = lds + wid * 16384; char* V_lds = K_lds + 8192;
  f32x16 o[4] = {}; bf16x8 qr[8];
  const bf16* Qw = Qb + (long)(wid * QBLK + r32) * LDP + hi * 8;
#pragma unroll
  for (int d0 = 0; d0 < 8; ++d0) qr[d0] = *reinterpret_cast<const bf16x8*>(Qw + d0 * 16);
  const int srow = lane >> 1, scol = (lane & 1) * 64;
  const int vo = (srow * LDP + scol) * 2;
  const int vb0 = (int)(uintptr_t)V_lds + v_rd_base(lane);
  const int krow = lane >> 4, kch = lane & 15;
  const unsigned klds = (unsigned)__builtin_amdgcn_readfirstlane((int)(uintptr_t)K_lds);
  const bf16* Ksrc = Pbase + koff;
  float R = 0.f;
  const int htd = 8 * qb + wid;
  bf16x8 tv[8];
#define AKDMA(ht_) do { _Pragma("unroll") for (int j = 0; j < 8; ++j) { const int row_ = 4 * j + krow; \
      __builtin_amdgcn_global_load_lds((const unsigned*)(Ksrc + (size_t)((ht_) * 32 + row_) * LDP + ((kch ^ (row_ & 7)) << 3)), (__attribute__((address_space(3))) unsigned*)(uintptr_t)(klds + j * 1024), 16, 0, 0); } } while (0)
#define AVLOAD(ht_) do { const int sV_ = __builtin_amdgcn_readfirstlane((voff + (ht_) * 32 * LDP) * 2); _Pragma("unroll") for (int j = 0; j < 8; ++j) tv[j] = bload16(rs, vo + 16 * j, sV_); } while (0)
  AKDMA(htd); AVLOAD(htd);
  for (int ht = htd; ht >= 0; --ht) {
    asm volatile("s_waitcnt vmcnt(0)" ::: "memory");
#pragma unroll
    for (int j = 0; j < 8; ++j) *(bf16x8*)(V_lds + v_st(srow, scol + 8 * j)) = tv[j];
    if (ht > 0) AVLOAD(ht - 1);
    asm volatile("s_waitcnt lgkmcnt(0)" ::: "memory");
    f32x16 p0 = f32x16{};
#pragma unroll
    for (int d0 = 0; d0 < 8; ++d0) { const int cb = (d0 * 16 + hi * 8) * 2;
      const bf16x8 b0 = *reinterpret_cast<const bf16x8*>(K_lds + KSWZ(r32, cb));
      p0 = __builtin_amdgcn_mfma_f32_32x32x16_bf16(b0, qr[d0], p0, 0, 0, 0); }
    asm volatile("s_waitcnt lgkmcnt(0)" : "+v"(p0) :: "memory");
    if (ht > 0) AKDMA(ht - 1);
    const int lim = (ht == htd) ? r32 : 32;
    float qs[4], oq[4]; f32x16 Ln;
#pragma unroll
    for (int g = 0; g < 4; ++g) { float s_ = 0.f;
#pragma unroll
      for (int i = 0; i < 4; ++i) { const int r = 4 * g + i; const float x = p0[r] * SCALE; p0[r] = x;
        const float sp = __logf(1.f + __expf(-fabsf(x))); const float ln = (crow(r, hi) < lim) ? -(fmaxf(x, 0.f) + sp) : 0.f;
        Ln[r] = ln; s_ += ln; }
      qs[g] = s_; }
#pragma unroll
    for (int g = 0; g < 4; ++g) oq[g] = __shfl_xor(qs[g], 32);
    float run = 0.f;
#pragma unroll
    for (int g = 3; g >= 0; --g) { float E = R + run + (hi == 0 ? oq[g] : 0.f);
#pragma unroll
      for (int i = 3; i >= 0; --i) { const int r = 4 * g + i;
        const bool valid = crow(r, hi) < lim;
        const float w = valid ? __expf(Ln[r] + p0[r] + E) : 0.f; E += Ln[r]; p0[r] = w; }
      run += qs[g] + oq[g]; }
    R += run;
    bf16x8 pa0, pa1; PK4(p0, 0, pa0); PK4(p0, 8, pa1);
#define AV_ONE(D0) do { const s16x4 l0 = tr_read<v_rd_off(D0, 0, 0)>(vb0), h0 = tr_read<v_rd_off(D0, 0, 1)>(vb0), l1 = tr_read<v_rd_off(D0, 1, 0)>(vb0), h1 = tr_read<v_rd_off(D0, 1, 1)>(vb0); \
      asm volatile("s_waitcnt lgkmcnt(0)" ::: "memory"); SBAR(); \
      o[D0] = __builtin_amdgcn_mfma_f32_32x32x16_bf16(pa0, mk8a(l0, h0), o[D0], 0, 0, 0); o[D0] = __builtin_amdgcn_mfma_f32_32x32x16_bf16(pa1, mk8a(l1, h1), o[D0], 0, 0, 0); } while (0)
    AV_ONE(0); AV_ONE(1); AV_ONE(2); AV_ONE(3);
#undef AV_ONE
    if (__all(R < -104.f)) break;
  }
#undef AKDMA
#undef AVLOAD
  asm volatile("s_waitcnt vmcnt(0)" ::: "memory");
  bf16* Ow = Ob + (long)(wid * QBLK) * LDO;
#pragma unroll
  for (int r = 0; r < 16; ++r) { const int orow = crow(r, hi);
#pragma unroll
    for (int d0 = 0; d0 < 4; ++d0) Ow[(long)orow * LDO + d0 * 32 + r32] = (bf16)f2bf(o[d0][r]); }
  __syncthreads();
}
__device__ __forceinline__ bf16x8 mk8(s16x4 l, s16x4 h) { return (bf16x8){l[0], l[1], l[2], l[3], h[0], h[1], h[2], h[3]}; }
__device__ __forceinline__ v4u pack8(const float* f) { v4u w; w.x = cvtpk(f[0], f[1]); w.y = cvtpk(f[2], f[3]); w.z = cvtpk(f[4], f[5]); w.w = cvtpk(f[6], f[7]); return w; }
__device__ __forceinline__ void rot8(v4u lo4, v4u hi4, const float2* cs, float mul, float* ol, float* oh) {
#pragma unroll
  for (int q = 0; q < 4; ++q) { const float2 c0 = cs[2 * q], c1 = cs[2 * q + 1];
    const float l0 = bflo(lo4[q]), l1 = bfhi(lo4[q]), h0 = bflo(hi4[q]), h1 = bfhi(hi4[q]);
    ol[2 * q] = (l0 * c0.x - h0 * c0.y) * mul; ol[2 * q + 1] = (l1 * c1.x - h1 * c1.y) * mul;
    oh[2 * q] = (h0 * c0.x + l0 * c0.y) * mul; oh[2 * q + 1] = (h1 * c1.x + l1 * c1.y) * mul; }
}
template <int LDP>
__device__ __forceinline__ void ret_kv_unit(const bf16* __restrict__ P, const float2* __restrict__ ROPE, bf16* __restrict__ kvo, int b, int h, int n, char* lds) {
  int tid = threadIdx.x; asm volatile("" : "+v"(tid));
  const int wid = tid >> 6, lane = tid & 63, r32 = lane & 31, hi = lane >> 5;
  char* Vt = lds; char* Kt = lds + 2 * SHM_V;
  const size_t t0 = (size_t)b * SEQ + 64 * n;
  const float lg = __logf(1.f - exp2f(-5.f - (float)h));
#pragma unroll
  for (int it = 0; it < 4; ++it) { const int task = it * 512 + tid, vt = task >> 10, row = (task >> 4) & 63, sc = (task & 15) * 8;
    const bf16x8 v = *reinterpret_cast<const bf16x8*>(P + (t0 + row) * LDP + 1024 + h * 256 + vt * 128 + sc);
    *(bf16x8*)(Vt + vt * SHM_V + v_st(row, sc)) = v; }
  { const int m = tid >> 3, dc = (tid & 7) * 8; const bf16* kr = P + (t0 + m) * LDP + 512 + h * 128;
    const v4u lo4 = *(const v4u*)(kr + dc), hi4 = *(const v4u*)(kr + 64 + dc);
    float ol[8], oh[8]; rot8(lo4, hi4, ROPE + (size_t)(64 * n + m) * 64 + dc, __expf(lg * (float)(63 - m)), ol, oh);
    *(v4u*)(Kt + v_st(m, dc)) = pack8(ol); *(v4u*)(Kt + v_st(m, 64 + dc)) = pack8(oh); }
  __syncthreads();
  const int vbA = (int)(uintptr_t)(Vt + (wid >> 2) * SHM_V) + v_rd_base(lane) + (wid & 3) * 512;
  const int vbB = (int)(uintptr_t)Kt + v_rd_base(lane);
  bf16x8 a[4];
  { const s16x4 l0 = tr_read<v_rd_off(0, 0, 0)>(vbA), h0 = tr_read<v_rd_off(0, 0, 1)>(vbA), l1 = tr_read<v_rd_off(0, 1, 0)>(vbA), h1 = tr_read<v_rd_off(0, 1, 1)>(vbA);
    const s16x4 l2 = tr_read<v_rd_off(0, 2, 0)>(vbA), h2 = tr_read<v_rd_off(0, 2, 1)>(vbA), l3 = tr_read<v_rd_off(0, 3, 0)>(vbA), h3 = tr_read<v_rd_off(0, 3, 1)>(vbA);
    asm volatile("s_waitcnt lgkmcnt(0)" ::: "memory"); SBAR();
    a[0] = mk8(l0, h0); a[1] = mk8(l1, h1); a[2] = mk8(l2, h2); a[3] = mk8(l3, h3); }
  f32x16 acc[4] = {};
  pv_one<0>(acc[0], vbB, a[0], a[1], a[2], a[3]); pv_one<1>(acc[1], vbB, a[0], a[1], a[2], a[3]); pv_one<2>(acc[2], vbB, a[0], a[1], a[2], a[3]); pv_one<3>(acc[3], vbB, a[0], a[1], a[2], a[3]);
#pragma unroll
  for (int db = 0; db < 4; ++db)
#pragma unroll
    for (int r = 0; r < 16; ++r) kvo[(size_t)(32 * wid + crow(r, hi)) * 128 + 32 * db + r32] = (bf16)f2bf(acc[db][r]);
  __syncthreads();
}
template <int LDP, int LDO>
__device__ __forceinline__ void ret_out_unit(const bf16* __restrict__ P, const float2* __restrict__ ROPE, const bf16* __restrict__ PREV, const float* __restrict__ rg, bf16* __restrict__ O, int b, int h, int np, char* lds) {
  int tid = threadIdx.x; asm volatile("" : "+v"(tid));
  const int wid = tid >> 6, lane = tid & 63, r32 = lane & 31, hi = lane >> 5;
  const int cw = wid >> 2, qh = (wid >> 1) & 1, eh = wid & 1, bh = b * 4 + h;
  constexpr int CH = 3 * SHM_V;
  float* red = (float*)(lds + 2 * CH);
  const float lg = __logf(1.f - exp2f(-5.f - (float)h));
#pragma unroll
  for (int cc = 0; cc < 2; ++cc) { const int n = 2 * np + cc; const size_t t0 = (size_t)b * SEQ + 64 * n;
    { const int m = tid >> 3, dc = (tid & 7) * 8; const bf16* kr = P + (t0 + m) * LDP + 512 + h * 128;
      const v4u lo4 = *(const v4u*)(kr + dc), hi4 = *(const v4u*)(kr + 64 + dc);
      float ol[8], oh[8]; rot8(lo4, hi4, ROPE + (size_t)(64 * n + m) * 64 + dc, 1.f, ol, oh);
      *(v4u*)(lds + cc * CH + KSWZ(m, dc * 2)) = pack8(ol); *(v4u*)(lds + cc * CH + KSWZ(m, (64 + dc) * 2)) = pack8(oh); }
#pragma unroll
    for (int it = 0; it < 4; ++it) { const int task = it * 512 + tid, vt = task >> 10, row = (task >> 4) & 63, sc = (task & 15) * 8;
      const bf16x8 v = *reinterpret_cast<const bf16x8*>(P + (t0 + row) * LDP + 1024 + h * 256 + vt * 128 + sc);
      *(bf16x8*)(lds + cc * CH + SHM_V + vt * SHM_V + v_st(row, sc)) = v; } }
  const int n = 2 * np + cw; const size_t tq = (size_t)b * SEQ + 64 * n + 32 * qh + r32;
  bf16x8 qr[8];
  { const bf16* qrow = P + tq * LDP + h * 128 + hi * 8; const float2* cs = ROPE + (size_t)(64 * n + 32 * qh + r32) * 64 + hi * 8;
#pragma unroll
    for (int d0 = 0; d0 < 4; ++d0) { const v4u lo4 = *(const v4u*)(qrow + d0 * 16), hi4 = *(const v4u*)(qrow + 64 + d0 * 16);
      float ol[8], oh[8]; rot8(lo4, hi4, cs + d0 * 16, SCALE, ol, oh);
      const v4u wl = pack8(ol), wh = pack8(oh); qr[d0] = __builtin_bit_cast(bf16x8, wl); qr[d0 + 4] = __builtin_bit_cast(bf16x8, wh); } }
  f32x16 o[4] = {};
  { const bf16* pv = PREV + ((size_t)bh * 64 + n) * 32768 + (size_t)(128 * eh + r32) * 128 + hi * 8;
#pragma unroll
    for (int d0 = 0; d0 < 4; ++d0)
#pragma unroll
      for (int ks = 0; ks < 8; ++ks) { const bf16x8 bf = *reinterpret_cast<const bf16x8*>(pv + (size_t)(32 * d0) * 128 + ks * 16);
        o[d0] = __builtin_amdgcn_mfma_f32_32x32x16_bf16(qr[ks], bf, o[d0], 0, 0, 0); } }
#pragma unroll
  for (int r = 0; r < 16; ++r) { const float qd = __expf(lg * (float)(32 * qh + crow(r, hi) + 1));
#pragma unroll
    for (int d0 = 0; d0 < 4; ++d0) o[d0][r] *= qd; }
  __syncthreads();
  { f32x16 p0, p1; qkt(p0, p1, lds + cw * CH, qr, r32, hi);
    const int c = 32 * qh + r32;
#pragma unroll
    for (int r = 0; r < 16; ++r) { const int m0 = crow(r, hi), m1 = m0 + 32; const int d0_ = c > m0 ? c - m0 : m0 - c, d1_ = c > m1 ? c - m1 : m1 - c;
      p0[r] *= __expf(lg * (float)d0_); p1[r] *= __expf(lg * (float)d1_); }
    bf16x8 pa0, pa1, pa2, pa3; packP(p0, p1, pa0, pa1, pa2, pa3);
    pv_d0(o, (int)(uintptr_t)(lds + cw * CH + SHM_V + eh * SHM_V) + v_rd_base(lane), pa0, pa1, pa2, pa3); }
  { float ssq[16];
#pragma unroll
    for (int r = 0; r < 16; ++r) { float s_ = (o[0][r] * o[0][r] + o[1][r] * o[1][r]) + (o[2][r] * o[2][r] + o[3][r] * o[3][r]);
      s_ += __shfl_xor(s_, 1); s_ += __shfl_xor(s_, 2); s_ += __shfl_xor(s_, 4); s_ += __shfl_xor(s_, 8); s_ += __shfl_xor(s_, 16); ssq[r] = s_; }
    if (r32 == 0) {
#pragma unroll
      for (int r = 0; r < 16; ++r) red[wid * 32 + crow(r, hi)] = ssq[r]; }
    __syncthreads();
    const size_t trow0 = (size_t)b * SEQ + 64 * n + 32 * qh;
#pragma unroll
    for (int r = 0; r < 16; ++r) { const int rl = crow(r, hi); const float tot = red[wid * 32 + rl] + red[(wid ^ 1) * 32 + rl]; const float rstd = rsqrtf(tot * (1.f / 256.f) + 1e-6f);
      const size_t row = trow0 + rl;
#pragma unroll
      for (int d0 = 0; d0 < 4; ++d0) { const int e = 128 * eh + 32 * d0 + r32;
        const float gate = silu_f(bf2f(P[row * LDP + 2048 + h * 256 + e]));
        O[row * LDO + h * 256 + e] = (bf16)f2bf(o[d0][r] * rstd * rg[e] * gate); } } }
  __syncthreads();
}
template <int LDP, int LDO>
__device__ __forceinline__ void sgu_unit(const bf16* __restrict__ P, const unsigned long long* __restrict__ lnsum, const float* __restrict__ lng, const float* __restrict__ lnb, const float* __restrict__ Wg, const float* __restrict__ bs,
                                         bf16* __restrict__ O, size_t t0, int g, char* lds) {
  int tid = threadIdx.x; asm volatile("" : "+v"(tid));
  const int wid = tid >> 6, lane = tid & 63, r32 = lane & 31, hi = lane >> 5;
#pragma unroll
  for (int it = 0; it < 8; ++it) { const int task = it * 512 + tid, j = task >> 5, cc = (task & 31) * 8;
    const v4u v4 = *(const v4u*)(P + (t0 + j) * LDP + 4096 + g * 256 + cc);
    const float s1 = (float)(long long)lnsum[2 * (t0 + j)] * (1.f / 16777216.f), s2 = (float)(long long)lnsum[2 * (t0 + j) + 1] * (1.f / 16777216.f); const float mean = s1 * (1.f / 1024.f); const float rstd = rsqrtf(fmaxf(s2 * (1.f / 1024.f) - mean * mean, 0.f) + 1e-6f);
    const f32x4 g0 = *(const f32x4*)(lng + g * 256 + cc), g1 = *(const f32x4*)(lng + g * 256 + cc + 4), b0 = *(const f32x4*)(lnb + g * 256 + cc), b1 = *(const f32x4*)(lnb + g * 256 + cc + 4);
    float y[8];
#pragma unroll
    for (int q = 0; q < 4; ++q) { y[2 * q] = gelu_tanh(bflo(v4[q])); y[2 * q + 1] = gelu_tanh(bfhi(v4[q])); }
#pragma unroll
    for (int q = 0; q < 4; ++q) { y[q] = (y[q] - mean) * rstd * g0[q] + b0[q]; y[4 + q] = (y[4 + q] - mean) * rstd * g1[q] + b1[q]; }
    *(v4u*)(lds + ((j >> 6) * 2 + (cc >> 7)) * SHM_V + v_st(j & 63, cc & 127)) = pack8(y); }
  const int ib = wid & 3, ct = wid >> 2;
  bf16x8 wa[8];
  { const float* wr = Wg + (size_t)(32 * ib + r32) * 128 + hi * 8;
#pragma unroll
    for (int ks = 0; ks < 8; ++ks) { if (ks < 4 || ib >= 2) { const f32x4 a0 = *(const f32x4*)(wr + ks * 16), a1 = *(const f32x4*)(wr + ks * 16 + 4);
        v4u w; w.x = cvtpk(a0[0], a0[1]); w.y = cvtpk(a0[2], a0[3]); w.z = cvtpk(a1[0], a1[1]); w.w = cvtpk(a1[2], a1[3]); wa[ks] = __builtin_bit_cast(bf16x8, w); }
      else wa[ks] = (bf16x8){0, 0, 0, 0, 0, 0, 0, 0}; } }
  __syncthreads();
  f32x16 o[4] = {};
  pv_d0(o, (int)(uintptr_t)(lds + (0 * 2 + ct) * SHM_V) + v_rd_base(lane), wa[0], wa[1], wa[2], wa[3]);
  if (ib >= 2) pv_d0(o, (int)(uintptr_t)(lds + (1 * 2 + ct) * SHM_V) + v_rd_base(lane), wa[4], wa[5], wa[6], wa[7]);
#pragma unroll
  for (int r = 0; r < 16; ++r) { const int i = 32 * ib + crow(r, hi); const float bi = bs[i]; const size_t row = t0 + i;
#pragma unroll
    for (int d0 = 0; d0 < 4; ++d0) { const int c = 128 * ct + 32 * d0 + r32;
      const float uu = gelu_tanh(bf2f(P[row * LDP + 3072 + g * 256 + c]));
      O[row * LDO + 1024 + g * 256 + c] = (bf16)f2bf(uu * (o[d0][r] + bi)); } }
  __syncthreads();
}
#undef SBAR
}

__device__ __forceinline__ f32x4 mma16(bf16x8 a, bf16x8 b, f32x4 c) { return __builtin_amdgcn_mfma_f32_16x16x32_bf16(a, b, c, 0, 0, 0); }

struct Args { const float* in[20]; float* out; unsigned char* ws; int ph_lo, ph_hi, sel, li; };

constexpr int N_PHASES = 17;

__global__ void __launch_bounds__(NWAVES * 64, 2) mega_fwd(Args args) {
    extern __shared__ __attribute__((aligned(16))) unsigned char lds[];
    LAS unsigned char* ldsl = (LAS unsigned char*)lds;
    const int G = gridDim.x; const int bx = blockIdx.x;
    const int vcu = (G % 8 == 0) ? (bx % 8) * (G / 8) + bx / 8 : bx;
#define PHASE_ENV() \
    const __attribute__((address_space(4))) Args* ap_ = (const __attribute__((address_space(4))) Args*)__builtin_amdgcn_kernarg_segment_ptr(); asm volatile("" : "+s"(ap_)); \
    int tid = threadIdx.x; asm volatile("" : "+v"(tid)); const int lane = tid & 63, wave = __builtin_amdgcn_readfirstlane(tid >> 6); (void)lane; \
    unsigned char* const ws = ap_->ws; const int gw = vcu * NWAVES + wave, NGW = G * NWAVES; const int gt = vcu * (NWAVES * 64) + tid, NGT = G * NWAVES * 64; \
    const float* const x_in = ap_->in[0]; \
    bf16* const W_ABIN = (bf16*)(ws + WS_W_ABIN); bf16* const W_ABOUT = (bf16*)(ws + WS_W_ABOUT); bf16* const W_CDIN = (bf16*)(ws + WS_W_CDIN); bf16* const W_CDOUT = (bf16*)(ws + WS_W_CDOUT); \
    bf16* const W_UP0 = (bf16*)(ws + WS_W_UP0); bf16* const W_UP1 = (bf16*)(ws + WS_W_UP1); bf16* const W_DN0 = (bf16*)(ws + WS_W_DN0); bf16* const W_DN1 = (bf16*)(ws + WS_W_DN1); \
    bf16* const XN = (bf16*)(ws + WS_XN); bf16* const OB16 = (bf16*)(ws + WS_O); float* const X = (float*)(ws + WS_X); bf16* const ACT = (bf16*)(ws + WS_ACT); \
    bf16* const P = (bf16*)(ws + WS_P); float* const OBF = (float*)(ws + WS_OB); bf16* const KV = (bf16*)(ws + WS_KV); bf16* const PREV = (bf16*)(ws + WS_PREV); bf16* const UP = (bf16*)(ws + WS_UP); \
    unsigned long long* const SS = (unsigned long long*)(ws + WS_SS); (void)SS; unsigned long long* const LNS = (unsigned long long*)(ws + WS_LNS); (void)LNS; bf16* const HALO = (bf16*)(ws + WS_HALO); (void)HALO; bf16* const SCR = (bf16*)(ws + WS_SCR); (void)SCR; float* const SCAL = (float*)(ws + WS_SCAL); float2* const ROPE = (float2*)(ws + WS_ROPE); \
    (void)gw; (void)NGW; (void)gt; (void)NGT; (void)x_in; (void)W_ABIN; (void)W_ABOUT; (void)W_CDIN; (void)W_CDOUT; (void)W_UP0; (void)W_UP1; (void)W_DN0; (void)W_DN1; (void)XN; (void)OB16; (void)X; (void)ACT; (void)P; (void)OBF; (void)KV; (void)PREV; (void)UP; (void)SCAL; (void)ROPE;
#define AIN(k) (ap_->in[k])

#if !MK_PER_PHASE
    for (int u = threadIdx.x; u < (LDS_BYTES - LDSCTL_OFF) / 4; u += NWAVES * 64) ((LAS unsigned*)(ldsl + LDSCTL_OFF))[u] = 0u;
    __syncthreads();
    XcdBarrier bar = xcd_barrier_post((unsigned*)(args.ws + WS_CTL) + 4096 + args.li * XCD_BAR_WORDS, (volatile LAS unsigned*)(ldsl + MISC_OFF) + 8);
#define GRID_BAR() xcd_barrier(bar)
#else
#define GRID_BAR() do {} while (0)
#endif
    const int lo = args.ph_lo, hi_ph = args.ph_hi;
#ifndef PH_MASK
#define PH_MASK 0xFFFFFFu
#endif
#define IN(k) (((PH_MASK >> (k)) & 1u) && lo <= (k) && (k) < hi_ph)
#define SEAM(k) do { if (IN(k) && IN((k) + 1)) GRID_BAR(); } while (0)
#ifndef REPEAT_MASK
#define REPEAT_MASK 0u
#endif
#define NREP(k) (((REPEAT_MASK >> (k)) & 1u) ? 2 : 1)

#define RAW_TO_XN(SRC, SSP) do { \
        for (int m = gw; m < MTOK; m += NGW) { const GAS f32x4* xr = (const GAS f32x4*)((SRC) + (size_t)m * DM) + lane; f32x4 v[8]; float s = 0.f; \
            _Pragma("unroll") for (int j = 0; j < 8; ++j) { v[j] = xr[64 * j]; s += (v[j].x * v[j].x + v[j].y * v[j].y) + (v[j].z * v[j].z + v[j].w * v[j].w); } \
            s = wave_sum(s); if (lane == 0) (SSP)[m] = (unsigned long long)(s * 16777216.f); \
            GAS v2u* o8 = (GAS v2u*)(XN + (size_t)m * DM) + lane; \
            _Pragma("unroll") for (int j = 0; j < 8; ++j) { v2u w; w.x = pk2(v[j].x, v[j].y); w.y = pk2(v[j].z, v[j].w); o8[64 * j] = w; } } } while (0)

    constexpr int CT_ABIN = 32 * (AB_IN / 64), CT_SQ = 32 * (DM / 64), CT_CDIN = 32 * (CD_IN / 64), CT_UP = 32 * (DFF2 / 64), CT_DN = (DFF / 64) * (DM / 64);
    constexpr int CT_L0 = CT_ABIN + CT_SQ + CT_UP + CT_DN, CT_S1 = CT_L0 + CT_CDIN + CT_SQ, CT_S2 = CT_S1 + 4900, CT_ALL = CT_S1 + CT_DN + CT_UP;
#define CONVERT_TILES(FIRST, LAST, W_ID, N_W) do { \
        LAS unsigned* T = (LAS unsigned*)(ldsl + wave * 9216); \
        const int rp = lane >> 4, cq = lane & 15; \
        struct TileRef { const float* src; bf16* dst; const float* gk; int K, N, perm; }; \
        auto tile_ref = [&](int it, TileRef& t) -> int { \
            int r = it; \
            if (r < CT_ABIN) { t = TileRef{AIN(5), W_ABIN, AIN(1), DM, AB_IN, 0}; return r; } r -= CT_ABIN; \
            if (r < CT_SQ) { t = TileRef{AIN(6), W_ABOUT, nullptr, DM, DM, 0}; return r; } r -= CT_SQ; \
            if (r < CT_UP) { t = TileRef{AIN(16), W_UP0, AIN(2), DM, DFF2, 1}; return r; } r -= CT_UP; \
            if (r < CT_DN) { t = TileRef{AIN(19), W_DN0, nullptr, DFF, DM, 0}; return r; } r -= CT_DN; \
            if (r < CT_CDIN) { t = TileRef{AIN(9), W_CDIN, AIN(1) + DM, DM, CD_IN, 0}; return r; } r -= CT_CDIN; \
            if (r < CT_SQ) { t = TileRef{AIN(10), W_CDOUT, nullptr, DM, DM, 0}; return r; } r -= CT_SQ; \
            if (r < CT_DN) { t = TileRef{AIN(19) + (size_t)DFF * DM, W_DN1, nullptr, DFF, DM, 0}; return r; } r -= CT_DN; \
            t = TileRef{AIN(16) + (size_t)DM * DFF2, W_UP1, AIN(2) + DM, DM, DFF2, 1}; return r; \
        }; \
        f32x4 va[8], vb[8]; float ga[8], gb[8]; \
        auto tile_load = [&](int it) { \
            TileRef t; const int r = tile_ref(it, t); const int nblk = t.N / 64, kb = r / nblk, nb = r % nblk; \
            const float* p = t.src + (size_t)(kb * 64 + 2 * rp) * t.N + nb * 64 + 4 * cq; \
            _Pragma("unroll") \
            for (int i = 0; i < 8; ++i) { va[i] = __builtin_nontemporal_load((const f32x4*)(p + (size_t)(8 * i) * t.N)); vb[i] = __builtin_nontemporal_load((const f32x4*)(p + (size_t)(8 * i + 1) * t.N)); \
                ga[i] = t.gk ? t.gk[kb * 64 + 8 * i + 2 * rp] : 1.f; gb[i] = t.gk ? t.gk[kb * 64 + 8 * i + 2 * rp + 1] : 1.f; } \
        }; \
        const int ct_last = (LAST), ct_step = (N_W); \
        int it = (FIRST) + (W_ID); \
        if (it < ct_last) tile_load(it); \
        while (it < ct_last) { \
            _Pragma("unroll") \
            for (int i = 0; i < 8; ++i) { \
                _Pragma("unroll") \
                for (int j = 0; j < 4; ++j) T[(4 * cq + j) * 36 + 4 * i + rp] = pk2(va[i][j] * ga[i], vb[i][j] * gb[i]); } \
            TileRef t; const int r = tile_ref(it, t); const int nblk = t.N / 64, kb = r / nblk, nb = r % nblk; \
            const int n0_ = nb * 64; const int drow0 = !t.perm ? n0_ : (n0_ < DFF ? (n0_ >> 7) * 256 + (n0_ & 127) : ((n0_ - DFF) >> 7) * 256 + 128 + ((n0_ - DFF) & 127)); \
            const int nxt = it + ct_step; \
            if (nxt < ct_last) tile_load(nxt); \
            LDS_WAIT(); asm volatile("" ::: "memory"); \
            _Pragma("unroll") \
            for (int o = 0; o < 8; ++o) { const int idx = o * 64 + lane, n = idx >> 3, c = idx & 7; \
                const v4u w = *(const LAS v4u*)(T + n * 36 + 4 * c); \
                *(GAS v4u*)(t.dst + (size_t)(drow0 + n) * t.K + kb * 64 + 8 * c) = w; } \
            LDS_WAIT(); asm volatile("" ::: "memory"); \
            it = nxt; \
        } \
    } while (0)

    for (int rep_ = 0; rep_ < NREP(0); ++rep_) if (IN(0)) { if (rep_) GRID_BAR(); PHASE_ENV();
        if (G == 256) { CONVERT_TILES(0, CT_L0, gw, NGW); CONVERT_TILES(CT_S2, CT_ALL, gw, NGW); } else { CONVERT_TILES(0, CT_ALL, gw, NGW); }
        for (int e = gt; e < SEQ * 64; e += NGT) { const int pos = e >> 6, i = e & 63;
            double f = 1.0; for (int k = 0; k < i; ++k) f *= 0.8659643233600653;
            const float ang = (float)pos * (float)f;
            double rev = (double)ang * 0.15915494309189535; rev -= floor(rev);
            const float rv = (float)rev;
            ROPE[e] = make_float2(__builtin_amdgcn_cosf(rv), __builtin_amdgcn_sinf(rv)); }
        if (vcu == 0 && wave == 0) { const float* lv = AIN(7);
            float a = lv[lane] * lv[128 + lane] + lv[64 + lane] * lv[192 + lane]; float b = lv[256 + lane] * lv[384 + lane] + lv[320 + lane] * lv[448 + lane];
            a = wave_sum(a); b = wave_sum(b);
            if (lane == 0) SCAL[0] = expf(a) - expf(b) + 0.2f; }
        RAW_TO_XN(x_in, SS);
    }
    SEAM(0);

    for (int rep_ = 0; rep_ < NREP(1); ++rep_) if (IN(1)) { if (rep_) GRID_BAR(); PHASE_ENV(); pg8::Gemm g{XN, W_ABIN, MTOK, AB_IN, DM}; pg8::StaticOrder S; S.init(MTOK, AB_IN, G, bx);
        pg8::EpiBf16 E{P, AB_IN, SS, nullptr, 0, 0}; pg8::gemm_phase<pg8::EpiBf16, pg8::StaticOrder, true, true>(ldsl, g, S, E, tid); }
    SEAM(1);

    for (int rep_ = 0; rep_ < NREP(2); ++rep_) if (IN(2)) { if (rep_) GRID_BAR(); PHASE_ENV();
#ifndef NO_B
        if (!(ap_->sel & 1)) { const int bh = vcu >> 5, comp = (vcu >> 4) & 1, s = vcu & 15, b = bh >> 2, h = bh & 3;
          float* tb = (float*)(lds + att::B2_TB);
          if (tid < 448) { const int rel = tid - 256 - 127, n = rel < 0 ? -rel : rel; int bucket = (n < 8) ? n : 8 + (31 - __clz((n * n) >> 6)); if (n >= 8 && bucket > 15) bucket = 15; if (rel > 0) bucket += 16;
              const float* rb = AIN(4); tb[tid] = (rel >= -127 && rel <= 63) ? (rb[bucket * 4 + h] - rb[15 * 4 + h]) * (1.f / att::SCALE) : 0.f; }
          __syncthreads();
          const bf16* Pb = P + (size_t)b * SEQ * AB_IN;
          for (int i = 0; i < 2; ++i) { const int q128 = i ? 31 - s : s;
              att::attnB2_unit<AB_IN, 1024>(Pb + (size_t)(128 * q128) * AB_IN + 3072 + h * 256 + comp * 128, Pb, 4096 + h * 256 + comp * 128, 5120 + h * 256,
                                            OBF + (size_t)comp * MTOK * 1024 + (size_t)(b * SEQ + 128 * q128) * 1024 + h * 256, q128, (char*)lds, ap_->sel); } }
#endif
#ifndef NO_A
#ifndef NREP_A
#define NREP_A 1
#endif
        for (int ra_ = 0; ra_ < NREP_A; ++ra_) if (!(ap_->sel & 2))
        { const int bh = vcu >> 4, qb = vcu & 15, b = bh >> 3, h = bh & 7;
          const bf16* Pb = P + (size_t)b * SEQ * AB_IN;
          att::attnA_unit<AB_IN, DM>(Pb + (size_t)(256 * qb) * AB_IN + h * 128, Pb, 1024 + h * 128, 2048 + h * 128, OB16 + (size_t)(b * SEQ + 256 * qb) * DM + h * 128, qb, (char*)lds); }
#endif
    }
    SEAM(2);

    for (int rep_ = 0; rep_ < NREP(3); ++rep_) if (IN(3)) { if (rep_) GRID_BAR(); PHASE_ENV();
        const float lam = SCAL[0]; const float* sg = AIN(8);
        f32x4 g4[4];
#pragma unroll
        for (int q = 0; q < 4; ++q) g4[q] = *(const f32x4*)(sg + (lane & 15) * 16 + q * 4);
        for (int row0 = gw * 2; row0 < MTOK; row0 += NGW * 2) { f32x4 a[2][4], c[2][4];
#pragma unroll
            for (int rr = 0; rr < 2; ++rr)
#pragma unroll
                for (int q = 0; q < 4; ++q) { a[rr][q] = *(const f32x4*)(OBF + (size_t)(row0 + rr) * 1024 + lane * 16 + q * 4); c[rr][q] = *(const f32x4*)(OBF + (size_t)MTOK * 1024 + (size_t)(row0 + rr) * 1024 + lane * 16 + q * 4); }
#pragma unroll
            for (int rr = 0; rr < 2; ++rr) { float ss = 0.f;
#pragma unroll
                for (int q = 0; q < 4; ++q) { a[rr][q] = a[rr][q] - lam * c[rr][q]; ss += (a[rr][q].x * a[rr][q].x + a[rr][q].y * a[rr][q].y) + (a[rr][q].z * a[rr][q].z + a[rr][q].w * a[rr][q].w); }
                ss += __shfl_xor(ss, 1); ss += __shfl_xor(ss, 2); ss += __shfl_xor(ss, 4); ss += __shfl_xor(ss, 8);
                const float rs = rsqrtf(ss * (1.f / 256.f) + EPS) * 0.8f;
                v4u w0, w1;
                w0.x = pk2(a[rr][0].x * rs * g4[0].x, a[rr][0].y * rs * g4[0].y); w0.y = pk2(a[rr][0].z * rs * g4[0].z, a[rr][0].w * rs * g4[0].w);
                w0.z = pk2(a[rr][1].x * rs * g4[1].x, a[rr][1].y * rs * g4[1].y); w0.w = pk2(a[rr][1].z * rs * g4[1].z, a[rr][1].w * rs * g4[1].w);
                w1.x = pk2(a[rr][2].x * rs * g4[2].x, a[rr][2].y * rs * g4[2].y); w1.y = pk2(a[rr][2].z * rs * g4[2].z, a[rr][2].w * rs * g4[2].w);
                w1.z = pk2(a[rr][3].x * rs * g4[3].x, a[rr][3].y * rs * g4[3].y); w1.w = pk2(a[rr][3].z * rs * g4[3].z, a[rr][3].w * rs * g4[3].w);
                bf16* op = OB16 + (size_t)(row0 + rr) * DM + 1024 + lane * 16; *(v4u*)op = w0; *(v4u*)(op + 8) = w1; } }
    }
    SEAM(3);

    for (int rep_ = 0; rep_ < NREP(4); ++rep_) if (IN(4)) { if (rep_) GRID_BAR(); PHASE_ENV(); pg8::Gemm g{OB16, W_ABOUT, MTOK, DM, DM}; pg8::StaticOrder S; S.init(MTOK, DM, G, bx);
        pg8::EpiRes E{nullptr, XN, DM, SS + 1 * MTOK}; pg8::gemm_phase<pg8::EpiRes, pg8::StaticOrder, false, true>(ldsl, g, S, E, tid); }
    SEAM(4);

#define FFN_PHASES(PB, WUP, WDN, L, SSIN, SSOUT) \
    for (int rep_ = 0; rep_ < NREP(PB); ++rep_) if (IN(PB)) { if (rep_) GRID_BAR(); PHASE_ENV(); pg8::Gemm g{XN, WUP, MTOK, DFF2, DM}; pg8::StaticOrder S; S.init(MTOK, DFF2, G, bx); \
        pg8::EpiConv E{ACT, SS + (SSIN) * MTOK, AIN(17) + (size_t)(L) * 3 * DFF2, AIN(18) + (size_t)(L) * DFF2, HALO, ldsl}; \
        pg8::gemm_phase<pg8::EpiConv, pg8::StaticOrder, true, true>(ldsl, g, S, E, tid); \
        if ((PB) == 5 && G == 256 && bx >= 128) { CONVERT_TILES(CT_L0, CT_S1, (bx - 128) * NWAVES + wave, 128 * NWAVES); } } \
    SEAM(PB); \
    for (int rep_ = 0; rep_ < NREP(PB + 1); ++rep_) if (IN(PB + 1)) { if (rep_) GRID_BAR(); PHASE_ENV(); conv_fix(HALO, ACT, AIN(17) + (size_t)(L) * 3 * DFF2, AIN(18) + (size_t)(L) * DFF2, gt, NGT); } \
    SEAM(PB + 1); \
    for (int rep_ = 0; rep_ < NREP(PB + 2); ++rep_) if (IN(PB + 2)) { if (rep_) GRID_BAR(); PHASE_ENV(); pg8::Gemm g{ACT, WDN, MTOK, DM, DFF}; pg8::StaticOrder S; S.init(MTOK, DM, G, bx); \
        if ((L) == 1 && G == 256) { pg8::EpiFinal E{XN, DM, SS + (SSOUT) * MTOK, (unsigned*)(ws + WS_CNT), AIN(3), ap_->out}; pg8::gemm_phase<pg8::EpiFinal, pg8::StaticOrder, false, true>(ldsl, g, S, E, tid); } \
        else { pg8::EpiRes E{nullptr, XN, DM, SS + (SSOUT) * MTOK}; pg8::gemm_phase<pg8::EpiRes, pg8::StaticOrder, false, true>(ldsl, g, S, E, tid); } } \
    SEAM(PB + 2);

    auto conv_fix = [&](const bf16* halo, bf16* act, const float* cw, const float* cb, int gt_, int ngt_) {
        constexpr int NCH = DFF / 8;
        for (int task = gt_; task < NCH * 64; task += ngt_) { const int ch = task % NCH, rr = (task / NCH) & 1, pm = task / (2 * NCH), n0 = ch * 8;
            const int pca = (n0 >> 7) * 256 + (n0 & 127); const bool first = (pm & 15) == 0;
            const bf16* H = halo + (size_t)pm * 4 * DFF2; const bf16* Hp = H - (size_t)4 * DFF2;
            float cv[2][8];
#pragma unroll
            for (int bj = 0; bj < 2; ++bj) { const int pc = pca + bj * 128, cc = bj * DFF + n0; const v4u z = {0u, 0u, 0u, 0u};
                const v4u c0 = *(const v4u*)(H + pc), c1 = *(const v4u*)(H + DFF2 + pc);
                const v4u q254 = first ? z : *(const v4u*)(Hp + 2 * DFF2 + pc), q255 = first ? z : *(const v4u*)(Hp + 3 * DFF2 + pc);
                const v4u x2 = rr == 0 ? q254 : q255, x1 = rr == 0 ? q255 : c0, x0 = rr == 0 ? c0 : c1;
#pragma unroll
                for (int q = 0; q < 4; ++q) {
                    cv[bj][2 * q] = cb[cc + 2 * q] + cw[cc + 2 * q] * bflo(x2[q]) + cw[DFF2 + cc + 2 * q] * bflo(x1[q]) + cw[2 * DFF2 + cc + 2 * q] * bflo(x0[q]);
                    cv[bj][2 * q + 1] = cb[cc + 2 * q + 1] + cw[cc + 2 * q + 1] * bfhi(x2[q]) + cw[DFF2 + cc + 2 * q + 1] * bfhi(x1[q]) + cw[2 * DFF2 + cc + 2 * q + 1] * bfhi(x0[q]); } }
            float o[8];
#pragma unroll
            for (int q = 0; q < 8; ++q) o[q] = silu_f(cv[1][q]) * cv[0][q];
            v4u w; w.x = pk2(o[0], o[1]); w.y = pk2(o[2], o[3]); w.z = pk2(o[4], o[5]); w.w = pk2(o[6], o[7]);
            *(v4u*)(act + (size_t)(pm * 256 + rr) * DFF + n0) = w; }
    };

    FFN_PHASES(5, W_UP0, W_DN0, 0, 1, 2)

    for (int rep_ = 0; rep_ < NREP(8); ++rep_) if (IN(8)) { if (rep_) GRID_BAR(); PHASE_ENV(); pg8::Gemm g{XN, W_CDIN, MTOK, CD_IN, DM}; pg8::StaticOrder S; S.init(MTOK, CD_IN, G, bx);
        pg8::EpiBf16 E{P, CD_IN, SS + 2 * MTOK, LNS, 16, 20}; pg8::gemm_phase<pg8::EpiBf16, pg8::StaticOrder, true, true>(ldsl, g, S, E, tid);
        if (G == 256 && bx >= 128) { CONVERT_TILES(CT_S1, CT_S2, (bx - 128) * NWAVES + wave, 128 * NWAVES); } }
    SEAM(8);

    for (int rep_ = 0; rep_ < NREP(9); ++rep_) if (IN(9)) { if (rep_) GRID_BAR(); PHASE_ENV();
        for (int u = vcu; u < 8 * 64; u += G) { const int bh = u >> 6, n = u & 63;
            att::ret_kv_unit<CD_IN>(P, ROPE, KV + ((size_t)bh * 64 + n) * 32768, bh >> 2, bh & 3, n, (char*)lds); }
        for (int u = vcu; u < 256; u += G) { const int g = u & 3, nbk = (u >> 2) & 31, b = u >> 7;
            att::sgu_unit<CD_IN, DM>(P, LNS, AIN(12), AIN(13), AIN(14) + (size_t)g * 128 * 128, AIN(15) + g * 128, OB16, (size_t)b * SEQ + 128 * nbk, g, (char*)lds); }
    }
    SEAM(9);

    for (int rep_ = 0; rep_ < NREP(10); ++rep_) if (IN(10)) { if (rep_) GRID_BAR(); PHASE_ENV();
        if (wave < 4) for (int e4 = (vcu * 4 + wave) * 64 + lane; e4 < 8 * 256 * 128 / 4; e4 += G * 4 * 64) { const int e = e4 * 4; const int bh = e >> 15, h = bh & 3; const int r = e & 32767;
            const float g64 = __expf(64.f * __logf(1.f - exp2f(-5.f - (float)h)));
            const bf16* src = KV + (size_t)bh * 64 * 32768 + r; bf16* dst = PREV + (size_t)bh * 64 * 32768 + r; float st[4] = {0.f, 0.f, 0.f, 0.f};
#pragma unroll 16
            for (int n = 0; n < 64; ++n) { const v2u kv = *(const v2u*)(src + (size_t)n * 32768);
                v2u w; w.x = pk2(st[0], st[1]); w.y = pk2(st[2], st[3]); *(v2u*)(dst + (size_t)n * 32768) = w;
                st[0] = g64 * st[0] + bflo(kv.x); st[1] = g64 * st[1] + bfhi(kv.x); st[2] = g64 * st[2] + bflo(kv.y); st[3] = g64 * st[3] + bfhi(kv.y); } }
    }
    SEAM(10);

    for (int rep_ = 0; rep_ < NREP(11); ++rep_) if (IN(11)) { if (rep_) GRID_BAR(); PHASE_ENV();
        for (int u = vcu; u < 256; u += G) { const int bh = u >> 5, np = u & 31;
            att::ret_out_unit<CD_IN, DM>(P, ROPE, PREV, AIN(11), OB16, bh >> 2, bh & 3, np, (char*)lds); }
    }
    SEAM(11);

    for (int rep_ = 0; rep_ < NREP(12); ++rep_) if (IN(12)) { if (rep_) GRID_BAR(); PHASE_ENV(); pg8::Gemm g{OB16, W_CDOUT, MTOK, DM, DM}; pg8::StaticOrder S; S.init(MTOK, DM, G, bx);
        pg8::EpiRes E{nullptr, XN, DM, SS + 3 * MTOK}; pg8::gemm_phase<pg8::EpiRes, pg8::StaticOrder, false, true>(ldsl, g, S, E, tid); }
    SEAM(12);

    FFN_PHASES(13, W_UP1, W_DN1, 1, 3, 4)

    for (int rep_ = 0; rep_ < NREP(16); ++rep_) if (IN(16) && G != 256) { if (rep_) GRID_BAR(); PHASE_ENV(); const float* fg = AIN(3); const unsigned long long* ss4 = SS + 4 * MTOK;
        for (int m0 = gw * 4; m0 < MTOK; m0 += NGW * 4) { v4u v[4][4]; float rstd[4];
#pragma unroll
            for (int rr = 0; rr < 4; ++rr) { const GAS v4u* xr = (const GAS v4u*)(XN + (size_t)(m0 + rr) * DM) + lane;
#pragma unroll
                for (int j = 0; j < 4; ++j) v[rr][j] = xr[64 * j];
                rstd[rr] = rsqrtf((float)ss4[m0 + rr] * (1.f / 16777216.f / DM) + EPS); }
#pragma unroll
            for (int rr = 0; rr < 4; ++rr) { float* orow = ap_->out + (size_t)(m0 + rr) * DM;
#pragma unroll
                for (int j = 0; j < 4; ++j) { const int c0 = (64 * j + lane) * 8; const f32x4 g0 = *(const f32x4*)(fg + c0), g1 = *(const f32x4*)(fg + c0 + 4); const float r_ = rstd[rr];
                    const f32x4 o0 = {bflo(v[rr][j].x) * r_ * g0.x, bfhi(v[rr][j].x) * r_ * g0.y, bflo(v[rr][j].y) * r_ * g0.z, bfhi(v[rr][j].y) * r_ * g0.w};
                    const f32x4 o1 = {bflo(v[rr][j].z) * r_ * g1.x, bfhi(v[rr][j].z) * r_ * g1.y, bflo(v[rr][j].w) * r_ * g1.z, bfhi(v[rr][j].w) * r_ * g1.w};
                    *(GAS f32x4*)(orow + c0) = o0; *(GAS f32x4*)(orow + c0 + 4) = o1; } } }
    }
#undef IN
#undef SEAM
}

extern "C" void kernel_launch(void* const* d_in, const int* in_sizes, int n_in, void* d_out, int out_size, void* d_ws, size_t ws_size, hipStream_t stream) {
    static int grid = 0;
    if (grid == 0) {
        if (n_in != 20 || in_sizes[0] != MTOK * DM || out_size != MTOK * DM || ws_size < WS_END) {
            fprintf(stderr, "kernel_launch: unexpected shapes: n_in %d in0 %d out %d ws %zu (need >= %zu)\n", n_in, n_in > 0 ? in_sizes[0] : -1, out_size, ws_size, (size_t)WS_END); grid = -1; return; }
        int dev = 0, cus = 0;
        if (hipGetDevice(&dev) != hipSuccess || hipDeviceGetAttribute(&cus, hipDeviceAttributeMultiprocessorCount, dev) != hipSuccess) { grid = -1; return; }
        if (hipFuncSetAttribute((const void*)mega_fwd, hipFuncAttributeMaxDynamicSharedMemorySize, LDS_BYTES) != hipSuccess) { fprintf(stderr, "kernel_launch: hipFuncSetAttribute failed\n"); grid = -1; return; }
        int per_cu = 0;
        if (hipOccupancyMaxActiveBlocksPerMultiprocessor(&per_cu, (const void*)mega_fwd, NWAVES * 64, LDS_BYTES) != hipSuccess || per_cu < 1) { fprintf(stderr, "kernel_launch: occupancy query says %d blocks per CU\n", per_cu); }
        (void)hipGetLastError();
        grid = cus;
    }
    if (grid < 0) return;
    hipMemsetAsync((char*)d_ws + WS_CTL, 0, CTL_ZERO_BYTES, stream);
    Args a{};
    for (int i = 0; i < 20; ++i) a.in[i] = (const float*)d_in[i];
    a.out = (float*)d_out; a.ws = (unsigned char*)d_ws;
#if MK_PER_PHASE
    for (int p = 0; p < N_PHASES; ++p) { a.ph_lo = p; a.ph_hi = p + 1; hipLaunchKernelGGL(mega_fwd, dim3(grid), dim3(NWAVES * 64), LDS_BYTES, stream, a); }
#else
    a.ph_lo = 0; a.ph_hi = (grid == 256) ? N_PHASES - 1 : N_PHASES; hipLaunchKernelGGL         (mega_fwd, dim3(grid), dim3(NWAVES * 64), LDS_BYTES, stream, a);
#if PROBE_PHASE >= 0
    a.ph_lo = PROBE_PHASE; a.ph_hi = PROBE_PHASE + PROBE_NPH; a.sel = PROBE_SEL; a.li = 1; hipLaunchKernelGGL(mega_fwd, dim3(grid), dim3(NWAVES * 64), LDS_BYTES, stream, a);
#endif
#endif
    const hipError_t le = hipPeekAtLastError();
    if (le != hipSuccess) fprintf(stderr, "kernel_launch: launch failed: %s\n", hipGetErrorName(le));
}
```

```cpp
#include <hip/hip_runtime.h>
#include <hip/hip_bf16.h>
#include <cstdio>
#include <cstdint>

#ifndef PROBE_PHASE
#define PROBE_PHASE -1
#endif
#ifndef PROBE_SEL
#define PROBE_SEL 0
#endif
#ifndef PROBE_NPH
#define PROBE_NPH 1
#endif
#ifndef MK_PER_PHASE
#define MK_PER_PHASE 0
#endif

namespace pg8 {
#define PG8_LAS __attribute__((address_space(3)))
typedef unsigned short bf16_t;
typedef short bf16x8 __attribute__((ext_vector_type(8)));
typedef float f32x4 __attribute__((ext_vector_type(4)));
typedef unsigned u32x4 __attribute__((ext_vector_type(4)));
constexpr int BM = 256, BK = 64, HALF = 128, HTB = HALF * BK * 2, STAGE_BYTES = 8 * HTB, NXCD = 8, WGM = 8;

__host__ __device__ __forceinline__ int lds_byte(int r, int c) { const int st = (r >> 4) * 2 + (c >> 5), rr = r & 15, cc = c & 31, ob = rr * 64 + cc * 2; return st * 1024 + (ob ^ (((ob >> 9) & 1) << 5)); }
__host__ __device__ __forceinline__ void stage_rc(int b, int& R, int& C) { const int st = b / 1024, sb = b % 1024, swz = sb ^ (((sb >> 9) & 1) << 5); R = (st >> 1) * 16 + swz / 64; C = (st & 1) * 32 + (swz % 64) / 2; }
__host__ __device__ __forceinline__ int perm32(int rho) { const int n = rho >> 4, i = rho & 15; return 8 * (i >> 2) + 4 * n + (i & 3); }

struct Unit { int pm, pn; };
struct Gemm { const bf16_t* A; const bf16_t* Bt; int M, N, K; };

struct StaticOrder {
    int nM, nN, nwg, G, c;
    __host__ __device__ void init(int M, int N, int G_, int c_) { nM = M / BM; nN = N / BM; nwg = nM * nN; G = G_; c = c_; }
    __host__ __device__ bool next(int i, Unit& u) const {
        const long L = (long)i * G + c; if (L >= nwg) return false;
        int wgid = (int)L; { const int q = nwg / NXCD, r = nwg % NXCD, xcd = wgid % NXCD, off = wgid / NXCD; wgid = (xcd < r ? xcd * (q + 1) : r * (q + 1) + (xcd - r) * q) + off; }
        const int nig = WGM * nN, gid = wgid / nig, fm = gid * WGM, gsz = (nM - fm) < WGM ? (nM - fm) : WGM;
        u.pm = fm + ((wgid % nig) % gsz); u.pn = (wgid % nig) / gsz; return true;
    }
    __device__ __forceinline__ void a_ready(const Unit&) const {}
    __device__ __forceinline__ void done(const Unit&) const {}
};

__device__ __forceinline__ unsigned cvt_pk_bf16(float lo, float hi) { unsigned r; asm volatile("v_cvt_pk_bf16_f32 %0, %1, %2" : "=v"(r) : "v"(lo), "v"(hi)); return r; }

__device__ __forceinline__ float gelu_tanh_e(float x) { const float u = 0.7978845608028654f * (x + 0.044715f * x * x * x); const float t = 1.f - 2.f / (__expf(2.f * u) + 1.f); return 0.5f * x * (1.f + t); }
struct EpiBf16 {
    static constexpr bool PERM = true, AFTER_DRAIN = false;
    bf16_t* O; int ldc; const unsigned long long* ss; unsigned long long* lnsum; int ln_pn0, ln_pn1;
    __device__ __forceinline__ void operator()(const f32x4 (&acc)[2][2][4][2], const Unit& u, int wr, int wc, int fr, int fq) const {
        const int row0 = u.pm * BM + wr * 64 + fr; const int col0 = u.pn * BM + wc * 32 + 8 * fq;
        const bool do_ln = lnsum != nullptr && u.pn >= ln_pn0 && u.pn < ln_pn1;
        unsigned long long ssv[2][4];
#pragma unroll
        for (int ai = 0; ai < 2; ++ai)
#pragma unroll
            for (int m = 0; m < 4; ++m) ssv[ai][m] = ss ? __hip_atomic_load(ss + row0 + ai * HALF + m * 16, __ATOMIC_RELAXED, __HIP_MEMORY_SCOPE_AGENT) : 0ull;
#pragma unroll
        for (int ai = 0; ai < 2; ++ai)
#pragma unroll
            for (int m = 0; m < 4; ++m) { const int row = row0 + ai * HALF + m * 16; bf16_t* rowp = O + (size_t)row * ldc + col0;
                const float sc = ss ? __builtin_amdgcn_rsqf((float)ssv[ai][m] * (1.f / 16777216.f / 2048.f) + 1e-6f) : 1.f;
                float s1 = 0.f, s2 = 0.f;
#pragma unroll
                for (int bj = 0; bj < 2; ++bj) { const f32x4 v0 = acc[ai][bj][m][0] * sc, v1 = acc[ai][bj][m][1] * sc;
                    u32x4 w; w.x = cvt_pk_bf16(v0[0], v0[1]); w.y = cvt_pk_bf16(v0[2], v0[3]); w.z = cvt_pk_bf16(v1[0], v1[1]); w.w = cvt_pk_bf16(v1[2], v1[3]);
                    *(u32x4*)(rowp + bj * HALF) = w;
                    if (do_ln) {
#pragma unroll
                        for (int q = 0; q < 4; ++q) { const float a = gelu_tanh_e(v0[q]), b = gelu_tanh_e(v1[q]); s1 += a + b; s2 += a * a + b * b; } } }
                if (do_ln) { s1 += __shfl_xor(s1, 16); s1 += __shfl_xor(s1, 32); s2 += __shfl_xor(s2, 16); s2 += __shfl_xor(s2, 32);
                    if (fq == 0) { atomicAdd(lnsum + 2 * row, (unsigned long long)(long long)(s1 * 16777216.f)); atomicAdd(lnsum + 2 * row + 1, (unsigned long long)(long long)(s2 * 16777216.f)); } } }
    }
};
struct EpiRes {
    static constexpr bool PERM = true, AFTER_DRAIN = false;
    const float* basef; bf16_t* xb; int ldc; unsigned long long* ss;
    __device__ __forceinline__ void operator()(const f32x4 (&acc)[2][2][4][2], const Unit& u, int wr, int wc, int fr, int fq) const {
        const int row0 = u.pm * BM + wr * 64 + fr; const int col0 = u.pn * BM + wc * 32 + 8 * fq;
#pragma unroll
        for (int ai = 0; ai < 2; ++ai)
#pragma unroll
            for (int m = 0; m < 4; ++m) { const int row = row0 + ai * HALF + m * 16; const size_t off = (size_t)row * ldc + col0; float sq = 0.f;
#pragma unroll
                for (int bj = 0; bj < 2; ++bj) { f32x4 b0, b1;
                    if (basef) { b0 = *(const f32x4*)(basef + off + bj * HALF); b1 = *(const f32x4*)(basef + off + bj * HALF + 4); }
                    else { const u32x4 w = *(const u32x4*)(xb + off + bj * HALF);
                        b0 = (f32x4){__builtin_bit_cast(float, w.x << 16), __builtin_bit_cast(float, w.x & 0xffff0000u), __builtin_bit_cast(float, w.y << 16), __builtin_bit_cast(float, w.y & 0xffff0000u)};
                        b1 = (f32x4){__builtin_bit_cast(float, w.z << 16), __builtin_bit_cast(float, w.z & 0xffff0000u), __builtin_bit_cast(float, w.w << 16), __builtin_bit_cast(float, w.w & 0xffff0000u)}; }
                    const f32x4 o0 = b0 + acc[ai][bj][m][0], o1 = b1 + acc[ai][bj][m][1];
                    u32x4 w; w.x = cvt_pk_bf16(o0[0], o0[1]); w.y = cvt_pk_bf16(o0[2], o0[3]); w.z = cvt_pk_bf16(o1[0], o1[1]); w.w = cvt_pk_bf16(o1[2], o1[3]);
                    *(u32x4*)(xb + off + bj * HALF) = w;
#pragma unroll
                    for (int q = 0; q < 4; ++q) { const unsigned ww = q == 0 ? w.x : q == 1 ? w.y : q == 2 ? w.z : w.w; const float lo = __builtin_bit_cast(float, ww << 16), hi = __builtin_bit_cast(float, ww & 0xffff0000u); sq += lo * lo + hi * hi; } }
                sq += __shfl_xor(sq, 16); sq += __shfl_xor(sq, 32);
                if (fq == 0) atomicAdd(ss + row, (unsigned long long)(sq * 16777216.f)); }
    }
};

struct EpiConv {
    static constexpr bool PERM = true, AFTER_DRAIN = false;
    bf16_t* act; const unsigned long long* ss; const float* cw; const float* cb; bf16_t* halo; PG8_LAS unsigned char* lds0;
    static constexpr int NFF = 5632, NFF2 = 11264;
    static constexpr int HX = STAGE_BYTES + 1024, CPAR = HX + 4096;
    __device__ __forceinline__ static int hxi(int wr, int ai, int rs, int bj, int wc, int fq) { return ((((((wr * 2 + ai) * 2 + rs) * 2 + bj) * 4 + wc) * 4 + fq) * 16); }
    __device__ __forceinline__ static u32x4 bperm4(int addr, u32x4 v) {
        u32x4 r; r.x = (unsigned)__builtin_amdgcn_ds_bpermute(addr, (int)v.x); r.y = (unsigned)__builtin_amdgcn_ds_bpermute(addr, (int)v.y);
        r.z = (unsigned)__builtin_amdgcn_ds_bpermute(addr, (int)v.z); r.w = (unsigned)__builtin_amdgcn_ds_bpermute(addr, (int)v.w); return r; }
    __device__ __forceinline__ void operator()(const f32x4 (&acc)[2][2][4][2], const Unit& u, int wr, int wc, int fr, int fq) const {
        asm volatile("" : "+v"(fr), "+v"(fq));
        typedef float f32x2 __attribute__((ext_vector_type(2)));
        const int lane = fq * 16 + fr, tid = (wr * 4 + wc) * 64 + lane;
        { PG8_LAS float* cp = (PG8_LAS float*)(lds0 + CPAR);
#pragma unroll
          for (int e = 0; e < 2; ++e) { const int idx = tid * 2 + e, bj = idx >> 9, j = (idx >> 7) & 3, c = idx & 127; const int gcol = bj * NFF + u.pn * 128 + c;
              cp[idx] = j < 3 ? cw[(size_t)j * NFF2 + gcol] : cb[gcol]; } }
        u32x4 pk[2][2][4];
        unsigned long long ssv[2][4];
#pragma unroll
        for (int ai = 0; ai < 2; ++ai)
#pragma unroll
            for (int m = 0; m < 4; ++m) ssv[ai][m] = __hip_atomic_load(ss + u.pm * BM + ai * HALF + wr * 64 + m * 16 + fr, __ATOMIC_RELAXED, __HIP_MEMORY_SCOPE_AGENT);
#pragma unroll
        for (int ai = 0; ai < 2; ++ai)
#pragma unroll
            for (int m = 0; m < 4; ++m) {
                const float sc = __builtin_amdgcn_rsqf((float)ssv[ai][m] * (1.f / 16777216.f / 2048.f) + 1e-6f);
#pragma unroll
                for (int bj = 0; bj < 2; ++bj) { const f32x4 v0 = acc[ai][bj][m][0] * sc, v1 = acc[ai][bj][m][1] * sc;
                    pk[ai][bj][m] = (u32x4){cvt_pk_bf16(v0[0], v0[1]), cvt_pk_bf16(v0[2], v0[3]), cvt_pk_bf16(v1[0], v1[1]), cvt_pk_bf16(v1[2], v1[3])}; } }
        const int pcol = u.pn * 256 + wc * 32 + 8 * fq;
        if (fr >= 14) {
#pragma unroll
            for (int ai = 0; ai < 2; ++ai)
#pragma unroll
                for (int bj = 0; bj < 2; ++bj) *(PG8_LAS u32x4*)(lds0 + HX + hxi(wr, ai, fr - 14, bj, wc, fq)) = pk[ai][bj][3];
            if (wr == 1) {
#pragma unroll
                for (int bj = 0; bj < 2; ++bj) *(u32x4*)(halo + ((size_t)u.pm * 4 + 2 + (fr - 14)) * NFF2 + pcol + bj * HALF) = pk[1][bj][3]; } }
        if (wr == 0 && fr < 2) {
#pragma unroll
            for (int bj = 0; bj < 2; ++bj) *(u32x4*)(halo + ((size_t)u.pm * 4 + fr) * NFF2 + pcol + bj * HALF) = pk[0][bj][0]; }
        asm volatile("s_waitcnt lgkmcnt(0)" ::: "memory"); __builtin_amdgcn_s_barrier(); asm volatile("" ::: "memory");
        const int i1 = ((lane & 48) | ((fr + 15) & 15)) * 4, i2 = ((lane & 48) | ((fr + 14) & 15)) * 4;
        const int ca = u.pn * 128 + wc * 32 + 8 * fq;
        const PG8_LAS float* cpl = (const PG8_LAS float*)(lds0 + CPAR) + wc * 32 + 8 * fq;
#define PG8_BLO(w_) __builtin_bit_cast(float, (w_) << 16)
#define PG8_BHI(w_) __builtin_bit_cast(float, (w_) & 0xffff0000u)
#define PG8_W(v_, q_) ((q_) == 0 ? (v_).x : (q_) == 1 ? (v_).y : (q_) == 2 ? (v_).z : (v_).w)
#define PG8_X2(v_, q_) ((f32x2){PG8_BLO(PG8_W(v_, q_)), PG8_BHI(PG8_W(v_, q_))})
#pragma unroll
        for (int ai = 0; ai < 2; ++ai) {
            const bool top = (wr == 0 && ai == 0);
            u32x4 q1[2], q2[2];
            if (top) { q1[0] = (u32x4){0u, 0u, 0u, 0u}; q1[1] = q1[0]; q2[0] = q1[0]; q2[1] = q1[0]; }
            else { const int swr = wr == 1 ? 0 : 1, sai = wr == 1 ? ai : 0;
#pragma unroll
                for (int bj = 0; bj < 2; ++bj) { const u32x4 h14 = *(const PG8_LAS u32x4*)(lds0 + HX + hxi(swr, sai, 0, bj, wc, fq)), h15 = *(const PG8_LAS u32x4*)(lds0 + HX + hxi(swr, sai, 1, bj, wc, fq));
                    q1[bj] = h15; q2[bj] = fr == 0 ? h14 : h15; } }
#pragma unroll
            for (int m = 0; m < 4; ++m) {
                const PG8_LAS float* cpb = cpl; asm volatile("" : "+v"(cpb));
                f32x2 cv[2][4];
#pragma unroll
                for (int bj = 0; bj < 2; ++bj) { const u32x4 cur = pk[ai][bj][m];
                    const u32x4 s1 = bperm4(i1, cur), s2 = bperm4(i2, cur);
                    const u32x4 p1 = fr == 0 ? q1[bj] : s1, p2 = fr < 2 ? q2[bj] : s2;
                    q1[bj] = s1; q2[bj] = s2;
#pragma unroll
                    for (int q = 0; q < 4; ++q) { const f32x2 w0 = *(const PG8_LAS f32x2*)(cpb + bj * 512 + 2 * q), w1 = *(const PG8_LAS f32x2*)(cpb + bj * 512 + 128 + 2 * q), w2 = *(const PG8_LAS f32x2*)(cpb + bj * 512 + 256 + 2 * q), bb = *(const PG8_LAS f32x2*)(cpb + bj * 512 + 384 + 2 * q);
                        cv[bj][q] = bb + w0 * PG8_X2(p2, q) + w1 * PG8_X2(p1, q) + w2 * PG8_X2(cur, q); } }
                float o[8];
#pragma unroll
                for (int q = 0; q < 4; ++q) { const f32x2 gv = cv[1][q]; const f32x2 sg = {__builtin_amdgcn_rcpf(1.f + __expf(-gv.x)), __builtin_amdgcn_rcpf(1.f + __expf(-gv.y))};
                    const f32x2 ov = cv[0][q] * gv * sg; o[2 * q] = ov.x; o[2 * q + 1] = ov.y; }
                u32x4 out; out.x = cvt_pk_bf16(o[0], o[1]); out.y = cvt_pk_bf16(o[2], o[3]); out.z = cvt_pk_bf16(o[4], o[5]); out.w = cvt_pk_bf16(o[6], o[7]);
                const int row = u.pm * BM + ai * HALF + wr * 64 + m * 16 + fr;
                if (!(top && m == 0 && fr < 2)) *(u32x4*)(act + (size_t)row * NFF + ca) = out;
                __builtin_amdgcn_sched_barrier(0); } }
#undef PG8_BLO
#undef PG8_BHI
#undef PG8_W
#undef PG8_X2
    }
};

struct EpiFinal {
    static constexpr bool PERM = true, AFTER_DRAIN = true;
    const bf16_t* xb; int ldc; unsigned long long* ss; unsigned* cnt; const float* g; float* out;
    __device__ __forceinline__ void fused(f32x4 (&acc)[2][2][4][2], const Unit& u, int wr, int wc, int fr, int fq, PG8_LAS unsigned char* lds, int wid, int lane) const {
        const int row0 = u.pm * BM + wr * 64 + fr; const int col0 = u.pn * BM + wc * 32 + 8 * fq;
        unsigned long long keep = 0ull;
#pragma unroll
        for (int ai = 0; ai < 2; ++ai)
#pragma unroll
            for (int m = 0; m < 4; ++m) { const int row = row0 + ai * HALF + m * 16; const size_t off = (size_t)row * ldc + col0; float sq = 0.f;
#pragma unroll
                for (int bj = 0; bj < 2; ++bj) { const u32x4 w = *(const u32x4*)(xb + off + bj * HALF);
                    const f32x4 b0 = {__builtin_bit_cast(float, w.x << 16), __builtin_bit_cast(float, w.x & 0xffff0000u), __builtin_bit_cast(float, w.y << 16), __builtin_bit_cast(float, w.y & 0xffff0000u)};
                    const f32x4 b1 = {__builtin_bit_cast(float, w.z << 16), __builtin_bit_cast(float, w.z & 0xffff0000u), __builtin_bit_cast(float, w.w << 16), __builtin_bit_cast(float, w.w & 0xffff0000u)};
                    const f32x4 o0 = b0 + acc[ai][bj][m][0], o1 = b1 + acc[ai][bj][m][1]; acc[ai][bj][m][0] = o0; acc[ai][bj][m][1] = o1;
                    sq += (o0[0] * o0[0] + o0[1] * o0[1]) + (o0[2] * o0[2] + o0[3] * o0[3]) + (o1[0] * o1[0] + o1[1] * o1[1]) + (o1[2] * o1[2] + o1[3] * o1[3]); }
                sq += __shfl_xor(sq, 16); sq += __shfl_xor(sq, 32);
                if (fq == 0) keep += atomicAdd(ss + row, (unsigned long long)(sq * 16777216.f)); }
        asm volatile("s_waitcnt vmcnt(0)" :: "v"((unsigned)keep), "v"((unsigned)(keep >> 32)) : "memory");
        if (lane == 0) __hip_atomic_fetch_add(cnt + 64 * u.pm, 1u, __ATOMIC_RELAXED, __HIP_MEMORY_SCOPE_AGENT);
        if (wid == 0) { unsigned sp = 0;
            while ((unsigned)__builtin_amdgcn_readfirstlane(__hip_atomic_load(cnt + 64 * u.pm, __ATOMIC_RELAXED, __HIP_MEMORY_SCOPE_AGENT)) < 64u) { __builtin_amdgcn_s_sleep(2); if (++sp > (1u << 22)) break; } }
        asm volatile("s_waitcnt vmcnt(0) lgkmcnt(0)" ::: "memory"); __builtin_amdgcn_s_barrier(); asm volatile("" ::: "memory");
        unsigned long long ssv[2][4];
#pragma unroll
        for (int ai = 0; ai < 2; ++ai)
#pragma unroll
            for (int m = 0; m < 4; ++m) ssv[ai][m] = __hip_atomic_load(ss + row0 + ai * HALF + m * 16, __ATOMIC_RELAXED, __HIP_MEMORY_SCOPE_AGENT);
#pragma unroll
        for (int ai = 0; ai < 2; ++ai)
#pragma unroll
            for (int m = 0; m < 4; ++m) { const int row = row0 + ai * HALF + m * 16; const size_t off = (size_t)row * ldc + col0;
                const float rstd = __builtin_amdgcn_rsqf((float)ssv[ai][m] * (1.f / 16777216.f / 2048.f) + 1e-6f);
#pragma unroll
                for (int bj = 0; bj < 2; ++bj) { const f32x4 g0 = *(const f32x4*)(g + col0 + bj * HALF), g1 = *(const f32x4*)(g + col0 + bj * HALF + 4);
                    *(f32x4*)(out + off + bj * HALF) = acc[ai][bj][m][0] * rstd * g0; *(f32x4*)(out + off + bj * HALF + 4) = acc[ai][bj][m][1] * rstd * g1; } }
    }
};

template <class Epi, class Sched, bool ALIGN_EPI = false, bool SP2 = false>
__device__ __forceinline__ void gemm_phase(PG8_LAS unsigned char* lds, const Gemm g, const Sched& S, const Epi& E, const int tid) {
    const int wid = __builtin_amdgcn_readfirstlane(tid >> 6), lane = tid & 63, wr = wid >> 2, wc = wid & 3, fr = lane & 15, fq = lane >> 4;
    const int K = g.K, nt = K / BK;
    unsigned voffA[2], voffB[2];
#pragma unroll
    for (int i = 0; i < 2; ++i) { int R, C; stage_rc(tid * 16 + i * 8192, R, C); const int Rb = Epi::PERM ? ((R & ~31) + perm32(R & 31)) : R;
        voffA[i] = (unsigned)(R * K + C) * 2u; voffB[i] = (unsigned)(Rb * K + C) * 2u; }
    const size_t kstep = (size_t)(BK * 2);
    const size_t hstep = (size_t)HALF * K * 2;
    const size_t tstep = 2 * hstep;
    const unsigned ldsw = (unsigned)wid * 1024u;
    const int aoff = lds_byte(wr * 64 + fr, fq * 8), boff = lds_byte(wc * 32 + fr, fq * 8);
#define PG8_SA(b, h) (((b) * 2 + (h)) * HTB)
#define PG8_SB(b, h) ((4 + (b) * 2 + (h)) * HTB)
#define PG8_STAGE(bufoff, gbase, voff) do { _Pragma("unroll") for (int _i = 0; _i < 2; ++_i) \
        __builtin_amdgcn_global_load_lds((const unsigned*)((const char*)(gbase) + (voff)[_i]), (PG8_LAS unsigned*)(lds + (bufoff) + ldsw + _i * 8192), 16, 0, 0); } while (0)
#define PG8_LDA(dst, b, h) do { _Pragma("unroll") for (int m = 0; m < 4; ++m) _Pragma("unroll") for (int k = 0; k < 2; ++k) dst[m][k] = *(const PG8_LAS bf16x8*)(lds + PG8_SA(b, h) + aoff + m * 2048 + k * 1024); } while (0)
#define PG8_LDB(dst, b, h) do { _Pragma("unroll") for (int n = 0; n < 2; ++n) _Pragma("unroll") for (int k = 0; k < 2; ++k) dst[n][k] = *(const PG8_LAS bf16x8*)(lds + PG8_SB(b, h) + boff + n * 2048 + k * 1024); } while (0)
#define PG8_MMA(ai, bj, At, Bt) do { __builtin_amdgcn_s_setprio(1); _Pragma("unroll") for (int m = 0; m < 4; ++m) _Pragma("unroll") for (int n = 0; n < 2; ++n) _Pragma("unroll") for (int k = 0; k < 2; ++k) \
        acc[ai][bj][m][n] = __builtin_amdgcn_mfma_f32_16x16x32_bf16(Bt[n][k], At[m][k], acc[ai][bj][m][n], 0, 0, 0); __builtin_amdgcn_s_setprio(0); } while (0)
#define PG8_WAIT_V(n) asm volatile("s_waitcnt vmcnt(" #n ")" ::: "memory")
#define PG8_WAIT_L(n) asm volatile("s_waitcnt lgkmcnt(" #n ")" ::: "memory")
#define PG8_BAR __builtin_amdgcn_s_barrier()
#define PG8_SCHED __builtin_amdgcn_sched_barrier(0)
    Unit cur, nxt; int ui = 0;
    if (!S.next(0, cur)) return;
    f32x4 acc[2][2][4][2];
#pragma unroll
    for (int a = 0; a < 2; ++a)
#pragma unroll
        for (int b = 0; b < 2; ++b)
#pragma unroll
            for (int m = 0; m < 4; ++m)
#pragma unroll
                for (int n = 0; n < 2; ++n) acc[a][b][m][n] = (f32x4){0.f, 0.f, 0.f, 0.f};
    bf16x8 At[4][2], B0[2][2], B1[2][2];
    const char* cA = (const char*)g.A + (size_t)cur.pm * tstep; const char* cB = (const char*)g.Bt + (size_t)cur.pn * tstep;
    S.a_ready(cur);
    if constexpr (SP2) {
        PG8_STAGE(PG8_SB(0, 0), cB, voffB); PG8_STAGE(PG8_SB(0, 1), cB + hstep, voffB); PG8_STAGE(PG8_SA(0, 0), cA, voffA); PG8_STAGE(PG8_SA(0, 1), cA + hstep, voffA);
        if (wr == 1) PG8_BAR;
        PG8_WAIT_V(2); PG8_BAR;
        PG8_STAGE(PG8_SB(1, 0), cB + kstep, voffB); PG8_STAGE(PG8_SA(1, 0), cA + kstep, voffA); PG8_STAGE(PG8_SB(1, 1), cB + hstep + kstep, voffB);
        PG8_WAIT_V(6); PG8_BAR;
    } else {
        PG8_STAGE(PG8_SB(0, 0), cB, voffB); PG8_STAGE(PG8_SA(0, 0), cA, voffA); PG8_STAGE(PG8_SB(0, 1), cB + hstep, voffB); PG8_STAGE(PG8_SA(0, 1), cA + hstep, voffA);
        if (wr == 1) PG8_BAR;
        PG8_WAIT_V(4); PG8_BAR;
        PG8_STAGE(PG8_SB(1, 0), cB + kstep, voffB); PG8_STAGE(PG8_SA(1, 0), cA + kstep, voffA); PG8_STAGE(PG8_SB(1, 1), cB + hstep + kstep, voffB);
        PG8_WAIT_V(6); PG8_BAR;
    }
    for (;;) {
        const bool has_next = S.next(ui + 1, nxt);
        const char* nA = has_next ? (const char*)g.A + (size_t)nxt.pm * tstep : cA; const char* nB = has_next ? (const char*)g.Bt + (size_t)nxt.pn * tstep : cB;
        for (int t = 0; t < nt; t += 2) {
            const bool last = (t == nt - 2);
            const char* a1 = cA + (size_t)(t + 1) * kstep;
            const char* a2 = last ? nA : cA + (size_t)(t + 2) * kstep; const char* b2 = last ? nB : cB + (size_t)(t + 2) * kstep;
            const char* a3 = a2 + kstep; const char* b3 = b2 + kstep;
            if (last && has_next) S.a_ready(nxt);
            if constexpr (SP2) {
            PG8_LDB(B0, 0, 0); PG8_LDB(B1, 0, 1); PG8_SCHED; PG8_LDA(At, 0, 0); PG8_STAGE(PG8_SA(1, 1), a1 + hstep, voffA);
            PG8_WAIT_V(8); PG8_WAIT_L(0); PG8_BAR; PG8_MMA(0, 0, At, B0); PG8_MMA(0, 1, At, B1); PG8_BAR; PG8_SCHED;
            PG8_LDA(At, 0, 1); PG8_STAGE(PG8_SB(0, 0), b2, voffB); PG8_STAGE(PG8_SB(0, 1), b2 + hstep, voffB); PG8_STAGE(PG8_SA(0, 0), a2, voffA);
            PG8_WAIT_V(8); PG8_WAIT_L(0); PG8_BAR; PG8_MMA(1, 0, At, B0); PG8_MMA(1, 1, At, B1); PG8_BAR; PG8_SCHED;
            PG8_LDB(B0, 1, 0); PG8_LDB(B1, 1, 1); PG8_SCHED; PG8_LDA(At, 1, 0); PG8_STAGE(PG8_SA(0, 1), a2 + hstep, voffA);
            PG8_WAIT_V(8); PG8_WAIT_L(0); PG8_BAR; PG8_MMA(0, 0, At, B0); PG8_MMA(0, 1, At, B1); PG8_BAR; PG8_SCHED;
            PG8_LDA(At, 1, 1); PG8_STAGE(PG8_SB(1, 0), b3, voffB); PG8_STAGE(PG8_SB(1, 1), b3 + hstep, voffB); PG8_STAGE(PG8_SA(1, 0), a3, voffA);
            PG8_WAIT_V(8); PG8_WAIT_L(0); PG8_BAR; PG8_MMA(1, 0, At, B0); PG8_MMA(1, 1, At, B1); PG8_BAR; PG8_SCHED;
            } else {
            PG8_LDB(B0, 0, 0); PG8_SCHED; PG8_LDA(At, 0, 0); PG8_STAGE(PG8_SA(1, 1), a1 + hstep, voffA);
            PG8_WAIT_L(8); PG8_BAR; PG8_WAIT_L(0); PG8_MMA(0, 0, At, B0); PG8_BAR; PG8_SCHED;
            PG8_LDB(B1, 0, 1); PG8_STAGE(PG8_SB(0, 0), b2, voffB);
            PG8_BAR; PG8_WAIT_L(0); PG8_MMA(0, 1, At, B1); PG8_BAR;
            PG8_LDA(At, 0, 1); PG8_STAGE(PG8_SA(0, 0), a2, voffA);
            PG8_BAR; PG8_WAIT_L(0); PG8_MMA(1, 0, At, B0); PG8_BAR; PG8_SCHED;
            PG8_STAGE(PG8_SB(0, 1), b2 + hstep, voffB);
            PG8_WAIT_V(6); PG8_BAR; PG8_MMA(1, 1, At, B1); PG8_BAR;
            PG8_LDB(B0, 1, 0); PG8_SCHED; PG8_LDA(At, 1, 0); PG8_STAGE(PG8_SA(0, 1), a2 + hstep, voffA);
            PG8_WAIT_L(8); PG8_BAR; PG8_WAIT_L(0); PG8_MMA(0, 0, At, B0); PG8_BAR; PG8_SCHED;
            PG8_LDB(B1, 1, 1); PG8_STAGE(PG8_SB(1, 0), b3, voffB);
            PG8_BAR; PG8_WAIT_L(0); PG8_MMA(0, 1, At, B1); PG8_BAR;
            PG8_LDA(At, 1, 1); PG8_STAGE(PG8_SA(1, 0), a3, voffA);
            PG8_BAR; PG8_WAIT_L(0); PG8_MMA(1, 0, At, B0); PG8_BAR; PG8_SCHED;
            PG8_STAGE(PG8_SB(1, 1), b3 + hstep, voffB);
            PG8_WAIT_V(6); PG8_BAR; PG8_MMA(1, 1, At, B1); PG8_BAR;
            }
        }
        if constexpr (ALIGN_EPI) { if (wr == 0) PG8_BAR; }
        if constexpr (!Epi::AFTER_DRAIN) { E(acc, cur, wr, wc, fr, fq); S.done(cur); }
        if (!has_next) break;
#pragma unroll
        for (int a = 0; a < 2; ++a)
#pragma unroll
            for (int b = 0; b < 2; ++b)
#pragma unroll
                for (int m = 0; m < 4; ++m)
#pragma unroll
                    for (int n = 0; n < 2; ++n) acc[a][b][m][n] = (f32x4){0.f, 0.f, 0.f, 0.f};
        cur = nxt; cA = nA; cB = nB; ++ui;
        if constexpr (ALIGN_EPI) { if (wr == 1) PG8_BAR; }
    }
    PG8_WAIT_V(0);
    if constexpr (!ALIGN_EPI) { if (wr == 0) PG8_BAR; }
    PG8_BAR;
    if constexpr (Epi::AFTER_DRAIN) { E.fused(acc, cur, wr, wc, fr, fq, lds, wid, lane); }
#undef PG8_SA
#undef PG8_SB
#undef PG8_STAGE
#undef PG8_LDA
#undef PG8_LDB
#undef PG8_MMA
#undef PG8_WAIT_V
#undef PG8_WAIT_L
#undef PG8_BAR
#undef PG8_SCHED
}
}

constexpr int DM = 2048, BATCH = 2, SEQ = 4096, MTOK = BATCH * SEQ;
constexpr int AB_IN = 6144, CD_IN = 5120, DFF = 5632, DFF2 = 11264;
constexpr float EPS = 1e-6f;
constexpr int NWAVES = 8;

#define GAS __attribute__((address_space(1)))
#define LAS __attribute__((address_space(3)))
typedef unsigned short bf16;
typedef unsigned v4u __attribute__((ext_vector_type(4)));
typedef unsigned v2u __attribute__((ext_vector_type(2)));
typedef float f32x4 __attribute__((ext_vector_type(4)));
typedef float f32x16 __attribute__((ext_vector_type(16)));
typedef short bf16x8 __attribute__((ext_vector_type(8)));
typedef short s16x4 __attribute__((ext_vector_type(4)));
typedef GAS unsigned gu32;
#define RLX_AGENT __ATOMIC_RELAXED, __HIP_MEMORY_SCOPE_AGENT
#define LDS_WAIT() asm volatile("s_waitcnt lgkmcnt(0)" ::: "memory")
#define VM_WAIT() asm volatile("s_waitcnt vmcnt(0)" ::: "memory")
__device__ __forceinline__ unsigned f2bf(float f) { unsigned u = __builtin_bit_cast(unsigned, f); return (u + 0x7fffu + ((u >> 16) & 1u)) >> 16; }
__device__ __forceinline__ unsigned pk2(float lo, float hi) { return f2bf(lo) | (f2bf(hi) << 16); }
__device__ __forceinline__ float bf2f(unsigned u16) { return __builtin_bit_cast(float, u16 << 16); }
__device__ __forceinline__ float bflo(unsigned w) { return __builtin_bit_cast(float, w << 16); }
__device__ __forceinline__ float bfhi(unsigned w) { return __builtin_bit_cast(float, w & 0xffff0000u); }
__device__ __forceinline__ float wave_sum(float v) {
#pragma unroll
    for (int o = 1; o < 64; o <<= 1) v += __shfl_xor(v, o);
    return v;
}
__device__ __forceinline__ float gelu_tanh(float x) {
    const float u = 0.7978845608028654f * (x + 0.044715f * x * x * x);
    const float t = 1.f - 2.f / (__expf(2.f * u) + 1.f);
    return 0.5f * x * (1.f + t);
}
__device__ __forceinline__ float silu_f(float x) { return x / (1.f + __expf(-x)); }

constexpr size_t MiB = 1u << 20;
constexpr size_t WS_CTL = 0, CTL_ZERO_BYTES = 1 * MiB;
constexpr size_t WS_SS = 128 * 1024;
constexpr size_t WS_LNS = 512 * 1024;
constexpr size_t WS_CNT = 768 * 1024;
constexpr size_t WS_SCAL = 1 * MiB;
constexpr size_t WS_ROPE = 2 * MiB;
constexpr size_t WS_W_ABIN = 4 * MiB;
constexpr size_t WS_W_ABOUT = WS_W_ABIN + 24 * MiB;
constexpr size_t WS_W_CDIN = WS_W_ABOUT + 8 * MiB;
constexpr size_t WS_W_CDOUT = WS_W_CDIN + 20 * MiB;
constexpr size_t WS_W_UP0 = WS_W_CDOUT + 8 * MiB;
constexpr size_t WS_W_UP1 = WS_W_UP0 + 44 * MiB;
constexpr size_t WS_W_DN0 = WS_W_UP1 + 44 * MiB;
constexpr size_t WS_W_DN1 = WS_W_DN0 + 22 * MiB;
constexpr size_t WS_XN = WS_W_DN1 + 22 * MiB;
constexpr size_t WS_O = WS_XN + 32 * MiB;
constexpr size_t WS_X = WS_O + 32 * MiB;
constexpr size_t WS_ACT = WS_X + 64 * MiB;
constexpr size_t WS_R1 = WS_ACT + 88 * MiB;
constexpr size_t WS_P = WS_R1;
constexpr size_t WS_OB = WS_R1 + 96 * MiB;
constexpr size_t WS_KV = WS_R1 + 96 * MiB;
constexpr size_t WS_PREV = WS_KV + 64 * MiB;
constexpr size_t WS_UP = WS_R1;
constexpr size_t WS_HALO = WS_R1 + 192 * MiB;
constexpr size_t WS_SCR = WS_HALO + 4 * MiB;
constexpr size_t WS_END = WS_SCR + 32 * MiB;

constexpr int RING_BYTES = 131072;
constexpr int LDSCTL_OFF = RING_BYTES, MISC_OFF = LDSCTL_OFF + 320;
constexpr int LDS_BYTES = 147456;

#define XB_TMO      128
#define XB_XCNT(j)  (256  + 64 * (j))
#define XB_XSUB(j)  (1280 + 64 * (j))
#define XB_XGEN(j)  (2304 + 64 * (j))
#define XB_TOP      3328
#define XB_TOPGEN   3392
#define XCD_BAR_WORDS 3456
#define XB_SPIN_CAP (1u << 20)
__device__ __forceinline__ unsigned xb_ld(unsigned* p)              { return __hip_atomic_load(p, __ATOMIC_RELAXED, __HIP_MEMORY_SCOPE_AGENT); }
__device__ __forceinline__ unsigned xb_add(unsigned* p, unsigned v) { return __hip_atomic_fetch_add(p, v, __ATOMIC_RELAXED, __HIP_MEMORY_SCOPE_AGENT); }
__device__ __forceinline__ unsigned xb_xcc_id() { return (unsigned)__builtin_amdgcn_s_getreg((3 << 11) | 20) & 0xFu; }
#define XB_SPIN(cond, bar) do { unsigned _sp = 0; while (cond) { __builtin_amdgcn_s_sleep(1); \
    if ((++_sp & 255u) == 0u) { if (xb_ld(&(bar)[XB_TMO])) break; if (_sp > XB_SPIN_CAP) { atomicAdd(&(bar)[XB_TMO], 1u); break; } } } } while (0)
struct XcdBarrier { unsigned* bar; unsigned x; volatile LAS unsigned* st; };
__device__ __forceinline__ XcdBarrier xcd_barrier_post(unsigned* bar, volatile LAS unsigned* st) {
    XcdBarrier b; b.bar = bar; b.x = xb_xcc_id(); b.st = st;
    if (threadIdx.x == 0) (void)xb_add(&bar[XB_XCNT(b.x)], 1u);
    return b;
}
__device__ __forceinline__ void xcd_barrier_complete(unsigned* bar, unsigned x, unsigned& nloc, unsigned& nx) {
    const unsigned G = gridDim.x * gridDim.y * gridDim.z;
    unsigned sum, cnt, mine, sp = 0u;
    for (;;) {
        sum = 0u; cnt = 0u; mine = 0u;
#pragma unroll
        for (unsigned j = 0; j < 16; ++j) { const unsigned c = xb_ld(&bar[XB_XCNT(j)]); sum += c; cnt += (c > 0u) ? 1u : 0u; mine = (j == x) ? c : mine; }
        if (sum == G) break;
        __builtin_amdgcn_s_sleep(1);
        if ((++sp & 255u) == 0u) { if (xb_ld(&bar[XB_TMO])) break; if (sp > XB_SPIN_CAP) { atomicAdd(&bar[XB_TMO], 1u); break; } }
    }
    nloc = mine > 0u ? mine : 1u; nx = cnt > 0u ? cnt : 1u;
}
__device__ __forceinline__ void xcd_barrier(const XcdBarrier& b) {
    asm volatile("s_waitcnt vmcnt(0)" ::: "memory");
    __syncthreads();
    if (threadIdx.x == 0) {
        unsigned* bar = b.bar;
        __builtin_amdgcn_s_waitcnt(0);
        unsigned nloc = b.st[0], nx = b.st[1];
        if (nloc == 0u) { xcd_barrier_complete(bar, b.x, nloc, nx); b.st[0] = nloc; b.st[1] = nx; }
        const unsigned old = xb_add(&bar[XB_XSUB(b.x)], 1u);
        const unsigned gen = old / nloc;
        if (old + 1u == (gen + 1u) * nloc) {
            __builtin_amdgcn_fence(__ATOMIC_RELEASE, "agent");
            asm volatile("s_waitcnt vmcnt(0)" ::: "memory");
            const unsigned og = xb_add(&bar[XB_TOP], 1u);
            const unsigned tg = og / nx;
            if (og + 1u == (tg + 1u) * nx) xb_add(&bar[XB_TOPGEN], 1u);
            else XB_SPIN(xb_ld(&bar[XB_TOPGEN]) == tg, bar);
            __builtin_amdgcn_fence(__ATOMIC_ACQUIRE, "agent");
            xb_add(&bar[XB_XGEN(b.x)], 1u);
            asm volatile("s_waitcnt vmcnt(0)" ::: "memory");
        } else {
            XB_SPIN(xb_ld(&bar[XB_XGEN(b.x)]) == gen, bar);
            __builtin_amdgcn_fence(__ATOMIC_ACQUIRE, "agent");
            asm volatile("s_waitcnt vmcnt(0)" ::: "memory");
        }
    }
    __syncthreads();
}

#ifndef ATT_SDEPTH
#define ATT_SDEPTH 1
#endif
namespace att {
constexpr int D = 128, QBLK = 32, KVBLK = 64;
constexpr float SCALE = 0.088388347648318440f;
constexpr float THR = 8.f;
constexpr int SHM_V = KVBLK * D * 2, SHM_K = KVBLK * D * 2;
constexpr int OFF_WS = 2 * SHM_V + 2 * SHM_K;
constexpr int OFF_TB = OFF_WS + 8 * 64 * 4;
constexpr int OFF_FLG = OFF_TB + 448 * 4;
#define KSWZ(row, colB) ((row) * 256 + ((colB) ^ (((row) & 7) << 4)))
#define SBAR() __builtin_amdgcn_sched_barrier(0)
__device__ __forceinline__ int crow(int r, int hi) { return (r & 3) + 8 * (r >> 2) + 4 * hi; }
__device__ __forceinline__ unsigned cvtpk(float lo, float hi) { unsigned r; asm volatile("v_cvt_pk_bf16_f32 %0, %1, %2" : "=v"(r) : "v"(lo), "v"(hi)); return r; }

__device__ __forceinline__ void partialSM(f32x16& p0, f32x16& p1, float& m_reg, float& mn, float& alpha) {
  constexpr float C = SCALE * 1.4426950408889634f;
  float pmax = p0[0];
#pragma unroll
  for (int r = 1; r < 16; ++r) pmax = fmaxf(pmax, p0[r]);
#pragma unroll
  for (int r = 0; r < 16; ++r) pmax = fmaxf(pmax, p1[r]);
  { auto rr = __builtin_amdgcn_permlane32_swap(__float_as_uint(pmax), __float_as_uint(pmax), false, false);
    pmax = fmaxf(__uint_as_float(rr[0]), __uint_as_float(rr[1])); }
  if (__builtin_expect(__all(pmax - m_reg <= THR / SCALE), 1)) { mn = m_reg; alpha = 1.f; }
  else { mn = fmaxf(m_reg, pmax); alpha = __builtin_amdgcn_exp2f((m_reg - mn) * C); m_reg = mn; }
  float mnC = -mn * C;
#pragma unroll
  for (int r = 0; r < 16; ++r) p0[r] = fmaf(p0[r], C, mnC);
#pragma unroll
  for (int r = 0; r < 16; ++r) p1[r] = fmaf(p1[r], C, mnC);
#pragma unroll
  for (int r = 0; r < 16; ++r) p0[r] = __builtin_amdgcn_exp2f(p0[r]);
}
#define PK4(P, BASE, OUT) do { unsigned a0 = cvtpk(P[BASE + 0], P[BASE + 1]), a1 = cvtpk(P[BASE + 2], P[BASE + 3]);   \
    unsigned b0 = cvtpk(P[BASE + 4], P[BASE + 5]), b1 = cvtpk(P[BASE + 6], P[BASE + 7]);                              \
    auto r0 = __builtin_amdgcn_permlane32_swap(a0, b0, false, false); auto r1 = __builtin_amdgcn_permlane32_swap(a1, b1, false, false); \
    v4u w = {r0[0], r1[0], r0[1], r1[1]}; OUT = *reinterpret_cast<bf16x8*>(&w); } while (0)
__device__ __forceinline__ void finishSM(f32x16& p0, f32x16& p1, float alpha, float& l_reg, bf16x8& pa0, bf16x8& pa1, bf16x8& pa2, bf16x8& pa3) {
#pragma unroll
  for (int r = 0; r < 16; ++r) p1[r] = __builtin_amdgcn_exp2f(p1[r]);
  float ps = 0;
#pragma unroll
  for (int r = 0; r < 16; ++r) ps += p0[r];
#pragma unroll
  for (int r = 0; r < 16; ++r) ps += p1[r];
  { auto rr = __builtin_amdgcn_permlane32_swap(__float_as_uint(ps), __float_as_uint(ps), false, false);
    ps = __uint_as_float(rr[0]) + __uint_as_float(rr[1]); }
  l_reg = l_reg * alpha + ps;
  PK4(p0, 0, pa0); PK4(p0, 8, pa1); PK4(p1, 0, pa2); PK4(p1, 8, pa3);
}
__device__ __forceinline__ void packP(const f32x16& p0, const f32x16& p1, bf16x8& pa0, bf16x8& pa1, bf16x8& pa2, bf16x8& pa3) {
  PK4(p0, 0, pa0); PK4(p0, 8, pa1); PK4(p1, 0, pa2); PK4(p1, 8, pa3);
}
__device__ __forceinline__ void qkt(f32x16& p0, f32x16& p1, const char* Ks, const bf16x8* qr, int r32, int hi) {
  p0 = f32x16{}; p1 = f32x16{};
#pragma unroll
  for (int d0 = 0; d0 < 8; ++d0) { int cb = (d0 * 16 + hi * 8) * 2;
    bf16x8 b0 = *reinterpret_cast<const bf16x8*>(Ks + KSWZ(r32, cb));
    bf16x8 b1 = *reinterpret_cast<const bf16x8*>(Ks + KSWZ(32 + r32, cb));
    p0 = __builtin_amdgcn_mfma_f32_32x32x16_bf16(b0, qr[d0], p0, 0, 0, 0);
    p1 = __builtin_amdgcn_mfma_f32_32x32x16_bf16(b1, qr[d0], p1, 0, 0, 0); }
}
__device__ __forceinline__ int v_st(int k, int c) { const int kk = (k & ~0xC) | ((k & 4) << 1) | ((k & 8) >> 1); return ((kk >> 3) * 4 + (c >> 5)) * 512 + ((kk & 7) * 32 + (c & 31)) * 2; }
__device__ __forceinline__ int v_rd_base(int lane) { return ((lane & 3) << 3) | (((lane >> 2) & 3) << 6) | (((lane >> 4) & 1) << 5) | (((lane >> 5) & 1) << 8); }
constexpr int v_rd_off(int d0, int ks, int half) { return d0 * 512 + ks * 4096 + half * 2048; }
template <int OFF> __device__ __forceinline__ s16x4 tr_read(int vb) {
  s16x4 r; asm volatile("ds_read_b64_tr_b16 %0, %1 offset:%2" : "=&v"(r) : "v"(vb), "i"(OFF) : "memory"); return r;
}
template <int D0> __device__ __forceinline__ void pv_one(f32x16& od, int vb, bf16x8 pa0, bf16x8 pa1, bf16x8 pa2, bf16x8 pa3) {
  const s16x4 l0 = tr_read<v_rd_off(D0, 0, 0)>(vb), h0 = tr_read<v_rd_off(D0, 0, 1)>(vb), l1 = tr_read<v_rd_off(D0, 1, 0)>(vb), h1 = tr_read<v_rd_off(D0, 1, 1)>(vb);
  const s16x4 l2 = tr_read<v_rd_off(D0, 2, 0)>(vb), h2 = tr_read<v_rd_off(D0, 2, 1)>(vb), l3 = tr_read<v_rd_off(D0, 3, 0)>(vb), h3 = tr_read<v_rd_off(D0, 3, 1)>(vb);
  asm volatile("s_waitcnt lgkmcnt(0)" ::: "memory"); SBAR();
#define PKV(L, H) (bf16x8){L[0], L[1], L[2], L[3], H[0], H[1], H[2], H[3]}
  od = __builtin_amdgcn_mfma_f32_32x32x16_bf16(pa0, PKV(l0, h0), od, 0, 0, 0);
  od = __builtin_amdgcn_mfma_f32_32x32x16_bf16(pa1, PKV(l1, h1), od, 0, 0, 0);
  od = __builtin_amdgcn_mfma_f32_32x32x16_bf16(pa2, PKV(l2, h2), od, 0, 0, 0);
  od = __builtin_amdgcn_mfma_f32_32x32x16_bf16(pa3, PKV(l3, h3), od, 0, 0, 0);
#undef PKV
}
__device__ __forceinline__ void pv_d0(f32x16* o, int vb, bf16x8 pa0, bf16x8 pa1, bf16x8 pa2, bf16x8 pa3) {
  pv_one<0>(o[0], vb, pa0, pa1, pa2, pa3); pv_one<1>(o[1], vb, pa0, pa1, pa2, pa3); pv_one<2>(o[2], vb, pa0, pa1, pa2, pa3); pv_one<3>(o[3], vb, pa0, pa1, pa2, pa3);
}

__device__ __forceinline__ void* uniform_ptr(const void* p) { const unsigned long long v = (unsigned long long)p;
  const unsigned lo = (unsigned)__builtin_amdgcn_readfirstlane((int)(unsigned)v), hi = (unsigned)__builtin_amdgcn_readfirstlane((int)(unsigned)(v >> 32)); return (void*)(((unsigned long long)hi << 32) | lo); }
__device__ __forceinline__ bf16x8 mk8a(s16x4 l, s16x4 h) { return (bf16x8){l[0], l[1], l[2], l[3], h[0], h[1], h[2], h[3]}; }
__device__ __forceinline__ bf16x8 bload16(__amdgpu_buffer_rsrc_t rs, int voff, int soff) {
  const v4u w = __builtin_amdgcn_raw_buffer_load_b128(rs, voff, soff, 0); return __builtin_bit_cast(bf16x8, w); }
template <int LDP, int LDO>
__device__ __forceinline__ void attnB_unit(const bf16* __restrict__ Qb, const bf16* Pbase, int koff, int voff, float* __restrict__ Ob, int qb, char* lds) {
  const __amdgpu_buffer_rsrc_t rs = __builtin_amdgcn_make_buffer_rsrc(uniform_ptr(Pbase), 0, SEQ * LDP * 2, 0x00020000);
  int tid = threadIdx.x; asm volatile("" : "+v"(tid));
  const int wid = tid >> 6, lane = tid & 63, r32 = lane & 31, hi = lane >> 5;
  char* V_lds = lds; char* K_lds = lds + 2 * SHM_V;
  float* ws = (float*)(lds + OFF_WS) + wid * 64; float* li_l = ws; float* al_l = ws + 32;
  const float* tb = (const float*)(lds + OFF_TB);
  float m_reg = -1e30f, l_reg = 0; f32x16 o[4] = {}; bf16x8 qr[8];
  const bf16* Qw = Qb + (long)(wid * QBLK + r32) * LDP + hi * 8;
#pragma unroll
  for (int d0 = 0; d0 < 8; ++d0) qr[d0] = *reinterpret_cast<const bf16x8*>(Qw + d0 * 16);
  const int sr = tid >> 4, sc = (tid & 15) * 8, vst0 = v_st(sr, sc), vst1 = v_st(32 + sr, sc);
  const int vb0 = (int)(uintptr_t)V_lds + v_rd_base(lane);
  constexpr int SDEPTH = ATT_SDEPTH;
  struct { bf16x8 vs0, vs1, ks0, ks1; } sr_[SDEPTH];
  const int vo0 = (sr * LDP + sc) * 2, vo1 = vo0 + 32 * LDP * 2;
#define SLOAD(i, k0) do { const int sV_ = (voff + (k0) * LDP) * 2, sK_ = (koff + (k0) * LDP) * 2; \
    sr_[i].vs0 = bload16(rs, vo0, sV_); sr_[i].vs1 = bload16(rs, vo1, sV_); sr_[i].ks0 = bload16(rs, vo0, sK_); sr_[i].ks1 = bload16(rs, vo1, sK_); } while (0)
#define SWRITE(b, i) do { *(bf16x8*)(V_lds + (b) * SHM_V + vst0) = sr_[i].vs0;          \
    *(bf16x8*)(V_lds + (b) * SHM_V + vst1) = sr_[i].vs1; int kc = sc * 2;               \
    *(bf16x8*)(K_lds + (b) * SHM_K + KSWZ(sr, kc)) = sr_[i].ks0;                       \
    *(bf16x8*)(K_lds + (b) * SHM_K + KSWZ(32 + sr, kc)) = sr_[i].ks1; } while (0)
#define SWAIT() do { if constexpr (SDEPTH == 2) asm volatile("s_waitcnt vmcnt(4)" ::: "memory"); else asm volatile("s_waitcnt vmcnt(0)" ::: "memory"); } while (0)
#define RESC(a) do { if (__any((a) < 1.f)) { if (hi == 0) al_l[r32] = (a); asm volatile("s_waitcnt lgkmcnt(0)" ::: "memory"); \
    _Pragma("unroll") for (int d = 0; d < 4; ++d) _Pragma("unroll") for (int r = 0; r < 16; ++r) o[d][r] *= al_l[crow(r, hi)]; } } while (0)
  const int NT = 4 * qb + 4, chunk_w = 4 * qb + (wid >> 1);
  const int ib0 = 4 * hi - 256 * qb - 32 * wid - r32 + 127 + 256;
#ifdef NO_FIX
#define FIX(P0, P1, j) do {} while (0)
#else
#define FIX(P0, P1, j) do { if ((j) > chunk_w) { _Pragma("unroll") for (int r = 0; r < 16; ++r) { P0[r] = -1e30f; P1[r] = -1e30f; } } \
    else if ((j) >= NT - 6) { const float* tbj = tb + (ib0 + 64 * (j)); \
      _Pragma("unroll") for (int r = 0; r < 16; ++r) { P0[r] += tbj[(r & 3) + 8 * (r >> 2)]; P1[r] += tbj[32 + (r & 3) + 8 * (r >> 2)]; } } } while (0)
#endif
  f32x16 pA0, pA1, pB0, pB1; float mnA, mnB, alA, alB; bf16x8 pa0, pa1, pa2, pa3;
  constexpr int SE = 0, SO = SDEPTH - 1;
  SLOAD(SE, 0); asm volatile("s_waitcnt vmcnt(0)" ::: "memory"); SWRITE(0, SE); __syncthreads();
  qkt(pA0, pA1, K_lds, qr, r32, hi); FIX(pA0, pA1, 0); partialSM(pA0, pA1, m_reg, mnA, alA);
  SLOAD(SO, KVBLK); if constexpr (SDEPTH == 2) { if (2 < NT) SLOAD(SE, 2 * KVBLK); }
  SWAIT(); SWRITE(1, SO); __syncthreads();
  for (int j = 1; j + 1 < NT; j += 2) {
    SBAR(); qkt(pB0, pB1, K_lds + SHM_K, qr, r32, hi);
    finishSM(pA0, pA1, alA, l_reg, pa0, pa1, pa2, pa3); SBAR();
    SLOAD(SO, (j + SDEPTH) * KVBLK); SBAR();
    pv_d0(o, vb0, pa0, pa1, pa2, pa3); FIX(pB0, pB1, j); partialSM(pB0, pB1, m_reg, mnB, alB);
    __syncthreads(); SWAIT(); SWRITE(0, SE);
    RESC(alB); __syncthreads();
    SBAR(); qkt(pA0, pA1, K_lds, qr, r32, hi);
    finishSM(pB0, pB1, alB, l_reg, pa0, pa1, pa2, pa3); SBAR();
    if (SDEPTH == 1 || j + 3 < NT) SLOAD(SE, (j + 1 + SDEPTH) * KVBLK); SBAR();
    pv_d0(o, vb0 + SHM_V, pa0, pa1, pa2, pa3); FIX(pA0, pA1, j + 1); partialSM(pA0, pA1, m_reg, mnA, alA);
    __syncthreads(); SWAIT(); SWRITE(1, SO);
    RESC(alA); __syncthreads();
  }
  SBAR(); qkt(pB0, pB1, K_lds + SHM_K, qr, r32, hi);
  finishSM(pA0, pA1, alA, l_reg, pa0, pa1, pa2, pa3); SBAR();
  pv_d0(o, vb0, pa0, pa1, pa2, pa3); FIX(pB0, pB1, NT - 1); partialSM(pB0, pB1, m_reg, mnB, alB);
  __syncthreads(); RESC(alB);
  finishSM(pB0, pB1, alB, l_reg, pa0, pa1, pa2, pa3); SBAR();
  pv_d0(o, vb0 + SHM_V, pa0, pa1, pa2, pa3);
  if (hi == 0) li_l[r32] = l_reg; asm volatile("s_waitcnt lgkmcnt(0)" ::: "memory");
  float rli[16];
#pragma unroll
  for (int r = 0; r < 16; ++r) rli[r] = __builtin_amdgcn_rcpf(li_l[crow(r, hi)]);
  float* Ow = Ob + (long)(wid * QBLK) * LDO;
#pragma unroll
  for (int r = 0; r < 16; ++r) { int orow = crow(r, hi);
#pragma unroll
    for (int d0 = 0; d0 < 4; ++d0) Ow[(long)orow * LDO + d0 * 32 + r32] = o[d0][r] * rli[r]; }
  __syncthreads();
#undef SLOAD
#undef SWRITE
#undef SWAIT
#undef RESC
#undef FIX
}

__device__ __forceinline__ void glds16_asm(const void* gsrc, unsigned lds_dst) { unsigned keep;
  asm volatile("s_mov_b32 %0, m0\n\ts_mov_b32 m0, %2\n\ts_nop 0\n\tglobal_load_lds_dwordx4 %1, off\n\ts_mov_b32 m0, %0" : "=&s"(keep) : "v"(gsrc), "s"(lds_dst) : "memory"); }
constexpr int B2_K = 0, B2_V = 2 * SHM_K, B2_P = B2_V + 4 * SHM_V, B2_X = 131072 + 1024;
constexpr int B2_AL = B2_X, B2_FL = B2_AL + 1024, B2_LI = B2_FL + 64, B2_TB = B2_LI + 512;
template <int LDP, int LDO>
__device__ __forceinline__ void attnB2_unit(const bf16* __restrict__ Qb, const bf16* Pbase, int koff, int voff, float* __restrict__ Ob, int q128, char* lds, int sel = 0) {
  int tid = threadIdx.x; asm volatile("" : "+v"(tid));
  const int wid = __builtin_amdgcn_readfirstlane(tid >> 6), lane = tid & 63, r32 = lane & 31, hi = lane >> 5, pw = wid & 3;
  const int NT = 2 * q128 + 2;
  const unsigned lbase = (unsigned)__builtin_amdgcn_readfirstlane((int)(uintptr_t)lds);
  const bf16* Ksrc; const bf16* Vsrc[4];
  { const int row0 = 8 * wid + (lane >> 4), row1 = row0 + 4;
    Ksrc = Pbase + koff + (size_t)row0 * LDP + (((lane & 15) ^ (row0 & 7)) << 3);
    (void)row1; }
  const int kx1 = (int)((((lane & 15) ^ ((8 * wid + (lane >> 4) + 4) & 7)) << 3)) - (int)((((lane & 15) ^ ((8 * wid + (lane >> 4)) & 7)) << 3));
#pragma unroll
  for (int q = 0; q < 4; ++q) { const int ci = wid * 4 + q, vt = ci >> 4, cs = ci & 15, st = cs * 2 + (lane >> 5);
    const int kk = (st >> 2) * 8 + ((lane >> 2) & 7), k = (kk & ~0xC) | ((kk & 4) << 1) | ((kk & 8) >> 1), c = vt * 128 + (st & 3) * 32 + (lane & 3) * 8;
    Vsrc[q] = Pbase + voff + (size_t)k * LDP + c; }
#define B2DMA_K(t_, b_) do { const bf16* ks_ = Ksrc + (size_t)(t_) * KVBLK * LDP; const unsigned kd_ = (unsigned)__builtin_amdgcn_readfirstlane((int)(lbase + B2_K + (b_) * SHM_K + wid * 2048)); \
    glds16_asm(ks_, kd_); glds16_asm(ks_ + 4 * LDP + kx1, kd_ + 1024); } while (0)
#define B2DMA_V(t_, b_) do { _Pragma("unroll") for (int q = 0; q < 4; ++q) { const int ci_ = wid * 4 + q; \
      glds16_asm(Vsrc[q] + (size_t)(t_) * KVBLK * LDP, (unsigned)__builtin_amdgcn_readfirstlane((int)(lbase + B2_V + (b_) * 2 * SHM_V + (ci_ >> 4) * SHM_V + (ci_ & 15) * 1024))); } } while (0)
#define B2SYNC() do { asm volatile("s_waitcnt vmcnt(0)" ::: "memory"); __syncthreads(); } while (0)
  typedef __attribute__((address_space(3))) float lds_f32; typedef __attribute__((address_space(3))) int lds_i32;
  lds_f32* al_s = (lds_f32*)(uintptr_t)(lbase + B2_AL); lds_i32* fl_s = (lds_i32*)(uintptr_t)(lbase + B2_FL); lds_f32* li_s = (lds_f32*)(uintptr_t)(lbase + B2_LI);
  B2DMA_K(0, 0); B2DMA_V(0, 0); B2DMA_K(1, 1);
  if (wid < 4) {
    const float* tb = (const float*)(lds + B2_TB);
    const int chunk_w = 2 * q128 + (pw >> 1);
    const int ib0 = 4 * hi - 128 * q128 - 32 * pw - r32 + 127 + 256;
    float m_reg = -1e30f, l_reg = 0.f; bf16x8 qr[8];
    { const bf16* Qw = Qb + (long)(pw * QBLK + r32) * LDP + hi * 8;
#pragma unroll
      for (int d0 = 0; d0 < 8; ++d0) qr[d0] = *reinterpret_cast<const bf16x8*>(Qw + d0 * 16); }
    B2SYNC();
#define B2PROD(t_) do { f32x16 p0, p1; qkt(p0, p1, lds + B2_K + ((t_) & 1) * SHM_K, qr, r32, hi); \
      if ((t_) > chunk_w) { _Pragma("unroll") for (int r = 0; r < 16; ++r) { p0[r] = -1e30f; p1[r] = -1e30f; } } \
      else if ((t_) >= NT - 4) { const float* tbj = tb + (ib0 + 64 * (t_)); \
        _Pragma("unroll") for (int r = 0; r < 16; ++r) { p0[r] += tbj[(r & 3) + 8 * (r >> 2)]; p1[r] += tbj[32 + (r & 3) + 8 * (r >> 2)]; } } \
      float mn_, al_; partialSM(p0, p1, m_reg, mn_, al_); bf16x8 pa0, pa1, pa2, pa3; finishSM(p0, p1, al_, l_reg, pa0, pa1, pa2, pa3); \
      char* pb_ = lds + B2_P + ((((t_) & 1) * 4 + pw) * 4) * 1024 + lane * 16; \
      *(bf16x8*)(pb_) = pa0; *(bf16x8*)(pb_ + 1024) = pa1; *(bf16x8*)(pb_ + 2048) = pa2; *(bf16x8*)(pb_ + 3072) = pa3; \
      if (hi == 0) al_s[(((t_) & 1) * 4 + pw) * 32 + r32] = al_; \
      const int any_ = __any(al_ < 1.f) ? 1 : 0; if (lane == 0) fl_s[((t_) & 1) * 4 + pw] = any_; } while (0)
    B2PROD(0);
    B2SYNC();
    for (int j = 0; j < NT; ++j) {
      if (j + 2 < NT) B2DMA_K(j + 2, j & 1);
      if (j + 1 < NT) B2DMA_V(j + 1, (j + 1) & 1);
      if (j + 1 < NT && !(sel & 4)) B2PROD(j + 1);
      B2SYNC();
    }
    if (hi == 0) li_s[pw * 32 + r32] = __builtin_amdgcn_rcpf(l_reg);
    __syncthreads();
#undef B2PROD
  } else {
    f32x16 o[8] = {};
    const int vb0 = (int)(uintptr_t)(lds + B2_V) + v_rd_base(lane);
    B2SYNC();
    B2SYNC();
    for (int j = 0; j < NT; ++j) {
      if (j + 2 < NT) B2DMA_K(j + 2, j & 1);
      if (j + 1 < NT) B2DMA_V(j + 1, (j + 1) & 1);
      if (!(sel & 8)) { const int bsel = j & 1;
        if (fl_s[bsel * 4 + pw]) { const lds_f32* ap = al_s + (bsel * 4 + pw) * 32;
#pragma unroll
          for (int d = 0; d < 8; ++d)
#pragma unroll
            for (int r = 0; r < 16; ++r) o[d][r] *= ap[crow(r, hi)]; }
        const char* pb_ = lds + B2_P + ((bsel * 4 + pw) * 4) * 1024 + lane * 16;
        const bf16x8 pa0 = *(const bf16x8*)(pb_), pa1 = *(const bf16x8*)(pb_ + 1024), pa2 = *(const bf16x8*)(pb_ + 2048), pa3 = *(const bf16x8*)(pb_ + 3072);
        pv_d0(o, vb0 + bsel * 2 * SHM_V, pa0, pa1, pa2, pa3); pv_d0(o + 4, vb0 + bsel * 2 * SHM_V + SHM_V, pa0, pa1, pa2, pa3); }
      B2SYNC();
    }
    __syncthreads();
    float rli[16];
#pragma unroll
    for (int r = 0; r < 16; ++r) rli[r] = li_s[pw * 32 + crow(r, hi)];
    float* Ow = Ob + (long)(pw * QBLK) * LDO;
#pragma unroll
    for (int r = 0; r < 16; ++r) { const int orow = crow(r, hi);
#pragma unroll
      for (int d = 0; d < 8; ++d) Ow[(long)orow * LDO + d * 32 + r32] = o[d][r] * rli[r]; }
  }
  __syncthreads();
#undef B2DMA_K
#undef B2DMA_V
#undef B2SYNC
}

template <int LDP, int LDO>
__device__ __forceinline__ void attnA_unit(const bf16* __restrict__ Qb, const bf16* Pbase, int koff, int voff, bf16* __restrict__ Ob, int qb, char* lds) {
  const __amdgpu_buffer_rsrc_t rs = __builtin_amdgcn_make_buffer_rsrc(uniform_ptr(Pbase), 0, SEQ * LDP * 2, 0x00020000);
  int tid = threadIdx.x; asm volatile("" : "+v"(tid));
  const int wid = __builtin_amdgcn_readfirstlane(tid >> 6), lane = tid & 63, r32 = lane & 31, hi = lane >> 5;
  char* K_lds = lds + wid * 16384; char* V_lds = K_lds + 8192;
  f32x16 o[4] = {}; bf16x8 qr[8];
  const bf16* Qw = Qb + (long)(wid * QBLK + r32) * LDP + hi * 8;
#pragma unroll
  for (int d0 = 0; d0 < 8; ++d0) qr[d0] = *reinterpret_cast<const bf16x8*>(Qw + d0 * 16);
  const int srow = lane >> 1, scol = (lane & 1) * 64;
  const int vo = (srow * LDP + scol) * 2;
  const int vb0 = (int)(uintptr_t)V_lds + v_rd_base(lane);
  const int krow = lane >> 4, kch = lane & 15;
  const unsigned klds = (unsigned)__builtin_amdgcn_readfirstlane((int)(uintptr_t)K_lds);
  const bf16* Ksrc = Pbase + koff;
  float R = 0.f;
  const int htd = 8 * qb + wid;
  bf16x8 tv[8];
#define AKDMA(ht_) do { _Pragma("unroll") for (int j = 0; j < 8; ++j) { const int row_ = 4 * j + krow; \
      __builtin_amdgcn_global_load_lds((const unsigned*)(Ksrc + (size_t)((ht_) * 32 + row_) * LDP + ((kch ^ (row_ & 7)) << 3)), (__attribute__((address_space(3))) unsigned*)(uintptr_t)(klds + j * 1024), 16, 0, 0); } } while (0)
#define AVLOAD(ht_) do { const int sV_ = __builtin_amdgcn_readfirstlane((voff + (ht_) * 32 * LDP) * 2); _Pragma("unroll") for (int j = 0; j < 8; ++j) tv[j] = bload16(rs, vo + 16 * j, sV_); } while (0)
  AKDMA(htd); AVLOAD(htd);
  for (int ht = htd; ht >= 0; --ht) {
    asm volatile("s_waitcnt vmcnt(0)" ::: "memory");
#pragma unroll
    for (int j = 0; j < 8; ++j) *(bf16x8*)(V_lds + v_st(srow, scol + 8 * j)) = tv[j];
    if (ht > 0) AVLOAD(ht - 1);
    asm volatile("s_waitcnt lgkmcnt(0)" ::: "memory");
    f32x16 p0 = f32x16{};
#pragma unroll
    for (int d0 = 0; d0 < 8; ++d0) { const int cb = (d0 * 16 + hi * 8) * 2;
      const bf16x8 b0 = *reinterpret_cast<const bf16x8*>(K_lds + KSWZ(r32, cb));
      p0 = __builtin_amdgcn_mfma_f32_32x32x16_bf16(b0, qr[d0], p0, 0, 0, 0); }
    asm volatile("s_waitcnt lgkmcnt(0)" : "+v"(p0) :: "memory");
    if (ht > 0) AKDMA(ht - 1);
    const int lim = (ht == htd) ? r32 : 32;
    float qs[4], oq[4]; f32x16 Ln;
#pragma unroll
    for (int g = 0; g < 4; ++g) { float s_ = 0.f;
#pragma unroll
      for (int i = 0; i < 4; ++i) { const int r = 4 * g + i; const float x = p0[r] * SCALE; p0[r] = x;
        const float sp = __logf(1.f + __expf(-fabsf(x))); const float ln = (crow(r, hi) < lim) ? -(fmaxf(x, 0.f) + sp) : 0.f;
        Ln[r] = ln; s_ += ln; }
      qs[g] = s_; }
#pragma unroll
    for (int g = 0; g < 4; ++g) oq[g] = __shfl_xor(qs[g], 32);
    float run = 0.f;
#pragma unroll
    for (int g = 3; g >= 0; --g) { float E = R + run + (hi == 0 ? oq[g] : 0.f);
#pragma unroll
      for (int i = 3; i >= 0; --i) { const int r = 4 * g + i;
        const bool valid = crow(r, hi) < lim;
        const float w = valid ? __expf(Ln[r] + p0[r] + E) : 0.f; E += Ln[r]; p0[r] = w; }
      run += qs[g] + oq[g]; }
    R += run;
    bf16x8 pa0, pa1; PK4(p0, 0, pa0); PK4(p0, 8, pa1);
#define AV_ONE(D0) do { const s16x4 l0 = tr_read<v_rd_off(D0, 0, 0)>(vb0), h0 = tr_read<v_rd_off(D0, 0, 1)>(vb0), l1 = tr_read<v_rd_off(D0, 1, 0)>(vb0), h1 = tr_read<v_rd_off(D0, 1, 1)>(vb0); \
      asm volatile("s_waitcnt lgkmcnt(0)" ::: "memory"); SBAR(); \
      o[D0] = __builtin_amdgcn_mfma_f32_32x32x16_bf16(pa0, mk8a(l0, h0), o[D0], 0, 0, 0); o[D0] = __builtin_amdgcn_mfma_f32_32x32x16_bf16(pa1, mk8a(l1, h1), o[D0], 0, 0, 0); } while (0)
    AV_ONE(0); AV_ONE(1); AV_ONE(2); AV_ONE(3);
#undef AV_ONE
    if (__all(R < -104.f)) break;
  }
#undef AKDMA
#undef AVLOAD
  asm volatile("s_waitcnt vmcnt(0)" ::: "memory");
  bf16* Ow = Ob + (long)(wid * QBLK) * LDO;
#pragma unroll
  for (int r = 0; r < 16; ++r) { const int orow = crow(r, hi);
#pragma unroll
    for (int d0 = 0; d0 < 4; ++d0) Ow[(long)orow * LDO + d0 * 32 + r32] = (bf16)f2bf(o[d0][r]); }
  __syncthreads();
}
__device__ __forceinline__ bf16x8 mk8(s16x4 l, s16x4 h) { return (bf16x8){l[0], l[1], l[2], l[3], h[0], h[1], h[2], h[3]}; }
__device__ __forceinline__ v4u pack8(const float* f) { v4u w; w.x = cvtpk(f[0], f[1]); w.y = cvtpk(f[2], f[3]); w.z = cvtpk(f[4], f[5]); w.w = cvtpk(f[6], f[7]); return w; }
__device__ __forceinline__ void rot8(v4u lo4, v4u hi4, const float2* cs, float mul, float* ol, float* oh) {
#pragma unroll
  for (int q = 0; q < 4; ++q) { const float2 c0 = cs[2 * q], c1 = cs[2 * q + 1];
    const float l0 = bflo(lo4[q]), l1 = bfhi(lo4[q]), h0 = bflo(hi4[q]), h1 = bfhi(hi4[q]);
    ol[2 * q] = (l0 * c0.x - h0 * c0.y) * mul; ol[2 * q + 1] = (l1 * c1.x - h1 * c1.y) * mul;
    oh[2 * q] = (h0 * c0.x + l0 * c0.y) * mul; oh[2 * q + 1] = (h1 * c1.x + l1 * c1.y) * mul; }
}
template <int LDP>
__device__ __forceinline__ void ret_kv_unit(const bf16* __restrict__ P, const float2* __restrict__ ROPE, bf16* __restrict__ kvo, int b, int h, int n, char* lds) {
  int tid = threadIdx.x; asm volatile("" : "+v"(tid));
  const int wid = tid >> 6, lane = tid & 63, r32 = lane & 31, hi = lane >> 5;
  char* Vt = lds; char* Kt = lds + 2 * SHM_V;
  const size_t t0 = (size_t)b * SEQ + 64 * n;
  const float lg = __logf(1.f - exp2f(-5.f - (float)h));
#pragma unroll
  for (int it = 0; it < 4; ++it) { const int task = it * 512 + tid, vt = task >> 10, row = (task >> 4) & 63, sc = (task & 15) * 8;
    const bf16x8 v = *reinterpret_cast<const bf16x8*>(P + (t0 + row) * LDP + 1024 + h * 256 + vt * 128 + sc);
    *(bf16x8*)(Vt + vt * SHM_V + v_st(row, sc)) = v; }
  { const int m = tid >> 3, dc = (tid & 7) * 8; const bf16* kr = P + (t0 + m) * LDP + 512 + h * 128;
    const v4u lo4 = *(const v4u*)(kr + dc), hi4 = *(const v4u*)(kr + 64 + dc);
    float ol[8], oh[8]; rot8(lo4, hi4, ROPE + (size_t)(64 * n + m) * 64 + dc, __expf(lg * (float)(63 - m)), ol, oh);
    *(v4u*)(Kt + v_st(m, dc)) = pack8(ol); *(v4u*)(Kt + v_st(m, 64 + dc)) = pack8(oh); }
  __syncthreads();
  const int vbA = (int)(uintptr_t)(Vt + (wid >> 2) * SHM_V) + v_rd_base(lane) + (wid & 3) * 512;
  const int vbB = (int)(uintptr_t)Kt + v_rd_base(lane);
  bf16x8 a[4];
  { const s16x4 l0 = tr_read<v_rd_off(0, 0, 0)>(vbA), h0 = tr_read<v_rd_off(0, 0, 1)>(vbA), l1 = tr_read<v_rd_off(0, 1, 0)>(vbA), h1 = tr_read<v_rd_off(0, 1, 1)>(vbA);
    const s16x4 l2 = tr_read<v_rd_off(0, 2, 0)>(vbA), h2 = tr_read<v_rd_off(0, 2, 1)>(vbA), l3 = tr_read<v_rd_off(0, 3, 0)>(vbA), h3 = tr_read<v_rd_off(0, 3, 1)>(vbA);
    asm volatile("s_waitcnt lgkmcnt(0)" ::: "memory"); SBAR();
    a[0] = mk8(l0, h0); a[1] = mk8(l1, h1); a[2] = mk8(l2, h2); a[3] = mk8(l3, h3); }
  f32x16 acc[4] = {};
  pv_one<0>(acc[0], vbB, a[0], a[1], a[2], a[3]); pv_one<1>(acc[1], vbB, a[0], a[1], a[2], a[3]); pv_one<2>(acc[2], vbB, a[0], a[1], a[2], a[3]); pv_one<3>(acc[3], vbB, a[0], a[1], a[2], a[3]);
#pragma unroll
  for (int db = 0; db < 4; ++db)
#pragma unroll
    for (int r = 0; r < 16; ++r) kvo[(size_t)(32 * wid + crow(r, hi)) * 128 + 32 * db + r32] = (bf16)f2bf(acc[db][r]);
  __syncthreads();
}
template <int LDP, int LDO>
__device__ __forceinline__ void ret_out_unit(const bf16* __restrict__ P, const float2* __restrict__ ROPE, const bf16* __restrict__ PREV, const float* __restrict__ rg, bf16* __restrict__ O, int b, int h, int np, char* lds) {
  int tid = threadIdx.x; asm volatile("" : "+v"(tid));
  const int wid = tid >> 6, lane = tid & 63, r32 = lane & 31, hi = lane >> 5;
  const int cw = wid >> 2, qh = (wid >> 1) & 1, eh = wid & 1, bh = b * 4 + h;
  constexpr int CH = 3 * SHM_V;
  float* red = (float*)(lds + 2 * CH);
  const float lg = __logf(1.f - exp2f(-5.f - (float)h));
#pragma unroll
  for (int cc = 0; cc < 2; ++cc) { const int n = 2 * np + cc; const size_t t0 = (size_t)b * SEQ + 64 * n;
    { const int m = tid >> 3, dc = (tid & 7) * 8; const bf16* kr = P + (t0 + m) * LDP + 512 + h * 128;
      const v4u lo4 = *(const v4u*)(kr + dc), hi4 = *(const v4u*)(kr + 64 + dc);
      float ol[8], oh[8]; rot8(lo4, hi4, ROPE + (size_t)(64 * n + m) * 64 + dc, 1.f, ol, oh);
      *(v4u*)(lds + cc * CH + KSWZ(m, dc * 2)) = pack8(ol); *(v4u*)(lds + cc * CH + KSWZ(m, (64 + dc) * 2)) = pack8(oh); }
#pragma unroll
    for (int it = 0; it < 4; ++it) { const int task = it * 512 + tid, vt = task >> 10, row = (task >> 4) & 63, sc = (task & 15) * 8;
      const bf16x8 v = *reinterpret_cast<const bf16x8*>(P + (t0 + row) * LDP + 1024 + h * 256 + vt * 128 + sc);
      *(bf16x8*)(lds + cc * CH + SHM_V + vt * SHM_V + v_st(row, sc)) = v; } }
  const int n = 2 * np + cw; const size_t tq = (size_t)b * SEQ + 64 * n + 32 * qh + r32;
  bf16x8 qr[8];
  { const bf16* qrow = P + tq * LDP + h * 128 + hi * 8; const float2* cs = ROPE + (size_t)(64 * n + 32 * qh + r32) * 64 + hi * 8;
#pragma unroll
    for (int d0 = 0; d0 < 4; ++d0) { const v4u lo4 = *(const v4u*)(qrow + d0 * 16), hi4 = *(const v4u*)(qrow + 64 + d0 * 16);
      float ol[8], oh[8]; rot8(lo4, hi4, cs + d0 * 16, SCALE, ol, oh);
      const v4u wl = pack8(ol), wh = pack8(oh); qr[d0] = __builtin_bit_cast(bf16x8, wl); qr[d0 + 4] = __builtin_bit_cast(bf16x8, wh); } }
  f32x16 o[4] = {};
  { const bf16* pv = PREV + ((size_t)bh * 64 + n) * 32768 + (size_t)(128 * eh + r32) * 128 + hi * 8;
#pragma unroll
    for (int d0 = 0; d0 < 4; ++d0)
#pragma unroll
      for (int ks = 0; ks < 8; ++ks) { const bf16x8 bf = *reinterpret_cast<const bf16x8*>(pv + (size_t)(32 * d0) * 128 + ks * 16);
        o[d0] = __builtin_amdgcn_mfma_f32_32x32x16_bf16(qr[ks], bf, o[d0], 0, 0, 0); } }
#pragma unroll
  for (int r = 0; r < 16; ++r) { const float qd = __expf(lg * (float)(32 * qh + crow(r, hi) + 1));
#pragma unroll
    for (int d0 = 0; d0 < 4; ++d0) o[d0][r] *= qd; }
  __syncthreads();
  { f32x16 p0, p1; qkt(p0, p1, lds + cw * CH, qr, r32, hi);
    const int c = 32 * qh + r32;
#pragma unroll
    for (int r = 0; r < 16; ++r) { const int m0 = crow(r, hi), m1 = m0 + 32; const int d0_ = c > m0 ? c - m0 : m0 - c, d1_ = c > m1 ? c - m1 : m1 - c;
      p0[r] *= __expf(lg * (float)d0_); p1[r] *= __expf(lg * (float)d1_); }
    bf16x8 pa0, pa1, pa2, pa3; packP(p0, p1, pa0, pa1, pa2, pa3);
    pv_d0(o, (int)(uintptr_t)(lds + cw * CH + SHM_V + eh * SHM_V) + v_rd_base(lane), pa0, pa1, pa2, pa3); }
  { float ssq[16];
#pragma unroll
    for (int r = 0; r < 16; ++r) { float s_ = (o[0][r] * o[0][r] + o[1][r] * o[1][r]) + (o[2][r] * o[2][r] + o[3][r] * o[3][r]);
      s_ += __shfl_xor(s_, 1); s_ += __shfl_xor(s_, 2); s_ += __shfl_xor(s_, 4); s_ += __shfl_xor(s_, 8); s_ += __shfl_xor(s_, 16); ssq[r] = s_; }
    if (r32 == 0) {
#pragma unroll
      for (int r = 0; r < 16; ++r) red[wid * 32 + crow(r, hi)] = ssq[r]; }
    __syncthreads();
    const size_t trow0 = (size_t)b * SEQ + 64 * n + 32 * qh;
#pragma unroll
    for (int r = 0; r < 16; ++r) { const int rl = crow(r, hi); const float tot = red[wid * 32 + rl] + red[(wid ^ 1) * 32 + rl]; const float rstd = rsqrtf(tot * (1.f / 256.f) + 1e-6f);
      const size_t row = trow0 + rl;
#pragma unroll
      for (int d0 = 0; d0 < 4; ++d0) { const int e = 128 * eh + 32 * d0 + r32;
        const float gate = silu_f(bf2f(P[row * LDP + 2048 + h * 256 + e]));
        O[row * LDO + h * 256 + e] = (bf16)f2bf(o[d0][r] * rstd * rg[e] * gate); } } }
  __syncthreads();
}
template <int LDP, int LDO>
__device__ __forceinline__ void sgu_unit(const bf16* __restrict__ P, const unsigned long long* __restrict__ lnsum, const float* __restrict__ lng, const float* __restrict__ lnb, const float* __restrict__ Wg, const float* __restrict__ bs,
                                         bf16* __restrict__ O, size_t t0, int g, char* lds) {
  int tid = threadIdx.x; asm volatile("" : "+v"(tid));
  const int wid = tid >> 6, lane = tid & 63, r32 = lane & 31, hi = lane >> 5;
#pragma unroll
  for (int it = 0; it < 8; ++it) { const int task = it * 512 + tid, j = task >> 5, cc = (task & 31) * 8;
    const v4u v4 = *(const v4u*)(P + (t0 + j) * LDP + 4096 + g * 256 + cc);
    const float s1 = (float)(long long)lnsum[2 * (t0 + j)] * (1.f / 16777216.f), s2 = (float)(long long)lnsum[2 * (t0 + j) + 1] * (1.f / 16777216.f); const float mean = s1 * (1.f / 1024.f); const float rstd = rsqrtf(fmaxf(s2 * (1.f / 1024.f) - mean * mean, 0.f) + 1e-6f);
    const f32x4 g0 = *(const f32x4*)(lng + g * 256 + cc), g1 = *(const f32x4*)(lng + g * 256 + cc + 4), b0 = *(const f32x4*)(lnb + g * 256 + cc), b1 = *(const f32x4*)(lnb + g * 256 + cc + 4);
    float y[8];
#pragma unroll
    for (int q = 0; q < 4; ++q) { y[2 * q] = gelu_tanh(bflo(v4[q])); y[2 * q + 1] = gelu_tanh(bfhi(v4[q])); }
#pragma unroll
    for (int q = 0; q < 4; ++q) { y[q] = (y[q] - mean) * rstd * g0[q] + b0[q]; y[4 + q] = (y[4 + q] - mean) * rstd * g1[q] + b1[q]; }
    *(v4u*)(lds + ((j >> 6) * 2 + (cc >> 7)) * SHM_V + v_st(j & 63, cc & 127)) = pack8(y); }
  const int ib = wid & 3, ct = wid >> 2;
  bf16x8 wa[8];
  { const float* wr = Wg + (size_t)(32 * ib + r32) * 128 + hi * 8;
#pragma unroll
    for (int ks = 0; ks < 8; ++ks) { if (ks < 4 || ib >= 2) { const f32x4 a0 = *(const f32x4*)(wr + ks * 16), a1 = *(const f32x4*)(wr + ks * 16 + 4);
        v4u w; w.x = cvtpk(a0[0], a0[1]); w.y = cvtpk(a0[2], a0[3]); w.z = cvtpk(a1[0], a1[1]); w.w = cvtpk(a1[2], a1[3]); wa[ks] = __builtin_bit_cast(bf16x8, w); }
      else wa[ks] = (bf16x8){0, 0, 0, 0, 0, 0, 0, 0}; } }
  __syncthreads();
  f32x16 o[4] = {};
  pv_d0(o, (int)(uintptr_t)(lds + (0 * 2 + ct) * SHM_V) + v_rd_base(lane), wa[0], wa[1], wa[2], wa[3]);
  if (ib >= 2) pv_d0(o, (int)(uintptr_t)(lds + (1 * 2 + ct) * SHM_V) + v_rd_base(lane), wa[4], wa[5], wa[6], wa[7]);
#pragma unroll
  for (int r = 0; r < 16; ++r) { const int i = 32 * ib + crow(r, hi); const float bi = bs[i]; const size_t row = t0 + i;
#pragma unroll
    for (int d0 = 0; d0 < 4; ++d0) { const int c = 128 * ct + 32 * d0 + r32;
      const float uu = gelu_tanh(bf2f(P[row * LDP + 3072 + g * 256 + c]));
      O[row * LDO + 1024 + g * 256 + c] = (bf16)f2bf(uu * (o[d0][r] + bi)); } }
  __syncthreads();
}
#undef SBAR
}

__device__ __forceinline__ f32x4 mma16(bf16x8 a, bf16x8 b, f32x4 c) { return __builtin_amdgcn_mfma_f32_16x16x32_bf16(a, b, c, 0, 0, 0); }

struct Args { const float* in[20]; float* out; unsigned char* ws; int ph_lo, ph_hi, sel, li; };

constexpr int N_PHASES = 17;

__global__ void __launch_bounds__(NWAVES * 64, 2) mega_fwd(Args args) {
    extern __shared__ __attribute__((aligned(16))) unsigned char lds[];
    LAS unsigned char* ldsl = (LAS unsigned char*)lds;
    const int G = gridDim.x; const int bx = blockIdx.x;
    const int vcu = (G % 8 == 0) ? (bx % 8) * (G / 8) + bx / 8 : bx;
#define PHASE_ENV() \
    const __attribute__((address_space(4))) Args* ap_ = (const __attribute__((address_space(4))) Args*)__builtin_amdgcn_kernarg_segment_ptr(); asm volatile("" : "+s"(ap_)); \
    int tid = threadIdx.x; asm volatile("" : "+v"(tid)); const int lane = tid & 63, wave = __builtin_amdgcn_readfirstlane(tid >> 6); (void)lane; \
    unsigned char* const ws = ap_->ws; const int gw = vcu * NWAVES + wave, NGW = G * NWAVES; const int gt = vcu * (NWAVES * 64) + tid, NGT = G * NWAVES * 64; \
    const float* const x_in = ap_->in[0]; \
    bf16* const W_ABIN = (bf16*)(ws + WS_W_ABIN); bf16* const W_ABOUT = (bf16*)(ws + WS_W_ABOUT); bf16* const W_CDIN = (bf16*)(ws + WS_W_CDIN); bf16* const W_CDOUT = (bf16*)(ws + WS_W_CDOUT); \
    bf16* const W_UP0 = (bf16*)(ws + WS_W_UP0); bf16* const W_UP1 = (bf16*)(ws + WS_W_UP1); bf16* const W_DN0 = (bf16*)(ws + WS_W_DN0); bf16* const W_DN1 = (bf16*)(ws + WS_W_DN1); \
    bf16* const XN = (bf16*)(ws + WS_XN); bf16* const OB16 = (bf16*)(ws + WS_O); float* const X = (float*)(ws + WS_X); bf16* const ACT = (bf16*)(ws + WS_ACT); \
    bf16* const P = (bf16*)(ws + WS_P); float* const OBF = (float*)(ws + WS_OB); bf16* const KV = (bf16*)(ws + WS_KV); bf16* const PREV = (bf16*)(ws + WS_PREV); bf16* const UP = (bf16*)(ws + WS_UP); \
    unsigned long long* const SS = (unsigned long long*)(ws + WS_SS); (void)SS; unsigned long long* const LNS = (unsigned long long*)(ws + WS_LNS); (void)LNS; bf16* const HALO = (bf16*)(ws + WS_HALO); (void)HALO; bf16* const SCR = (bf16*)(ws + WS_SCR); (void)SCR; float* const SCAL = (float*)(ws + WS_SCAL); float2* const ROPE = (float2*)(ws + WS_ROPE); \
    (void)gw; (void)NGW; (void)gt; (void)NGT; (void)x_in; (void)W_ABIN; (void)W_ABOUT; (void)W_CDIN; (void)W_CDOUT; (void)W_UP0; (void)W_UP1; (void)W_DN0; (void)W_DN1; (void)XN; (void)OB16; (void)X; (void)ACT; (void)P; (void)OBF; (void)KV; (void)PREV; (void)UP; (void)SCAL; (void)ROPE;
#define AIN(k) (ap_->in[k])

#if !MK_PER_PHASE
    for (int u = threadIdx.x; u < (LDS_BYTES - LDSCTL_OFF) / 4; u += NWAVES * 64) ((LAS unsigned*)(ldsl + LDSCTL_OFF))[u] = 0u;
    __syncthreads();
    XcdBarrier bar = xcd_barrier_post((unsigned*)(args.ws + WS_CTL) + 4096 + args.li * XCD_BAR_WORDS, (volatile LAS unsigned*)(ldsl + MISC_OFF) + 8);
#define GRID_BAR() xcd_barrier(bar)
#else
#define GRID_BAR() do {} while (0)
#endif
    const int lo = args.ph_lo, hi_ph = args.ph_hi;
#ifndef PH_MASK
#define PH_MASK 0xFFFFFFu
#endif
#define IN(k) (((PH_MASK >> (k)) & 1u) && lo <= (k) && (k) < hi_ph)
#define SEAM(k) do { if (IN(k) && IN((k) + 1)) GRID_BAR(); } while (0)
#ifndef REPEAT_MASK
#define REPEAT_MASK 0u
#endif
#define NREP(k) (((REPEAT_MASK >> (k)) & 1u) ? 2 : 1)

#define RAW_TO_XN(SRC, SSP) do { \
        for (int m = gw; m < MTOK; m += NGW) { const GAS f32x4* xr = (const GAS f32x4*)((SRC) + (size_t)m * DM) + lane; f32x4 v[8]; float s = 0.f; \
            _Pragma("unroll") for (int j = 0; j < 8; ++j) { v[j] = xr[64 * j]; s += (v[j].x * v[j].x + v[j].y * v[j].y) + (v[j].z * v[j].z + v[j].w * v[j].w); } \
            s = wave_sum(s); if (lane == 0) (SSP)[m] = (unsigned long long)(s * 16777216.f); \
            GAS v2u* o8 = (GAS v2u*)(XN + (size_t)m * DM) + lane; \
            _Pragma("unroll") for (int j = 0; j < 8; ++j) { v2u w; w.x = pk2(v[j].x, v[j].y); w.y = pk2(v[j].z, v[j].w); o8[64 * j] = w; } } } while (0)

    constexpr int CT_ABIN = 32 * (AB_IN / 64), CT_SQ = 32 * (DM / 64), CT_CDIN = 32 * (CD_IN / 64), CT_UP = 32 * (DFF2 / 64), CT_DN = (DFF / 64) * (DM / 64);
    constexpr int CT_L0 = CT_ABIN + CT_SQ + CT_UP + CT_DN, CT_S1 = CT_L0 + CT_CDIN + CT_SQ, CT_S2 = CT_S1 + 4900, CT_ALL = CT_S1 + CT_DN + CT_UP;
#define CONVERT_TILES(FIRST, LAST, W_ID, N_W) do { \
        LAS unsigned* T = (LAS unsigned*)(ldsl + wave * 9216); \
        const int rp = lane >> 4, cq = lane & 15; \
        struct TileRef { const float* src; bf16* dst; const float* gk; int K, N, perm; }; \
        auto tile_ref = [&](int it, TileRef& t) -> int { \
            int r = it; \
            if (r < CT_ABIN) { t = TileRef{AIN(5), W_ABIN, AIN(1), DM, AB_IN, 0}; return r; } r -= CT_ABIN; \
            if (r < CT_SQ) { t = TileRef{AIN(6), W_ABOUT, nullptr, DM, DM, 0}; return r; } r -= CT_SQ; \
            if (r < CT_UP) { t = TileRef{AIN(16), W_UP0, AIN(2), DM, DFF2, 1}; return r; } r -= CT_UP; \
            if (r < CT_DN) { t = TileRef{AIN(19), W_DN0, nullptr, DFF, DM, 0}; return r; } r -= CT_DN; \
            if (r < CT_CDIN) { t = TileRef{AIN(9), W_CDIN, AIN(1) + DM, DM, CD_IN, 0}; return r; } r -= CT_CDIN; \
            if (r < CT_SQ) { t = TileRef{AIN(10), W_CDOUT, nullptr, DM, DM, 0}; return r; } r -= CT_SQ; \
            if (r < CT_DN) { t = TileRef{AIN(19) + (size_t)DFF * DM, W_DN1, nullptr, DFF, DM, 0}; return r; } r -= CT_DN; \
            t = TileRef{AIN(16) + (size_t)DM * DFF2, W_UP1, AIN(2) + DM, DM, DFF2, 1}; return r; \
        }; \
        f32x4 va[8], vb[8]; float ga[8], gb[8]; \
        auto tile_load = [&](int it) { \
            TileRef t; const int r = tile_ref(it, t); const int nblk = t.N / 64, kb = r / nblk, nb = r % nblk; \
            const float* p = t.src + (size_t)(kb * 64 + 2 * rp) * t.N + nb * 64 + 4 * cq; \
            _Pragma("unroll") \
            for (int i = 0; i < 8; ++i) { va[i] = __builtin_nontemporal_load((const f32x4*)(p + (size_t)(8 * i) * t.N)); vb[i] = __builtin_nontemporal_load((const f32x4*)(p + (size_t)(8 * i + 1) * t.N)); \
                ga[i] = t.gk ? t.gk[kb * 64 + 8 * i + 2 * rp] : 1.f; gb[i] = t.gk ? t.gk[kb * 64 + 8 * i + 2 * rp + 1] : 1.f; } \
        }; \
        const int ct_last = (LAST), ct_step = (N_W); \
        int it = (FIRST) + (W_ID); \
        if (it < ct_last) tile_load(it); \
        while (it < ct_last) { \
            _Pragma("unroll") \
            for (int i = 0; i < 8; ++i) { \
                _Pragma("unroll") \
                for (int j = 0; j < 4; ++j) T[(4 * cq + j) * 36 + 4 * i + rp] = pk2(va[i][j] * ga[i], vb[i][j] * gb[i]); } \
            TileRef t; const int r = tile_ref(it, t); const int nblk = t.N / 64, kb = r / nblk, nb = r % nblk; \
            const int n0_ = nb * 64; const int drow0 = !t.perm ? n0_ : (n0_ < DFF ? (n0_ >> 7) * 256 + (n0_ & 127) : ((n0_ - DFF) >> 7) * 256 + 128 + ((n0_ - DFF) & 127)); \
            const int nxt = it + ct_step; \
            if (nxt < ct_last) tile_load(nxt); \
            LDS_WAIT(); asm volatile("" ::: "memory"); \
            _Pragma("unroll") \
            for (int o = 0; o < 8; ++o) { const int idx = o * 64 + lane, n = idx >> 3, c = idx & 7; \
                const v4u w = *(const LAS v4u*)(T + n * 36 + 4 * c); \
                *(GAS v4u*)(t.dst + (size_t)(drow0 + n) * t.K + kb * 64 + 8 * c) = w; } \
            LDS_WAIT(); asm volatile("" ::: "memory"); \
            it = nxt; \
        } \
    } while (0)

    for (int rep_ = 0; rep_ < NREP(0); ++rep_) if (IN(0)) { if (rep_) GRID_BAR(); PHASE_ENV();
        if (G == 256) { CONVERT_TILES(0, CT_L0, gw, NGW); CONVERT_TILES(CT_S2, CT_ALL, gw, NGW); } else { CONVERT_TILES(0, CT_ALL, gw, NGW); }
        for (int e = gt; e < SEQ * 64; e += NGT) { const int pos = e >> 6, i = e & 63;
            double f = 1.0; for (int k = 0; k < i; ++k) f *= 0.8659643233600653;
            const float ang = (float)pos * (float)f;
            double rev = (double)ang * 0.15915494309189535; rev -= floor(rev);
            const float rv = (float)rev;
            ROPE[e] = make_float2(__builtin_amdgcn_cosf(rv), __builtin_amdgcn_sinf(rv)); }
        if (vcu == 0 && wave == 0) { const float* lv = AIN(7);
            float a = lv[lane] * lv[128 + lane] + lv[64 + lane] * lv[192 + lane]; float b = lv[256 + lane] * lv[384 + lane] + lv[320 + lane] * lv[448 + lane];
            a = wave_sum(a); b = wave_sum(b);
            if (lane == 0) SCAL[0] = expf(a) - expf(b) + 0.2f; }
        RAW_TO_XN(x_in, SS);
    }
    SEAM(0);

    for (int rep_ = 0; rep_ < NREP(1); ++rep_) if (IN(1)) { if (rep_) GRID_BAR(); PHASE_ENV(); pg8::Gemm g{XN, W_ABIN, MTOK, AB_IN, DM}; pg8::StaticOrder S; S.init(MTOK, AB_IN, G, bx);
        pg8::EpiBf16 E{P, AB_IN, SS, nullptr, 0, 0}; pg8::gemm_phase<pg8::EpiBf16, pg8::StaticOrder, true, true>(ldsl, g, S, E, tid); }
    SEAM(1);

    for (int rep_ = 0; rep_ < NREP(2); ++rep_) if (IN(2)) { if (rep_) GRID_BAR(); PHASE_ENV();
#ifndef NO_B
        if (!(ap_->sel & 1)) { const int bh = vcu >> 5, comp = (vcu >> 4) & 1, s = vcu & 15, b = bh >> 2, h = bh & 3;
          float* tb = (float*)(lds + att::B2_TB);
          if (tid < 448) { const int rel = tid - 256 - 127, n = rel < 0 ? -rel : rel; int bucket = (n < 8) ? n : 8 + (31 - __clz((n * n) >> 6)); if (n >= 8 && bucket > 15) bucket = 15; if (rel > 0) bucket += 16;
              const float* rb = AIN(4); tb[tid] = (rel >= -127 && rel <= 63) ? (rb[bucket * 4 + h] - rb[15 * 4 + h]) * (1.f / att::SCALE) : 0.f; }
          __syncthreads();
          const bf16* Pb = P + (size_t)b * SEQ * AB_IN;
          for (int i = 0; i < 2; ++i) { const int q128 = i ? 31 - s : s;
              att::attnB2_unit<AB_IN, 1024>(Pb + (size_t)(128 * q128) * AB_IN + 3072 + h * 256 + comp * 128, Pb, 4096 + h * 256 + comp * 128, 5120 + h * 256,
                                            OBF + (size_t)comp * MTOK * 1024 + (size_t)(b * SEQ + 128 * q128) * 1024 + h * 256, q128, (char*)lds, ap_->sel); } }
#endif
#ifndef NO_A
#ifndef NREP_A
#define NREP_A 1
#endif
        for (int ra_ = 0; ra_ < NREP_A; ++ra_) if (!(ap_->sel & 2))
        { const int bh = vcu >> 4, qb = vcu & 15, b = bh >> 3, h = bh & 7;
          const bf16* Pb = P + (size_t)b * SEQ * AB_IN;
          att::attnA_unit<AB_IN, DM>(Pb + (size_t)(256 * qb) * AB_IN + h * 128, Pb, 1024 + h * 128, 2048 + h * 128, OB16 + (size_t)(b * SEQ + 256 * qb) * DM + h * 128, qb, (char*)lds); }
#endif
    }
    SEAM(2);

    for (int rep_ = 0; rep_ < NREP(3); ++rep_) if (IN(3)) { if (rep_) GRID_BAR(); PHASE_ENV();
        const float lam = SCAL[0]; const float* sg = AIN(8);
        f32x4 g4[4];
#pragma unroll
        for (int q = 0; q < 4; ++q) g4[q] = *(const f32x4*)(sg + (lane & 15) * 16 + q * 4);
        for (int row0 = gw * 2; row0 < MTOK; row0 += NGW * 2) { f32x4 a[2][4], c[2][4];
#pragma unroll
            for (int rr = 0; rr < 2; ++rr)
#pragma unroll
                for (int q = 0; q < 4; ++q) { a[rr][q] = *(const f32x4*)(OBF + (size_t)(row0 + rr) * 1024 + lane * 16 + q * 4); c[rr][q] = *(const f32x4*)(OBF + (size_t)MTOK * 1024 + (size_t)(row0 + rr) * 1024 + lane * 16 + q * 4); }
#pragma unroll
            for (int rr = 0; rr < 2; ++rr) { float ss = 0.f;
#pragma unroll
                for (int q = 0; q < 4; ++q) { a[rr][q] = a[rr][q] - lam * c[rr][q]; ss += (a[rr][q].x * a[rr][q].x + a[rr][q].y * a[rr][q].y) + (a[rr][q].z * a[rr][q].z + a[rr][q].w * a[rr][q].w); }
                ss += __shfl_xor(ss, 1); ss += __shfl_xor(ss, 2); ss += __shfl_xor(ss, 4); ss += __shfl_xor(ss, 8);
                const float rs = rsqrtf(ss * (1.f / 256.f) + EPS) * 0.8f;
                v4u w0, w1;
                w0.x = pk2(a[rr][0].x * rs * g4[0].x, a[rr][0].y * rs * g4[0].y); w0.y = pk2(a[rr][0].z * rs * g4[0].z, a[rr][0].w * rs * g4[0].w);
                w0.z = pk2(a[rr][1].x * rs * g4[1].x, a[rr][1].y * rs * g4[1].y); w0.w = pk2(a[rr][1].z * rs * g4[1].z, a[rr][1].w * rs * g4[1].w);
                w1.x = pk2(a[rr][2].x * rs * g4[2].x, a[rr][2].y * rs * g4[2].y); w1.y = pk2(a[rr][2].z * rs * g4[2].z, a[rr][2].w * rs * g4[2].w);
                w1.z = pk2(a[rr][3].x * rs * g4[3].x, a[rr][3].y * rs * g4[3].y); w1.w = pk2(a[rr][3].z * rs * g4[3].z, a[rr][3].w * rs * g4[3].w);
                bf16* op = OB16 + (size_t)(row0 + rr) * DM + 1024 + lane * 16; *(v4u*)op = w0; *(v4u*)(op + 8) = w1; } }
    }
    SEAM(3);

    for (int rep_ = 0; rep_ < NREP(4); ++rep_) if (IN(4)) { if (rep_) GRID_BAR(); PHASE_ENV(); pg8::Gemm g{OB16, W_ABOUT, MTOK, DM, DM}; pg8::StaticOrder S; S.init(MTOK, DM, G, bx);
        pg8::EpiRes E{nullptr, XN, DM, SS + 1 * MTOK}; pg8::gemm_phase<pg8::EpiRes, pg8::StaticOrder, false, true>(ldsl, g, S, E, tid); }
    SEAM(4);

#define FFN_PHASES(PB, WUP, WDN, L, SSIN, SSOUT) \
    for (int rep_ = 0; rep_ < NREP(PB); ++rep_) if (IN(PB)) { if (rep_) GRID_BAR(); PHASE_ENV(); pg8::Gemm g{XN, WUP, MTOK, DFF2, DM}; pg8::StaticOrder S; S.init(MTOK, DFF2, G, bx); \
        pg8::EpiConv E{ACT, SS + (SSIN) * MTOK, AIN(17) + (size_t)(L) * 3 * DFF2, AIN(18) + (size_t)(L) * DFF2, HALO, ldsl}; \
        pg8::gemm_phase<pg8::EpiConv, pg8::StaticOrder, true, true>(ldsl, g, S, E, tid); \
        if ((PB) == 5 && G == 256 && bx >= 128) { CONVERT_TILES(CT_L0, CT_S1, (bx - 128) * NWAVES + wave, 128 * NWAVES); } } \
    SEAM(PB); \
    for (int rep_ = 0; rep_ < NREP(PB + 1); ++rep_) if (IN(PB + 1)) { if (rep_) GRID_BAR(); PHASE_ENV(); conv_fix(HALO, ACT, AIN(17) + (size_t)(L) * 3 * DFF2, AIN(18) + (size_t)(L) * DFF2, gt, NGT); } \
    SEAM(PB + 1); \
    for (int rep_ = 0; rep_ < NREP(PB + 2); ++rep_) if (IN(PB + 2)) { if (rep_) GRID_BAR(); PHASE_ENV(); pg8::Gemm g{ACT, WDN, MTOK, DM, DFF}; pg8::StaticOrder S; S.init(MTOK, DM, G, bx); \
        if ((L) == 1 && G == 256) { pg8::EpiFinal E{XN, DM, SS + (SSOUT) * MTOK, (unsigned*)(ws + WS_CNT), AIN(3), ap_->out}; pg8::gemm_phase<pg8::EpiFinal, pg8::StaticOrder, false, true>(ldsl, g, S, E, tid); } \
        else { pg8::EpiRes E{nullptr, XN, DM, SS + (SSOUT) * MTOK}; pg8::gemm_phase<pg8::EpiRes, pg8::StaticOrder, false, true>(ldsl, g, S, E, tid); } } \
    SEAM(PB + 2);

    auto conv_fix = [&](const bf16* halo, bf16* act, const float* cw, const float* cb, int gt_, int ngt_) {
        constexpr int NCH = DFF / 8;
        for (int task = gt_; task < NCH * 64; task += ngt_) { const int ch = task % NCH, rr = (task / NCH) & 1, pm = task / (2 * NCH), n0 = ch * 8;
            const int pca = (n0 >> 7) * 256 + (n0 & 127); const bool first = (pm & 15) == 0;
            const bf16* H = halo + (size_t)pm * 4 * DFF2; const bf16* Hp = H - (size_t)4 * DFF2;
            float cv[2][8];
#pragma unroll
            for (int bj = 0; bj < 2; ++bj) { const int pc = pca + bj * 128, cc = bj * DFF + n0; const v4u z = {0u, 0u, 0u, 0u};
                const v4u c0 = *(const v4u*)(H + pc), c1 = *(const v4u*)(H + DFF2 + pc);
                const v4u q254 = first ? z : *(const v4u*)(Hp + 2 * DFF2 + pc), q255 = first ? z : *(const v4u*)(Hp + 3 * DFF2 + pc);
                const v4u x2 = rr == 0 ? q254 : q255, x1 = rr == 0 ? q255 : c0, x0 = rr == 0 ? c0 : c1;
#pragma unroll
                for (int q = 0; q < 4; ++q) {
                    cv[bj][2 * q] = cb[cc + 2 * q] + cw[cc + 2 * q] * bflo(x2[q]) + cw[DFF2 + cc + 2 * q] * bflo(x1[q]) + cw[2 * DFF2 + cc + 2 * q] * bflo(x0[q]);
                    cv[bj][2 * q + 1] = cb[cc + 2 * q + 1] + cw[cc + 2 * q + 1] * bfhi(x2[q]) + cw[DFF2 + cc + 2 * q + 1] * bfhi(x1[q]) + cw[2 * DFF2 + cc + 2 * q + 1] * bfhi(x0[q]); } }
            float o[8];
#pragma unroll
            for (int q = 0; q < 8; ++q) o[q] = silu_f(cv[1][q]) * cv[0][q];
            v4u w; w.x = pk2(o[0], o[1]); w.y = pk2(o[2], o[3]); w.z = pk2(o[4], o[5]); w.w = pk2(o[6], o[7]);
            *(v4u*)(act + (size_t)(pm * 256 + rr) * DFF + n0) = w; }
    };

    FFN_PHASES(5, W_UP0, W_DN0, 0, 1, 2)

    for (int rep_ = 0; rep_ < NREP(8); ++rep_) if (IN(8)) { if (rep_) GRID_BAR(); PHASE_ENV(); pg8::Gemm g{XN, W_CDIN, MTOK, CD_IN, DM}; pg8::StaticOrder S; S.init(MTOK, CD_IN, G, bx);
        pg8::EpiBf16 E{P, CD_IN, SS + 2 * MTOK, LNS, 16, 20}; pg8::gemm_phase<pg8::EpiBf16, pg8::StaticOrder, true, true>(ldsl, g, S, E, tid);
        if (G == 256 && bx >= 128) { CONVERT_TILES(CT_S1, CT_S2, (bx - 128) * NWAVES + wave, 128 * NWAVES); } }
    SEAM(8);

    for (int rep_ = 0; rep_ < NREP(9); ++rep_) if (IN(9)) { if (rep_) GRID_BAR(); PHASE_ENV();
        for (int u = vcu; u < 8 * 64; u += G) { const int bh = u >> 6, n = u & 63;
            att::ret_kv_unit<CD_IN>(P, ROPE, KV + ((size_t)bh * 64 + n) * 32768, bh >> 2, bh & 3, n, (char*)lds); }
        for (int u = vcu; u < 256; u += G) { const int g = u & 3, nbk = (u >> 2) & 31, b = u >> 7;
            att::sgu_unit<CD_IN, DM>(P, LNS, AIN(12), AIN(13), AIN(14) + (size_t)g * 128 * 128, AIN(15) + g * 128, OB16, (size_t)b * SEQ + 128 * nbk, g, (char*)lds); }
    }
    SEAM(9);

    for (int rep_ = 0; rep_ < NREP(10); ++rep_) if (IN(10)) { if (rep_) GRID_BAR(); PHASE_ENV();
        if (wave < 4) for (int e4 = (vcu * 4 + wave) * 64 + lane; e4 < 8 * 256 * 128 / 4; e4 += G * 4 * 64) { const int e = e4 * 4; const int bh = e >> 15, h = bh & 3; const int r = e & 32767;
            const float g64 = __expf(64.f * __logf(1.f - exp2f(-5.f - (float)h)));
            const bf16* src = KV + (size_t)bh * 64 * 32768 + r; bf16* dst = PREV + (size_t)bh * 64 * 32768 + r; float st[4] = {0.f, 0.f, 0.f, 0.f};
#pragma unroll 16
            for (int n = 0; n < 64; ++n) { const v2u kv = *(const v2u*)(src + (size_t)n * 32768);
                v2u w; w.x = pk2(st[0], st[1]); w.y = pk2(st[2], st[3]); *(v2u*)(dst + (size_t)n * 32768) = w;
                st[0] = g64 * st[0] + bflo(kv.x); st[1] = g64 * st[1] + bfhi(kv.x); st[2] = g64 * st[2] + bflo(kv.y); st[3] = g64 * st[3] + bfhi(kv.y); } }
    }
    SEAM(10);

    for (int rep_ = 0; rep_ < NREP(11); ++rep_) if (IN(11)) { if (rep_) GRID_BAR(); PHASE_ENV();
        for (int u = vcu; u < 256; u += G) { const int bh = u >> 5, np = u & 31;
            att::ret_out_unit<CD_IN, DM>(P, ROPE, PREV, AIN(11), OB16, bh >> 2, bh & 3, np, (char*)lds); }
    }
    SEAM(11);

    for (int rep_ = 0; rep_ < NREP(12); ++rep_) if (IN(12)) { if (rep_) GRID_BAR(); PHASE_ENV(); pg8::Gemm g{OB16, W_CDOUT, MTOK, DM, DM}; pg8::StaticOrder S; S.init(MTOK, DM, G, bx);
        pg8::EpiRes E{nullptr, XN, DM, SS + 3 * MTOK}; pg8::gemm_phase<pg8::EpiRes, pg8::StaticOrder, false, true>(ldsl, g, S, E, tid); }
    SEAM(12);

    FFN_PHASES(13, W_UP1, W_DN1, 1, 3, 4)

    for (int rep_ = 0; rep_ < NREP(16); ++rep_) if (IN(16) && G != 256) { if (rep_) GRID_BAR(); PHASE_ENV(); const float* fg = AIN(3); const unsigned long long* ss4 = SS + 4 * MTOK;
        for (int m0 = gw * 4; m0 < MTOK; m0 += NGW * 4) { v4u v[4][4]; float rstd[4];
#pragma unroll
            for (int rr = 0; rr < 4; ++rr) { const GAS v4u* xr = (const GAS v4u*)(XN + (size_t)(m0 + rr) * DM) + lane;
#pragma unroll
                for (int j = 0; j < 4; ++j) v[rr][j] = xr[64 * j];
                rstd[rr] = rsqrtf((float)ss4[m0 + rr] * (1.f / 16777216.f / DM) + EPS); }
#pragma unroll
            for (int rr = 0; rr < 4; ++rr) { float* orow = ap_->out + (size_t)(m0 + rr) * DM;
#pragma unroll
                for (int j = 0; j < 4; ++j) { const int c0 = (64 * j + lane) * 8; const f32x4 g0 = *(const f32x4*)(fg + c0), g1 = *(const f32x4*)(fg + c0 + 4); const float r_ = rstd[rr];
                    const f32x4 o0 = {bflo(v[rr][j].x) * r_ * g0.x, bfhi(v[rr][j].x) * r_ * g0.y, bflo(v[rr][j].y) * r_ * g0.z, bfhi(v[rr][j].y) * r_ * g0.w};
                    const f32x4 o1 = {bflo(v[rr][j].z) * r_ * g1.x, bfhi(v[rr][j].z) * r_ * g1.y, bflo(v[rr][j].w) * r_ * g1.z, bfhi(v[rr][j].w) * r_ * g1.w};
                    *(GAS f32x4*)(orow + c0) = o0; *(GAS f32x4*)(orow + c0 + 4) = o1; } } }
    }
#undef IN
#undef SEAM
}

extern "C" void kernel_launch(void* const* d_in, const int* in_sizes, int n_in, void* d_out, int out_size, void* d_ws, size_t ws_size, hipStream_t stream) {
    static int grid = 0;
    if (grid == 0) {
        if (n_in != 20 || in_sizes[0] != MTOK * DM || out_size != MTOK * DM || ws_size < WS_END) {
            fprintf(stderr, "kernel_launch: unexpected shapes: n_in %d in0 %d out %d ws %zu (need >= %zu)\n", n_in, n_in > 0 ? in_sizes[0] : -1, out_size, ws_size, (size_t)WS_END); grid = -1; return; }
        int dev = 0, cus = 0;
        if (hipGetDevice(&dev) != hipSuccess || hipDeviceGetAttribute(&cus, hipDeviceAttributeMultiprocessorCount, dev) != hipSuccess) { grid = -1; return; }
        if (hipFuncSetAttribute((const void*)mega_fwd, hipFuncAttributeMaxDynamicSharedMemorySize, LDS_BYTES) != hipSuccess) { fprintf(stderr, "kernel_launch: hipFuncSetAttribute failed\n"); grid = -1; return; }
        int per_cu = 0;
        if (hipOccupancyMaxActiveBlocksPerMultiprocessor(&per_cu, (const void*)mega_fwd, NWAVES * 64, LDS_BYTES) != hipSuccess || per_cu < 1) { fprintf(stderr, "kernel_launch: occupancy query says %d blocks per CU\n", per_cu); }
        (void)hipGetLastError();
        grid = cus;
    }
    if (grid < 0) return;
    hipMemsetAsync((char*)d_ws + WS_CTL, 0, CTL_ZERO_BYTES, stream);
    Args a{};
    for (int i = 0; i < 20; ++i) a.in[i] = (const float*)d_in[i];
    a.out = (float*)d_out; a.ws = (unsigned char*)d_ws;
#if MK_PER_PHASE
    for (int p = 0; p < N_PHASES; ++p) { a.ph_lo = p; a.ph_hi = p + 1; hipLaunchKernelGGL(mega_fwd, dim3(grid), dim3(NWAVES * 64), LDS_BYTES, stream, a); }
#else
    a.ph_lo = 0; a.ph_hi = (grid == 256) ? N_PHASES - 1 : N_PHASES; hipLaunchKernelGGL         (mega_fwd, dim3(grid), dim3(NWAVES * 64), LDS_BYTES, stream, a);
#if PROBE_PHASE >= 0
    a.ph_lo = PROBE_PHASE; a.ph_hi = PROBE_PHASE + PROBE_NPH; a.sel = PROBE_SEL; a.li = 1; hipLaunchKernelGGL(mega_fwd, dim3(grid), dim3(NWAVES * 64), LDS_BYTES, stream, a);
#endif
#endif
    const hipError_t le = hipPeekAtLastError();
    if (le != hipSuccess) fprintf(stderr, "kernel_launch: launch failed: %s\n", hipGetErrorName(le));
}
```

```cpp
#include <hip/hip_runtime.h>
#include <hip/hip_bf16.h>
#include <cstdio>
#include <cstdint>

#ifndef PROBE_PHASE
#define PROBE_PHASE -1
#endif
#ifndef PROBE_SEL
#define PROBE_SEL 0
#endif
#ifndef PROBE_NPH
#define PROBE_NPH 1
#endif
#ifndef MK_PER_PHASE
#define MK_PER_PHASE 0
#endif

namespace pg8 {
#define PG8_LAS __attribute__((address_space(3)))
typedef unsigned short bf16_t;
typedef short bf16x8 __attribute__((ext_vector_type(8)));
typedef float f32x4 __attribute__((ext_vector_type(4)));
typedef unsigned u32x4 __attribute__((ext_vector_type(4)));
constexpr int BM = 256, BK = 64, HALF = 128, HTB = HALF * BK * 2, STAGE_BYTES = 8 * HTB, NXCD = 8, WGM = 8;

__host__ __device__ __forceinline__ int lds_byte(int r, int c) { const int st = (r >> 4) * 2 + (c >> 5), rr = r & 15, cc = c & 31, ob = rr * 64 + cc * 2; return st * 1024 + (ob ^ (((ob >> 9) & 1) << 5)); }
__host__ __device__ __forceinline__ void stage_rc(int b, int& R, int& C) { const int st = b / 1024, sb = b % 1024, swz = sb ^ (((sb >> 9) & 1) << 5); R = (st >> 1) * 16 + swz / 64; C = (st & 1) * 32 + (swz % 64) / 2; }
__host__ __device__ __forceinline__ int perm32(int rho) { const int n = rho >> 4, i = rho & 15; return 8 * (i >> 2) + 4 * n + (i & 3); }

struct Unit { int pm, pn; };
struct Gemm { const bf16_t* A; const bf16_t* Bt; int M, N, K; };

struct StaticOrder {
    int nM, nN, nwg, G, c;
    __host__ __device__ void init(int M, int N, int G_, int c_) { nM = M / BM; nN = N / BM; nwg = nM * nN; G = G_; c = c_; }
    __host__ __device__ bool next(int i, Unit& u) const {
        const long L = (long)i * G + c; if (L >= nwg) return false;
        int wgid = (int)L; { const int q = nwg / NXCD, r = nwg % NXCD, xcd = wgid % NXCD, off = wgid / NXCD; wgid = (xcd < r ? xcd * (q + 1) : r * (q + 1) + (xcd - r) * q) + off; }
        const int nig = WGM * nN, gid = wgid / nig, fm = gid * WGM, gsz = (nM - fm) < WGM ? (nM - fm) : WGM;
        u.pm = fm + ((wgid % nig) % gsz); u.pn = (wgid % nig) / gsz; return true;
    }
    __device__ __forceinline__ void a_ready(const Unit&) const {}
    __device__ __forceinline__ void done(const Unit&) const {}
};

__device__ __forceinline__ unsigned cvt_pk_bf16(float lo, float hi) { unsigned r; asm volatile("v_cvt_pk_bf16_f32 %0, %1, %2" : "=v"(r) : "v"(lo), "v"(hi)); return r; }

__device__ __forceinline__ float gelu_tanh_e(float x) { const float u = 0.7978845608028654f * (x + 0.044715f * x * x * x); const float t = 1.f - 2.f / (__expf(2.f * u) + 1.f); return 0.5f * x * (1.f + t); }
struct EpiBf16 {
    static constexpr bool PERM = true, AFTER_DRAIN = false;
    bf16_t* O; int ldc; const unsigned long long* ss; unsigned long long* lnsum; int ln_pn0, ln_pn1;
    __device__ __forceinline__ void operator()(const f32x4 (&acc)[2][2][4][2], const Unit& u, int wr, int wc, int fr, int fq) const {
        const int row0 = u.pm * BM + wr * 64 + fr; const int col0 = u.pn * BM + wc * 32 + 8 * fq;
        const bool do_ln = lnsum != nullptr && u.pn >= ln_pn0 && u.pn < ln_pn1;
        unsigned long long ssv[2][4];
#pragma unroll
        for (int ai = 0; ai < 2; ++ai)
#pragma unroll
            for (int m = 0; m < 4; ++m) ssv[ai][m] = ss ? __hip_atomic_load(ss + row0 + ai * HALF + m * 16, __ATOMIC_RELAXED, __HIP_MEMORY_SCOPE_AGENT) : 0ull;
#pragma unroll
        for (int ai = 0; ai < 2; ++ai)
#pragma unroll
            for (int m = 0; m < 4; ++m) { const int row = row0 + ai * HALF + m * 16; bf16_t* rowp = O + (size_t)row * ldc + col0;
                const float sc = ss ? __builtin_amdgcn_rsqf((float)ssv[ai][m] * (1.f / 16777216.f / 2048.f) + 1e-6f) : 1.f;
                float s1 = 0.f, s2 = 0.f;
#pragma unroll
                for (int bj = 0; bj < 2; ++bj) { const f32x4 v0 = acc[ai][bj][m][0] * sc, v1 = acc[ai][bj][m][1] * sc;
                    u32x4 w; w.x = cvt_pk_bf16(v0[0], v0[1]); w.y = cvt_pk_bf16(v0[2], v0[3]); w.z = cvt_pk_bf16(v1[0], v1[1]); w.w = cvt_pk_bf16(v1[2], v1[3]);
                    *(u32x4*)(rowp + bj * HALF) = w;
                    if (do_ln) {
#pragma unroll
                        for (int q = 0; q < 4; ++q) { const float a = gelu_tanh_e(v0[q]), b = gelu_tanh_e(v1[q]); s1 += a + b; s2 += a * a + b * b; } } }
                if (do_ln) { s1 += __shfl_xor(s1, 16); s1 += __shfl_xor(s1, 32); s2 += __shfl_xor(s2, 16); s2 += __shfl_xor(s2, 32);
                    if (fq == 0) { atomicAdd(lnsum + 2 * row, (unsigned long long)(long long)(s1 * 16777216.f)); atomicAdd(lnsum + 2 * row + 1, (unsigned long long)(long long)(s2 * 16777216.f)); } } }
    }
};
struct EpiRes {
    static constexpr bool PERM = true, AFTER_DRAIN = false;
    const float* basef; bf16_t* xb; int ldc; unsigned long long* ss;
    __device__ __forceinline__ void operator()(const f32x4 (&acc)[2][2][4][2], const Unit& u, int wr, int wc, int fr, int fq) const {
        const int row0 = u.pm * BM + wr * 64 + fr; const int col0 = u.pn * BM + wc * 32 + 8 * fq;
        f32x4 b0[2][4][2], b1[2][4][2];
#pragma unroll
        for (int ai = 0; ai < 2; ++ai)
#pragma unroll
            for (int m = 0; m < 4; ++m) { const size_t off = (size_t)(row0 + ai * HALF + m * 16) * ldc + col0;
#pragma unroll
                for (int bj = 0; bj < 2; ++bj) {
                    if (basef) { b0[ai][m][bj] = *(const f32x4*)(basef + off + bj * HALF); b1[ai][m][bj] = *(const f32x4*)(basef + off + bj * HALF + 4); }
                    else { const u32x4 w = *(const u32x4*)(xb + off + bj * HALF);
                        b0[ai][m][bj] = (f32x4){__builtin_bit_cast(float, w.x << 16), __builtin_bit_cast(float, w.x & 0xffff0000u), __builtin_bit_cast(float, w.y << 16), __builtin_bit_cast(float, w.y & 0xffff0000u)};
                        b1[ai][m][bj] = (f32x4){__builtin_bit_cast(float, w.z << 16), __builtin_bit_cast(float, w.z & 0xffff0000u), __builtin_bit_cast(float, w.w << 16), __builtin_bit_cast(float, w.w & 0xffff0000u)}; } } }
#pragma unroll
        for (int ai = 0; ai < 2; ++ai)
#pragma unroll
            for (int m = 0; m < 4; ++m) { const int row = row0 + ai * HALF + m * 16; const size_t off = (size_t)row * ldc + col0; float sq = 0.f;
#pragma unroll
                for (int bj = 0; bj < 2; ++bj) {
                    const f32x4 o0 = b0[ai][m][bj] + acc[ai][bj][m][0], o1 = b1[ai][m][bj] + acc[ai][bj][m][1];
                    u32x4 w; w.x = cvt_pk_bf16(o0[0], o0[1]); w.y = cvt_pk_bf16(o0[2], o0[3]); w.z = cvt_pk_bf16(o1[0], o1[1]); w.w = cvt_pk_bf16(o1[2], o1[3]);
                    *(u32x4*)(xb + off + bj * HALF) = w;
#pragma unroll
                    for (int q = 0; q < 4; ++q) { const unsigned ww = q == 0 ? w.x : q == 1 ? w.y : q == 2 ? w.z : w.w; const float lo = __builtin_bit_cast(float, ww << 16), hi = __builtin_bit_cast(float, ww & 0xffff0000u); sq += lo * lo + hi * hi; } }
                sq += __shfl_xor(sq, 16); sq += __shfl_xor(sq, 32);
                if (fq == 0) atomicAdd(ss + row, (unsigned long long)(sq * 16777216.f)); }
    }
};

struct EpiConv {
    static constexpr bool PERM = true, AFTER_DRAIN = false;
    bf16_t* act; const unsigned long long* ss; const float* cw; const float* cb; bf16_t* halo; PG8_LAS unsigned char* lds0;
    static constexpr int NFF = 5632, NFF2 = 11264;
    static constexpr int HX = STAGE_BYTES + 1024, CPAR = HX + 4096;
    __device__ __forceinline__ static int hxi(int wr, int ai, int rs, int bj, int wc, int fq) { return ((((((wr * 2 + ai) * 2 + rs) * 2 + bj) * 4 + wc) * 4 + fq) * 16); }
    __device__ __forceinline__ static u32x4 bperm4(int addr, u32x4 v) {
        u32x4 r; r.x = (unsigned)__builtin_amdgcn_ds_bpermute(addr, (int)v.x); r.y = (unsigned)__builtin_amdgcn_ds_bpermute(addr, (int)v.y);
        r.z = (unsigned)__builtin_amdgcn_ds_bpermute(addr, (int)v.z); r.w = (unsigned)__builtin_amdgcn_ds_bpermute(addr, (int)v.w); return r; }
    __device__ __forceinline__ void operator()(const f32x4 (&acc)[2][2][4][2], const Unit& u, int wr, int wc, int fr, int fq) const {
        asm volatile("" : "+v"(fr), "+v"(fq));
        typedef float f32x2 __attribute__((ext_vector_type(2)));
        const int lane = fq * 16 + fr, tid = (wr * 4 + wc) * 64 + lane;
        { PG8_LAS float* cp = (PG8_LAS float*)(lds0 + CPAR);
#pragma unroll
          for (int e = 0; e < 2; ++e) { const int idx = tid * 2 + e, bj = idx >> 9, j = (idx >> 7) & 3, c = idx & 127; const int gcol = bj * NFF + u.pn * 128 + c;
              cp[idx] = j < 3 ? cw[(size_t)j * NFF2 + gcol] : cb[gcol]; } }
        u32x4 pk[2][2][4];
        unsigned long long ssv[2][4];
#pragma unroll
        for (int ai = 0; ai < 2; ++ai)
#pragma unroll
            for (int m = 0; m < 4; ++m) ssv[ai][m] = __hip_atomic_load(ss + u.pm * BM + ai * HALF + wr * 64 + m * 16 + fr, __ATOMIC_RELAXED, __HIP_MEMORY_SCOPE_AGENT);
#pragma unroll
        for (int ai = 0; ai < 2; ++ai)
#pragma unroll
            for (int m = 0; m < 4; ++m) {
                const float sc = __builtin_amdgcn_rsqf((float)ssv[ai][m] * (1.f / 16777216.f / 2048.f) + 1e-6f);
#pragma unroll
                for (int bj = 0; bj < 2; ++bj) { const f32x4 v0 = acc[ai][bj][m][0] * sc, v1 = acc[ai][bj][m][1] * sc;
                    pk[ai][bj][m] = (u32x4){cvt_pk_bf16(v0[0], v0[1]), cvt_pk_bf16(v0[2], v0[3]), cvt_pk_bf16(v1[0], v1[1]), cvt_pk_bf16(v1[2], v1[3])}; } }
        const int pcol = u.pn * 256 + wc * 32 + 8 * fq;
        if (fr >= 14) {
#pragma unroll
            for (int ai = 0; ai < 2; ++ai)
#pragma unroll
                for (int bj = 0; bj < 2; ++bj) *(PG8_LAS u32x4*)(lds0 + HX + hxi(wr, ai, fr - 14, bj, wc, fq)) = pk[ai][bj][3];
            if (wr == 1) {
#pragma unroll
                for (int bj = 0; bj < 2; ++bj) *(u32x4*)(halo + ((size_t)u.pm * 4 + 2 + (fr - 14)) * NFF2 + pcol + bj * HALF) = pk[1][bj][3]; } }
        if (wr == 0 && fr < 2) {
#pragma unroll
            for (int bj = 0; bj < 2; ++bj) *(u32x4*)(halo + ((size_t)u.pm * 4 + fr) * NFF2 + pcol + bj * HALF) = pk[0][bj][0]; }
        asm volatile("s_waitcnt lgkmcnt(0)" ::: "memory"); __builtin_amdgcn_s_barrier(); asm volatile("" ::: "memory");
        const int i1 = ((lane & 48) | ((fr + 15) & 15)) * 4, i2 = ((lane & 48) | ((fr + 14) & 15)) * 4;
        const int ca = u.pn * 128 + wc * 32 + 8 * fq;
        const PG8_LAS float* cpl = (const PG8_LAS float*)(lds0 + CPAR) + wc * 32 + 8 * fq;
#define PG8_BLO(w_) __builtin_bit_cast(float, (w_) << 16)
#define PG8_BHI(w_) __builtin_bit_cast(float, (w_) & 0xffff0000u)
#define PG8_W(v_, q_) ((q_) == 0 ? (v_).x : (q_) == 1 ? (v_).y : (q_) == 2 ? (v_).z : (v_).w)
#define PG8_X2(v_, q_) ((f32x2){PG8_BLO(PG8_W(v_, q_)), PG8_BHI(PG8_W(v_, q_))})
#pragma unroll
        for (int ai = 0; ai < 2; ++ai) {
            const bool top = (wr == 0 && ai == 0);
            u32x4 q1[2], q2[2];
            if (top) { q1[0] = (u32x4){0u, 0u, 0u, 0u}; q1[1] = q1[0]; q2[0] = q1[0]; q2[1] = q1[0]; }
            else { const int swr = wr == 1 ? 0 : 1, sai = wr == 1 ? ai : 0;
#pragma unroll
                for (int bj = 0; bj < 2; ++bj) { const u32x4 h14 = *(const PG8_LAS u32x4*)(lds0 + HX + hxi(swr, sai, 0, bj, wc, fq)), h15 = *(const PG8_LAS u32x4*)(lds0 + HX + hxi(swr, sai, 1, bj, wc, fq));
                    q1[bj] = h15; q2[bj] = fr == 0 ? h14 : h15; } }
#pragma unroll
            for (int m = 0; m < 4; ++m) {
                const PG8_LAS float* cpb = cpl; asm volatile("" : "+v"(cpb));
                f32x2 cv[2][4];
#pragma unroll
                for (int bj = 0; bj < 2; ++bj) { const u32x4 cur = pk[ai][bj][m];
                    const u32x4 s1 = bperm4(i1, cur), s2 = bperm4(i2, cur);
                    const u32x4 p1 = fr == 0 ? q1[bj] : s1, p2 = fr < 2 ? q2[bj] : s2;
                    q1[bj] = s1; q2[bj] = s2;
#pragma unroll
                    for (int q = 0; q < 4; ++q) { const f32x2 w0 = *(const PG8_LAS f32x2*)(cpb + bj * 512 + 2 * q), w1 = *(const PG8_LAS f32x2*)(cpb + bj * 512 + 128 + 2 * q), w2 = *(const PG8_LAS f32x2*)(cpb + bj * 512 + 256 + 2 * q), bb = *(const PG8_LAS f32x2*)(cpb + bj * 512 + 384 + 2 * q);
                        cv[bj][q] = bb + w0 * PG8_X2(p2, q) + w1 * PG8_X2(p1, q) + w2 * PG8_X2(cur, q); } }
                float o[8];
#pragma unroll
                for (int q = 0; q < 4; ++q) { const f32x2 gv = cv[1][q]; const f32x2 sg = {__builtin_amdgcn_rcpf(1.f + __expf(-gv.x)), __builtin_amdgcn_rcpf(1.f + __expf(-gv.y))};
                    const f32x2 ov = cv[0][q] * gv * sg; o[2 * q] = ov.x; o[2 * q + 1] = ov.y; }
                u32x4 out; out.x = cvt_pk_bf16(o[0], o[1]); out.y = cvt_pk_bf16(o[2], o[3]); out.z = cvt_pk_bf16(o[4], o[5]); out.w = cvt_pk_bf16(o[6], o[7]);
                const int row = u.pm * BM + ai * HALF + wr * 64 + m * 16 + fr;
                if (!(top && m == 0 && fr < 2)) *(u32x4*)(act + (size_t)row * NFF + ca) = out;
                __builtin_amdgcn_sched_barrier(0); } }
#undef PG8_BLO
#undef PG8_BHI
#undef PG8_W
#undef PG8_X2
    }
};

struct EpiFinal {
    static constexpr bool PERM = true, AFTER_DRAIN = true;
    const bf16_t* xb; int ldc; unsigned long long* ss; unsigned* cnt; const float* g; float* out;
    __device__ __forceinline__ void fused(f32x4 (&acc)[2][2][4][2], const Unit& u, int wr, int wc, int fr, int fq, PG8_LAS unsigned char* lds, int wid, int lane) const {
        const int row0 = u.pm * BM + wr * 64 + fr; const int col0 = u.pn * BM + wc * 32 + 8 * fq;
        u32x4 bw[2][4][2];
#pragma unroll
        for (int ai = 0; ai < 2; ++ai)
#pragma unroll
            for (int m = 0; m < 4; ++m)
#pragma unroll
                for (int bj = 0; bj < 2; ++bj) bw[ai][m][bj] = *(const u32x4*)(xb + (size_t)(row0 + ai * HALF + m * 16) * ldc + col0 + bj * HALF);
        float sqv[2][4];
#pragma unroll
        for (int ai = 0; ai < 2; ++ai)
#pragma unroll
            for (int m = 0; m < 4; ++m) { float sq = 0.f;
#pragma unroll
                for (int bj = 0; bj < 2; ++bj) { const u32x4 w = bw[ai][m][bj];
                    const f32x4 b0 = {__builtin_bit_cast(float, w.x << 16), __builtin_bit_cast(float, w.x & 0xffff0000u), __builtin_bit_cast(float, w.y << 16), __builtin_bit_cast(float, w.y & 0xffff0000u)};
                    const f32x4 b1 = {__builtin_bit_cast(float, w.z << 16), __builtin_bit_cast(float, w.z & 0xffff0000u), __builtin_bit_cast(float, w.w << 16), __builtin_bit_cast(float, w.w & 0xffff0000u)};
                    const f32x4 o0 = b0 + acc[ai][bj][m][0], o1 = b1 + acc[ai][bj][m][1]; acc[ai][bj][m][0] = o0; acc[ai][bj][m][1] = o1;
                    sq += (o0[0] * o0[0] + o0[1] * o0[1]) + (o0[2] * o0[2] + o0[3] * o0[3]) + (o1[0] * o1[0] + o1[1] * o1[1]) + (o1[2] * o1[2] + o1[3] * o1[3]); }
                sq += __shfl_xor(sq, 16); sq += __shfl_xor(sq, 32); sqv[ai][m] = sq; }
        unsigned long long keep = 0ull, kr[2][4];
        if (fq == 0) {
#pragma unroll
            for (int ai = 0; ai < 2; ++ai)
#pragma unroll
                for (int m = 0; m < 4; ++m) kr[ai][m] = atomicAdd(ss + row0 + ai * HALF + m * 16, (unsigned long long)(sqv[ai][m] * 16777216.f));
#pragma unroll
            for (int ai = 0; ai < 2; ++ai)
#pragma unroll
                for (int m = 0; m < 4; ++m) keep += kr[ai][m]; }
        asm volatile("s_waitcnt vmcnt(0)" :: "v"((unsigned)keep), "v"((unsigned)(keep >> 32)) : "memory");
        if (lane == 0) __hip_atomic_fetch_add(cnt + 64 * u.pm, 1u, __ATOMIC_RELAXED, __HIP_MEMORY_SCOPE_AGENT);
        if (wid == 0) { unsigned sp = 0;
            while ((unsigned)__builtin_amdgcn_readfirstlane(__hip_atomic_load(cnt + 64 * u.pm, __ATOMIC_RELAXED, __HIP_MEMORY_SCOPE_AGENT)) < 64u) { __builtin_amdgcn_s_sleep(2); if (++sp > (1u << 22)) break; } }
        asm volatile("s_waitcnt vmcnt(0) lgkmcnt(0)" ::: "memory"); __builtin_amdgcn_s_barrier(); asm volatile("" ::: "memory");
        unsigned long long ssv[2][4];
#pragma unroll
        for (int ai = 0; ai < 2; ++ai)
#pragma unroll
            for (int m = 0; m < 4; ++m) ssv[ai][m] = __hip_atomic_load(ss + row0 + ai * HALF + m * 16, __ATOMIC_RELAXED, __HIP_MEMORY_SCOPE_AGENT);
#pragma unroll
        for (int ai = 0; ai < 2; ++ai)
#pragma unroll
            for (int m = 0; m < 4; ++m) { const int row = row0 + ai * HALF + m * 16; const size_t off = (size_t)row * ldc + col0;
                const float rstd = __builtin_amdgcn_rsqf((float)ssv[ai][m] * (1.f / 16777216.f / 2048.f) + 1e-6f);
#pragma unroll
                for (int bj = 0; bj < 2; ++bj) { const f32x4 g0 = *(const f32x4*)(g + col0 + bj * HALF), g1 = *(const f32x4*)(g + col0 + bj * HALF + 4);
                    *(f32x4*)(out + off + bj * HALF) = acc[ai][bj][m][0] * rstd * g0; *(f32x4*)(out + off + bj * HALF + 4) = acc[ai][bj][m][1] * rstd * g1; } }
    }
};

template <class Epi, class Sched, bool ALIGN_EPI = false, bool SP2 = false>
__device__ __forceinline__ void gemm_phase(PG8_LAS unsigned char* lds, const Gemm g, const Sched& S, const Epi& E, const int tid) {
    const int wid = __builtin_amdgcn_readfirstlane(tid >> 6), lane = tid & 63, wr = wid >> 2, wc = wid & 3, fr = lane & 15, fq = lane >> 4;
    const int K = g.K, nt = K / BK;
    unsigned voffA[2], voffB[2];
#pragma unroll
    for (int i = 0; i < 2; ++i) { int R, C; stage_rc(tid * 16 + i * 8192, R, C); const int Rb = Epi::PERM ? ((R & ~31) + perm32(R & 31)) : R;
        voffA[i] = (unsigned)(R * K + C) * 2u; voffB[i] = (unsigned)(Rb * K + C) * 2u; }
    const size_t kstep = (size_t)(BK * 2);
    const size_t hstep = (size_t)HALF * K * 2;
    const size_t tstep = 2 * hstep;
    const unsigned ldsw = (unsigned)wid * 1024u;
    const int aoff = lds_byte(wr * 64 + fr, fq * 8), boff = lds_byte(wc * 32 + fr, fq * 8);
#define PG8_SA(b, h) (((b) * 2 + (h)) * HTB)
#define PG8_SB(b, h) ((4 + (b) * 2 + (h)) * HTB)
#define PG8_STAGE(bufoff, gbase, voff) do { _Pragma("unroll") for (int _i = 0; _i < 2; ++_i) \
        __builtin_amdgcn_global_load_lds((const unsigned*)((const char*)(gbase) + (voff)[_i]), (PG8_LAS unsigned*)(lds + (bufoff) + ldsw + _i * 8192), 16, 0, 0); } while (0)
#define PG8_LDA(dst, b, h) do { _Pragma("unroll") for (int m = 0; m < 4; ++m) _Pragma("unroll") for (int k = 0; k < 2; ++k) dst[m][k] = *(const PG8_LAS bf16x8*)(lds + PG8_SA(b, h) + aoff + m * 2048 + k * 1024); } while (0)
#define PG8_LDB(dst, b, h) do { _Pragma("unroll") for (int n = 0; n < 2; ++n) _Pragma("unroll") for (int k = 0; k < 2; ++k) dst[n][k] = *(const PG8_LAS bf16x8*)(lds + PG8_SB(b, h) + boff + n * 2048 + k * 1024); } while (0)
#define PG8_MMA(ai, bj, At, Bt) do { __builtin_amdgcn_s_setprio(1); _Pragma("unroll") for (int m = 0; m < 4; ++m) _Pragma("unroll") for (int n = 0; n < 2; ++n) _Pragma("unroll") for (int k = 0; k < 2; ++k) \
        acc[ai][bj][m][n] = __builtin_amdgcn_mfma_f32_16x16x32_bf16(Bt[n][k], At[m][k], acc[ai][bj][m][n], 0, 0, 0); __builtin_amdgcn_s_setprio(0); } while (0)
#define PG8_WAIT_V(n) asm volatile("s_waitcnt vmcnt(" #n ")" ::: "memory")
#define PG8_WAIT_L(n) asm volatile("s_waitcnt lgkmcnt(" #n ")" ::: "memory")
#define PG8_BAR __builtin_amdgcn_s_barrier()
#define PG8_SCHED __builtin_amdgcn_sched_barrier(0)
    Unit cur, nxt; int ui = 0;
    if (!S.next(0, cur)) return;
    f32x4 acc[2][2][4][2];
#pragma unroll
    for (int a = 0; a < 2; ++a)
#pragma unroll
        for (int b = 0; b < 2; ++b)
#pragma unroll
            for (int m = 0; m < 4; ++m)
#pragma unroll
                for (int n = 0; n < 2; ++n) acc[a][b][m][n] = (f32x4){0.f, 0.f, 0.f, 0.f};
    bf16x8 At[4][2], B0[2][2], B1[2][2];
    const char* cA = (const char*)g.A + (size_t)cur.pm * tstep; const char* cB = (const char*)g.Bt + (size_t)cur.pn * tstep;
    S.a_ready(cur);
    if constexpr (SP2) {
        PG8_STAGE(PG8_SB(0, 0), cB, voffB); PG8_STAGE(PG8_SB(0, 1), cB + hstep, voffB); PG8_STAGE(PG8_SA(0, 0), cA, voffA); PG8_STAGE(PG8_SA(0, 1), cA + hstep, voffA);
        if (wr == 1) PG8_BAR;
        PG8_WAIT_V(2); PG8_BAR;
        PG8_STAGE(PG8_SB(1, 0), cB + kstep, voffB); PG8_STAGE(PG8_SA(1, 0), cA + kstep, voffA); PG8_STAGE(PG8_SB(1, 1), cB + hstep + kstep, voffB);
        PG8_WAIT_V(6); PG8_BAR;
    } else {
        PG8_STAGE(PG8_SB(0, 0), cB, voffB); PG8_STAGE(PG8_SA(0, 0), cA, voffA); PG8_STAGE(PG8_SB(0, 1), cB + hstep, voffB); PG8_STAGE(PG8_SA(0, 1), cA + hstep, voffA);
        if (wr == 1) PG8_BAR;
        PG8_WAIT_V(4); PG8_BAR;
        PG8_STAGE(PG8_SB(1, 0), cB + kstep, voffB); PG8_STAGE(PG8_SA(1, 0), cA + kstep, voffA); PG8_STAGE(PG8_SB(1, 1), cB + hstep + kstep, voffB);
        PG8_WAIT_V(6); PG8_BAR;
    }
    for (;;) {
        const bool has_next = S.next(ui + 1, nxt);
        const char* nA = has_next ? (const char*)g.A + (size_t)nxt.pm * tstep : cA; const char* nB = has_next ? (const char*)g.Bt + (size_t)nxt.pn * tstep : cB;
        for (int t = 0; t < nt; t += 2) {
            const bool last = (t == nt - 2);
            const char* a1 = cA + (size_t)(t + 1) * kstep;
            const char* a2 = last ? nA : cA + (size_t)(t + 2) * kstep; const char* b2 = last ? nB : cB + (size_t)(t + 2) * kstep;
            const char* a3 = a2 + kstep; const char* b3 = b2 + kstep;
            if (last && has_next) S.a_ready(nxt);
            if constexpr (SP2) {
            PG8_LDB(B0, 0, 0); PG8_LDB(B1, 0, 1); PG8_SCHED; PG8_LDA(At, 0, 0); PG8_STAGE(PG8_SA(1, 1), a1 + hstep, voffA);
            PG8_WAIT_V(8); PG8_WAIT_L(0); PG8_BAR; PG8_MMA(0, 0, At, B0); PG8_MMA(0, 1, At, B1); PG8_BAR; PG8_SCHED;
            PG8_LDA(At, 0, 1); PG8_STAGE(PG8_SB(0, 0), b2, voffB); PG8_STAGE(PG8_SB(0, 1), b2 + hstep, voffB); PG8_STAGE(PG8_SA(0, 0), a2, voffA);
            PG8_WAIT_V(8); PG8_WAIT_L(0); PG8_BAR; PG8_MMA(1, 0, At, B0); PG8_MMA(1, 1, At, B1); PG8_BAR; PG8_SCHED;
            PG8_LDB(B0, 1, 0); PG8_LDB(B1, 1, 1); PG8_SCHED; PG8_LDA(At, 1, 0); PG8_STAGE(PG8_SA(0, 1), a2 + hstep, voffA);
            PG8_WAIT_V(8); PG8_WAIT_L(0); PG8_BAR; PG8_MMA(0, 0, At, B0); PG8_MMA(0, 1, At, B1); PG8_BAR; PG8_SCHED;
            PG8_LDA(At, 1, 1); PG8_STAGE(PG8_SB(1, 0), b3, voffB); PG8_STAGE(PG8_SB(1, 1), b3 + hstep, voffB); PG8_STAGE(PG8_SA(1, 0), a3, voffA);
            PG8_WAIT_V(8); PG8_WAIT_L(0); PG8_BAR; PG8_MMA(1, 0, At, B0); PG8_MMA(1, 1, At, B1); PG8_BAR; PG8_SCHED;
            } else {
            PG8_LDB(B0, 0, 0); PG8_SCHED; PG8_LDA(At, 0, 0); PG8_STAGE(PG8_SA(1, 1), a1 + hstep, voffA);
            PG8_WAIT_L(8); PG8_BAR; PG8_WAIT_L(0); PG8_MMA(0, 0, At, B0); PG8_BAR; PG8_SCHED;
            PG8_LDB(B1, 0, 1); PG8_STAGE(PG8_SB(0, 0), b2, voffB);
            PG8_BAR; PG8_WAIT_L(0); PG8_MMA(0, 1, At, B1); PG8_BAR;
            PG8_LDA(At, 0, 1); PG8_STAGE(PG8_SA(0, 0), a2, voffA);
            PG8_BAR; PG8_WAIT_L(0); PG8_MMA(1, 0, At, B0); PG8_BAR; PG8_SCHED;
            PG8_STAGE(PG8_SB(0, 1), b2 + hstep, voffB);
            PG8_WAIT_V(6); PG8_BAR; PG8_MMA(1, 1, At, B1); PG8_BAR;
            PG8_LDB(B0, 1, 0); PG8_SCHED; PG8_LDA(At, 1, 0); PG8_STAGE(PG8_SA(0, 1), a2 + hstep, voffA);
            PG8_WAIT_L(8); PG8_BAR; PG8_WAIT_L(0); PG8_MMA(0, 0, At, B0); PG8_BAR; PG8_SCHED;
            PG8_LDB(B1, 1, 1); PG8_STAGE(PG8_SB(1, 0), b3, voffB);
            PG8_BAR; PG8_WAIT_L(0); PG8_MMA(0, 1, At, B1); PG8_BAR;
            PG8_LDA(At, 1, 1); PG8_STAGE(PG8_SA(1, 0), a3, voffA);
            PG8_BAR; PG8_WAIT_L(0); PG8_MMA(1, 0, At, B0); PG8_BAR; PG8_SCHED;
            PG8_STAGE(PG8_SB(1, 1), b3 + hstep, voffB);
            PG8_WAIT_V(6); PG8_BAR; PG8_MMA(1, 1, At, B1); PG8_BAR;
            }
        }
        if constexpr (ALIGN_EPI) { if (wr == 0) PG8_BAR; }
        if constexpr (!Epi::AFTER_DRAIN) { E(acc, cur, wr, wc, fr, fq); S.done(cur); }
        if (!has_next) break;
#pragma unroll
        for (int a = 0; a < 2; ++a)
#pragma unroll
            for (int b = 0; b < 2; ++b)
#pragma unroll
                for (int m = 0; m < 4; ++m)
#pragma unroll
                    for (int n = 0; n < 2; ++n) acc[a][b][m][n] = (f32x4){0.f, 0.f, 0.f, 0.f};
        cur = nxt; cA = nA; cB = nB; ++ui;
        if constexpr (ALIGN_EPI) { if (wr == 1) PG8_BAR; }
    }
    PG8_WAIT_V(0);
    if constexpr (!ALIGN_EPI) { if (wr == 0) PG8_BAR; }
    PG8_BAR;
    if constexpr (Epi::AFTER_DRAIN) { E.fused(acc, cur, wr, wc, fr, fq, lds, wid, lane); }
#undef PG8_SA
#undef PG8_SB
#undef PG8_STAGE
#undef PG8_LDA
#undef PG8_LDB
#undef PG8_MMA
#undef PG8_WAIT_V
#undef PG8_WAIT_L
#undef PG8_BAR
#undef PG8_SCHED
}
}

constexpr int DM = 2048, BATCH = 2, SEQ = 4096, MTOK = BATCH * SEQ;
constexpr int AB_IN = 6144, CD_IN = 5120, DFF = 5632, DFF2 = 11264;
constexpr float EPS = 1e-6f;
constexpr int NWAVES = 8;

#define GAS __attribute__((address_space(1)))
#define LAS __attribute__((address_space(3)))
typedef unsigned short bf16;
typedef unsigned v4u __attribute__((ext_vector_type(4)));
typedef unsigned v2u __attribute__((ext_vector_type(2)));
typedef float f32x4 __attribute__((ext_vector_type(4)));
typedef float f32x16 __attribute__((ext_vector_type(16)));
typedef short bf16x8 __attribute__((ext_vector_type(8)));
typedef short s16x4 __attribute__((ext_vector_type(4)));
typedef GAS unsigned gu32;
#define RLX_AGENT __ATOMIC_RELAXED, __HIP_MEMORY_SCOPE_AGENT
#define LDS_WAIT() asm volatile("s_waitcnt lgkmcnt(0)" ::: "memory")
#define VM_WAIT() asm volatile("s_waitcnt vmcnt(0)" ::: "memory")
__device__ __forceinline__ unsigned f2bf(float f) { unsigned u = __builtin_bit_cast(unsigned, f); return (u + 0x7fffu + ((u >> 16) & 1u)) >> 16; }
__device__ __forceinline__ unsigned pk2(float lo, float hi) { return f2bf(lo) | (f2bf(hi) << 16); }
__device__ __forceinline__ float bf2f(unsigned u16) { return __builtin_bit_cast(float, u16 << 16); }
__device__ __forceinline__ float bflo(unsigned w) { return __builtin_bit_cast(float, w << 16); }
__device__ __forceinline__ float bfhi(unsigned w) { return __builtin_bit_cast(float, w & 0xffff0000u); }
__device__ __forceinline__ float wave_sum(float v) {
#pragma unroll
    for (int o = 1; o < 64; o <<= 1) v += __shfl_xor(v, o);
    return v;
}
__device__ __forceinline__ float gelu_tanh(float x) {
    const float u = 0.7978845608028654f * (x + 0.044715f * x * x * x);
    const float t = 1.f - 2.f / (__expf(2.f * u) + 1.f);
    return 0.5f * x * (1.f + t);
}
__device__ __forceinline__ float silu_f(float x) { return x / (1.f + __expf(-x)); }

constexpr size_t MiB = 1u << 20;
constexpr size_t WS_CTL = 0, CTL_ZERO_BYTES = 1 * MiB;
constexpr size_t WS_SS = 128 * 1024;
constexpr size_t WS_LNS = 512 * 1024;
constexpr size_t WS_CNT = 768 * 1024;
constexpr size_t WS_SCAL = 1 * MiB;
constexpr size_t WS_ROPE = 2 * MiB;
constexpr size_t WS_W_ABIN = 4 * MiB;
constexpr size_t WS_W_ABOUT = WS_W_ABIN + 24 * MiB;
constexpr size_t WS_W_CDIN = WS_W_ABOUT + 8 * MiB;
constexpr size_t WS_W_CDOUT = WS_W_CDIN + 20 * MiB;
constexpr size_t WS_W_UP0 = WS_W_CDOUT + 8 * MiB;
constexpr size_t WS_W_UP1 = WS_W_UP0 + 44 * MiB;
constexpr size_t WS_W_DN0 = WS_W_UP1 + 44 * MiB;
constexpr size_t WS_W_DN1 = WS_W_DN0 + 22 * MiB;
constexpr size_t WS_XN = WS_W_DN1 + 22 * MiB;
constexpr size_t WS_O = WS_XN + 32 * MiB;
constexpr size_t WS_X = WS_O + 32 * MiB;
constexpr size_t WS_ACT = WS_X + 64 * MiB;
constexpr size_t WS_R1 = WS_ACT + 88 * MiB;
constexpr size_t WS_P = WS_R1;
constexpr size_t WS_OB = WS_R1 + 96 * MiB;
constexpr size_t WS_KV = WS_R1 + 96 * MiB;
constexpr size_t WS_PREV = WS_KV + 64 * MiB;
constexpr size_t WS_UP = WS_R1;
constexpr size_t WS_HALO = WS_R1 + 192 * MiB;
constexpr size_t WS_SCR = WS_HALO + 4 * MiB;
constexpr size_t WS_END = WS_SCR + 32 * MiB;

constexpr int RING_BYTES = 131072;
constexpr int LDSCTL_OFF = RING_BYTES, MISC_OFF = LDSCTL_OFF + 320;
constexpr int LDS_BYTES = 147456;

#define XB_TMO      128
#define XB_XCNT(j)  (256  + 64 * (j))
#define XB_XSUB(j)  (1280 + 64 * (j))
#define XB_XGEN(j)  (2304 + 64 * (j))
#define XB_TOP      3328
#define XB_TOPGEN   3392
#define XCD_BAR_WORDS 3456
#define XB_SPIN_CAP (1u << 20)
__device__ __forceinline__ unsigned xb_ld(unsigned* p)              { return __hip_atomic_load(p, __ATOMIC_RELAXED, __HIP_MEMORY_SCOPE_AGENT); }
__device__ __forceinline__ unsigned xb_add(unsigned* p, unsigned v) { return __hip_atomic_fetch_add(p, v, __ATOMIC_RELAXED, __HIP_MEMORY_SCOPE_AGENT); }
__device__ __forceinline__ unsigned xb_xcc_id() { return (unsigned)__builtin_amdgcn_s_getreg((3 << 11) | 20) & 0xFu; }
#define XB_SPIN(cond, bar) do { unsigned _sp = 0; while (cond) { __builtin_amdgcn_s_sleep(1); \
    if ((++_sp & 255u) == 0u) { if (xb_ld(&(bar)[XB_TMO])) break; if (_sp > XB_SPIN_CAP) { atomicAdd(&(bar)[XB_TMO], 1u); break; } } } } while (0)
struct XcdBarrier { unsigned* bar; unsigned x; volatile LAS unsigned* st; };
__device__ __forceinline__ XcdBarrier xcd_barrier_post(unsigned* bar, volatile LAS unsigned* st) {
    XcdBarrier b; b.bar = bar; b.x = xb_xcc_id(); b.st = st;
    if (threadIdx.x == 0) (void)xb_add(&bar[XB_XCNT(b.x)], 1u);
    return b;
}
__device__ __forceinline__ void xcd_barrier_complete(unsigned* bar, unsigned x, unsigned& nloc, unsigned& nx) {
    const unsigned G = gridDim.x * gridDim.y * gridDim.z;
    unsigned sum, cnt, mine, sp = 0u;
    for (;;) {
        sum = 0u; cnt = 0u; mine = 0u;
#pragma unroll
        for (unsigned j = 0; j < 16; ++j) { const unsigned c = xb_ld(&bar[XB_XCNT(j)]); sum += c; cnt += (c > 0u) ? 1u : 0u; mine = (j == x) ? c : mine; }
        if (sum == G) break;
        __builtin_amdgcn_s_sleep(1);
        if ((++sp & 255u) == 0u) { if (xb_ld(&bar[XB_TMO])) break; if (sp > XB_SPIN_CAP) { atomicAdd(&bar[XB_TMO], 1u); break; } }
    }
    nloc = mine > 0u ? mine : 1u; nx = cnt > 0u ? cnt : 1u;
}
__device__ __forceinline__ void xcd_barrier(const XcdBarrier& b) {
    asm volatile("s_waitcnt vmcnt(0)" ::: "memory");
    __syncthreads();
    if (threadIdx.x == 0) {
        unsigned* bar = b.bar;
        __builtin_amdgcn_s_waitcnt(0);
        unsigned nloc = b.st[0], nx = b.st[1];
        if (nloc == 0u) { xcd_barrier_complete(bar, b.x, nloc, nx); b.st[0] = nloc; b.st[1] = nx; }
        const unsigned old = xb_add(&bar[XB_XSUB(b.x)], 1u);
        const unsigned gen = old / nloc;
        if (old + 1u == (gen + 1u) * nloc) {
            __builtin_amdgcn_fence(__ATOMIC_RELEASE, "agent");
            asm volatile("s_waitcnt vmcnt(0)" ::: "memory");
            const unsigned og = xb_add(&bar[XB_TOP], 1u);
            const unsigned tg = og / nx;
            if (og + 1u == (tg + 1u) * nx) xb_add(&bar[XB_TOPGEN], 1u);
            else XB_SPIN(xb_ld(&bar[XB_TOPGEN]) == tg, bar);
            __builtin_amdgcn_fence(__ATOMIC_ACQUIRE, "agent");
            xb_add(&bar[XB_XGEN(b.x)], 1u);
            asm volatile("s_waitcnt vmcnt(0)" ::: "memory");
        } else {
            XB_SPIN(xb_ld(&bar[XB_XGEN(b.x)]) == gen, bar);
            __builtin_amdgcn_fence(__ATOMIC_ACQUIRE, "agent");
            asm volatile("s_waitcnt vmcnt(0)" ::: "memory");
        }
    }
    __syncthreads();
}

#ifndef ATT_SDEPTH
#define ATT_SDEPTH 1
#endif
namespace att {
constexpr int D = 128, QBLK = 32, KVBLK = 64;
constexpr float SCALE = 0.088388347648318440f;
constexpr float THR = 8.f;
constexpr int SHM_V = KVBLK * D * 2, SHM_K = KVBLK * D * 2;
constexpr int OFF_WS = 2 * SHM_V + 2 * SHM_K;
constexpr int OFF_TB = OFF_WS + 8 * 64 * 4;
constexpr int OFF_FLG = OFF_TB + 448 * 4;
#define KSWZ(row, colB) ((row) * 256 + ((colB) ^ (((row) & 7) << 4)))
#define SBAR() __builtin_amdgcn_sched_barrier(0)
__device__ __forceinline__ int crow(int r, int hi) { return (r & 3) + 8 * (r >> 2) + 4 * hi; }
__device__ __forceinline__ unsigned cvtpk(float lo, float hi) { unsigned r; asm volatile("v_cvt_pk_bf16_f32 %0, %1, %2" : "=v"(r) : "v"(lo), "v"(hi)); return r; }

__device__ __forceinline__ void partialSM(f32x16& p0, f32x16& p1, float& m_reg, float& mn, float& alpha) {
  constexpr float C = SCALE * 1.4426950408889634f;
  float pmax = p0[0];
#pragma unroll
  for (int r = 1; r < 16; ++r) pmax = fmaxf(pmax, p0[r]);
#pragma unroll
  for (int r = 0; r < 16; ++r) pmax = fmaxf(pmax, p1[r]);
  { auto rr = __builtin_amdgcn_permlane32_swap(__float_as_uint(pmax), __float_as_uint(pmax), false, false);
    pmax = fmaxf(__uint_as_float(rr[0]), __uint_as_float(rr[1])); }
  if (__builtin_expect(__all(pmax - m_reg <= THR / SCALE), 1)) { mn = m_reg; alpha = 1.f; }
  else { mn = fmaxf(m_reg, pmax); alpha = __builtin_amdgcn_exp2f((m_reg - mn) * C); m_reg = mn; }
  float mnC = -mn * C;
#pragma unroll
  for (int r = 0; r < 16; ++r) p0[r] = fmaf(p0[r], C, mnC);
#pragma unroll
  for (int r = 0; r < 16; ++r) p1[r] = fmaf(p1[r], C, mnC);
#pragma unroll
  for (int r = 0; r < 16; ++r) p0[r] = __builtin_amdgcn_exp2f(p0[r]);
}
#define PK4(P, BASE, OUT) do { unsigned a0 = cvtpk(P[BASE + 0], P[BASE + 1]), a1 = cvtpk(P[BASE + 2], P[BASE + 3]);   \
    unsigned b0 = cvtpk(P[BASE + 4], P[BASE + 5]), b1 = cvtpk(P[BASE + 6], P[BASE + 7]);                              \
    auto r0 = __builtin_amdgcn_permlane32_swap(a0, b0, false, false); auto r1 = __builtin_amdgcn_permlane32_swap(a1, b1, false, false); \
    v4u w = {r0[0], r1[0], r0[1], r1[1]}; OUT = *reinterpret_cast<bf16x8*>(&w); } while (0)
__device__ __forceinline__ void finishSM(f32x16& p0, f32x16& p1, float alpha, float& l_reg, bf16x8& pa0, bf16x8& pa1, bf16x8& pa2, bf16x8& pa3) {
#pragma unroll
  for (int r = 0; r < 16; ++r) p1[r] = __builtin_amdgcn_exp2f(p1[r]);
  float ps = 0;
#pragma unroll
  for (int r = 0; r < 16; ++r) ps += p0[r];
#pragma unroll
  for (int r = 0; r < 16; ++r) ps += p1[r];
  { auto rr = __builtin_amdgcn_permlane32_swap(__float_as_uint(ps), __float_as_uint(ps), false, false);
    ps = __uint_as_float(rr[0]) + __uint_as_float(rr[1]); }
  l_reg = l_reg * alpha + ps;
  PK4(p0, 0, pa0); PK4(p0, 8, pa1); PK4(p1, 0, pa2); PK4(p1, 8, pa3);
}
__device__ __forceinline__ void packP(const f32x16& p0, const f32x16& p1, bf16x8& pa0, bf16x8& pa1, bf16x8& pa2, bf16x8& pa3) {
  PK4(p0, 0, pa0); PK4(p0, 8, pa1); PK4(p1, 0, pa2); PK4(p1, 8, pa3);
}
__device__ __forceinline__ void qkt(f32x16& p0, f32x16& p1, const char* Ks, const bf16x8* qr, int r32, int hi) {
  p0 = f32x16{}; p1 = f32x16{};
#pragma unroll
  for (int d0 = 0; d0 < 8; ++d0) { int cb = (d0 * 16 + hi * 8) * 2;
    bf16x8 b0 = *reinterpret_cast<const bf16x8*>(Ks + KSWZ(r32, cb));
    bf16x8 b1 = *reinterpret_cast<const bf16x8*>(Ks + KSWZ(32 + r32, cb));
    p0 = __builtin_amdgcn_mfma_f32_32x32x16_bf16(b0, qr[d0], p0, 0, 0, 0);
    p1 = __builtin_amdgcn_mfma_f32_32x32x16_bf16(b1, qr[d0], p1, 0, 0, 0); }
}
__device__ __forceinline__ int v_st(int k, int c) { const int kk = (k & ~0xC) | ((k & 4) << 1) | ((k & 8) >> 1); return ((kk >> 3) * 4 + (c >> 5)) * 512 + ((kk & 7) * 32 + (c & 31)) * 2; }
__device__ __forceinline__ int v_rd_base(int lane) { return ((lane & 3) << 3) | (((lane >> 2) & 3) << 6) | (((lane >> 4) & 1) << 5) | (((lane >> 5) & 1) << 8); }
constexpr int v_rd_off(int d0, int ks, int half) { return d0 * 512 + ks * 4096 + half * 2048; }
template <int OFF> __device__ __forceinline__ s16x4 tr_read(int vb) {
  s16x4 r; asm volatile("ds_read_b64_tr_b16 %0, %1 offset:%2" : "=&v"(r) : "v"(vb), "i"(OFF) : "memory"); return r;
}
template <int D0> __device__ __forceinline__ void pv_one(f32x16& od, int vb, bf16x8 pa0, bf16x8 pa1, bf16x8 pa2, bf16x8 pa3) {
  const s16x4 l0 = tr_read<v_rd_off(D0, 0, 0)>(vb), h0 = tr_read<v_rd_off(D0, 0, 1)>(vb), l1 = tr_read<v_rd_off(D0, 1, 0)>(vb), h1 = tr_read<v_rd_off(D0, 1, 1)>(vb);
  const s16x4 l2 = tr_read<v_rd_off(D0, 2, 0)>(vb), h2 = tr_read<v_rd_off(D0, 2, 1)>(vb), l3 = tr_read<v_rd_off(D0, 3, 0)>(vb), h3 = tr_read<v_rd_off(D0, 3, 1)>(vb);
  asm volatile("s_waitcnt lgkmcnt(0)" ::: "memory"); SBAR();
#define PKV(L, H) (bf16x8){L[0], L[1], L[2], L[3], H[0], H[1], H[2], H[3]}
  od = __builtin_amdgcn_mfma_f32_32x32x16_bf16(pa0, PKV(l0, h0), od, 0, 0, 0);
  od = __builtin_amdgcn_mfma_f32_32x32x16_bf16(pa1, PKV(l1, h1), od, 0, 0, 0);
  od = __builtin_amdgcn_mfma_f32_32x32x16_bf16(pa2, PKV(l2, h2), od, 0, 0, 0);
  od = __builtin_amdgcn_mfma_f32_32x32x16_bf16(pa3, PKV(l3, h3), od, 0, 0, 0);
#undef PKV
}
__device__ __forceinline__ void pv_d0(f32x16* o, int vb, bf16x8 pa0, bf16x8 pa1, bf16x8 pa2, bf16x8 pa3) {
  pv_one<0>(o[0], vb, pa0, pa1, pa2, pa3); pv_one<1>(o[1], vb, pa0, pa1, pa2, pa3); pv_one<2>(o[2], vb, pa0, pa1, pa2, pa3); pv_one<3>(o[3], vb, pa0, pa1, pa2, pa3);
}

__device__ __forceinline__ void* uniform_ptr(const void* p) { const unsigned long long v = (unsigned long long)p;
  const unsigned lo = (unsigned)__builtin_amdgcn_readfirstlane((int)(unsigned)v), hi = (unsigned)__builtin_amdgcn_readfirstlane((int)(unsigned)(v >> 32)); return (void*)(((unsigned long long)hi << 32) | lo); }
__device__ __forceinline__ bf16x8 mk8a(s16x4 l, s16x4 h) { return (bf16x8){l[0], l[1], l[2], l[3], h[0], h[1], h[2], h[3]}; }
__device__ __forceinline__ bf16x8 bload16(__amdgpu_buffer_rsrc_t rs, int voff, int soff) {
  const v4u w = __builtin_amdgcn_raw_buffer_load_b128(rs, voff, soff, 0); return __builtin_bit_cast(bf16x8, w); }
template <int LDP, int LDO>
__device__ __forceinline__ void attnB_unit(const bf16* __restrict__ Qb, const bf16* Pbase, int koff, int voff, float* __restrict__ Ob, int qb, char* lds) {
  const __amdgpu_buffer_rsrc_t rs = __builtin_amdgcn_make_buffer_rsrc(uniform_ptr(Pbase), 0, SEQ * LDP * 2, 0x00020000);
  int tid = threadIdx.x; asm volatile("" : "+v"(tid));
  const int wid = tid >> 6, lane = tid & 63, r32 = lane & 31, hi = lane >> 5;
  char* V_lds = lds; char* K_lds = lds + 2 * SHM_V;
  float* ws = (float*)(lds + OFF_WS) + wid * 64; float* li_l = ws; float* al_l = ws + 32;
  const float* tb = (const float*)(lds + OFF_TB);
  float m_reg = -1e30f, l_reg = 0; f32x16 o[4] = {}; bf16x8 qr[8];
  const bf16* Qw = Qb + (long)(wid * QBLK + r32) * LDP + hi * 8;
#pragma unroll
  for (int d0 = 0; d0 < 8; ++d0) qr[d0] = *reinterpret_cast<const bf16x8*>(Qw + d0 * 16);
  const int sr = tid >> 4, sc = (tid & 15) * 8, vst0 = v_st(sr, sc), vst1 = v_st(32 + sr, sc);
  const int vb0 = (int)(uintptr_t)V_lds + v_rd_base(lane);
  constexpr int SDEPTH = ATT_SDEPTH;
  struct { bf16x8 vs0, vs1, ks0, ks1; } sr_[SDEPTH];
  const int vo0 = (sr * LDP + sc) * 2, vo1 = vo0 + 32 * LDP * 2;
#define SLOAD(i, k0) do { const int sV_ = (voff + (k0) * LDP) * 2, sK_ = (koff + (k0) * LDP) * 2; \
    sr_[i].vs0 = bload16(rs, vo0, sV_); sr_[i].vs1 = bload16(rs, vo1, sV_); sr_[i].ks0 = bload16(rs, vo0, sK_); sr_[i].ks1 = bload16(rs, vo1, sK_); } while (0)
#define SWRITE(b, i) do { *(bf16x8*)(V_lds + (b) * SHM_V + vst0) = sr_[i].vs0;          \
    *(bf16x8*)(V_lds + (b) * SHM_V + vst1) = sr_[i].vs1; int kc = sc * 2;               \
    *(bf16x8*)(K_lds + (b) * SHM_K + KSWZ(sr, kc)) = sr_[i].ks0;                       \
    *(bf16x8*)(K_lds + (b) * SHM_K + KSWZ(32 + sr, kc)) = sr_[i].ks1; } while (0)
#define SWAIT() do { if constexpr (SDEPTH == 2) asm volatile("s_waitcnt vmcnt(4)" ::: "memory"); else asm volatile("s_waitcnt vmcnt(0)" ::: "memory"); } while (0)
#define RESC(a) do { if (__any((a) < 1.f)) { if (hi == 0) al_l[r32] = (a); asm volatile("s_waitcnt lgkmcnt(0)" ::: "memory"); \
    _Pragma("unroll") for (int d = 0; d < 4; ++d) _Pragma("unroll") for (int r = 0; r < 16; ++r) o[d][r] *= al_l[crow(r, hi)]; } } while (0)
  const int NT = 4 * qb + 4, chunk_w = 4 * qb + (wid >> 1);
  const int ib0 = 4 * hi - 256 * qb - 32 * wid - r32 + 127 + 256;
#ifdef NO_FIX
#define FIX(P0, P1, j) do {} while (0)
#else
#define FIX(P0, P1, j) do { if ((j) > chunk_w) { _Pragma("unroll") for (int r = 0; r < 16; ++r) { P0[r] = -1e30f; P1[r] = -1e30f; } } \
    else if ((j) >= NT - 6) { const float* tbj = tb + (ib0 + 64 * (j)); \
      _Pragma("unroll") for (int r = 0; r < 16; ++r) { P0[r] += tbj[(r & 3) + 8 * (r >> 2)]; P1[r] += tbj[32 + (r & 3) + 8 * (r >> 2)]; } } } while (0)
#endif
  f32x16 pA0, pA1, pB0, pB1; float mnA, mnB, alA, alB; bf16x8 pa0, pa1, pa2, pa3;
  constexpr int SE = 0, SO = SDEPTH - 1;
  SLOAD(SE, 0); asm volatile("s_waitcnt vmcnt(0)" ::: "memory"); SWRITE(0, SE); __syncthreads();
  qkt(pA0, pA1, K_lds, qr, r32, hi); FIX(pA0, pA1, 0); partialSM(pA0, pA1, m_reg, mnA, alA);
  SLOAD(SO, KVBLK); if constexpr (SDEPTH == 2) { if (2 < NT) SLOAD(SE, 2 * KVBLK); }
  SWAIT(); SWRITE(1, SO); __syncthreads();
  for (int j = 1; j + 1 < NT; j += 2) {
    SBAR(); qkt(pB0, pB1, K_lds + SHM_K, qr, r32, hi);
    finishSM(pA0, pA1, alA, l_reg, pa0, pa1, pa2, pa3); SBAR();
    SLOAD(SO, (j + SDEPTH) * KVBLK); SBAR();
    pv_d0(o, vb0, pa0, pa1, pa2, pa3); FIX(pB0, pB1, j); partialSM(pB0, pB1, m_reg, mnB, alB);
    __syncthreads(); SWAIT(); SWRITE(0, SE);
    RESC(alB); __syncthreads();
    SBAR(); qkt(pA0, pA1, K_lds, qr, r32, hi);
    finishSM(pB0, pB1, alB, l_reg, pa0, pa1, pa2, pa3); SBAR();
    if (SDEPTH == 1 || j + 3 < NT) SLOAD(SE, (j + 1 + SDEPTH) * KVBLK); SBAR();
    pv_d0(o, vb0 + SHM_V, pa0, pa1, pa2, pa3); FIX(pA0, pA1, j + 1); partialSM(pA0, pA1, m_reg, mnA, alA);
    __syncthreads(); SWAIT(); SWRITE(1, SO);
    RESC(alA); __syncthreads();
  }
  SBAR(); qkt(pB0, pB1, K_lds + SHM_K, qr, r32, hi);
  finishSM(pA0, pA1, alA, l_reg, pa0, pa1, pa2, pa3); SBAR();
  pv_d0(o, vb0, pa0, pa1, pa2, pa3); FIX(pB0, pB1, NT - 1); partialSM(pB0, pB1, m_reg, mnB, alB);
  __syncthreads(); RESC(alB);
  finishSM(pB0, pB1, alB, l_reg, pa0, pa1, pa2, pa3); SBAR();
  pv_d0(o, vb0 + SHM_V, pa0, pa1, pa2, pa3);
  if (hi == 0) li_l[r32] = l_reg; asm volatile("s_waitcnt lgkmcnt(0)" ::: "memory");
  float rli[16];
#pragma unroll
  for (int r = 0; r < 16; ++r) rli[r] = __builtin_amdgcn_rcpf(li_l[crow(r, hi)]);
  float* Ow = Ob + (long)(wid * QBLK) * LDO;
#pragma unroll
  for (int r = 0; r < 16; ++r) { int orow = crow(r, hi);
#pragma unroll
    for (int d0 = 0; d0 < 4; ++d0) Ow[(long)orow * LDO + d0 * 32 + r32] = o[d0][r] * rli[r]; }
  __syncthreads();
#undef SLOAD
#undef SWRITE
#undef SWAIT
#undef RESC
#undef FIX
}

__device__ __forceinline__ void glds16_asm(const void* gsrc, unsigned lds_dst) { unsigned keep;
  asm volatile("s_mov_b32 %0, m0\n\ts_mov_b32 m0, %2\n\ts_nop 0\n\tglobal_load_lds_dwordx4 %1, off\n\ts_mov_b32 m0, %0" : "=&s"(keep) : "v"(gsrc), "s"(lds_dst) : "memory"); }
constexpr int B2_K = 0, B2_V = 2 * SHM_K, B2_P = B2_V + 4 * SHM_V, B2_X = 131072 + 1024;
constexpr int B2_AL = B2_X, B2_FL = B2_AL + 1024, B2_LI = B2_FL + 64, B2_TB = B2_LI + 512;
template <int LDP, int LDO>
__device__ __forceinline__ void attnB2_unit(const bf16* __restrict__ Qb, const bf16* Pbase, int koff, int voff, float* __restrict__ Ob, int q128, char* lds, int sel = 0) {
  int tid = threadIdx.x; asm volatile("" : "+v"(tid));
  const int wid = __builtin_amdgcn_readfirstlane(tid >> 6), lane = tid & 63, r32 = lane & 31, hi = lane >> 5, pw = wid & 3;
  const int NT = 2 * q128 + 2;
  const unsigned lbase = (unsigned)__builtin_amdgcn_readfirstlane((int)(uintptr_t)lds);
  const bf16* Ksrc; const bf16* Vsrc[4];
  { const int row0 = 8 * wid + (lane >> 4), row1 = row0 + 4;
    Ksrc = Pbase + koff + (size_t)row0 * LDP + (((lane & 15) ^ (row0 & 7)) << 3);
    (void)row1; }
  const int kx1 = (int)((((lane & 15) ^ ((8 * wid + (lane >> 4) + 4) & 7)) << 3)) - (int)((((lane & 15) ^ ((8 * wid + (lane >> 4)) & 7)) << 3));
#pragma unroll
  for (int q = 0; q < 4; ++q) { const int ci = wid * 4 + q, vt = ci >> 4, cs = ci & 15, st = cs * 2 + (lane >> 5);
    const int kk = (st >> 2) * 8 + ((lane >> 2) & 7), k = (kk & ~0xC) | ((kk & 4) << 1) | ((kk & 8) >> 1), c = vt * 128 + (st & 3) * 32 + (lane & 3) * 8;
    Vsrc[q] = Pbase + voff + (size_t)k * LDP + c; }
#define B2DMA_K(t_, b_) do { const bf16* ks_ = Ksrc + (size_t)(t_) * KVBLK * LDP; const unsigned kd_ = (unsigned)__builtin_amdgcn_readfirstlane((int)(lbase + B2_K + (b_) * SHM_K + wid * 2048)); \
    glds16_asm(ks_, kd_); glds16_asm(ks_ + 4 * LDP + kx1, kd_ + 1024); } while (0)
#define B2DMA_V(t_, b_) do { _Pragma("unroll") for (int q = 0; q < 4; ++q) { const int ci_ = wid * 4 + q; \
      glds16_asm(Vsrc[q] + (size_t)(t_) * KVBLK * LDP, (unsigned)__builtin_amdgcn_readfirstlane((int)(lbase + B2_V + (b_) * 2 * SHM_V + (ci_ >> 4) * SHM_V + (ci_ & 15) * 1024))); } } while (0)
#define B2SYNC() do { asm volatile("s_waitcnt vmcnt(0)" ::: "memory"); __syncthreads(); } while (0)
  typedef __attribute__((address_space(3))) float lds_f32; typedef __attribute__((address_space(3))) int lds_i32;
  lds_f32* al_s = (lds_f32*)(uintptr_t)(lbase + B2_AL); lds_i32* fl_s = (lds_i32*)(uintptr_t)(lbase + B2_FL); lds_f32* li_s = (lds_f32*)(uintptr_t)(lbase + B2_LI);
  B2DMA_K(0, 0); B2DMA_V(0, 0); B2DMA_K(1, 1);
  if (wid < 4) {
    const float* tb = (const float*)(lds + B2_TB);
    const int chunk_w = 2 * q128 + (pw >> 1);
    const int ib0 = 4 * hi - 128 * q128 - 32 * pw - r32 + 127 + 256;
    float m_reg = -1e30f, l_reg = 0.f; bf16x8 qr[8];
    { const bf16* Qw = Qb + (long)(pw * QBLK + r32) * LDP + hi * 8;
#pragma unroll
      for (int d0 = 0; d0 < 8; ++d0) qr[d0] = *reinterpret_cast<const bf16x8*>(Qw + d0 * 16); }
    B2SYNC();
#define B2PROD(t_) do { f32x16 p0, p1; qkt(p0, p1, lds + B2_K + ((t_) & 1) * SHM_K, qr, r32, hi); \
      if ((t_) > chunk_w) { _Pragma("unroll") for (int r = 0; r < 16; ++r) { p0[r] = -1e30f; p1[r] = -1e30f; } } \
      else if ((t_) >= NT - 4) { const float* tbj = tb + (ib0 + 64 * (t_)); \
        _Pragma("unroll") for (int r = 0; r < 16; ++r) { p0[r] += tbj[(r & 3) + 8 * (r >> 2)]; p1[r] += tbj[32 + (r & 3) + 8 * (r >> 2)]; } } \
      float mn_, al_; partialSM(p0, p1, m_reg, mn_, al_); bf16x8 pa0, pa1, pa2, pa3; finishSM(p0, p1, al_, l_reg, pa0, pa1, pa2, pa3); \
      char* pb_ = lds + B2_P + ((((t_) & 1) * 4 + pw) * 4) * 1024 + lane * 16; \
      *(bf16x8*)(pb_) = pa0; *(bf16x8*)(pb_ + 1024) = pa1; *(bf16x8*)(pb_ + 2048) = pa2; *(bf16x8*)(pb_ + 3072) = pa3; \
      if (hi == 0) al_s[(((t_) & 1) * 4 + pw) * 32 + r32] = al_; \
      const int any_ = __any(al_ < 1.f) ? 1 : 0; if (lane == 0) fl_s[((t_) & 1) * 4 + pw] = any_; } while (0)
    B2PROD(0);
    B2SYNC();
    for (int j = 0; j < NT; ++j) {
      if (j + 2 < NT) B2DMA_K(j + 2, j & 1);
      if (j + 1 < NT) B2DMA_V(j + 1, (j + 1) & 1);
      if (j + 1 < NT && !(sel & 4)) B2PROD(j + 1);
      B2SYNC();
    }
    if (hi == 0) li_s[pw * 32 + r32] = __builtin_amdgcn_rcpf(l_reg);
    __syncthreads();
#undef B2PROD
  } else {
    f32x16 o[8] = {};
    const int vb0 = (int)(uintptr_t)(lds + B2_V) + v_rd_base(lane);
    B2SYNC();
    B2SYNC();
    for (int j = 0; j < NT; ++j) {
      if (j + 2 < NT) B2DMA_K(j + 2, j & 1);
      if (j + 1 < NT) B2DMA_V(j + 1, (j + 1) & 1);
      if (!(sel & 8)) { const int bsel = j & 1;
        if (fl_s[bsel * 4 + pw]) { const lds_f32* ap = al_s + (bsel * 4 + pw) * 32;
#pragma unroll
          for (int d = 0; d < 8; ++d)
#pragma unroll
            for (int r = 0; r < 16; ++r) o[d][r] *= ap[crow(r, hi)]; }
        const char* pb_ = lds + B2_P + ((bsel * 4 + pw) * 4) * 1024 + lane * 16;
        const bf16x8 pa0 = *(const bf16x8*)(pb_), pa1 = *(const bf16x8*)(pb_ + 1024), pa2 = *(const bf16x8*)(pb_ + 2048), pa3 = *(const bf16x8*)(pb_ + 3072);
        pv_d0(o, vb0 + bsel * 2 * SHM_V, pa0, pa1, pa2, pa3); pv_d0(o + 4, vb0 + bsel * 2 * SHM_V + SHM_V, pa0, pa1, pa2, pa3); }
      B2SYNC();
    }
    __syncthreads();
    float rli[16];
#pragma unroll
    for (int r = 0; r < 16; ++r) rli[r] = li_s[pw * 32 + crow(r, hi)];
    float* Ow = Ob + (long)(pw * QBLK) * LDO;
#pragma unroll
    for (int r = 0; r < 16; ++r) { const int orow = crow(r, hi);
#pragma unroll
      for (int d = 0; d < 8; ++d) Ow[(long)orow * LDO + d * 32 + r32] = o[d][r] * rli[r]; }
  }
  __syncthreads();
#undef B2DMA_K
#undef B2DMA_V
#undef B2SYNC
}

template <int LDP, int LDO>
__device__ __forceinline__ void attnA_unit(const bf16* __restrict__ Qb, const bf16* Pbase, int koff, int voff, bf16* __restrict__ Ob, int qb, char* lds) {
  const __amdgpu_buffer_rsrc_t rs = __builtin_amdgcn_make_buffer_rsrc(uniform_ptr(Pbase), 0, SEQ * LDP * 2, 0x00020000);
  int tid = threadIdx.x; asm volatile("" : "+v"(tid));
  const int wid = __builtin_amdgcn_readfirstlane(tid >> 6), lane = tid & 63, r32 = lane & 31, hi = lane >> 5;
  char* K_lds = lds + wid * 16384; char* V_lds = K_lds + 8192;
  f32x16 o[4] = {}; bf16x8 qr[8];
  const bf16* Qw = Qb + (long)(wid * QBLK + r32) * LDP + hi * 8;
#pragma unroll
  for (int d0 = 0; d0 < 8; ++d0) qr[d0] = *reinterpret_cast<const bf16x8*>(Qw + d0 * 16);
  const int srow = lane >> 1, scol = (lane & 1) * 64;
  const int vo = (srow * LDP + scol) * 2;
  const int vb0 = (int)(uintptr_t)V_lds + v_rd_base(lane);
  const int krow = lane >> 4, kch = lane & 15;
  const unsigned klds = (unsigned)__builtin_amdgcn_readfirstlane((int)(uintptr_t)K_lds);
  const bf16* Ksrc = Pbase + koff;
  float R = 0.f;
  const int htd = 8 * qb + wid;
  bf16x8 tv[8];
#define AKDMA(ht_) do { _Pragma("unroll") for (int j = 0; j < 8; ++j) { const int row_ = 4 * j + krow; \
      __builtin_amdgcn_global_load_lds((const unsigned*)(Ksrc + (size_t)((ht_) * 32 + row_) * LDP + ((kch ^ (row_ & 7)) << 3)), (__attribute__((address_space(3))) unsigned*)(uintptr_t)(klds + j * 1024), 16, 0, 0); } } while (0)
#define AVLOAD(ht_) do { const int sV_ = __builtin_amdgcn_readfirstlane((voff + (ht_) * 32 * LDP) * 2); _Pragma("unroll") for (int j = 0; j < 8; ++j) tv[j] = bload16(rs, vo + 16 * j, sV_); } while (0)
  AKDMA(htd); AVLOAD(htd);
  for (int ht = htd; ht >= 0; --ht) {
    asm volatile("s_waitcnt vmcnt(0)" ::: "memory");
#pragma unroll
    for (int j = 0; j < 8; ++j) *(bf16x8*)(V_lds + v_st(srow, scol + 8 * j)) = tv[j];
    if (ht > 0) AVLOAD(ht - 1);
    asm volatile("s_waitcnt lgkmcnt(0)" ::: "memory");
    f32x16 p0 = f32x16{};
#pragma unroll
    for (int d0 = 0; d0 < 8; ++d0) { const int cb = (d0 * 16 + hi * 8) * 2;
      const bf16x8 b0 = *reinterpret_cast<const bf16x8*>(K_lds + KSWZ(r32, cb));
      p0 = __builtin_amdgcn_mfma_f32_32x32x16_bf16(b0, qr[d0], p0, 0, 0, 0); }
    asm volatile("s_waitcnt lgkmcnt(0)" : "+v"(p0) :: "memory");
    if (ht > 0) AKDMA(ht - 1);
    const int lim = (ht == htd) ? r32 : 32;
    float qs[4], oq[4]; f32x16 Ln;
#pragma unroll
    for (int g = 0; g < 4; ++g) { float s_ = 0.f;
#pragma unroll
      for (int i = 0; i < 4; ++i) { const int r = 4 * g + i; const float x = p0[r] * SCALE; p0[r] = x;
        const float sp = __logf(1.f + __expf(-fabsf(x))); const float ln = (crow(r, hi) < lim) ? -(fmaxf(x, 0.f) + sp) : 0.f;
        Ln[r] = ln; s_ += ln; }
      qs[g] = s_; }
#pragma unroll
    for (int g = 0; g < 4; ++g) oq[g] = __shfl_xor(qs[g], 32);
    float run = 0.f;
#pragma unroll
    for (int g = 3; g >= 0; --g) { float E = R + run + (hi == 0 ? oq[g] : 0.f);
#pragma unroll
      for (int i = 3; i >= 0; --i) { const int r = 4 * g + i;
        const bool valid = crow(r, hi) < lim;
        const float w = valid ? __expf(Ln[r] + p0[r] + E) : 0.f; E += Ln[r]; p0[r] = w; }
      run += qs[g] + oq[g]; }
    R += run;
    bf16x8 pa0, pa1; PK4(p0, 0, pa0); PK4(p0, 8, pa1);
#define AV_ONE(D0) do { const s16x4 l0 = tr_read<v_rd_off(D0, 0, 0)>(vb0), h0 = tr_read<v_rd_off(D0, 0, 1)>(vb0), l1 = tr_read<v_rd_off(D0, 1, 0)>(vb0), h1 = tr_read<v_rd_off(D0, 1, 1)>(vb0); \
      asm volatile("s_waitcnt lgkmcnt(0)" ::: "memory"); SBAR(); \
      o[D0] = __builtin_amdgcn_mfma_f32_32x32x16_bf16(pa0, mk8a(l0, h0), o[D0], 0, 0, 0); o[D0] = __builtin_amdgcn_mfma_f32_32x32x16_bf16(pa1, mk8a(l1, h1), o[D0], 0, 0, 0); } while (0)
    AV_ONE(0); AV_ONE(1); AV_ONE(2); AV_ONE(3);
#undef AV_ONE
    if (__all(R < -104.f)) break;
  }
#undef AKDMA
#undef AVLOAD
  asm volatile("s_waitcnt vmcnt(0)" ::: "memory");
  bf16* Ow = Ob + (long)(wid * QBLK) * LDO;
#pragma unroll
  for (int r = 0; r < 16; ++r) { const int orow = crow(r, hi);
#pragma unroll
    for (int d0 = 0; d0 < 4; ++d0) Ow[(long)orow * LDO + d0 * 32 + r32] = (bf16)f2bf(o[d0][r]); }
  __syncthreads();
}
__device__ __forceinline__ bf16x8 mk8(s16x4 l, s16x4 h) { return (bf16x8){l[0], l[1], l[2], l[3], h[0], h[1], h[2], h[3]}; }
__device__ __forceinline__ v4u pack8(const float* f) { v4u w; w.x = cvtpk(f[0], f[1]); w.y = cvtpk(f[2], f[3]); w.z = cvtpk(f[4], f[5]); w.w = cvtpk(f[6], f[7]); return w; }
__device__ __forceinline__ void rot8(v4u lo4, v4u hi4, const float2* cs, float mul, float* ol, float* oh) {
#pragma unroll
  for (int q = 0; q < 4; ++q) { const float2 c0 = cs[2 * q], c1 = cs[2 * q + 1];
    const float l0 = bflo(lo4[q]), l1 = bfhi(lo4[q]), h0 = bflo(hi4[q]), h1 = bfhi(hi4[q]);
    ol[2 * q] = (l0 * c0.x - h0 * c0.y) * mul; ol[2 * q + 1] = (l1 * c1.x - h1 * c1.y) * mul;
    oh[2 * q] = (h0 * c0.x + l0 * c0.y) * mul; oh[2 * q + 1] = (h1 * c1.x + l1 * c1.y) * mul; }
}
template <int LDP>
__device__ __forceinline__ void ret_kv_unit(const bf16* __restrict__ P, const float2* __restrict__ ROPE, bf16* __restrict__ kvo, int b, int h, int n, char* lds) {
  int tid = threadIdx.x; asm volatile("" : "+v"(tid));
  const int wid = tid >> 6, lane = tid & 63, r32 = lane & 31, hi = lane >> 5;
  char* Vt = lds; char* Kt = lds + 2 * SHM_V;
  const size_t t0 = (size_t)b * SEQ + 64 * n;
  const float lg = __logf(1.f - exp2f(-5.f - (float)h));
  {
    bf16x8 vv[4];
#pragma unroll
    for (int it = 0; it < 4; ++it) { const int task = it * 512 + tid, vt = task >> 10, row = (task >> 4) & 63, sc = (task & 15) * 8;
      vv[it] = *reinterpret_cast<const bf16x8*>(P + (t0 + row) * LDP + 1024 + h * 256 + vt * 128 + sc); }
    const int m = tid >> 3, dc = (tid & 7) * 8; const bf16* kr = P + (t0 + m) * LDP + 512 + h * 128;
    const v4u lo4 = *(const v4u*)(kr + dc), hi4 = *(const v4u*)(kr + 64 + dc);
    float2 csv[8]; { const float2* cs = ROPE + (size_t)(64 * n + m) * 64 + dc;
#pragma unroll
      for (int q = 0; q < 8; ++q) csv[q] = cs[q]; }
#pragma unroll
    for (int it = 0; it < 4; ++it) { const int task = it * 512 + tid, vt = task >> 10, row = (task >> 4) & 63, sc = (task & 15) * 8;
      *(bf16x8*)(Vt + vt * SHM_V + v_st(row, sc)) = vv[it]; }
    float ol[8], oh[8]; rot8(lo4, hi4, csv, __expf(lg * (float)(63 - m)), ol, oh);
    *(v4u*)(Kt + v_st(m, dc)) = pack8(ol); *(v4u*)(Kt + v_st(m, 64 + dc)) = pack8(oh); }
  __syncthreads();
  const int vbA = (int)(uintptr_t)(Vt + (wid >> 2) * SHM_V) + v_rd_base(lane) + (wid & 3) * 512;
  const int vbB = (int)(uintptr_t)Kt + v_rd_base(lane);
  bf16x8 a[4];
  { const s16x4 l0 = tr_read<v_rd_off(0, 0, 0)>(vbA), h0 = tr_read<v_rd_off(0, 0, 1)>(vbA), l1 = tr_read<v_rd_off(0, 1, 0)>(vbA), h1 = tr_read<v_rd_off(0, 1, 1)>(vbA);
    const s16x4 l2 = tr_read<v_rd_off(0, 2, 0)>(vbA), h2 = tr_read<v_rd_off(0, 2, 1)>(vbA), l3 = tr_read<v_rd_off(0, 3, 0)>(vbA), h3 = tr_read<v_rd_off(0, 3, 1)>(vbA);
    asm volatile("s_waitcnt lgkmcnt(0)" ::: "memory"); SBAR();
    a[0] = mk8(l0, h0); a[1] = mk8(l1, h1); a[2] = mk8(l2, h2); a[3] = mk8(l3, h3); }
  f32x16 acc[4] = {};
  pv_one<0>(acc[0], vbB, a[0], a[1], a[2], a[3]); pv_one<1>(acc[1], vbB, a[0], a[1], a[2], a[3]); pv_one<2>(acc[2], vbB, a[0], a[1], a[2], a[3]); pv_one<3>(acc[3], vbB, a[0], a[1], a[2], a[3]);
#pragma unroll
  for (int db = 0; db < 4; ++db)
#pragma unroll
    for (int r = 0; r < 16; ++r) kvo[(size_t)(32 * wid + crow(r, hi)) * 128 + 32 * db + r32] = (bf16)f2bf(acc[db][r]);
  __syncthreads();
}
template <int LDP, int LDO>
__device__ __forceinline__ void ret_out_unit(const bf16* __restrict__ P, const float2* __restrict__ ROPE, const bf16* __restrict__ PREV, const float* __restrict__ rg, bf16* __restrict__ O, int b, int h, int np, char* lds) {
  int tid = threadIdx.x; asm volatile("" : "+v"(tid));
  const int wid = tid >> 6, lane = tid & 63, r32 = lane & 31, hi = lane >> 5;
  const int cw = wid >> 2, qh = (wid >> 1) & 1, eh = wid & 1, bh = b * 4 + h;
  constexpr int CH = 3 * SHM_V;
  float* red = (float*)(lds + 2 * CH);
  const float lg = __logf(1.f - exp2f(-5.f - (float)h));
  { v4u klo[2], khi[2]; float2 csv[2][8]; bf16x8 vv[2][4]; const int m = tid >> 3, dc = (tid & 7) * 8;
#pragma unroll
    for (int cc = 0; cc < 2; ++cc) { const int n = 2 * np + cc; const size_t t0 = (size_t)b * SEQ + 64 * n;
      const bf16* kr = P + (t0 + m) * LDP + 512 + h * 128; klo[cc] = *(const v4u*)(kr + dc); khi[cc] = *(const v4u*)(kr + 64 + dc);
      const float2* cs = ROPE + (size_t)(64 * n + m) * 64 + dc;
#pragma unroll
      for (int q = 0; q < 8; ++q) csv[cc][q] = cs[q];
#pragma unroll
      for (int it = 0; it < 4; ++it) { const int task = it * 512 + tid, vt = task >> 10, row = (task >> 4) & 63, sc = (task & 15) * 8;
        vv[cc][it] = *reinterpret_cast<const bf16x8*>(P + (t0 + row) * LDP + 1024 + h * 256 + vt * 128 + sc); } }
#pragma unroll
    for (int cc = 0; cc < 2; ++cc) { float ol[8], oh[8]; rot8(klo[cc], khi[cc], csv[cc], 1.f, ol, oh);
      *(v4u*)(lds + cc * CH + KSWZ(m, dc * 2)) = pack8(ol); *(v4u*)(lds + cc * CH + KSWZ(m, (64 + dc) * 2)) = pack8(oh);
#pragma unroll
      for (int it = 0; it < 4; ++it) { const int task = it * 512 + tid, vt = task >> 10, row = (task >> 4) & 63, sc = (task & 15) * 8;
        *(bf16x8*)(lds + cc * CH + SHM_V + vt * SHM_V + v_st(row, sc)) = vv[cc][it]; } } }
  const int n = 2 * np + cw; const size_t tq = (size_t)b * SEQ + 64 * n + 32 * qh + r32;
  bf16x8 qr[8];
  { const bf16* qrow = P + tq * LDP + h * 128 + hi * 8; const float2* cs = ROPE + (size_t)(64 * n + 32 * qh + r32) * 64 + hi * 8;
#pragma unroll
    for (int d0 = 0; d0 < 4; ++d0) { const v4u lo4 = *(const v4u*)(qrow + d0 * 16), hi4 = *(const v4u*)(qrow + 64 + d0 * 16);
      float ol[8], oh[8]; rot8(lo4, hi4, cs + d0 * 16, SCALE, ol, oh);
      const v4u wl = pack8(ol), wh = pack8(oh); qr[d0] = __builtin_bit_cast(bf16x8, wl); qr[d0 + 4] = __builtin_bit_cast(bf16x8, wh); } }
  f32x16 o[4] = {};
  { const bf16* pv = PREV + ((size_t)bh * 64 + n) * 32768 + (size_t)(128 * eh + r32) * 128 + hi * 8;
    bf16x8 bc[8], bn[8];
#pragma unroll
    for (int ks = 0; ks < 8; ++ks) bc[ks] = *reinterpret_cast<const bf16x8*>(pv + ks * 16);
#pragma unroll
    for (int d0 = 0; d0 < 4; ++d0) {
      if (d0 < 3) {
#pragma unroll
        for (int ks = 0; ks < 8; ++ks) bn[ks] = *reinterpret_cast<const bf16x8*>(pv + (size_t)(32 * (d0 + 1)) * 128 + ks * 16); }
      __builtin_amdgcn_sched_barrier(0);
#pragma unroll
      for (int ks = 0; ks < 8; ++ks) o[d0] = __builtin_amdgcn_mfma_f32_32x32x16_bf16(qr[ks], bc[ks], o[d0], 0, 0, 0);
      __builtin_amdgcn_sched_barrier(0);
      if (d0 < 3) {
#pragma unroll
        for (int ks = 0; ks < 8; ++ks) bc[ks] = bn[ks]; } } }
#pragma unroll
  for (int r = 0; r < 16; ++r) { const float qd = __expf(lg * (float)(32 * qh + crow(r, hi) + 1));
#pragma unroll
    for (int d0 = 0; d0 < 4; ++d0) o[d0][r] *= qd; }
  __syncthreads();
  { f32x16 p0, p1; qkt(p0, p1, lds + cw * CH, qr, r32, hi);
    const int c = 32 * qh + r32;
#pragma unroll
    for (int r = 0; r < 16; ++r) { const int m0 = crow(r, hi), m1 = m0 + 32; const int d0_ = c > m0 ? c - m0 : m0 - c, d1_ = c > m1 ? c - m1 : m1 - c;
      p0[r] *= __expf(lg * (float)d0_); p1[r] *= __expf(lg * (float)d1_); }
    bf16x8 pa0, pa1, pa2, pa3; packP(p0, p1, pa0, pa1, pa2, pa3);
    pv_d0(o, (int)(uintptr_t)(lds + cw * CH + SHM_V + eh * SHM_V) + v_rd_base(lane), pa0, pa1, pa2, pa3); }
  { float ssq[16];
#pragma unroll
    for (int r = 0; r < 16; ++r) { float s_ = (o[0][r] * o[0][r] + o[1][r] * o[1][r]) + (o[2][r] * o[2][r] + o[3][r] * o[3][r]);
      s_ += __shfl_xor(s_, 1); s_ += __shfl_xor(s_, 2); s_ += __shfl_xor(s_, 4); s_ += __shfl_xor(s_, 8); s_ += __shfl_xor(s_, 16); ssq[r] = s_; }
    if (r32 == 0) {
#pragma unroll
      for (int r = 0; r < 16; ++r) red[wid * 32 + crow(r, hi)] = ssq[r]; }
    __syncthreads();
    const size_t trow0 = (size_t)b * SEQ + 64 * n + 32 * qh;
    bf16 gv[16][4];
#pragma unroll
    for (int r = 0; r < 16; ++r)
#pragma unroll
      for (int d0 = 0; d0 < 4; ++d0) gv[r][d0] = P[(trow0 + crow(r, hi)) * LDP + 2048 + h * 256 + 128 * eh + 32 * d0 + r32];
#pragma unroll
    for (int r = 0; r < 16; ++r) { const int rl = crow(r, hi); const float tot = red[wid * 32 + rl] + red[(wid ^ 1) * 32 + rl]; const float rstd = rsqrtf(tot * (1.f / 256.f) + 1e-6f);
      const size_t row = trow0 + rl;
#pragma unroll
      for (int d0 = 0; d0 < 4; ++d0) { const int e = 128 * eh + 32 * d0 + r32;
        const float gate = silu_f(bf2f(gv[r][d0]));
        O[row * LDO + h * 256 + e] = (bf16)f2bf(o[d0][r] * rstd * rg[e] * gate); } } }
  __syncthreads();
}
template <int LDP, int LDO>
__device__ __forceinline__ void sgu_unit(const bf16* __restrict__ P, const unsigned long long* __restrict__ lnsum, const float* __restrict__ lng, const float* __restrict__ lnb, const float* __restrict__ Wg, const float* __restrict__ bs,
                                         bf16* __restrict__ O, size_t t0, int g, char* lds) {
  int tid = threadIdx.x; asm volatile("" : "+v"(tid));
  const int wid = tid >> 6, lane = tid & 63, r32 = lane & 31, hi = lane >> 5;
  { const int cc = (tid & 31) * 8;
    v4u vin[8]; unsigned long long s1v[8], s2v[8];
#pragma unroll
    for (int it = 0; it < 8; ++it) { const int j = it * 16 + (tid >> 5);
      vin[it] = *(const v4u*)(P + (t0 + j) * LDP + 4096 + g * 256 + cc); s1v[it] = lnsum[2 * (t0 + j)]; s2v[it] = lnsum[2 * (t0 + j) + 1]; }
    const f32x4 g0 = *(const f32x4*)(lng + g * 256 + cc), g1 = *(const f32x4*)(lng + g * 256 + cc + 4), b0 = *(const f32x4*)(lnb + g * 256 + cc), b1 = *(const f32x4*)(lnb + g * 256 + cc + 4);
#pragma unroll
    for (int it = 0; it < 8; ++it) { const int j = it * 16 + (tid >> 5); const v4u v4 = vin[it];
      const float s1 = (float)(long long)s1v[it] * (1.f / 16777216.f), s2 = (float)(long long)s2v[it] * (1.f / 16777216.f); const float mean = s1 * (1.f / 1024.f); const float rstd = rsqrtf(fmaxf(s2 * (1.f / 1024.f) - mean * mean, 0.f) + 1e-6f);
      float y[8];
#pragma unroll
      for (int q = 0; q < 4; ++q) { y[2 * q] = gelu_tanh(bflo(v4[q])); y[2 * q + 1] = gelu_tanh(bfhi(v4[q])); }
#pragma unroll
      for (int q = 0; q < 4; ++q) { y[q] = (y[q] - mean) * rstd * g0[q] + b0[q]; y[4 + q] = (y[4 + q] - mean) * rstd * g1[q] + b1[q]; }
      *(v4u*)(lds + ((j >> 6) * 2 + (cc >> 7)) * SHM_V + v_st(j & 63, cc & 127)) = pack8(y); } }
  const int ib = wid & 3, ct = wid >> 2;
  bf16x8 wa[8];
  { const float* wr = Wg + (size_t)(32 * ib + r32) * 128 + hi * 8;
#pragma unroll
    for (int ks = 0; ks < 8; ++ks) { if (ks < 4 || ib >= 2) { const f32x4 a0 = *(const f32x4*)(wr + ks * 16), a1 = *(const f32x4*)(wr + ks * 16 + 4);
        v4u w; w.x = cvtpk(a0[0], a0[1]); w.y = cvtpk(a0[2], a0[3]); w.z = cvtpk(a1[0], a1[1]); w.w = cvtpk(a1[2], a1[3]); wa[ks] = __builtin_bit_cast(bf16x8, w); }
      else wa[ks] = (bf16x8){0, 0, 0, 0, 0, 0, 0, 0}; } }
  __syncthreads();
  f32x16 o[4] = {};
  pv_d0(o, (int)(uintptr_t)(lds + (0 * 2 + ct) * SHM_V) + v_rd_base(lane), wa[0], wa[1], wa[2], wa[3]);
  if (ib >= 2) pv_d0(o, (int)(uintptr_t)(lds + (1 * 2 + ct) * SHM_V) + v_rd_base(lane), wa[4], wa[5], wa[6], wa[7]);
  { bf16 uv[16][4];
#pragma unroll
    for (int r = 0; r < 16; ++r)
#pragma unroll
      for (int d0 = 0; d0 < 4; ++d0) uv[r][d0] = P[(t0 + 32 * ib + crow(r, hi)) * LDP + 3072 + g * 256 + 128 * ct + 32 * d0 + r32];
#pragma unroll
    for (int r = 0; r < 16; ++r) { const int i = 32 * ib + crow(r, hi); const float bi = bs[i]; const size_t row = t0 + i;
#pragma unroll
      for (int d0 = 0; d0 < 4; ++d0) { const int c = 128 * ct + 32 * d0 + r32;
        const float uu = gelu_tanh(bf2f(uv[r][d0]));
        O[row * LDO + 1024 + g * 256 + c] = (bf16)f2bf(uu * (o[d0][r] + bi)); } } }
  __syncthreads();
}
#undef SBAR
}

__device__ __forceinline__ f32x4 mma16(bf16x8 a, bf16x8 b, f32x4 c) { return __builtin_amdgcn_mfma_f32_16x16x32_bf16(a, b, c, 0, 0, 0); }

struct Args { const float* in[20]; float* out; unsigned char* ws; int ph_lo, ph_hi, sel, li; };

constexpr int N_PHASES = 17;

__global__ void __launch_bounds__(NWAVES * 64, 2) mega_fwd(Args args) {
    extern __shared__ __attribute__((aligned(16))) unsigned char lds[];
    LAS unsigned char* ldsl = (LAS unsigned char*)lds;
    const int G = gridDim.x; const int bx = blockIdx.x;
    const int vcu = (G % 8 == 0) ? (bx % 8) * (G / 8) + bx / 8 : bx;
#define PHASE_ENV() \
    const __attribute__((address_space(4))) Args* ap_ = (const __attribute__((address_space(4))) Args*)__builtin_amdgcn_kernarg_segment_ptr(); asm volatile("" : "+s"(ap_)); \
    int tid = threadIdx.x; asm volatile("" : "+v"(tid)); const int lane = tid & 63, wave = __builtin_amdgcn_readfirstlane(tid >> 6); (void)lane; \
    unsigned char* const ws = ap_->ws; const int gw = vcu * NWAVES + wave, NGW = G * NWAVES; const int gt = vcu * (NWAVES * 64) + tid, NGT = G * NWAVES * 64; \
    const float* const x_in = ap_->in[0]; \
    bf16* const W_ABIN = (bf16*)(ws + WS_W_ABIN); bf16* const W_ABOUT = (bf16*)(ws + WS_W_ABOUT); bf16* const W_CDIN = (bf16*)(ws + WS_W_CDIN); bf16* const W_CDOUT = (bf16*)(ws + WS_W_CDOUT); \
    bf16* const W_UP0 = (bf16*)(ws + WS_W_UP0); bf16* const W_UP1 = (bf16*)(ws + WS_W_UP1); bf16* const W_DN0 = (bf16*)(ws + WS_W_DN0); bf16* const W_DN1 = (bf16*)(ws + WS_W_DN1); \
    bf16* const XN = (bf16*)(ws + WS_XN); bf16* const OB16 = (bf16*)(ws + WS_O); float* const X = (float*)(ws + WS_X); bf16* const ACT = (bf16*)(ws + WS_ACT); \
    bf16* const P = (bf16*)(ws + WS_P); float* const OBF = (float*)(ws + WS_OB); bf16* const KV = (bf16*)(ws + WS_KV); bf16* const PREV = (bf16*)(ws + WS_PREV); bf16* const UP = (bf16*)(ws + WS_UP); \
    unsigned long long* const SS = (unsigned long long*)(ws + WS_SS); (void)SS; unsigned long long* const LNS = (unsigned long long*)(ws + WS_LNS); (void)LNS; bf16* const HALO = (bf16*)(ws + WS_HALO); (void)HALO; bf16* const SCR = (bf16*)(ws + WS_SCR); (void)SCR; float* const SCAL = (float*)(ws + WS_SCAL); float2* const ROPE = (float2*)(ws + WS_ROPE); \
    (void)gw; (void)NGW; (void)gt; (void)NGT; (void)x_in; (void)W_ABIN; (void)W_ABOUT; (void)W_CDIN; (void)W_CDOUT; (void)W_UP0; (void)W_UP1; (void)W_DN0; (void)W_DN1; (void)XN; (void)OB16; (void)X; (void)ACT; (void)P; (void)OBF; (void)KV; (void)PREV; (void)UP; (void)SCAL; (void)ROPE;
#define AIN(k) (ap_->in[k])

#if !MK_PER_PHASE
    for (int u = threadIdx.x; u < (LDS_BYTES - LDSCTL_OFF) / 4; u += NWAVES * 64) ((LAS unsigned*)(ldsl + LDSCTL_OFF))[u] = 0u;
    __syncthreads();
    XcdBarrier bar = xcd_barrier_post((unsigned*)(args.ws + WS_CTL) + 4096 + args.li * XCD_BAR_WORDS, (volatile LAS unsigned*)(ldsl + MISC_OFF) + 8);
#define GRID_BAR() xcd_barrier(bar)
#else
#define GRID_BAR() do {} while (0)
#endif
    const int lo = args.ph_lo, hi_ph = args.ph_hi;
#ifndef PH_MASK
#define PH_MASK 0xFFFFFFu
#endif
#define IN(k) (((PH_MASK >> (k)) & 1u) && lo <= (k) && (k) < hi_ph)
#define SEAM(k) do { if (IN(k) && IN((k) + 1)) GRID_BAR(); } while (0)
#ifndef REPEAT_MASK
#define REPEAT_MASK 0u
#endif
#define NREP(k) (((REPEAT_MASK >> (k)) & 1u) ? 2 : 1)

#define RAW_TO_XN(SRC, SSP) do { \
        for (int m = gw; m < MTOK; m += NGW) { const GAS f32x4* xr = (const GAS f32x4*)((SRC) + (size_t)m * DM) + lane; f32x4 v[8]; float s = 0.f; \
            _Pragma("unroll") for (int j = 0; j < 8; ++j) { v[j] = xr[64 * j]; s += (v[j].x * v[j].x + v[j].y * v[j].y) + (v[j].z * v[j].z + v[j].w * v[j].w); } \
            s = wave_sum(s); if (lane == 0) (SSP)[m] = (unsigned long long)(s * 16777216.f); \
            GAS v2u* o8 = (GAS v2u*)(XN + (size_t)m * DM) + lane; \
            _Pragma("unroll") for (int j = 0; j < 8; ++j) { v2u w; w.x = pk2(v[j].x, v[j].y); w.y = pk2(v[j].z, v[j].w); o8[64 * j] = w; } } } while (0)

    constexpr int CT_ABIN = 32 * (AB_IN / 64), CT_SQ = 32 * (DM / 64), CT_CDIN = 32 * (CD_IN / 64), CT_UP = 32 * (DFF2 / 64), CT_DN = (DFF / 64) * (DM / 64);
    constexpr int CT_L0 = CT_ABIN + CT_SQ + CT_UP + CT_DN, CT_S1 = CT_L0 + CT_CDIN + CT_SQ, CT_S2 = CT_S1 + 4900, CT_ALL = CT_S1 + CT_DN + CT_UP;
#define CONVERT_TILES(FIRST, LAST, W_ID, N_W) do { \
        LAS unsigned* T = (LAS unsigned*)(ldsl + wave * 9216); \
        const int rp = lane >> 4, cq = lane & 15; \
        struct TileRef { const float* src; bf16* dst; const float* gk; int K, N, perm; }; \
        auto tile_ref = [&](int it, TileRef& t) -> int { \
            int r = it; \
            if (r < CT_ABIN) { t = TileRef{AIN(5), W_ABIN, AIN(1), DM, AB_IN, 0}; return r; } r -= CT_ABIN; \
            if (r < CT_SQ) { t = TileRef{AIN(6), W_ABOUT, nullptr, DM, DM, 0}; return r; } r -= CT_SQ; \
            if (r < CT_UP) { t = TileRef{AIN(16), W_UP0, AIN(2), DM, DFF2, 1}; return r; } r -= CT_UP; \
            if (r < CT_DN) { t = TileRef{AIN(19), W_DN0, nullptr, DFF, DM, 0}; return r; } r -= CT_DN; \
            if (r < CT_CDIN) { t = TileRef{AIN(9), W_CDIN, AIN(1) + DM, DM, CD_IN, 0}; return r; } r -= CT_CDIN; \
            if (r < CT_SQ) { t = TileRef{AIN(10), W_CDOUT, nullptr, DM, DM, 0}; return r; } r -= CT_SQ; \
            if (r < CT_DN) { t = TileRef{AIN(19) + (size_t)DFF * DM, W_DN1, nullptr, DFF, DM, 0}; return r; } r -= CT_DN; \
            t = TileRef{AIN(16) + (size_t)DM * DFF2, W_UP1, AIN(2) + DM, DM, DFF2, 1}; return r; \
        }; \
        f32x4 va[8], vb[8]; float ga[8], gb[8]; \
        auto tile_load = [&](int it) { \
            TileRef t; const int r = tile_ref(it, t); const int nblk = t.N / 64, kb = r / nblk, nb = r % nblk; \
            const float* p = t.src + (size_t)(kb * 64 + 2 * rp) * t.N + nb * 64 + 4 * cq; \
            _Pragma("unroll") \
            for (int i = 0; i < 8; ++i) { va[i] = __builtin_nontemporal_load((const f32x4*)(p + (size_t)(8 * i) * t.N)); vb[i] = __builtin_nontemporal_load((const f32x4*)(p + (size_t)(8 * i + 1) * t.N)); \
                ga[i] = t.gk ? t.gk[kb * 64 + 8 * i + 2 * rp] : 1.f; gb[i] = t.gk ? t.gk[kb * 64 + 8 * i + 2 * rp + 1] : 1.f; } \
        }; \
        const int ct_last = (LAST), ct_step = (N_W); \
        int it = (FIRST) + (W_ID); \
        if (it < ct_last) tile_load(it); \
        while (it < ct_last) { \
            _Pragma("unroll") \
            for (int i = 0; i < 8; ++i) { \
                _Pragma("unroll") \
                for (int j = 0; j < 4; ++j) T[(4 * cq + j) * 36 + 4 * i + rp] = pk2(va[i][j] * ga[i], vb[i][j] * gb[i]); } \
            TileRef t; const int r = tile_ref(it, t); const int nblk = t.N / 64, kb = r / nblk, nb = r % nblk; \
            const int n0_ = nb * 64; const int drow0 = !t.perm ? n0_ : (n0_ < DFF ? (n0_ >> 7) * 256 + (n0_ & 127) : ((n0_ - DFF) >> 7) * 256 + 128 + ((n0_ - DFF) & 127)); \
            const int nxt = it + ct_step; \
            if (nxt < ct_last) tile_load(nxt); \
            LDS_WAIT(); asm volatile("" ::: "memory"); \
            _Pragma("unroll") \
            for (int o = 0; o < 8; ++o) { const int idx = o * 64 + lane, n = idx >> 3, c = idx & 7; \
                const v4u w = *(const LAS v4u*)(T + n * 36 + 4 * c); \
                *(GAS v4u*)(t.dst + (size_t)(drow0 + n) * t.K + kb * 64 + 8 * c) = w; } \
            LDS_WAIT(); asm volatile("" ::: "memory"); \
            it = nxt; \
        } \
    } while (0)

    for (int rep_ = 0; rep_ < NREP(0); ++rep_) if (IN(0)) { if (rep_) GRID_BAR(); PHASE_ENV();
        if (G == 256) { CONVERT_TILES(0, CT_L0, gw, NGW); CONVERT_TILES(CT_S2, CT_ALL, gw, NGW); } else { CONVERT_TILES(0, CT_ALL, gw, NGW); }
        for (int e = gt; e < SEQ * 64; e += NGT) { const int pos = e >> 6, i = e & 63;
            double f = 1.0; for (int k = 0; k < i; ++k) f *= 0.8659643233600653;
            const float ang = (float)pos * (float)f;
            double rev = (double)ang * 0.15915494309189535; rev -= floor(rev);
            const float rv = (float)rev;
            ROPE[e] = make_float2(__builtin_amdgcn_cosf(rv), __builtin_amdgcn_sinf(rv)); }
        if (vcu == 0 && wave == 0) { const float* lv = AIN(7);
            float a = lv[lane] * lv[128 + lane] + lv[64 + lane] * lv[192 + lane]; float b = lv[256 + lane] * lv[384 + lane] + lv[320 + lane] * lv[448 + lane];
            a = wave_sum(a); b = wave_sum(b);
            if (lane == 0) SCAL[0] = expf(a) - expf(b) + 0.2f; }
        RAW_TO_XN(x_in, SS);
    }
    SEAM(0);

    for (int rep_ = 0; rep_ < NREP(1); ++rep_) if (IN(1)) { if (rep_) GRID_BAR(); PHASE_ENV(); pg8::Gemm g{XN, W_ABIN, MTOK, AB_IN, DM}; pg8::StaticOrder S; S.init(MTOK, AB_IN, G, bx);
        pg8::EpiBf16 E{P, AB_IN, SS, nullptr, 0, 0}; pg8::gemm_phase<pg8::EpiBf16, pg8::StaticOrder, true, true>(ldsl, g, S, E, tid); }
    SEAM(1);

    for (int rep_ = 0; rep_ < NREP(2); ++rep_) if (IN(2)) { if (rep_) GRID_BAR(); PHASE_ENV();
#ifndef NO_B
        if (!(ap_->sel & 1)) { const int bh = vcu >> 5, comp = (vcu >> 4) & 1, s = vcu & 15, b = bh >> 2, h = bh & 3;
          float* tb = (float*)(lds + att::B2_TB);
          if (tid < 448) { const int rel = tid - 256 - 127, n = rel < 0 ? -rel : rel; int bucket = (n < 8) ? n : 8 + (31 - __clz((n * n) >> 6)); if (n >= 8 && bucket > 15) bucket = 15; if (rel > 0) bucket += 16;
              const float* rb = AIN(4); tb[tid] = (rel >= -127 && rel <= 63) ? (rb[bucket * 4 + h] - rb[15 * 4 + h]) * (1.f / att::SCALE) : 0.f; }
          __syncthreads();
          const bf16* Pb = P + (size_t)b * SEQ * AB_IN;
          for (int i = 0; i < 2; ++i) { const int q128 = i ? 31 - s : s;
              att::attnB2_unit<AB_IN, 1024>(Pb + (size_t)(128 * q128) * AB_IN + 3072 + h * 256 + comp * 128, Pb, 4096 + h * 256 + comp * 128, 5120 + h * 256,
                                            OBF + (size_t)comp * MTOK * 1024 + (size_t)(b * SEQ + 128 * q128) * 1024 + h * 256, q128, (char*)lds, ap_->sel); } }
#endif
#ifndef NO_A
#ifndef NREP_A
#define NREP_A 1
#endif
        for (int ra_ = 0; ra_ < NREP_A; ++ra_) if (!(ap_->sel & 2))
        { const int bh = vcu >> 4, qb = vcu & 15, b = bh >> 3, h = bh & 7;
          const bf16* Pb = P + (size_t)b * SEQ * AB_IN;
          att::attnA_unit<AB_IN, DM>(Pb + (size_t)(256 * qb) * AB_IN + h * 128, Pb, 1024 + h * 128, 2048 + h * 128, OB16 + (size_t)(b * SEQ + 256 * qb) * DM + h * 128, qb, (char*)lds); }
#endif
    }
    SEAM(2);

    for (int rep_ = 0; rep_ < NREP(3); ++rep_) if (IN(3)) { if (rep_) GRID_BAR(); PHASE_ENV();
        const float lam = SCAL[0]; const float* sg = AIN(8);
        f32x4 g4[4];
#pragma unroll
        for (int q = 0; q < 4; ++q) g4[q] = *(const f32x4*)(sg + (lane & 15) * 16 + q * 4);
        for (int row0 = gw * 2; row0 < MTOK; row0 += NGW * 2) { f32x4 a[2][4], c[2][4];
#pragma unroll
            for (int rr = 0; rr < 2; ++rr)
#pragma unroll
                for (int q = 0; q < 4; ++q) { a[rr][q] = *(const f32x4*)(OBF + (size_t)(row0 + rr) * 1024 + lane * 16 + q * 4); c[rr][q] = *(const f32x4*)(OBF + (size_t)MTOK * 1024 + (size_t)(row0 + rr) * 1024 + lane * 16 + q * 4); }
#pragma unroll
            for (int rr = 0; rr < 2; ++rr) { float ss = 0.f;
#pragma unroll
                for (int q = 0; q < 4; ++q) { a[rr][q] = a[rr][q] - lam * c[rr][q]; ss += (a[rr][q].x * a[rr][q].x + a[rr][q].y * a[rr][q].y) + (a[rr][q].z * a[rr][q].z + a[rr][q].w * a[rr][q].w); }
                ss += __shfl_xor(ss, 1); ss += __shfl_xor(ss, 2); ss += __shfl_xor(ss, 4); ss += __shfl_xor(ss, 8);
                const float rs = rsqrtf(ss * (1.f / 256.f) + EPS) * 0.8f;
                v4u w0, w1;
                w0.x = pk2(a[rr][0].x * rs * g4[0].x, a[rr][0].y * rs * g4[0].y); w0.y = pk2(a[rr][0].z * rs * g4[0].z, a[rr][0].w * rs * g4[0].w);
                w0.z = pk2(a[rr][1].x * rs * g4[1].x, a[rr][1].y * rs * g4[1].y); w0.w = pk2(a[rr][1].z * rs * g4[1].z, a[rr][1].w * rs * g4[1].w);
                w1.x = pk2(a[rr][2].x * rs * g4[2].x, a[rr][2].y * rs * g4[2].y); w1.y = pk2(a[rr][2].z * rs * g4[2].z, a[rr][2].w * rs * g4[2].w);
                w1.z = pk2(a[rr][3].x * rs * g4[3].x, a[rr][3].y * rs * g4[3].y); w1.w = pk2(a[rr][3].z * rs * g4[3].z, a[rr][3].w * rs * g4[3].w);
                bf16* op = OB16 + (size_t)(row0 + rr) * DM + 1024 + lane * 16; *(v4u*)op = w0; *(v4u*)(op + 8) = w1; } }
    }
    SEAM(3);

    for (int rep_ = 0; rep_ < NREP(4); ++rep_) if (IN(4)) { if (rep_) GRID_BAR(); PHASE_ENV(); pg8::Gemm g{OB16, W_ABOUT, MTOK, DM, DM}; pg8::StaticOrder S; S.init(MTOK, DM, G, bx);
        pg8::EpiRes E{nullptr, XN, DM, SS + 1 * MTOK}; pg8::gemm_phase<pg8::EpiRes, pg8::StaticOrder, false, true>(ldsl, g, S, E, tid); }
    SEAM(4);

#define FFN_PHASES(PB, WUP, WDN, L, SSIN, SSOUT) \
    for (int rep_ = 0; rep_ < NREP(PB); ++rep_) if (IN(PB)) { if (rep_) GRID_BAR(); PHASE_ENV(); pg8::Gemm g{XN, WUP, MTOK, DFF2, DM}; pg8::StaticOrder S; S.init(MTOK, DFF2, G, bx); \
        pg8::EpiConv E{ACT, SS + (SSIN) * MTOK, AIN(17) + (size_t)(L) * 3 * DFF2, AIN(18) + (size_t)(L) * DFF2, HALO, ldsl}; \
        pg8::gemm_phase<pg8::EpiConv, pg8::StaticOrder, true, true>(ldsl, g, S, E, tid); \
        if ((PB) == 5 && G == 256 && bx >= 128) { CONVERT_TILES(CT_L0, CT_S1, (bx - 128) * NWAVES + wave, 128 * NWAVES); } } \
    SEAM(PB); \
    for (int rep_ = 0; rep_ < NREP(PB + 1); ++rep_) if (IN(PB + 1)) { if (rep_) GRID_BAR(); PHASE_ENV(); conv_fix(HALO, ACT, AIN(17) + (size_t)(L) * 3 * DFF2, AIN(18) + (size_t)(L) * DFF2, gt, NGT); } \
    SEAM(PB + 1); \
    for (int rep_ = 0; rep_ < NREP(PB + 2); ++rep_) if (IN(PB + 2)) { if (rep_) GRID_BAR(); PHASE_ENV(); pg8::Gemm g{ACT, WDN, MTOK, DM, DFF}; pg8::StaticOrder S; S.init(MTOK, DM, G, bx); \
        if ((L) == 1 && G == 256) { pg8::EpiFinal E{XN, DM, SS + (SSOUT) * MTOK, (unsigned*)(ws + WS_CNT), AIN(3), ap_->out}; pg8::gemm_phase<pg8::EpiFinal, pg8::StaticOrder, false, true>(ldsl, g, S, E, tid); } \
        else { pg8::EpiRes E{nullptr, XN, DM, SS + (SSOUT) * MTOK}; pg8::gemm_phase<pg8::EpiRes, pg8::StaticOrder, false, true>(ldsl, g, S, E, tid); } } \
    SEAM(PB + 2);

    auto conv_fix = [&](const bf16* halo, bf16* act, const float* cw, const float* cb, int gt_, int ngt_) {
        constexpr int NCH = DFF / 8;
        for (int task = gt_; task < NCH * 64; task += ngt_) { const int ch = task % NCH, rr = (task / NCH) & 1, pm = task / (2 * NCH), n0 = ch * 8;
            const int pca = (n0 >> 7) * 256 + (n0 & 127); const bool first = (pm & 15) == 0;
            const bf16* H = halo + (size_t)pm * 4 * DFF2; const bf16* Hp = H - (size_t)4 * DFF2;
            float cv[2][8];
#pragma unroll
            for (int bj = 0; bj < 2; ++bj) { const int pc = pca + bj * 128, cc = bj * DFF + n0; const v4u z = {0u, 0u, 0u, 0u};
                const v4u c0 = *(const v4u*)(H + pc), c1 = *(const v4u*)(H + DFF2 + pc);
                const v4u q254 = first ? z : *(const v4u*)(Hp + 2 * DFF2 + pc), q255 = first ? z : *(const v4u*)(Hp + 3 * DFF2 + pc);
                const v4u x2 = rr == 0 ? q254 : q255, x1 = rr == 0 ? q255 : c0, x0 = rr == 0 ? c0 : c1;
#pragma unroll
                for (int q = 0; q < 4; ++q) {
                    cv[bj][2 * q] = cb[cc + 2 * q] + cw[cc + 2 * q] * bflo(x2[q]) + cw[DFF2 + cc + 2 * q] * bflo(x1[q]) + cw[2 * DFF2 + cc + 2 * q] * bflo(x0[q]);
                    cv[bj][2 * q + 1] = cb[cc + 2 * q + 1] + cw[cc + 2 * q + 1] * bfhi(x2[q]) + cw[DFF2 + cc + 2 * q + 1] * bfhi(x1[q]) + cw[2 * DFF2 + cc + 2 * q + 1] * bfhi(x0[q]); } }
            float o[8];
#pragma unroll
            for (int q = 0; q < 8; ++q) o[q] = silu_f(cv[1][q]) * cv[0][q];
            v4u w; w.x = pk2(o[0], o[1]); w.y = pk2(o[2], o[3]); w.z = pk2(o[4], o[5]); w.w = pk2(o[6], o[7]);
            *(v4u*)(act + (size_t)(pm * 256 + rr) * DFF + n0) = w; }
    };

    FFN_PHASES(5, W_UP0, W_DN0, 0, 1, 2)

    for (int rep_ = 0; rep_ < NREP(8); ++rep_) if (IN(8)) { if (rep_) GRID_BAR(); PHASE_ENV(); pg8::Gemm g{XN, W_CDIN, MTOK, CD_IN, DM}; pg8::StaticOrder S; S.init(MTOK, CD_IN, G, bx);
        pg8::EpiBf16 E{P, CD_IN, SS + 2 * MTOK, LNS, 16, 20}; pg8::gemm_phase<pg8::EpiBf16, pg8::StaticOrder, true, true>(ldsl, g, S, E, tid);
        if (G == 256 && bx >= 128) { CONVERT_TILES(CT_S1, CT_S2, (bx - 128) * NWAVES + wave, 128 * NWAVES); } }
    SEAM(8);

    for (int rep_ = 0; rep_ < NREP(9); ++rep_) if (IN(9)) { if (rep_) GRID_BAR(); PHASE_ENV();
        for (int u = vcu; u < 8 * 64; u += G) { const int bh = u >> 6, n = u & 63;
            att::ret_kv_unit<CD_IN>(P, ROPE, KV + ((size_t)bh * 64 + n) * 32768, bh >> 2, bh & 3, n, (char*)lds); }
        for (int u = vcu; u < 256; u += G) { const int g = u & 3, nbk = (u >> 2) & 31, b = u >> 7;
            att::sgu_unit<CD_IN, DM>(P, LNS, AIN(12), AIN(13), AIN(14) + (size_t)g * 128 * 128, AIN(15) + g * 128, OB16, (size_t)b * SEQ + 128 * nbk, g, (char*)lds); }
    }
    SEAM(9);

    for (int rep_ = 0; rep_ < NREP(10); ++rep_) if (IN(10)) { if (rep_) GRID_BAR(); PHASE_ENV();
        if (wave < 4) for (int e4 = (vcu * 4 + wave) * 64 + lane; e4 < 8 * 256 * 128 / 4; e4 += G * 4 * 64) { const int e = e4 * 4; const int bh = e >> 15, h = bh & 3; const int r = e & 32767;
            const float g64 = __expf(64.f * __logf(1.f - exp2f(-5.f - (float)h)));
            const bf16* src = KV + (size_t)bh * 64 * 32768 + r; bf16* dst = PREV + (size_t)bh * 64 * 32768 + r; float st[4] = {0.f, 0.f, 0.f, 0.f};
#pragma unroll 16
            for (int n = 0; n < 64; ++n) { const v2u kv = *(const v2u*)(src + (size_t)n * 32768);
                v2u w; w.x = pk2(st[0], st[1]); w.y = pk2(st[2], st[3]); *(v2u*)(dst + (size_t)n * 32768) = w;
                st[0] = g64 * st[0] + bflo(kv.x); st[1] = g64 * st[1] + bfhi(kv.x); st[2] = g64 * st[2] + bflo(kv.y); st[3] = g64 * st[3] + bfhi(kv.y); } }
    }
    SEAM(10);

    for (int rep_ = 0; rep_ < NREP(11); ++rep_) if (IN(11)) { if (rep_) GRID_BAR(); PHASE_ENV();
        for (int u = vcu; u < 256; u += G) { const int bh = u >> 5, np = u & 31;
            att::ret_out_unit<CD_IN, DM>(P, ROPE, PREV, AIN(11), OB16, bh >> 2, bh & 3, np, (char*)lds); }
    }
    SEAM(11);

    for (int rep_ = 0; rep_ < NREP(12); ++rep_) if (IN(12)) { if (rep_) GRID_BAR(); PHASE_ENV(); pg8::Gemm g{OB16, W_CDOUT, MTOK, DM, DM}; pg8::StaticOrder S; S.init(MTOK, DM, G, bx);
        pg8::EpiRes E{nullptr, XN, DM, SS + 3 * MTOK}; pg8::gemm_phase<pg8::EpiRes, pg8::StaticOrder, false, true>(ldsl, g, S, E, tid); }
    SEAM(12);

    FFN_PHASES(13, W_UP1, W_DN1, 1, 3, 4)

    for (int rep_ = 0; rep_ < NREP(16); ++rep_) if (IN(16) && G != 256) { if (rep_) GRID_BAR(); PHASE_ENV(); const float* fg = AIN(3); const unsigned long long* ss4 = SS + 4 * MTOK;
        for (int m0 = gw * 4; m0 < MTOK; m0 += NGW * 4) { v4u v[4][4]; float rstd[4];
#pragma unroll
            for (int rr = 0; rr < 4; ++rr) { const GAS v4u* xr = (const GAS v4u*)(XN + (size_t)(m0 + rr) * DM) + lane;
#pragma unroll
                for (int j = 0; j < 4; ++j) v[rr][j] = xr[64 * j];
                rstd[rr] = rsqrtf((float)ss4[m0 + rr] * (1.f / 16777216.f / DM) + EPS); }
#pragma unroll
            for (int rr = 0; rr < 4; ++rr) { float* orow = ap_->out + (size_t)(m0 + rr) * DM;
#pragma unroll
                for (int j = 0; j < 4; ++j) { const int c0 = (64 * j + lane) * 8; const f32x4 g0 = *(const f32x4*)(fg + c0), g1 = *(const f32x4*)(fg + c0 + 4); const float r_ = rstd[rr];
                    const f32x4 o0 = {bflo(v[rr][j].x) * r_ * g0.x, bfhi(v[rr][j].x) * r_ * g0.y, bflo(v[rr][j].y) * r_ * g0.z, bfhi(v[rr][j].y) * r_ * g0.w};
                    const f32x4 o1 = {bflo(v[rr][j].z) * r_ * g1.x, bfhi(v[rr][j].z) * r_ * g1.y, bflo(v[rr][j].w) * r_ * g1.z, bfhi(v[rr][j].w) * r_ * g1.w};
                    *(GAS f32x4*)(orow + c0) = o0; *(GAS f32x4*)(orow + c0 + 4) = o1; } } }
    }
#undef IN
#undef SEAM
}

extern "C" void kernel_launch(void* const* d_in, const int* in_sizes, int n_in, void* d_out, int out_size, void* d_ws, size_t ws_size, hipStream_t stream) {
    static int grid = 0;
    if (grid == 0) {
        if (n_in != 20 || in_sizes[0] != MTOK * DM || out_size != MTOK * DM || ws_size < WS_END) {
            fprintf(stderr, "kernel_launch: unexpected shapes: n_in %d in0 %d out %d ws %zu (need >= %zu)\n", n_in, n_in > 0 ? in_sizes[0] : -1, out_size, ws_size, (size_t)WS_END); grid = -1; return; }
        int dev = 0, cus = 0;
        if (hipGetDevice(&dev) != hipSuccess || hipDeviceGetAttribute(&cus, hipDeviceAttributeMultiprocessorCount, dev) != hipSuccess) { grid = -1; return; }
        if (hipFuncSetAttribute((const void*)mega_fwd, hipFuncAttributeMaxDynamicSharedMemorySize, LDS_BYTES) != hipSuccess) { fprintf(stderr, "kernel_launch: hipFuncSetAttribute failed\n"); grid = -1; return; }
        int per_cu = 0;
        if (hipOccupancyMaxActiveBlocksPerMultiprocessor(&per_cu, (const void*)mega_fwd, NWAVES * 64, LDS_BYTES) != hipSuccess || per_cu < 1) { fprintf(stderr, "kernel_launch: occupancy query says %d blocks per CU\n", per_cu); }
        (void)hipGetLastError();
        grid = cus;
    }
    if (grid < 0) return;
    hipMemsetAsync((char*)d_ws + WS_CTL, 0, CTL_ZERO_BYTES, stream);
    Args a{};
    for (int i = 0; i < 20; ++i) a.in[i] = (const float*)d_in[i];
    a.out = (float*)d_out; a.ws = (unsigned char*)d_ws;
#if MK_PER_PHASE
    for (int p = 0; p < N_PHASES; ++p) { a.ph_lo = p; a.ph_hi = p + 1; hipLaunchKernelGGL(mega_fwd, dim3(grid), dim3(NWAVES * 64), LDS_BYTES, stream, a); }
#else
    a.ph_lo = 0; a.ph_hi = (grid == 256) ? N_PHASES - 1 : N_PHASES; hipLaunchKernelGGL         (mega_fwd, dim3(grid), dim3(NWAVES * 64), LDS_BYTES, stream, a);
#if PROBE_PHASE >= 0
    a.ph_lo = PROBE_PHASE; a.ph_hi = PROBE_PHASE + PROBE_NPH; a.sel = PROBE_SEL; a.li = 1; hipLaunchKernelGGL(mega_fwd, dim3(grid), dim3(NWAVES * 64), LDS_BYTES, stream, a);
#endif
#endif
    const hipError_t le = hipPeekAtLastError();
    if (le != hipSuccess) fprintf(stderr, "kernel_launch: launch failed: %s\n", hipGetErrorName(le));
}
```

```cpp
#include <hip/hip_runtime.h>
#include <hip/hip_bf16.h>
#include <cstdio>
#include <cstdint>

#ifndef PROBE_PHASE
#define PROBE_PHASE -1
#endif
#ifndef PROBE_SEL
#define PROBE_SEL 0
#endif
#ifndef PROBE_NPH
#define PROBE_NPH 1
#endif
#ifndef MK_PER_PHASE
#define MK_PER_PHASE 0
#endif

namespace pg8 {
#define PG8_LAS __attribute__((address_space(3)))
typedef unsigned short bf16_t;
typedef short bf16x8 __attribute__((ext_vector_type(8)));
typedef float f32x4 __attribute__((ext_vector_type(4)));
typedef unsigned u32x4 __attribute__((ext_vector_type(4)));
constexpr int BM = 256, BK = 64, HALF = 128, HTB = HALF * BK * 2, STAGE_BYTES = 8 * HTB, NXCD = 8, WGM = 8;

__host__ __device__ __forceinline__ int lds_byte(int r, int c) { const int st = (r >> 4) * 2 + (c >> 5), rr = r & 15, cc = c & 31, ob = rr * 64 + cc * 2; return st * 1024 + (ob ^ (((ob >> 9) & 1) << 5)); }
__host__ __device__ __forceinline__ void stage_rc(int b, int& R, int& C) { const int st = b / 1024, sb = b % 1024, swz = sb ^ (((sb >> 9) & 1) << 5); R = (st >> 1) * 16 + swz / 64; C = (st & 1) * 32 + (swz % 64) / 2; }
__host__ __device__ __forceinline__ int perm32(int rho) { const int n = rho >> 4, i = rho & 15; return 8 * (i >> 2) + 4 * n + (i & 3); }

struct Unit { int pm, pn; };
struct Gemm { const bf16_t* A; const bf16_t* Bt; int M, N, K; };

struct StaticOrder {
    int nM, nN, nwg, G, c;
    __host__ __device__ void init(int M, int N, int G_, int c_) { nM = M / BM; nN = N / BM; nwg = nM * nN; G = G_; c = c_; }
    __host__ __device__ bool next(int i, Unit& u) const {
        const long L = (long)i * G + c; if (L >= nwg) return false;
        int wgid = (int)L; { const int q = nwg / NXCD, r = nwg % NXCD, xcd = wgid % NXCD, off = wgid / NXCD; wgid = (xcd < r ? xcd * (q + 1) : r * (q + 1) + (xcd - r) * q) + off; }
        const int nig = WGM * nN, gid = wgid / nig, fm = gid * WGM, gsz = (nM - fm) < WGM ? (nM - fm) : WGM;
        u.pm = fm + ((wgid % nig) % gsz); u.pn = (wgid % nig) / gsz; return true;
    }
    __device__ __forceinline__ void a_ready(const Unit&) const {}
    __device__ __forceinline__ void done(const Unit&) const {}
};

__device__ __forceinline__ unsigned cvt_pk_bf16(float lo, float hi) { unsigned r; asm volatile("v_cvt_pk_bf16_f32 %0, %1, %2" : "=v"(r) : "v"(lo), "v"(hi)); return r; }

__device__ __forceinline__ float gelu_tanh_e(float x) { const float u = 0.7978845608028654f * (x + 0.044715f * x * x * x); const float t = 1.f - 2.f / (__expf(2.f * u) + 1.f); return 0.5f * x * (1.f + t); }
struct EpiBf16 {
    static constexpr bool PERM = true, AFTER_DRAIN = false;
    bf16_t* O; int ldc; const unsigned long long* ss; unsigned long long* lnsum; int ln_pn0, ln_pn1;
    __device__ __forceinline__ void operator()(const f32x4 (&acc)[2][2][4][2], const Unit& u, int wr, int wc, int fr, int fq) const {
        const int row0 = u.pm * BM + wr * 64 + fr; const int col0 = u.pn * BM + wc * 32 + 8 * fq;
        const bool do_ln = lnsum != nullptr && u.pn >= ln_pn0 && u.pn < ln_pn1;
        unsigned long long ssv[2][4];
#pragma unroll
        for (int ai = 0; ai < 2; ++ai)
#pragma unroll
            for (int m = 0; m < 4; ++m) ssv[ai][m] = ss ? __hip_atomic_load(ss + row0 + ai * HALF + m * 16, __ATOMIC_RELAXED, __HIP_MEMORY_SCOPE_AGENT) : 0ull;
#pragma unroll
        for (int ai = 0; ai < 2; ++ai)
#pragma unroll
            for (int m = 0; m < 4; ++m) { const int row = row0 + ai * HALF + m * 16; bf16_t* rowp = O + (size_t)row * ldc + col0;
                const float sc = ss ? __builtin_amdgcn_rsqf((float)ssv[ai][m] * (1.f / 16777216.f / 2048.f) + 1e-6f) : 1.f;
                float s1 = 0.f, s2 = 0.f;
#pragma unroll
                for (int bj = 0; bj < 2; ++bj) { const f32x4 v0 = acc[ai][bj][m][0] * sc, v1 = acc[ai][bj][m][1] * sc;
                    u32x4 w; w.x = cvt_pk_bf16(v0[0], v0[1]); w.y = cvt_pk_bf16(v0[2], v0[3]); w.z = cvt_pk_bf16(v1[0], v1[1]); w.w = cvt_pk_bf16(v1[2], v1[3]);
                    *(u32x4*)(rowp + bj * HALF) = w;
                    if (do_ln) {
#pragma unroll
                        for (int q = 0; q < 4; ++q) { const float a = gelu_tanh_e(v0[q]), b = gelu_tanh_e(v1[q]); s1 += a + b; s2 += a * a + b * b; } } }
                if (do_ln) { s1 += __shfl_xor(s1, 16); s1 += __shfl_xor(s1, 32); s2 += __shfl_xor(s2, 16); s2 += __shfl_xor(s2, 32);
                    if (fq == 0) { atomicAdd(lnsum + 2 * row, (unsigned long long)(long long)(s1 * 16777216.f)); atomicAdd(lnsum + 2 * row + 1, (unsigned long long)(long long)(s2 * 16777216.f)); } } }
    }
};
struct EpiRes {
    static constexpr bool PERM = true, AFTER_DRAIN = false;
    const float* basef; bf16_t* xb; int ldc; unsigned long long* ss;
    __device__ __forceinline__ void operator()(const f32x4 (&acc)[2][2][4][2], const Unit& u, int wr, int wc, int fr, int fq) const {
        const int row0 = u.pm * BM + wr * 64 + fr; const int col0 = u.pn * BM + wc * 32 + 8 * fq;
        f32x4 b0[2][4][2], b1[2][4][2];
#pragma unroll
        for (int ai = 0; ai < 2; ++ai)
#pragma unroll
            for (int m = 0; m < 4; ++m) { const size_t off = (size_t)(row0 + ai * HALF + m * 16) * ldc + col0;
#pragma unroll
                for (int bj = 0; bj < 2; ++bj) {
                    if (basef) { b0[ai][m][bj] = *(const f32x4*)(basef + off + bj * HALF); b1[ai][m][bj] = *(const f32x4*)(basef + off + bj * HALF + 4); }
                    else { const u32x4 w = *(const u32x4*)(xb + off + bj * HALF);
                        b0[ai][m][bj] = (f32x4){__builtin_bit_cast(float, w.x << 16), __builtin_bit_cast(float, w.x & 0xffff0000u), __builtin_bit_cast(float, w.y << 16), __builtin_bit_cast(float, w.y & 0xffff0000u)};
                        b1[ai][m][bj] = (f32x4){__builtin_bit_cast(float, w.z << 16), __builtin_bit_cast(float, w.z & 0xffff0000u), __builtin_bit_cast(float, w.w << 16), __builtin_bit_cast(float, w.w & 0xffff0000u)}; } } }
#pragma unroll
        for (int ai = 0; ai < 2; ++ai)
#pragma unroll
            for (int m = 0; m < 4; ++m) { const int row = row0 + ai * HALF + m * 16; const size_t off = (size_t)row * ldc + col0; float sq = 0.f;
#pragma unroll
                for (int bj = 0; bj < 2; ++bj) {
                    const f32x4 o0 = b0[ai][m][bj] + acc[ai][bj][m][0], o1 = b1[ai][m][bj] + acc[ai][bj][m][1];
                    u32x4 w; w.x = cvt_pk_bf16(o0[0], o0[1]); w.y = cvt_pk_bf16(o0[2], o0[3]); w.z = cvt_pk_bf16(o1[0], o1[1]); w.w = cvt_pk_bf16(o1[2], o1[3]);
                    *(u32x4*)(xb + off + bj * HALF) = w;
#pragma unroll
                    for (int q = 0; q < 4; ++q) { const unsigned ww = q == 0 ? w.x : q == 1 ? w.y : q == 2 ? w.z : w.w; const float lo = __builtin_bit_cast(float, ww << 16), hi = __builtin_bit_cast(float, ww & 0xffff0000u); sq += lo * lo + hi * hi; } }
                sq += __shfl_xor(sq, 16); sq += __shfl_xor(sq, 32);
                if (fq == 0) atomicAdd(ss + row, (unsigned long long)(sq * 16777216.f)); }
    }
};

struct EpiConv {
    static constexpr bool PERM = true, AFTER_DRAIN = false;
    bf16_t* act; const unsigned long long* ss; const float* cw; const float* cb; bf16_t* halo; PG8_LAS unsigned char* lds0;
    static constexpr int NFF = 5632, NFF2 = 11264;
    static constexpr int HX = STAGE_BYTES + 1024, CPAR = HX + 4096;
    __device__ __forceinline__ static int hxi(int wr, int ai, int rs, int bj, int wc, int fq) { return ((((((wr * 2 + ai) * 2 + rs) * 2 + bj) * 4 + wc) * 4 + fq) * 16); }
    __device__ __forceinline__ static u32x4 bperm4(int addr, u32x4 v) {
        u32x4 r; r.x = (unsigned)__builtin_amdgcn_ds_bpermute(addr, (int)v.x); r.y = (unsigned)__builtin_amdgcn_ds_bpermute(addr, (int)v.y);
        r.z = (unsigned)__builtin_amdgcn_ds_bpermute(addr, (int)v.z); r.w = (unsigned)__builtin_amdgcn_ds_bpermute(addr, (int)v.w); return r; }
    __device__ __forceinline__ void operator()(const f32x4 (&acc)[2][2][4][2], const Unit& u, int wr, int wc, int fr, int fq) const {
        asm volatile("" : "+v"(fr), "+v"(fq));
        typedef float f32x2 __attribute__((ext_vector_type(2)));
        const int lane = fq * 16 + fr, tid = (wr * 4 + wc) * 64 + lane;
        { PG8_LAS float* cp = (PG8_LAS float*)(lds0 + CPAR);
#pragma unroll
          for (int e = 0; e < 2; ++e) { const int idx = tid * 2 + e, bj = idx >> 9, j = (idx >> 7) & 3, c = idx & 127; const int gcol = bj * NFF + u.pn * 128 + c;
              cp[idx] = j < 3 ? cw[(size_t)j * NFF2 + gcol] : cb[gcol]; } }
        u32x4 pk[2][2][4];
        unsigned long long ssv[2][4];
#pragma unroll
        for (int ai = 0; ai < 2; ++ai)
#pragma unroll
            for (int m = 0; m < 4; ++m) ssv[ai][m] = __hip_atomic_load(ss + u.pm * BM + ai * HALF + wr * 64 + m * 16 + fr, __ATOMIC_RELAXED, __HIP_MEMORY_SCOPE_AGENT);
#pragma unroll
        for (int ai = 0; ai < 2; ++ai)
#pragma unroll
            for (int m = 0; m < 4; ++m) {
                const float sc = __builtin_amdgcn_rsqf((float)ssv[ai][m] * (1.f / 16777216.f / 2048.f) + 1e-6f);
#pragma unroll
                for (int bj = 0; bj < 2; ++bj) { const f32x4 v0 = acc[ai][bj][m][0] * sc, v1 = acc[ai][bj][m][1] * sc;
                    pk[ai][bj][m] = (u32x4){cvt_pk_bf16(v0[0], v0[1]), cvt_pk_bf16(v0[2], v0[3]), cvt_pk_bf16(v1[0], v1[1]), cvt_pk_bf16(v1[2], v1[3])}; } }
        const int pcol = u.pn * 256 + wc * 32 + 8 * fq;
        if (fr >= 14) {
#pragma unroll
            for (int ai = 0; ai < 2; ++ai)
#pragma unroll
                for (int bj = 0; bj < 2; ++bj) *(PG8_LAS u32x4*)(lds0 + HX + hxi(wr, ai, fr - 14, bj, wc, fq)) = pk[ai][bj][3];
            if (wr == 1) {
#pragma unroll
                for (int bj = 0; bj < 2; ++bj) *(u32x4*)(halo + ((size_t)u.pm * 4 + 2 + (fr - 14)) * NFF2 + pcol + bj * HALF) = pk[1][bj][3]; } }
        if (wr == 0 && fr < 2) {
#pragma unroll
            for (int bj = 0; bj < 2; ++bj) *(u32x4*)(halo + ((size_t)u.pm * 4 + fr) * NFF2 + pcol + bj * HALF) = pk[0][bj][0]; }
        asm volatile("s_waitcnt lgkmcnt(0)" ::: "memory"); __builtin_amdgcn_s_barrier(); asm volatile("" ::: "memory");
        const int i1 = ((lane & 48) | ((fr + 15) & 15)) * 4, i2 = ((lane & 48) | ((fr + 14) & 15)) * 4;
        const int ca = u.pn * 128 + wc * 32 + 8 * fq;
        const PG8_LAS float* cpl = (const PG8_LAS float*)(lds0 + CPAR) + wc * 32 + 8 * fq;
#define PG8_BLO(w_) __builtin_bit_cast(float, (w_) << 16)
#define PG8_BHI(w_) __builtin_bit_cast(float, (w_) & 0xffff0000u)
#define PG8_W(v_, q_) ((q_) == 0 ? (v_).x : (q_) == 1 ? (v_).y : (q_) == 2 ? (v_).z : (v_).w)
#define PG8_X2(v_, q_) ((f32x2){PG8_BLO(PG8_W(v_, q_)), PG8_BHI(PG8_W(v_, q_))})
#pragma unroll
        for (int ai = 0; ai < 2; ++ai) {
            const bool top = (wr == 0 && ai == 0);
            u32x4 q1[2], q2[2];
            if (top) { q1[0] = (u32x4){0u, 0u, 0u, 0u}; q1[1] = q1[0]; q2[0] = q1[0]; q2[1] = q1[0]; }
            else { const int swr = wr == 1 ? 0 : 1, sai = wr == 1 ? ai : 0;
#pragma unroll
                for (int bj = 0; bj < 2; ++bj) { const u32x4 h14 = *(const PG8_LAS u32x4*)(lds0 + HX + hxi(swr, sai, 0, bj, wc, fq)), h15 = *(const PG8_LAS u32x4*)(lds0 + HX + hxi(swr, sai, 1, bj, wc, fq));
                    q1[bj] = h15; q2[bj] = fr == 0 ? h14 : h15; } }
#pragma unroll
            for (int m = 0; m < 4; ++m) {
                const PG8_LAS float* cpb = cpl; asm volatile("" : "+v"(cpb));
                f32x2 cv[2][4];
#pragma unroll
                for (int bj = 0; bj < 2; ++bj) { const u32x4 cur = pk[ai][bj][m];
                    const u32x4 s1 = bperm4(i1, cur), s2 = bperm4(i2, cur);
                    const u32x4 p1 = fr == 0 ? q1[bj] : s1, p2 = fr < 2 ? q2[bj] : s2;
                    q1[bj] = s1; q2[bj] = s2;
#pragma unroll
                    for (int q = 0; q < 4; ++q) { const f32x2 w0 = *(const PG8_LAS f32x2*)(cpb + bj * 512 + 2 * q), w1 = *(const PG8_LAS f32x2*)(cpb + bj * 512 + 128 + 2 * q), w2 = *(const PG8_LAS f32x2*)(cpb + bj * 512 + 256 + 2 * q), bb = *(const PG8_LAS f32x2*)(cpb + bj * 512 + 384 + 2 * q);
                        cv[bj][q] = bb + w0 * PG8_X2(p2, q) + w1 * PG8_X2(p1, q) + w2 * PG8_X2(cur, q); } }
                float o[8];
#pragma unroll
                for (int q = 0; q < 4; ++q) { const f32x2 gv = cv[1][q]; const f32x2 sg = {__builtin_amdgcn_rcpf(1.f + __expf(-gv.x)), __builtin_amdgcn_rcpf(1.f + __expf(-gv.y))};
                    const f32x2 ov = cv[0][q] * gv * sg; o[2 * q] = ov.x; o[2 * q + 1] = ov.y; }
                u32x4 out; out.x = cvt_pk_bf16(o[0], o[1]); out.y = cvt_pk_bf16(o[2], o[3]); out.z = cvt_pk_bf16(o[4], o[5]); out.w = cvt_pk_bf16(o[6], o[7]);
                const int row = u.pm * BM + ai * HALF + wr * 64 + m * 16 + fr;
                if (!(top && m == 0 && fr < 2)) *(u32x4*)(act + (size_t)row * NFF + ca) = out;
                __builtin_amdgcn_sched_barrier(0); } }
#undef PG8_BLO
#undef PG8_BHI
#undef PG8_W
#undef PG8_X2
    }
};

struct EpiFinal {
    static constexpr bool PERM = true, AFTER_DRAIN = true;
    const bf16_t* xb; int ldc; unsigned long long* ss; unsigned* cnt; const float* g; float* out;
    __device__ __forceinline__ void fused(f32x4 (&acc)[2][2][4][2], const Unit& u, int wr, int wc, int fr, int fq, PG8_LAS unsigned char* lds, int wid, int lane) const {
        const int row0 = u.pm * BM + wr * 64 + fr; const int col0 = u.pn * BM + wc * 32 + 8 * fq;
        u32x4 bw[2][4][2];
#pragma unroll
        for (int ai = 0; ai < 2; ++ai)
#pragma unroll
            for (int m = 0; m < 4; ++m)
#pragma unroll
                for (int bj = 0; bj < 2; ++bj) bw[ai][m][bj] = *(const u32x4*)(xb + (size_t)(row0 + ai * HALF + m * 16) * ldc + col0 + bj * HALF);
        float sqv[2][4];
#pragma unroll
        for (int ai = 0; ai < 2; ++ai)
#pragma unroll
            for (int m = 0; m < 4; ++m) { float sq = 0.f;
#pragma unroll
                for (int bj = 0; bj < 2; ++bj) { const u32x4 w = bw[ai][m][bj];
                    const f32x4 b0 = {__builtin_bit_cast(float, w.x << 16), __builtin_bit_cast(float, w.x & 0xffff0000u), __builtin_bit_cast(float, w.y << 16), __builtin_bit_cast(float, w.y & 0xffff0000u)};
                    const f32x4 b1 = {__builtin_bit_cast(float, w.z << 16), __builtin_bit_cast(float, w.z & 0xffff0000u), __builtin_bit_cast(float, w.w << 16), __builtin_bit_cast(float, w.w & 0xffff0000u)};
                    const f32x4 o0 = b0 + acc[ai][bj][m][0], o1 = b1 + acc[ai][bj][m][1]; acc[ai][bj][m][0] = o0; acc[ai][bj][m][1] = o1;
                    sq += (o0[0] * o0[0] + o0[1] * o0[1]) + (o0[2] * o0[2] + o0[3] * o0[3]) + (o1[0] * o1[0] + o1[1] * o1[1]) + (o1[2] * o1[2] + o1[3] * o1[3]); }
                sq += __shfl_xor(sq, 16); sq += __shfl_xor(sq, 32); sqv[ai][m] = sq; }
        unsigned long long keep = 0ull, kr[2][4];
        if (fq == 0) {
#pragma unroll
            for (int ai = 0; ai < 2; ++ai)
#pragma unroll
                for (int m = 0; m < 4; ++m) kr[ai][m] = atomicAdd(ss + row0 + ai * HALF + m * 16, (unsigned long long)(sqv[ai][m] * 16777216.f));
#pragma unroll
            for (int ai = 0; ai < 2; ++ai)
#pragma unroll
                for (int m = 0; m < 4; ++m) keep += kr[ai][m]; }
        asm volatile("s_waitcnt vmcnt(0)" :: "v"((unsigned)keep), "v"((unsigned)(keep >> 32)) : "memory");
        if (lane == 0) __hip_atomic_fetch_add(cnt + 64 * u.pm, 1u, __ATOMIC_RELAXED, __HIP_MEMORY_SCOPE_AGENT);
        if (wid == 0) { unsigned sp = 0;
            while ((unsigned)__builtin_amdgcn_readfirstlane(__hip_atomic_load(cnt + 64 * u.pm, __ATOMIC_RELAXED, __HIP_MEMORY_SCOPE_AGENT)) < 64u) { __builtin_amdgcn_s_sleep(2); if (++sp > (1u << 22)) break; } }
        asm volatile("s_waitcnt vmcnt(0) lgkmcnt(0)" ::: "memory"); __builtin_amdgcn_s_barrier(); asm volatile("" ::: "memory");
        unsigned long long ssv[2][4];
#pragma unroll
        for (int ai = 0; ai < 2; ++ai)
#pragma unroll
            for (int m = 0; m < 4; ++m) ssv[ai][m] = __hip_atomic_load(ss + row0 + ai * HALF + m * 16, __ATOMIC_RELAXED, __HIP_MEMORY_SCOPE_AGENT);
#pragma unroll
        for (int ai = 0; ai < 2; ++ai)
#pragma unroll
            for (int m = 0; m < 4; ++m) { const int row = row0 + ai * HALF + m * 16; const size_t off = (size_t)row * ldc + col0;
                const float rstd = __builtin_amdgcn_rsqf((float)ssv[ai][m] * (1.f / 16777216.f / 2048.f) + 1e-6f);
#pragma unroll
                for (int bj = 0; bj < 2; ++bj) { const f32x4 g0 = *(const f32x4*)(g + col0 + bj * HALF), g1 = *(const f32x4*)(g + col0 + bj * HALF + 4);
                    *(f32x4*)(out + off + bj * HALF) = acc[ai][bj][m][0] * rstd * g0; *(f32x4*)(out + off + bj * HALF + 4) = acc[ai][bj][m][1] * rstd * g1; } }
    }
};

template <class Epi, class Sched, bool ALIGN_EPI = false, bool SP2 = false>
__device__ __forceinline__ void gemm_phase(PG8_LAS unsigned char* lds, const Gemm g, const Sched& S, const Epi& E, const int tid) {
    const int wid = __builtin_amdgcn_readfirstlane(tid >> 6), lane = tid & 63, wr = wid >> 2, wc = wid & 3, fr = lane & 15, fq = lane >> 4;
    const int K = g.K, nt = K / BK;
    unsigned voffA[2], voffB[2];
#pragma unroll
    for (int i = 0; i < 2; ++i) { int R, C; stage_rc(tid * 16 + i * 8192, R, C); const int Rb = Epi::PERM ? ((R & ~31) + perm32(R & 31)) : R;
        voffA[i] = (unsigned)(R * K + C) * 2u; voffB[i] = (unsigned)(Rb * K + C) * 2u; }
    const size_t kstep = (size_t)(BK * 2);
    const size_t hstep = (size_t)HALF * K * 2;
    const size_t tstep = 2 * hstep;
    const unsigned ldsw = (unsigned)wid * 1024u;
    const int aoff = lds_byte(wr * 64 + fr, fq * 8), boff = lds_byte(wc * 32 + fr, fq * 8);
#define PG8_SA(b, h) (((b) * 2 + (h)) * HTB)
#define PG8_SB(b, h) ((4 + (b) * 2 + (h)) * HTB)
#define PG8_STAGE(bufoff, gbase, voff) do { _Pragma("unroll") for (int _i = 0; _i < 2; ++_i) \
        __builtin_amdgcn_global_load_lds((const unsigned*)((const char*)(gbase) + (voff)[_i]), (PG8_LAS unsigned*)(lds + (bufoff) + ldsw + _i * 8192), 16, 0, 0); } while (0)
#define PG8_LDA(dst, b, h) do { _Pragma("unroll") for (int m = 0; m < 4; ++m) _Pragma("unroll") for (int k = 0; k < 2; ++k) dst[m][k] = *(const PG8_LAS bf16x8*)(lds + PG8_SA(b, h) + aoff + m * 2048 + k * 1024); } while (0)
#define PG8_LDB(dst, b, h) do { _Pragma("unroll") for (int n = 0; n < 2; ++n) _Pragma("unroll") for (int k = 0; k < 2; ++k) dst[n][k] = *(const PG8_LAS bf16x8*)(lds + PG8_SB(b, h) + boff + n * 2048 + k * 1024); } while (0)
#define PG8_MMA(ai, bj, At, Bt) do { __builtin_amdgcn_s_setprio(1); _Pragma("unroll") for (int m = 0; m < 4; ++m) _Pragma("unroll") for (int n = 0; n < 2; ++n) _Pragma("unroll") for (int k = 0; k < 2; ++k) \
        acc[ai][bj][m][n] = __builtin_amdgcn_mfma_f32_16x16x32_bf16(Bt[n][k], At[m][k], acc[ai][bj][m][n], 0, 0, 0); __builtin_amdgcn_s_setprio(0); } while (0)
#define PG8_WAIT_V(n) asm volatile("s_waitcnt vmcnt(" #n ")" ::: "memory")
#define PG8_WAIT_L(n) asm volatile("s_waitcnt lgkmcnt(" #n ")" ::: "memory")
#define PG8_BAR __builtin_amdgcn_s_barrier()
#define PG8_SCHED __builtin_amdgcn_sched_barrier(0)
    Unit cur, nxt; int ui = 0;
    if (!S.next(0, cur)) return;
    f32x4 acc[2][2][4][2];
#pragma unroll
    for (int a = 0; a < 2; ++a)
#pragma unroll
        for (int b = 0; b < 2; ++b)
#pragma unroll
            for (int m = 0; m < 4; ++m)
#pragma unroll
                for (int n = 0; n < 2; ++n) acc[a][b][m][n] = (f32x4){0.f, 0.f, 0.f, 0.f};
    bf16x8 At[4][2], B0[2][2], B1[2][2];
    const char* cA = (const char*)g.A + (size_t)cur.pm * tstep; const char* cB = (const char*)g.Bt + (size_t)cur.pn * tstep;
    S.a_ready(cur);
    if constexpr (SP2) {
        PG8_STAGE(PG8_SB(0, 0), cB, voffB); PG8_STAGE(PG8_SB(0, 1), cB + hstep, voffB); PG8_STAGE(PG8_SA(0, 0), cA, voffA); PG8_STAGE(PG8_SA(0, 1), cA + hstep, voffA);
        if (wr == 1) PG8_BAR;
        PG8_WAIT_V(2); PG8_BAR;
        PG8_STAGE(PG8_SB(1, 0), cB + kstep, voffB); PG8_STAGE(PG8_SA(1, 0), cA + kstep, voffA); PG8_STAGE(PG8_SB(1, 1), cB + hstep + kstep, voffB);
        PG8_WAIT_V(6); PG8_BAR;
    } else {
        PG8_STAGE(PG8_SB(0, 0), cB, voffB); PG8_STAGE(PG8_SA(0, 0), cA, voffA); PG8_STAGE(PG8_SB(0, 1), cB + hstep, voffB); PG8_STAGE(PG8_SA(0, 1), cA + hstep, voffA);
        if (wr == 1) PG8_BAR;
        PG8_WAIT_V(4); PG8_BAR;
        PG8_STAGE(PG8_SB(1, 0), cB + kstep, voffB); PG8_STAGE(PG8_SA(1, 0), cA + kstep, voffA); PG8_STAGE(PG8_SB(1, 1), cB + hstep + kstep, voffB);
        PG8_WAIT_V(6); PG8_BAR;
    }
    for (;;) {
        const bool has_next = S.next(ui + 1, nxt);
        const char* nA = has_next ? (const char*)g.A + (size_t)nxt.pm * tstep : cA; const char* nB = has_next ? (const char*)g.Bt + (size_t)nxt.pn * tstep : cB;
        for (int t = 0; t < nt; t += 2) {
            const bool last = (t == nt - 2);
            const char* a1 = cA + (size_t)(t + 1) * kstep;
            const char* a2 = last ? nA : cA + (size_t)(t + 2) * kstep; const char* b2 = last ? nB : cB + (size_t)(t + 2) * kstep;
            const char* a3 = a2 + kstep; const char* b3 = b2 + kstep;
            if (last && has_next) S.a_ready(nxt);
            if constexpr (SP2) {
            PG8_LDB(B0, 0, 0); PG8_LDB(B1, 0, 1); PG8_SCHED; PG8_LDA(At, 0, 0); PG8_STAGE(PG8_SA(1, 1), a1 + hstep, voffA);
            PG8_WAIT_V(8); PG8_WAIT_L(0); PG8_BAR; PG8_MMA(0, 0, At, B0); PG8_MMA(0, 1, At, B1); PG8_BAR; PG8_SCHED;
            PG8_LDA(At, 0, 1); PG8_STAGE(PG8_SB(0, 0), b2, voffB); PG8_STAGE(PG8_SB(0, 1), b2 + hstep, voffB); PG8_STAGE(PG8_SA(0, 0), a2, voffA);
            PG8_WAIT_V(8); PG8_WAIT_L(0); PG8_BAR; PG8_MMA(1, 0, At, B0); PG8_MMA(1, 1, At, B1); PG8_BAR; PG8_SCHED;
            PG8_LDB(B0, 1, 0); PG8_LDB(B1, 1, 1); PG8_SCHED; PG8_LDA(At, 1, 0); PG8_STAGE(PG8_SA(0, 1), a2 + hstep, voffA);
            PG8_WAIT_V(8); PG8_WAIT_L(0); PG8_BAR; PG8_MMA(0, 0, At, B0); PG8_MMA(0, 1, At, B1); PG8_BAR; PG8_SCHED;
            PG8_LDA(At, 1, 1); PG8_STAGE(PG8_SB(1, 0), b3, voffB); PG8_STAGE(PG8_SB(1, 1), b3 + hstep, voffB); PG8_STAGE(PG8_SA(1, 0), a3, voffA);
            PG8_WAIT_V(8); PG8_WAIT_L(0); PG8_BAR; PG8_MMA(1, 0, At, B0); PG8_MMA(1, 1, At, B1); PG8_BAR; PG8_SCHED;
            } else {
            PG8_LDB(B0, 0, 0); PG8_SCHED; PG8_LDA(At, 0, 0); PG8_STAGE(PG8_SA(1, 1), a1 + hstep, voffA);
            PG8_WAIT_L(8); PG8_BAR; PG8_WAIT_L(0); PG8_MMA(0, 0, At, B0); PG8_BAR; PG8_SCHED;
            PG8_LDB(B1, 0, 1); PG8_STAGE(PG8_SB(0, 0), b2, voffB);
            PG8_BAR; PG8_WAIT_L(0); PG8_MMA(0, 1, At, B1); PG8_BAR;
            PG8_LDA(At, 0, 1); PG8_STAGE(PG8_SA(0, 0), a2, voffA);
            PG8_BAR; PG8_WAIT_L(0); PG8_MMA(1, 0, At, B0); PG8_BAR; PG8_SCHED;
            PG8_STAGE(PG8_SB(0, 1), b2 + hstep, voffB);
            PG8_WAIT_V(6); PG8_BAR; PG8_MMA(1, 1, At, B1); PG8_BAR;
            PG8_LDB(B0, 1, 0); PG8_SCHED; PG8_LDA(At, 1, 0); PG8_STAGE(PG8_SA(0, 1), a2 + hstep, voffA);
            PG8_WAIT_L(8); PG8_BAR; PG8_WAIT_L(0); PG8_MMA(0, 0, At, B0); PG8_BAR; PG8_SCHED;
            PG8_LDB(B1, 1, 1); PG8_STAGE(PG8_SB(1, 0), b3, voffB);
            PG8_BAR; PG8_WAIT_L(0); PG8_MMA(0, 1, At, B1); PG8_BAR;
            PG8_LDA(At, 1, 1); PG8_STAGE(PG8_SA(1, 0), a3, voffA);
            PG8_BAR; PG8_WAIT_L(0); PG8_MMA(1, 0, At, B0); PG8_BAR; PG8_SCHED;
            PG8_STAGE(PG8_SB(1, 1), b3 + hstep, voffB);
            PG8_WAIT_V(6); PG8_BAR; PG8_MMA(1, 1, At, B1); PG8_BAR;
            }
        }
        if constexpr (ALIGN_EPI) { if (wr == 0) PG8_BAR; }
        if constexpr (!Epi::AFTER_DRAIN) { E(acc, cur, wr, wc, fr, fq); S.done(cur); }
        if (!has_next) break;
#pragma unroll
        for (int a = 0; a < 2; ++a)
#pragma unroll
            for (int b = 0; b < 2; ++b)
#pragma unroll
                for (int m = 0; m < 4; ++m)
#pragma unroll
                    for (int n = 0; n < 2; ++n) acc[a][b][m][n] = (f32x4){0.f, 0.f, 0.f, 0.f};
        cur = nxt; cA = nA; cB = nB; ++ui;
        if constexpr (ALIGN_EPI) { if (wr == 1) PG8_BAR; }
    }
    PG8_WAIT_V(0);
    if constexpr (!ALIGN_EPI) { if (wr == 0) PG8_BAR; }
    PG8_BAR;
    if constexpr (Epi::AFTER_DRAIN) { E.fused(acc, cur, wr, wc, fr, fq, lds, wid, lane); }
#undef PG8_SA
#undef PG8_SB
#undef PG8_STAGE
#undef PG8_LDA
#undef PG8_LDB
#undef PG8_MMA
#undef PG8_WAIT_V
#undef PG8_WAIT_L
#undef PG8_BAR
#undef PG8_SCHED
}
}

constexpr int DM = 2048, BATCH = 2, SEQ = 4096, MTOK = BATCH * SEQ;
constexpr int AB_IN = 6144, CD_IN = 5120, DFF = 5632, DFF2 = 11264;
constexpr float EPS = 1e-6f;
constexpr int NWAVES = 8;

#define GAS __attribute__((address_space(1)))
#define LAS __attribute__((address_space(3)))
typedef unsigned short bf16;
typedef unsigned v4u __attribute__((ext_vector_type(4)));
typedef unsigned v2u __attribute__((ext_vector_type(2)));
typedef float f32x4 __attribute__((ext_vector_type(4)));
typedef float f32x16 __attribute__((ext_vector_type(16)));
typedef short bf16x8 __attribute__((ext_vector_type(8)));
typedef short s16x4 __attribute__((ext_vector_type(4)));
typedef GAS unsigned gu32;
#define RLX_AGENT __ATOMIC_RELAXED, __HIP_MEMORY_SCOPE_AGENT
#define LDS_WAIT() asm volatile("s_waitcnt lgkmcnt(0)" ::: "memory")
#define VM_WAIT() asm volatile("s_waitcnt vmcnt(0)" ::: "memory")
__device__ __forceinline__ unsigned f2bf(float f) { unsigned u = __builtin_bit_cast(unsigned, f); return (u + 0x7fffu + ((u >> 16) & 1u)) >> 16; }
__device__ __forceinline__ unsigned pk2(float lo, float hi) { return f2bf(lo) | (f2bf(hi) << 16); }
__device__ __forceinline__ float bf2f(unsigned u16) { return __builtin_bit_cast(float, u16 << 16); }
__device__ __forceinline__ float bflo(unsigned w) { return __builtin_bit_cast(float, w << 16); }
__device__ __forceinline__ float bfhi(unsigned w) { return __builtin_bit_cast(float, w & 0xffff0000u); }
__device__ __forceinline__ float wave_sum(float v) {
#pragma unroll
    for (int o = 1; o < 64; o <<= 1) v += __shfl_xor(v, o);
    return v;
}
__device__ __forceinline__ float gelu_tanh(float x) {
    const float u = 0.7978845608028654f * (x + 0.044715f * x * x * x);
    const float t = 1.f - 2.f / (__expf(2.f * u) + 1.f);
    return 0.5f * x * (1.f + t);
}
__device__ __forceinline__ float silu_f(float x) { return x / (1.f + __expf(-x)); }

constexpr size_t MiB = 1u << 20;
constexpr size_t WS_CTL = 0, CTL_ZERO_BYTES = 1 * MiB;
constexpr size_t WS_SS = 128 * 1024;
constexpr size_t WS_LNS = 512 * 1024;
constexpr size_t WS_CNT = 768 * 1024;
constexpr size_t WS_SCAL = 1 * MiB;
constexpr size_t WS_ROPE = 2 * MiB;
constexpr size_t WS_W_ABIN = 4 * MiB;
constexpr size_t WS_W_ABOUT = WS_W_ABIN + 24 * MiB;
constexpr size_t WS_W_CDIN = WS_W_ABOUT + 8 * MiB;
constexpr size_t WS_W_CDOUT = WS_W_CDIN + 20 * MiB;
constexpr size_t WS_W_UP0 = WS_W_CDOUT + 8 * MiB;
constexpr size_t WS_W_UP1 = WS_W_UP0 + 44 * MiB;
constexpr size_t WS_W_DN0 = WS_W_UP1 + 44 * MiB;
constexpr size_t WS_W_DN1 = WS_W_DN0 + 22 * MiB;
constexpr size_t WS_XN = WS_W_DN1 + 22 * MiB;
constexpr size_t WS_O = WS_XN + 32 * MiB;
constexpr size_t WS_X = WS_O + 32 * MiB;
constexpr size_t WS_ACT = WS_X + 64 * MiB;
constexpr size_t WS_R1 = WS_ACT + 88 * MiB;
constexpr size_t WS_P = WS_R1;
constexpr size_t WS_OB = WS_R1 + 96 * MiB;
constexpr size_t WS_KV = WS_R1 + 96 * MiB;
constexpr size_t WS_PREV = WS_KV + 64 * MiB;
constexpr size_t WS_UP = WS_R1;
constexpr size_t WS_HALO = WS_R1 + 192 * MiB;
constexpr size_t WS_SCR = WS_HALO + 4 * MiB;
constexpr size_t WS_END = WS_SCR + 32 * MiB;

constexpr int RING_BYTES = 131072;
constexpr int LDSCTL_OFF = RING_BYTES, MISC_OFF = LDSCTL_OFF + 320;
constexpr int LDS_BYTES = 147456;

#define XB_TMO      128
#define XB_XCNT(j)  (256  + 64 * (j))
#define XB_XSUB(j)  (1280 + 64 * (j))
#define XB_XGEN(j)  (2304 + 64 * (j))
#define XB_TOP      3328
#define XB_TOPGEN   3392
#define XCD_BAR_WORDS 3456
#define XB_SPIN_CAP (1u << 20)
__device__ __forceinline__ unsigned xb_ld(unsigned* p)              { return __hip_atomic_load(p, __ATOMIC_RELAXED, __HIP_MEMORY_SCOPE_AGENT); }
__device__ __forceinline__ unsigned xb_add(unsigned* p, unsigned v) { return __hip_atomic_fetch_add(p, v, __ATOMIC_RELAXED, __HIP_MEMORY_SCOPE_AGENT); }
__device__ __forceinline__ unsigned xb_xcc_id() { return (unsigned)__builtin_amdgcn_s_getreg((3 << 11) | 20) & 0xFu; }
#define XB_SPIN(cond, bar) do { unsigned _sp = 0; while (cond) { __builtin_amdgcn_s_sleep(1); \
    if ((++_sp & 255u) == 0u) { if (xb_ld(&(bar)[XB_TMO])) break; if (_sp > XB_SPIN_CAP) { atomicAdd(&(bar)[XB_TMO], 1u); break; } } } } while (0)
struct XcdBarrier { unsigned* bar; unsigned x; volatile LAS unsigned* st; };
__device__ __forceinline__ XcdBarrier xcd_barrier_post(unsigned* bar, volatile LAS unsigned* st) {
    XcdBarrier b; b.bar = bar; b.x = xb_xcc_id(); b.st = st;
    if (threadIdx.x == 0) (void)xb_add(&bar[XB_XCNT(b.x)], 1u);
    return b;
}
__device__ __forceinline__ void xcd_barrier_complete(unsigned* bar, unsigned x, unsigned& nloc, unsigned& nx) {
    const unsigned G = gridDim.x * gridDim.y * gridDim.z;
    unsigned sum, cnt, mine, sp = 0u;
    for (;;) {
        sum = 0u; cnt = 0u; mine = 0u;
#pragma unroll
        for (unsigned j = 0; j < 16; ++j) { const unsigned c = xb_ld(&bar[XB_XCNT(j)]); sum += c; cnt += (c > 0u) ? 1u : 0u; mine = (j == x) ? c : mine; }
        if (sum == G) break;
        __builtin_amdgcn_s_sleep(1);
        if ((++sp & 255u) == 0u) { if (xb_ld(&bar[XB_TMO])) break; if (sp > XB_SPIN_CAP) { atomicAdd(&bar[XB_TMO], 1u); break; } }
    }
    nloc = mine > 0u ? mine : 1u; nx = cnt > 0u ? cnt : 1u;
}
__device__ __forceinline__ void xcd_barrier(const XcdBarrier& b) {
    asm volatile("s_waitcnt vmcnt(0)" ::: "memory");
    __syncthreads();
    if (threadIdx.x == 0) {
        unsigned* bar = b.bar;
        __builtin_amdgcn_s_waitcnt(0);
        unsigned nloc = b.st[0], nx = b.st[1];
        if (nloc == 0u) { xcd_barrier_complete(bar, b.x, nloc, nx); b.st[0] = nloc; b.st[1] = nx; }
        const unsigned old = xb_add(&bar[XB_XSUB(b.x)], 1u);
        const unsigned gen = old / nloc;
        if (old + 1u == (gen + 1u) * nloc) {
            __builtin_amdgcn_fence(__ATOMIC_RELEASE, "agent");
            asm volatile("s_waitcnt vmcnt(0)" ::: "memory");
            const unsigned og = xb_add(&bar[XB_TOP], 1u);
            const unsigned tg = og / nx;
            if (og + 1u == (tg + 1u) * nx) xb_add(&bar[XB_TOPGEN], 1u);
            else XB_SPIN(xb_ld(&bar[XB_TOPGEN]) == tg, bar);
            __builtin_amdgcn_fence(__ATOMIC_ACQUIRE, "agent");
            xb_add(&bar[XB_XGEN(b.x)], 1u);
            asm volatile("s_waitcnt vmcnt(0)" ::: "memory");
        } else {
            XB_SPIN(xb_ld(&bar[XB_XGEN(b.x)]) == gen, bar);
            __builtin_amdgcn_fence(__ATOMIC_ACQUIRE, "agent");
            asm volatile("s_waitcnt vmcnt(0)" ::: "memory");
        }
    }
    __syncthreads();
}

#ifndef ATT_SDEPTH
#define ATT_SDEPTH 1
#endif
namespace att {
constexpr int D = 128, QBLK = 32, KVBLK = 64;
constexpr float SCALE = 0.088388347648318440f;
constexpr float THR = 8.f;
constexpr int SHM_V = KVBLK * D * 2, SHM_K = KVBLK * D * 2;
constexpr int OFF_WS = 2 * SHM_V + 2 * SHM_K;
constexpr int OFF_TB = OFF_WS + 8 * 64 * 4;
constexpr int OFF_FLG = OFF_TB + 448 * 4;
#define KSWZ(row, colB) ((row) * 256 + ((colB) ^ (((row) & 7) << 4)))
#define SBAR() __builtin_amdgcn_sched_barrier(0)
__device__ __forceinline__ int crow(int r, int hi) { return (r & 3) + 8 * (r >> 2) + 4 * hi; }
__device__ __forceinline__ unsigned cvtpk(float lo, float hi) { unsigned r; asm volatile("v_cvt_pk_bf16_f32 %0, %1, %2" : "=v"(r) : "v"(lo), "v"(hi)); return r; }

__device__ __forceinline__ void partialSM(f32x16& p0, f32x16& p1, float& m_reg, float& mn, float& alpha) {
  constexpr float C = SCALE * 1.4426950408889634f;
  float pmax = p0[0];
#pragma unroll
  for (int r = 1; r < 16; ++r) pmax = fmaxf(pmax, p0[r]);
#pragma unroll
  for (int r = 0; r < 16; ++r) pmax = fmaxf(pmax, p1[r]);
  { auto rr = __builtin_amdgcn_permlane32_swap(__float_as_uint(pmax), __float_as_uint(pmax), false, false);
    pmax = fmaxf(__uint_as_float(rr[0]), __uint_as_float(rr[1])); }
  if (__builtin_expect(__all(pmax - m_reg <= THR / SCALE), 1)) { mn = m_reg; alpha = 1.f; }
  else { mn = fmaxf(m_reg, pmax); alpha = __builtin_amdgcn_exp2f((m_reg - mn) * C); m_reg = mn; }
  float mnC = -mn * C;
#pragma unroll
  for (int r = 0; r < 16; ++r) p0[r] = fmaf(p0[r], C, mnC);
#pragma unroll
  for (int r = 0; r < 16; ++r) p1[r] = fmaf(p1[r], C, mnC);
#pragma unroll
  for (int r = 0; r < 16; ++r) p0[r] = __builtin_amdgcn_exp2f(p0[r]);
}
#define PK4(P, BASE, OUT) do { unsigned a0 = cvtpk(P[BASE + 0], P[BASE + 1]), a1 = cvtpk(P[BASE + 2], P[BASE + 3]);   \
    unsigned b0 = cvtpk(P[BASE + 4], P[BASE + 5]), b1 = cvtpk(P[BASE + 6], P[BASE + 7]);                              \
    auto r0 = __builtin_amdgcn_permlane32_swap(a0, b0, false, false); auto r1 = __builtin_amdgcn_permlane32_swap(a1, b1, false, false); \
    v4u w = {r0[0], r1[0], r0[1], r1[1]}; OUT = *reinterpret_cast<bf16x8*>(&w); } while (0)
__device__ __forceinline__ void finishSM(f32x16& p0, f32x16& p1, float alpha, float& l_reg, bf16x8& pa0, bf16x8& pa1, bf16x8& pa2, bf16x8& pa3) {
#pragma unroll
  for (int r = 0; r < 16; ++r) p1[r] = __builtin_amdgcn_exp2f(p1[r]);
  float ps = 0;
#pragma unroll
  for (int r = 0; r < 16; ++r) ps += p0[r];
#pragma unroll
  for (int r = 0; r < 16; ++r) ps += p1[r];
  { auto rr = __builtin_amdgcn_permlane32_swap(__float_as_uint(ps), __float_as_uint(ps), false, false);
    ps = __uint_as_float(rr[0]) + __uint_as_float(rr[1]); }
  l_reg = l_reg * alpha + ps;
  PK4(p0, 0, pa0); PK4(p0, 8, pa1); PK4(p1, 0, pa2); PK4(p1, 8, pa3);
}
__device__ __forceinline__ void packP(const f32x16& p0, const f32x16& p1, bf16x8& pa0, bf16x8& pa1, bf16x8& pa2, bf16x8& pa3) {
  PK4(p0, 0, pa0); PK4(p0, 8, pa1); PK4(p1, 0, pa2); PK4(p1, 8, pa3);
}
__device__ __forceinline__ void qkt(f32x16& p0, f32x16& p1, const char* Ks, const bf16x8* qr, int r32, int hi) {
  p0 = f32x16{}; p1 = f32x16{};
#pragma unroll
  for (int d0 = 0; d0 < 8; ++d0) { int cb = (d0 * 16 + hi * 8) * 2;
    bf16x8 b0 = *reinterpret_cast<const bf16x8*>(Ks + KSWZ(r32, cb));
    bf16x8 b1 = *reinterpret_cast<const bf16x8*>(Ks + KSWZ(32 + r32, cb));
    p0 = __builtin_amdgcn_mfma_f32_32x32x16_bf16(b0, qr[d0], p0, 0, 0, 0);
    p1 = __builtin_amdgcn_mfma_f32_32x32x16_bf16(b1, qr[d0], p1, 0, 0, 0); }
}
__device__ __forceinline__ int v_st(int k, int c) { const int kk = (k & ~0xC) | ((k & 4) << 1) | ((k & 8) >> 1); return ((kk >> 3) * 4 + (c >> 5)) * 512 + ((kk & 7) * 32 + (c & 31)) * 2; }
__device__ __forceinline__ int v_rd_base(int lane) { return ((lane & 3) << 3) | (((lane >> 2) & 3) << 6) | (((lane >> 4) & 1) << 5) | (((lane >> 5) & 1) << 8); }
constexpr int v_rd_off(int d0, int ks, int half) { return d0 * 512 + ks * 4096 + half * 2048; }
template <int OFF> __device__ __forceinline__ s16x4 tr_read(int vb) {
  s16x4 r; asm volatile("ds_read_b64_tr_b16 %0, %1 offset:%2" : "=&v"(r) : "v"(vb), "i"(OFF) : "memory"); return r;
}
template <int D0> __device__ __forceinline__ void pv_one(f32x16& od, int vb, bf16x8 pa0, bf16x8 pa1, bf16x8 pa2, bf16x8 pa3) {
  const s16x4 l0 = tr_read<v_rd_off(D0, 0, 0)>(vb), h0 = tr_read<v_rd_off(D0, 0, 1)>(vb), l1 = tr_read<v_rd_off(D0, 1, 0)>(vb), h1 = tr_read<v_rd_off(D0, 1, 1)>(vb);
  const s16x4 l2 = tr_read<v_rd_off(D0, 2, 0)>(vb), h2 = tr_read<v_rd_off(D0, 2, 1)>(vb), l3 = tr_read<v_rd_off(D0, 3, 0)>(vb), h3 = tr_read<v_rd_off(D0, 3, 1)>(vb);
  asm volatile("s_waitcnt lgkmcnt(0)" ::: "memory"); SBAR();
#define PKV(L, H) (bf16x8){L[0], L[1], L[2], L[3], H[0], H[1], H[2], H[3]}
  od = __builtin_amdgcn_mfma_f32_32x32x16_bf16(pa0, PKV(l0, h0), od, 0, 0, 0);
  od = __builtin_amdgcn_mfma_f32_32x32x16_bf16(pa1, PKV(l1, h1), od, 0, 0, 0);
  od = __builtin_amdgcn_mfma_f32_32x32x16_bf16(pa2, PKV(l2, h2), od, 0, 0, 0);
  od = __builtin_amdgcn_mfma_f32_32x32x16_bf16(pa3, PKV(l3, h3), od, 0, 0, 0);
#undef PKV
}
__device__ __forceinline__ void pv_d0(f32x16* o, int vb, bf16x8 pa0, bf16x8 pa1, bf16x8 pa2, bf16x8 pa3) {
  pv_one<0>(o[0], vb, pa0, pa1, pa2, pa3); pv_one<1>(o[1], vb, pa0, pa1, pa2, pa3); pv_one<2>(o[2], vb, pa0, pa1, pa2, pa3); pv_one<3>(o[3], vb, pa0, pa1, pa2, pa3);
}

__device__ __forceinline__ void* uniform_ptr(const void* p) { const unsigned long long v = (unsigned long long)p;
  const unsigned lo = (unsigned)__builtin_amdgcn_readfirstlane((int)(unsigned)v), hi = (unsigned)__builtin_amdgcn_readfirstlane((int)(unsigned)(v >> 32)); return (void*)(((unsigned long long)hi << 32) | lo); }
__device__ __forceinline__ bf16x8 mk8a(s16x4 l, s16x4 h) { return (bf16x8){l[0], l[1], l[2], l[3], h[0], h[1], h[2], h[3]}; }
__device__ __forceinline__ bf16x8 bload16(__amdgpu_buffer_rsrc_t rs, int voff, int soff) {
  const v4u w = __builtin_amdgcn_raw_buffer_load_b128(rs, voff, soff, 0); return __builtin_bit_cast(bf16x8, w); }
template <int LDP, int LDO>
__device__ __forceinline__ void attnB_unit(const bf16* __restrict__ Qb, const bf16* Pbase, int koff, int voff, float* __restrict__ Ob, int qb, char* lds) {
  const __amdgpu_buffer_rsrc_t rs = __builtin_amdgcn_make_buffer_rsrc(uniform_ptr(Pbase), 0, SEQ * LDP * 2, 0x00020000);
  int tid = threadIdx.x; asm volatile("" : "+v"(tid));
  const int wid = tid >> 6, lane = tid & 63, r32 = lane & 31, hi = lane >> 5;
  char* V_lds = lds; char* K_lds = lds + 2 * SHM_V;
  float* ws = (float*)(lds + OFF_WS) + wid * 64; float* li_l = ws; float* al_l = ws + 32;
  const float* tb = (const float*)(lds + OFF_TB);
  float m_reg = -1e30f, l_reg = 0; f32x16 o[4] = {}; bf16x8 qr[8];
  const bf16* Qw = Qb + (long)(wid * QBLK + r32) * LDP + hi * 8;
#pragma unroll
  for (int d0 = 0; d0 < 8; ++d0) qr[d0] = *reinterpret_cast<const bf16x8*>(Qw + d0 * 16);
  const int sr = tid >> 4, sc = (tid & 15) * 8, vst0 = v_st(sr, sc), vst1 = v_st(32 + sr, sc);
  const int vb0 = (int)(uintptr_t)V_lds + v_rd_base(lane);
  constexpr int SDEPTH = ATT_SDEPTH;
  struct { bf16x8 vs0, vs1, ks0, ks1; } sr_[SDEPTH];
  const int vo0 = (sr * LDP + sc) * 2, vo1 = vo0 + 32 * LDP * 2;
#define SLOAD(i, k0) do { const int sV_ = (voff + (k0) * LDP) * 2, sK_ = (koff + (k0) * LDP) * 2; \
    sr_[i].vs0 = bload16(rs, vo0, sV_); sr_[i].vs1 = bload16(rs, vo1, sV_); sr_[i].ks0 = bload16(rs, vo0, sK_); sr_[i].ks1 = bload16(rs, vo1, sK_); } while (0)
#define SWRITE(b, i) do { *(bf16x8*)(V_lds + (b) * SHM_V + vst0) = sr_[i].vs0;          \
    *(bf16x8*)(V_lds + (b) * SHM_V + vst1) = sr_[i].vs1; int kc = sc * 2;               \
    *(bf16x8*)(K_lds + (b) * SHM_K + KSWZ(sr, kc)) = sr_[i].ks0;                       \
    *(bf16x8*)(K_lds + (b) * SHM_K + KSWZ(32 + sr, kc)) = sr_[i].ks1; } while (0)
#define SWAIT() do { if constexpr (SDEPTH == 2) asm volatile("s_waitcnt vmcnt(4)" ::: "memory"); else asm volatile("s_waitcnt vmcnt(0)" ::: "memory"); } while (0)
#define RESC(a) do { if (__any((a) < 1.f)) { if (hi == 0) al_l[r32] = (a); asm volatile("s_waitcnt lgkmcnt(0)" ::: "memory"); \
    _Pragma("unroll") for (int d = 0; d < 4; ++d) _Pragma("unroll") for (int r = 0; r < 16; ++r) o[d][r] *= al_l[crow(r, hi)]; } } while (0)
  const int NT = 4 * qb + 4, chunk_w = 4 * qb + (wid >> 1);
  const int ib0 = 4 * hi - 256 * qb - 32 * wid - r32 + 127 + 256;
#ifdef NO_FIX
#define FIX(P0, P1, j) do {} while (0)
#else
#define FIX(P0, P1, j) do { if ((j) > chunk_w) { _Pragma("unroll") for (int r = 0; r < 16; ++r) { P0[r] = -1e30f; P1[r] = -1e30f; } } \
    else if ((j) >= NT - 6) { const float* tbj = tb + (ib0 + 64 * (j)); \
      _Pragma("unroll") for (int r = 0; r < 16; ++r) { P0[r] += tbj[(r & 3) + 8 * (r >> 2)]; P1[r] += tbj[32 + (r & 3) + 8 * (r >> 2)]; } } } while (0)
#endif
  f32x16 pA0, pA1, pB0, pB1; float mnA, mnB, alA, alB; bf16x8 pa0, pa1, pa2, pa3;
  constexpr int SE = 0, SO = SDEPTH - 1;
  SLOAD(SE, 0); asm volatile("s_waitcnt vmcnt(0)" ::: "memory"); SWRITE(0, SE); __syncthreads();
  qkt(pA0, pA1, K_lds, qr, r32, hi); FIX(pA0, pA1, 0); partialSM(pA0, pA1, m_reg, mnA, alA);
  SLOAD(SO, KVBLK); if constexpr (SDEPTH == 2) { if (2 < NT) SLOAD(SE, 2 * KVBLK); }
  SWAIT(); SWRITE(1, SO); __syncthreads();
  for (int j = 1; j + 1 < NT; j += 2) {
    SBAR(); qkt(pB0, pB1, K_lds + SHM_K, qr, r32, hi);
    finishSM(pA0, pA1, alA, l_reg, pa0, pa1, pa2, pa3); SBAR();
    SLOAD(SO, (j + SDEPTH) * KVBLK); SBAR();
    pv_d0(o, vb0, pa0, pa1, pa2, pa3); FIX(pB0, pB1, j); partialSM(pB0, pB1, m_reg, mnB, alB);
    __syncthreads(); SWAIT(); SWRITE(0, SE);
    RESC(alB); __syncthreads();
    SBAR(); qkt(pA0, pA1, K_lds, qr, r32, hi);
    finishSM(pB0, pB1, alB, l_reg, pa0, pa1, pa2, pa3); SBAR();
    if (SDEPTH == 1 || j + 3 < NT) SLOAD(SE, (j + 1 + SDEPTH) * KVBLK); SBAR();
    pv_d0(o, vb0 + SHM_V, pa0, pa1, pa2, pa3); FIX(pA0, pA1, j + 1); partialSM(pA0, pA1, m_reg, mnA, alA);
    __syncthreads(); SWAIT(); SWRITE(1, SO);
    RESC(alA); __syncthreads();
  }
  SBAR(); qkt(pB0, pB1, K_lds + SHM_K, qr, r32, hi);
  finishSM(pA0, pA1, alA, l_reg, pa0, pa1, pa2, pa3); SBAR();
  pv_d0(o, vb0, pa0, pa1, pa2, pa3); FIX(pB0, pB1, NT - 1); partialSM(pB0, pB1, m_reg, mnB, alB);
  __syncthreads(); RESC(alB);
  finishSM(pB0, pB1, alB, l_reg, pa0, pa1, pa2, pa3); SBAR();
  pv_d0(o, vb0 + SHM_V, pa0, pa1, pa2, pa3);
  if (hi == 0) li_l[r32] = l_reg; asm volatile("s_waitcnt lgkmcnt(0)" ::: "memory");
  float rli[16];
#pragma unroll
  for (int r = 0; r < 16; ++r) rli[r] = __builtin_amdgcn_rcpf(li_l[crow(r, hi)]);
  float* Ow = Ob + (long)(wid * QBLK) * LDO;
#pragma unroll
  for (int r = 0; r < 16; ++r) { int orow = crow(r, hi);
#pragma unroll
    for (int d0 = 0; d0 < 4; ++d0) Ow[(long)orow * LDO + d0 * 32 + r32] = o[d0][r] * rli[r]; }
  __syncthreads();
#undef SLOAD
#undef SWRITE
#undef SWAIT
#undef RESC
#undef FIX
}

__device__ __forceinline__ void glds16_asm(const void* gsrc, unsigned lds_dst) { unsigned keep;
  asm volatile("s_mov_b32 %0, m0\n\ts_mov_b32 m0, %2\n\ts_nop 0\n\tglobal_load_lds_dwordx4 %1, off\n\ts_mov_b32 m0, %0" : "=&s"(keep) : "v"(gsrc), "s"(lds_dst) : "memory"); }
constexpr int B2_K = 0, B2_V = 2 * SHM_K, B2_P = B2_V + 4 * SHM_V, B2_X = 131072 + 1024;
constexpr int B2_AL = B2_X, B2_FL = B2_AL + 1024, B2_LI = B2_FL + 64, B2_TB = B2_LI + 512;
template <int LDP, int LDO>
__device__ __forceinline__ void attnB2_unit(const bf16* __restrict__ Qb, const bf16* Pbase, int koff, int voff, float* __restrict__ Ob, int q128, char* lds, int sel = 0) {
  int tid = threadIdx.x; asm volatile("" : "+v"(tid));
  const int wid = __builtin_amdgcn_readfirstlane(tid >> 6), lane = tid & 63, r32 = lane & 31, hi = lane >> 5, pw = wid & 3;
  const int NT = 2 * q128 + 2;
  const unsigned lbase = (unsigned)__builtin_amdgcn_readfirstlane((int)(uintptr_t)lds);
  const bf16* Ksrc; const bf16* Vsrc[4];
  { const int row0 = 8 * wid + (lane >> 4), row1 = row0 + 4;
    Ksrc = Pbase + koff + (size_t)row0 * LDP + (((lane & 15) ^ (row0 & 7)) << 3);
    (void)row1; }
  const int kx1 = (int)((((lane & 15) ^ ((8 * wid + (lane >> 4) + 4) & 7)) << 3)) - (int)((((lane & 15) ^ ((8 * wid + (lane >> 4)) & 7)) << 3));
#pragma unroll
  for (int q = 0; q < 4; ++q) { const int ci = wid * 4 + q, vt = ci >> 4, cs = ci & 15, st = cs * 2 + (lane >> 5);
    const int kk = (st >> 2) * 8 + ((lane >> 2) & 7), k = (kk & ~0xC) | ((kk & 4) << 1) | ((kk & 8) >> 1), c = vt * 128 + (st & 3) * 32 + (lane & 3) * 8;
    Vsrc[q] = Pbase + voff + (size_t)k * LDP + c; }
#define B2DMA_K(t_, b_) do { const bf16* ks_ = Ksrc + (size_t)(t_) * KVBLK * LDP; const unsigned kd_ = (unsigned)__builtin_amdgcn_readfirstlane((int)(lbase + B2_K + (b_) * SHM_K + wid * 2048)); \
    glds16_asm(ks_, kd_); glds16_asm(ks_ + 4 * LDP + kx1, kd_ + 1024); } while (0)
#define B2DMA_V(t_, b_) do { _Pragma("unroll") for (int q = 0; q < 4; ++q) { const int ci_ = wid * 4 + q; \
      glds16_asm(Vsrc[q] + (size_t)(t_) * KVBLK * LDP, (unsigned)__builtin_amdgcn_readfirstlane((int)(lbase + B2_V + (b_) * 2 * SHM_V + (ci_ >> 4) * SHM_V + (ci_ & 15) * 1024))); } } while (0)
#define B2SYNC() do { asm volatile("s_waitcnt vmcnt(0)" ::: "memory"); __syncthreads(); } while (0)
  typedef __attribute__((address_space(3))) float lds_f32; typedef __attribute__((address_space(3))) int lds_i32;
  lds_f32* al_s = (lds_f32*)(uintptr_t)(lbase + B2_AL); lds_i32* fl_s = (lds_i32*)(uintptr_t)(lbase + B2_FL); lds_f32* li_s = (lds_f32*)(uintptr_t)(lbase + B2_LI);
  B2DMA_K(0, 0); B2DMA_V(0, 0); B2DMA_K(1, 1);
  if (wid < 4) {
    const float* tb = (const float*)(lds + B2_TB);
    const int chunk_w = 2 * q128 + (pw >> 1);
    const int ib0 = 4 * hi - 128 * q128 - 32 * pw - r32 + 127 + 256;
    float m_reg = -1e30f, l_reg = 0.f; bf16x8 qr[8];
    { const bf16* Qw = Qb + (long)(pw * QBLK + r32) * LDP + hi * 8;
#pragma unroll
      for (int d0 = 0; d0 < 8; ++d0) qr[d0] = *reinterpret_cast<const bf16x8*>(Qw + d0 * 16); }
    B2SYNC();
#define B2PROD(t_) do { f32x16 p0, p1; qkt(p0, p1, lds + B2_K + ((t_) & 1) * SHM_K, qr, r32, hi); \
      if ((t_) > chunk_w) { _Pragma("unroll") for (int r = 0; r < 16; ++r) { p0[r] = -1e30f; p1[r] = -1e30f; } } \
      else if ((t_) >= NT - 4) { const float* tbj = tb + (ib0 + 64 * (t_)); \
        _Pragma("unroll") for (int r = 0; r < 16; ++r) { p0[r] += tbj[(r & 3) + 8 * (r >> 2)]; p1[r] += tbj[32 + (r & 3) + 8 * (r >> 2)]; } } \
      float mn_, al_; partialSM(p0, p1, m_reg, mn_, al_); bf16x8 pa0, pa1, pa2, pa3; finishSM(p0, p1, al_, l_reg, pa0, pa1, pa2, pa3); \
      char* pb_ = lds + B2_P + ((((t_) & 1) * 4 + pw) * 4) * 1024 + lane * 16; \
      *(bf16x8*)(pb_) = pa0; *(bf16x8*)(pb_ + 1024) = pa1; *(bf16x8*)(pb_ + 2048) = pa2; *(bf16x8*)(pb_ + 3072) = pa3; \
      if (hi == 0) al_s[(((t_) & 1) * 4 + pw) * 32 + r32] = al_; \
      const int any_ = __any(al_ < 1.f) ? 1 : 0; if (lane == 0) fl_s[((t_) & 1) * 4 + pw] = any_; } while (0)
    B2PROD(0);
    B2SYNC();
    for (int j = 0; j < NT; ++j) {
      if (j + 2 < NT) B2DMA_K(j + 2, j & 1);
      if (j + 1 < NT) B2DMA_V(j + 1, (j + 1) & 1);
      if (j + 1 < NT && !(sel & 4)) B2PROD(j + 1);
      B2SYNC();
    }
    if (hi == 0) li_s[pw * 32 + r32] = __builtin_amdgcn_rcpf(l_reg);
    __syncthreads();
#undef B2PROD
  } else {
    f32x16 o[8] = {};
    const int vb0 = (int)(uintptr_t)(lds + B2_V) + v_rd_base(lane);
    B2SYNC();
    B2SYNC();
    for (int j = 0; j < NT; ++j) {
      if (j + 2 < NT) B2DMA_K(j + 2, j & 1);
      if (j + 1 < NT) B2DMA_V(j + 1, (j + 1) & 1);
      if (!(sel & 8)) { const int bsel = j & 1;
        if (fl_s[bsel * 4 + pw]) { const lds_f32* ap = al_s + (bsel * 4 + pw) * 32;
#pragma unroll
          for (int d = 0; d < 8; ++d)
#pragma unroll
            for (int r = 0; r < 16; ++r) o[d][r] *= ap[crow(r, hi)]; }
        const char* pb_ = lds + B2_P + ((bsel * 4 + pw) * 4) * 1024 + lane * 16;
        const bf16x8 pa0 = *(const bf16x8*)(pb_), pa1 = *(const bf16x8*)(pb_ + 1024), pa2 = *(const bf16x8*)(pb_ + 2048), pa3 = *(const bf16x8*)(pb_ + 3072);
        pv_d0(o, vb0 + bsel * 2 * SHM_V, pa0, pa1, pa2, pa3); pv_d0(o + 4, vb0 + bsel * 2 * SHM_V + SHM_V, pa0, pa1, pa2, pa3); }
      B2SYNC();
    }
    __syncthreads();
    float rli[16];
#pragma unroll
    for (int r = 0; r < 16; ++r) rli[r] = li_s[pw * 32 + crow(r, hi)];
    float* Ow = Ob + (long)(pw * QBLK) * LDO;
#pragma unroll
    for (int r = 0; r < 16; ++r) { const int orow = crow(r, hi);
#pragma unroll
      for (int d = 0; d < 8; ++d) Ow[(long)orow * LDO + d * 32 + r32] = o[d][r] * rli[r]; }
  }
  __syncthreads();
#undef B2DMA_K
#undef B2DMA_V
#undef B2SYNC
}

template <int LDP, int LDO>
__device__ __forceinline__ void attnA_unit(const bf16* __restrict__ Qb, const bf16* Pbase, int koff, int voff, bf16* __restrict__ Ob, int qb, char* lds) {
  const __amdgpu_buffer_rsrc_t rs = __builtin_amdgcn_make_buffer_rsrc(uniform_ptr(Pbase), 0, SEQ * LDP * 2, 0x00020000);
  int tid = threadIdx.x; asm volatile("" : "+v"(tid));
  const int wid = __builtin_amdgcn_readfirstlane(tid >> 6), lane = tid & 63, r32 = lane & 31, hi = lane >> 5;
  char* K_lds = lds + wid * 16384; char* V_lds = K_lds + 8192;
  f32x16 o[4] = {}; bf16x8 qr[8];
  const bf16* Qw = Qb + (long)(wid * QBLK + r32) * LDP + hi * 8;
#pragma unroll
  for (int d0 = 0; d0 < 8; ++d0) qr[d0] = *reinterpret_cast<const bf16x8*>(Qw + d0 * 16);
  const int srow = lane >> 1, scol = (lane & 1) * 64;
  const int vo = (srow * LDP + scol) * 2;
  const int vb0 = (int)(uintptr_t)V_lds + v_rd_base(lane);
  const int krow = lane >> 4, kch = lane & 15;
  const unsigned klds = (unsigned)__builtin_amdgcn_readfirstlane((int)(uintptr_t)K_lds);
  const bf16* Ksrc = Pbase + koff;
  float R = 0.f;
  const int htd = 8 * qb + wid;
  bf16x8 tv[8];
#define AKDMA(ht_) do { _Pragma("unroll") for (int j = 0; j < 8; ++j) { const int row_ = 4 * j + krow; \
      __builtin_amdgcn_global_load_lds((const unsigned*)(Ksrc + (size_t)((ht_) * 32 + row_) * LDP + ((kch ^ (row_ & 7)) << 3)), (__attribute__((address_space(3))) unsigned*)(uintptr_t)(klds + j * 1024), 16, 0, 0); } } while (0)
#define AVLOAD(ht_) do { const int sV_ = __builtin_amdgcn_readfirstlane((voff + (ht_) * 32 * LDP) * 2); _Pragma("unroll") for (int j = 0; j < 8; ++j) tv[j] = bload16(rs, vo + 16 * j, sV_); } while (0)
  AKDMA(htd); AVLOAD(htd);
  for (int ht = htd; ht >= 0; --ht) {
    asm volatile("s_waitcnt vmcnt(0)" ::: "memory");
#pragma unroll
    for (int j = 0; j < 8; ++j) *(bf16x8*)(V_lds + v_st(srow, scol + 8 * j)) = tv[j];
    if (ht > 0) AVLOAD(ht - 1);
    asm volatile("s_waitcnt lgkmcnt(0)" ::: "memory");
    f32x16 p0 = f32x16{};
#pragma unroll
    for (int d0 = 0; d0 < 8; ++d0) { const int cb = (d0 * 16 + hi * 8) * 2;
      const bf16x8 b0 = *reinterpret_cast<const bf16x8*>(K_lds + KSWZ(r32, cb));
      p0 = __builtin_amdgcn_mfma_f32_32x32x16_bf16(b0, qr[d0], p0, 0, 0, 0); }
    asm volatile("s_waitcnt lgkmcnt(0)" : "+v"(p0) :: "memory");
    if (ht > 0) AKDMA(ht - 1);
    const int lim = (ht == htd) ? r32 : 32;
    float qs[4], oq[4]; f32x16 Ln;
#pragma unroll
    for (int g = 0; g < 4; ++g) { float s_ = 0.f;
#pragma unroll
      for (int i = 0; i < 4; ++i) { const int r = 4 * g + i; const float x = p0[r] * SCALE; p0[r] = x;
        const float sp = __logf(1.f + __expf(-fabsf(x))); const float ln = (crow(r, hi) < lim) ? -(fmaxf(x, 0.f) + sp) : 0.f;
        Ln[r] = ln; s_ += ln; }
      qs[g] = s_; }
#pragma unroll
    for (int g = 0; g < 4; ++g) oq[g] = __shfl_xor(qs[g], 32);
    float run = 0.f;
#pragma unroll
    for (int g = 3; g >= 0; --g) { float E = R + run + (hi == 0 ? oq[g] : 0.f);
#pragma unroll
      for (int i = 3; i >= 0; --i) { const int r = 4 * g + i;
        const bool valid = crow(r, hi) < lim;
        const float w = valid ? __expf(Ln[r] + p0[r] + E) : 0.f; E += Ln[r]; p0[r] = w; }
      run += qs[g] + oq[g]; }
    R += run;
    bf16x8 pa0, pa1; PK4(p0, 0, pa0); PK4(p0, 8, pa1);
#define AV_ONE(D0) do { const s16x4 l0 = tr_read<v_rd_off(D0, 0, 0)>(vb0), h0 = tr_read<v_rd_off(D0, 0, 1)>(vb0), l1 = tr_read<v_rd_off(D0, 1, 0)>(vb0), h1 = tr_read<v_rd_off(D0, 1, 1)>(vb0); \
      asm volatile("s_waitcnt lgkmcnt(0)" ::: "memory"); SBAR(); \
      o[D0] = __builtin_amdgcn_mfma_f32_32x32x16_bf16(pa0, mk8a(l0, h0), o[D0], 0, 0, 0); o[D0] = __builtin_amdgcn_mfma_f32_32x32x16_bf16(pa1, mk8a(l1, h1), o[D0], 0, 0, 0); } while (0)
    AV_ONE(0); AV_ONE(1); AV_ONE(2); AV_ONE(3);
#undef AV_ONE
    if (__all(R < -104.f)) break;
  }
#undef AKDMA
#undef AVLOAD
  asm volatile("s_waitcnt vmcnt(0)" ::: "memory");
  bf16* Ow = Ob + (long)(wid * QBLK) * LDO;
#pragma unroll
  for (int r = 0; r < 16; ++r) { const int orow = crow(r, hi);
#pragma unroll
    for (int d0 = 0; d0 < 4; ++d0) Ow[(long)orow * LDO + d0 * 32 + r32] = (bf16)f2bf(o[d0][r]); }
  __syncthreads();
}
__device__ __forceinline__ bf16x8 mk8(s16x4 l, s16x4 h) { return (bf16x8){l[0], l[1], l[2], l[3], h[0], h[1], h[2], h[3]}; }
__device__ __forceinline__ v4u pack8(const float* f) { v4u w; w.x = cvtpk(f[0], f[1]); w.y = cvtpk(f[2], f[3]); w.z = cvtpk(f[4], f[5]); w.w = cvtpk(f[6], f[7]); return w; }
__device__ __forceinline__ void rot8(v4u lo4, v4u hi4, const float2* cs, float mul, float* ol, float* oh) {
#pragma unroll
  for (int q = 0; q < 4; ++q) { const float2 c0 = cs[2 * q], c1 = cs[2 * q + 1];
    const float l0 = bflo(lo4[q]), l1 = bfhi(lo4[q]), h0 = bflo(hi4[q]), h1 = bfhi(hi4[q]);
    ol[2 * q] = (l0 * c0.x - h0 * c0.y) * mul; ol[2 * q + 1] = (l1 * c1.x - h1 * c1.y) * mul;
    oh[2 * q] = (h0 * c0.x + l0 * c0.y) * mul; oh[2 * q + 1] = (h1 * c1.x + l1 * c1.y) * mul; }
}
template <int LDP>
__device__ __forceinline__ void ret_kv_unit(const bf16* __restrict__ P, const float2* __restrict__ ROPE, bf16* __restrict__ kvo, int b, int h, int n, char* lds) {
  int tid = threadIdx.x; asm volatile("" : "+v"(tid));
  const int wid = tid >> 6, lane = tid & 63, r32 = lane & 31, hi = lane >> 5;
  char* Vt = lds; char* Kt = lds + 2 * SHM_V;
  const size_t t0 = (size_t)b * SEQ + 64 * n;
  const float lg = __logf(1.f - exp2f(-5.f - (float)h));
  {
    bf16x8 vv[4];
#pragma unroll
    for (int it = 0; it < 4; ++it) { const int task = it * 512 + tid, vt = task >> 10, row = (task >> 4) & 63, sc = (task & 15) * 8;
      vv[it] = *reinterpret_cast<const bf16x8*>(P + (t0 + row) * LDP + 1024 + h * 256 + vt * 128 + sc); }
    const int m = tid >> 3, dc = (tid & 7) * 8; const bf16* kr = P + (t0 + m) * LDP + 512 + h * 128;
    const v4u lo4 = *(const v4u*)(kr + dc), hi4 = *(const v4u*)(kr + 64 + dc);
    float2 csv[8]; { const float2* cs = ROPE + (size_t)(64 * n + m) * 64 + dc;
#pragma unroll
      for (int q = 0; q < 8; ++q) csv[q] = cs[q]; }
#pragma unroll
    for (int it = 0; it < 4; ++it) { const int task = it * 512 + tid, vt = task >> 10, row = (task >> 4) & 63, sc = (task & 15) * 8;
      *(bf16x8*)(Vt + vt * SHM_V + v_st(row, sc)) = vv[it]; }
    float ol[8], oh[8]; rot8(lo4, hi4, csv, __expf(lg * (float)(63 - m)), ol, oh);
    *(v4u*)(Kt + v_st(m, dc)) = pack8(ol); *(v4u*)(Kt + v_st(m, 64 + dc)) = pack8(oh); }
  __syncthreads();
  const int vbA = (int)(uintptr_t)(Vt + (wid >> 2) * SHM_V) + v_rd_base(lane) + (wid & 3) * 512;
  const int vbB = (int)(uintptr_t)Kt + v_rd_base(lane);
  bf16x8 a[4];
  { const s16x4 l0 = tr_read<v_rd_off(0, 0, 0)>(vbA), h0 = tr_read<v_rd_off(0, 0, 1)>(vbA), l1 = tr_read<v_rd_off(0, 1, 0)>(vbA), h1 = tr_read<v_rd_off(0, 1, 1)>(vbA);
    const s16x4 l2 = tr_read<v_rd_off(0, 2, 0)>(vbA), h2 = tr_read<v_rd_off(0, 2, 1)>(vbA), l3 = tr_read<v_rd_off(0, 3, 0)>(vbA), h3 = tr_read<v_rd_off(0, 3, 1)>(vbA);
    asm volatile("s_waitcnt lgkmcnt(0)" ::: "memory"); SBAR();
    a[0] = mk8(l0, h0); a[1] = mk8(l1, h1); a[2] = mk8(l2, h2); a[3] = mk8(l3, h3); }
  f32x16 acc[4] = {};
  pv_one<0>(acc[0], vbB, a[0], a[1], a[2], a[3]); pv_one<1>(acc[1], vbB, a[0], a[1], a[2], a[3]); pv_one<2>(acc[2], vbB, a[0], a[1], a[2], a[3]); pv_one<3>(acc[3], vbB, a[0], a[1], a[2], a[3]);
#pragma unroll
  for (int db = 0; db < 4; ++db)
#pragma unroll
    for (int r = 0; r < 16; ++r) kvo[(size_t)(32 * wid + crow(r, hi)) * 128 + 32 * db + r32] = (bf16)f2bf(acc[db][r]);
  __syncthreads();
}
template <int LDP, int LDO>
__device__ __forceinline__ void ret_out_unit(const bf16* __restrict__ P, const float2* __restrict__ ROPE, const bf16* __restrict__ PREV, const float* __restrict__ rg, bf16* __restrict__ O, int b, int h, int np, char* lds) {
  int tid = threadIdx.x; asm volatile("" : "+v"(tid));
  const int wid = tid >> 6, lane = tid & 63, r32 = lane & 31, hi = lane >> 5;
  const int cw = wid >> 2, qh = (wid >> 1) & 1, eh = wid & 1, bh = b * 4 + h;
  constexpr int CH = 3 * SHM_V;
  float* red = (float*)(lds + 2 * CH);
  const float lg = __logf(1.f - exp2f(-5.f - (float)h));
  { v4u klo[2], khi[2]; float2 csv[2][8]; bf16x8 vv[2][4]; const int m = tid >> 3, dc = (tid & 7) * 8;
#pragma unroll
    for (int cc = 0; cc < 2; ++cc) { const int n = 2 * np + cc; const size_t t0 = (size_t)b * SEQ + 64 * n;
      const bf16* kr = P + (t0 + m) * LDP + 512 + h * 128; klo[cc] = *(const v4u*)(kr + dc); khi[cc] = *(const v4u*)(kr + 64 + dc);
      const float2* cs = ROPE + (size_t)(64 * n + m) * 64 + dc;
#pragma unroll
      for (int q = 0; q < 8; ++q) csv[cc][q] = cs[q];
#pragma unroll
      for (int it = 0; it < 4; ++it) { const int task = it * 512 + tid, vt = task >> 10, row = (task >> 4) & 63, sc = (task & 15) * 8;
        vv[cc][it] = *reinterpret_cast<const bf16x8*>(P + (t0 + row) * LDP + 1024 + h * 256 + vt * 128 + sc); } }
#pragma unroll
    for (int cc = 0; cc < 2; ++cc) { float ol[8], oh[8]; rot8(klo[cc], khi[cc], csv[cc], 1.f, ol, oh);
      *(v4u*)(lds + cc * CH + KSWZ(m, dc * 2)) = pack8(ol); *(v4u*)(lds + cc * CH + KSWZ(m, (64 + dc) * 2)) = pack8(oh);
#pragma unroll
      for (int it = 0; it < 4; ++it) { const int task = it * 512 + tid, vt = task >> 10, row = (task >> 4) & 63, sc = (task & 15) * 8;
        *(bf16x8*)(lds + cc * CH + SHM_V + vt * SHM_V + v_st(row, sc)) = vv[cc][it]; } } }
  const int n = 2 * np + cw; const size_t tq = (size_t)b * SEQ + 64 * n + 32 * qh + r32;
  bf16x8 qr[8];
  { const bf16* qrow = P + tq * LDP + h * 128 + hi * 8; const float2* cs = ROPE + (size_t)(64 * n + 32 * qh + r32) * 64 + hi * 8;
#pragma unroll
    for (int d0 = 0; d0 < 4; ++d0) { const v4u lo4 = *(const v4u*)(qrow + d0 * 16), hi4 = *(const v4u*)(qrow + 64 + d0 * 16);
      float ol[8], oh[8]; rot8(lo4, hi4, cs + d0 * 16, SCALE, ol, oh);
      const v4u wl = pack8(ol), wh = pack8(oh); qr[d0] = __builtin_bit_cast(bf16x8, wl); qr[d0 + 4] = __builtin_bit_cast(bf16x8, wh); } }
  f32x16 o[4] = {};
  { const bf16* pv = PREV + ((size_t)bh * 64 + n) * 32768 + (size_t)(128 * eh + r32) * 128 + hi * 8;
    bf16x8 bc[8], bn[8];
#pragma unroll
    for (int ks = 0; ks < 8; ++ks) bc[ks] = *reinterpret_cast<const bf16x8*>(pv + ks * 16);
#pragma unroll
    for (int d0 = 0; d0 < 4; ++d0) {
      if (d0 < 3) {
#pragma unroll
        for (int ks = 0; ks < 8; ++ks) bn[ks] = *reinterpret_cast<const bf16x8*>(pv + (size_t)(32 * (d0 + 1)) * 128 + ks * 16); }
      __builtin_amdgcn_sched_barrier(0);
#pragma unroll
      for (int ks = 0; ks < 8; ++ks) o[d0] = __builtin_amdgcn_mfma_f32_32x32x16_bf16(qr[ks], bc[ks], o[d0], 0, 0, 0);
      __builtin_amdgcn_sched_barrier(0);
      if (d0 < 3) {
#pragma unroll
        for (int ks = 0; ks < 8; ++ks) bc[ks] = bn[ks]; } } }
#pragma unroll
  for (int r = 0; r < 16; ++r) { const float qd = __expf(lg * (float)(32 * qh + crow(r, hi) + 1));
#pragma unroll
    for (int d0 = 0; d0 < 4; ++d0) o[d0][r] *= qd; }
  __syncthreads();
  { f32x16 p0, p1; qkt(p0, p1, lds + cw * CH, qr, r32, hi);
    const int c = 32 * qh + r32;
#pragma unroll
    for (int r = 0; r < 16; ++r) { const int m0 = crow(r, hi), m1 = m0 + 32; const int d0_ = c > m0 ? c - m0 : m0 - c, d1_ = c > m1 ? c - m1 : m1 - c;
      p0[r] *= __expf(lg * (float)d0_); p1[r] *= __expf(lg * (float)d1_); }
    bf16x8 pa0, pa1, pa2, pa3; packP(p0, p1, pa0, pa1, pa2, pa3);
    pv_d0(o, (int)(uintptr_t)(lds + cw * CH + SHM_V + eh * SHM_V) + v_rd_base(lane), pa0, pa1, pa2, pa3); }
  { float ssq[16];
#pragma unroll
    for (int r = 0; r < 16; ++r) { float s_ = (o[0][r] * o[0][r] + o[1][r] * o[1][r]) + (o[2][r] * o[2][r] + o[3][r] * o[3][r]);
      s_ += __shfl_xor(s_, 1); s_ += __shfl_xor(s_, 2); s_ += __shfl_xor(s_, 4); s_ += __shfl_xor(s_, 8); s_ += __shfl_xor(s_, 16); ssq[r] = s_; }
    if (r32 == 0) {
#pragma unroll
      for (int r = 0; r < 16; ++r) red[wid * 32 + crow(r, hi)] = ssq[r]; }
    __syncthreads();
    const size_t trow0 = (size_t)b * SEQ + 64 * n + 32 * qh;
    bf16 gv[16][4];
#pragma unroll
    for (int r = 0; r < 16; ++r)
#pragma unroll
      for (int d0 = 0; d0 < 4; ++d0) gv[r][d0] = P[(trow0 + crow(r, hi)) * LDP + 2048 + h * 256 + 128 * eh + 32 * d0 + r32];
#pragma unroll
    for (int r = 0; r < 16; ++r) { const int rl = crow(r, hi); const float tot = red[wid * 32 + rl] + red[(wid ^ 1) * 32 + rl]; const float rstd = rsqrtf(tot * (1.f / 256.f) + 1e-6f);
      const size_t row = trow0 + rl;
#pragma unroll
      for (int d0 = 0; d0 < 4; ++d0) { const int e = 128 * eh + 32 * d0 + r32;
        const float gate = silu_f(bf2f(gv[r][d0]));
        O[row * LDO + h * 256 + e] = (bf16)f2bf(o[d0][r] * rstd * rg[e] * gate); } } }
  __syncthreads();
}
template <int LDP, int LDO>
__device__ __forceinline__ void sgu_unit(const bf16* __restrict__ P, const unsigned long long* __restrict__ lnsum, const float* __restrict__ lng, const float* __restrict__ lnb, const float* __restrict__ Wg, const float* __restrict__ bs,
                                         bf16* __restrict__ O, size_t t0, int g, char* lds) {
  int tid = threadIdx.x; asm volatile("" : "+v"(tid));
  const int wid = tid >> 6, lane = tid & 63, r32 = lane & 31, hi = lane >> 5;
  { const int cc = (tid & 31) * 8;
    v4u vin[8]; unsigned long long s1v[8], s2v[8];
#pragma unroll
    for (int it = 0; it < 8; ++it) { const int j = it * 16 + (tid >> 5);
      vin[it] = *(const v4u*)(P + (t0 + j) * LDP + 4096 + g * 256 + cc); s1v[it] = lnsum[2 * (t0 + j)]; s2v[it] = lnsum[2 * (t0 + j) + 1]; }
    const f32x4 g0 = *(const f32x4*)(lng + g * 256 + cc), g1 = *(const f32x4*)(lng + g * 256 + cc + 4), b0 = *(const f32x4*)(lnb + g * 256 + cc), b1 = *(const f32x4*)(lnb + g * 256 + cc + 4);
#pragma unroll
    for (int it = 0; it < 8; ++it) { const int j = it * 16 + (tid >> 5); const v4u v4 = vin[it];
      const float s1 = (float)(long long)s1v[it] * (1.f / 16777216.f), s2 = (float)(long long)s2v[it] * (1.f / 16777216.f); const float mean = s1 * (1.f / 1024.f); const float rstd = rsqrtf(fmaxf(s2 * (1.f / 1024.f) - mean * mean, 0.f) + 1e-6f);
      float y[8];
#pragma unroll
      for (int q = 0; q < 4; ++q) { y[2 * q] = gelu_tanh(bflo(v4[q])); y[2 * q + 1] = gelu_tanh(bfhi(v4[q])); }
#pragma unroll
      for (int q = 0; q < 4; ++q) { y[q] = (y[q] - mean) * rstd * g0[q] + b0[q]; y[4 + q] = (y[4 + q] - mean) * rstd * g1[q] + b1[q]; }
      *(v4u*)(lds + ((j >> 6) * 2 + (cc >> 7)) * SHM_V + v_st(j & 63, cc & 127)) = pack8(y); } }
  const int ib = wid & 3, ct = wid >> 2;
  bf16x8 wa[8];
  { const float* wr = Wg + (size_t)(32 * ib + r32) * 128 + hi * 8;
#pragma unroll
    for (int ks = 0; ks < 8; ++ks) { if (ks < 4 || ib >= 2) { const f32x4 a0 = *(const f32x4*)(wr + ks * 16), a1 = *(const f32x4*)(wr + ks * 16 + 4);
        v4u w; w.x = cvtpk(a0[0], a0[1]); w.y = cvtpk(a0[2], a0[3]); w.z = cvtpk(a1[0], a1[1]); w.w = cvtpk(a1[2], a1[3]); wa[ks] = __builtin_bit_cast(bf16x8, w); }
      else wa[ks] = (bf16x8){0, 0, 0, 0, 0, 0, 0, 0}; } }
  __syncthreads();
  f32x16 o[4] = {};
  pv_d0(o, (int)(uintptr_t)(lds + (0 * 2 + ct) * SHM_V) + v_rd_base(lane), wa[0], wa[1], wa[2], wa[3]);
  if (ib >= 2) pv_d0(o, (int)(uintptr_t)(lds + (1 * 2 + ct) * SHM_V) + v_rd_base(lane), wa[4], wa[5], wa[6], wa[7]);
  { bf16 uv[16][4];
#pragma unroll
    for (int r = 0; r < 16; ++r)
#pragma unroll
      for (int d0 = 0; d0 < 4; ++d0) uv[r][d0] = P[(t0 + 32 * ib + crow(r, hi)) * LDP + 3072 + g * 256 + 128 * ct + 32 * d0 + r32];
#pragma unroll
    for (int r = 0; r < 16; ++r) { const int i = 32 * ib + crow(r, hi); const float bi = bs[i]; const size_t row = t0 + i;
#pragma unroll
      for (int d0 = 0; d0 < 4; ++d0) { const int c = 128 * ct + 32 * d0 + r32;
        const float uu = gelu_tanh(bf2f(uv[r][d0]));
        O[row * LDO + 1024 + g * 256 + c] = (bf16)f2bf(uu * (o[d0][r] + bi)); } } }
  __syncthreads();
}
#undef SBAR
}

__device__ __forceinline__ f32x4 mma16(bf16x8 a, bf16x8 b, f32x4 c) { return __builtin_amdgcn_mfma_f32_16x16x32_bf16(a, b, c, 0, 0, 0); }

struct Args { const float* in[20]; float* out; unsigned char* ws; int ph_lo, ph_hi, sel, li; };

constexpr int N_PHASES = 17;

__global__ void __launch_bounds__(NWAVES * 64, 2) mega_fwd(Args args) {
    extern __shared__ __attribute__((aligned(16))) unsigned char lds[];
    LAS unsigned char* ldsl = (LAS unsigned char*)lds;
    const int G = gridDim.x; const int bx = blockIdx.x;
    const int vcu = (G % 8 == 0) ? (bx % 8) * (G / 8) + bx / 8 : bx;
#define PHASE_ENV() \
    const __attribute__((address_space(4))) Args* ap_ = (const __attribute__((address_space(4))) Args*)__builtin_amdgcn_kernarg_segment_ptr(); asm volatile("" : "+s"(ap_)); \
    int tid = threadIdx.x; asm volatile("" : "+v"(tid)); const int lane = tid & 63, wave = __builtin_amdgcn_readfirstlane(tid >> 6); (void)lane; \
    unsigned char* const ws = ap_->ws; const int gw = vcu * NWAVES + wave, NGW = G * NWAVES; const int gt = vcu * (NWAVES * 64) + tid, NGT = G * NWAVES * 64; \
    const float* const x_in = ap_->in[0]; \
    bf16* const W_ABIN = (bf16*)(ws + WS_W_ABIN); bf16* const W_ABOUT = (bf16*)(ws + WS_W_ABOUT); bf16* const W_CDIN = (bf16*)(ws + WS_W_CDIN); bf16* const W_CDOUT = (bf16*)(ws + WS_W_CDOUT); \
    bf16* const W_UP0 = (bf16*)(ws + WS_W_UP0); bf16* const W_UP1 = (bf16*)(ws + WS_W_UP1); bf16* const W_DN0 = (bf16*)(ws + WS_W_DN0); bf16* const W_DN1 = (bf16*)(ws + WS_W_DN1); \
    bf16* const XN = (bf16*)(ws + WS_XN); bf16* const OB16 = (bf16*)(ws + WS_O); float* const X = (float*)(ws + WS_X); bf16* const ACT = (bf16*)(ws + WS_ACT); \
    bf16* const P = (bf16*)(ws + WS_P); float* const OBF = (float*)(ws + WS_OB); bf16* const KV = (bf16*)(ws + WS_KV); bf16* const PREV = (bf16*)(ws + WS_PREV); bf16* const UP = (bf16*)(ws + WS_UP); \
    unsigned long long* const SS = (unsigned long long*)(ws + WS_SS); (void)SS; unsigned long long* const LNS = (unsigned long long*)(ws + WS_LNS); (void)LNS; bf16* const HALO = (bf16*)(ws + WS_HALO); (void)HALO; bf16* const SCR = (bf16*)(ws + WS_SCR); (void)SCR; float* const SCAL = (float*)(ws + WS_SCAL); float2* const ROPE = (float2*)(ws + WS_ROPE); \
    (void)gw; (void)NGW; (void)gt; (void)NGT; (void)x_in; (void)W_ABIN; (void)W_ABOUT; (void)W_CDIN; (void)W_CDOUT; (void)W_UP0; (void)W_UP1; (void)W_DN0; (void)W_DN1; (void)XN; (void)OB16; (void)X; (void)ACT; (void)P; (void)OBF; (void)KV; (void)PREV; (void)UP; (void)SCAL; (void)ROPE;
#define AIN(k) (ap_->in[k])

#if !MK_PER_PHASE
    for (int u = threadIdx.x; u < (LDS_BYTES - LDSCTL_OFF) / 4; u += NWAVES * 64) ((LAS unsigned*)(ldsl + LDSCTL_OFF))[u] = 0u;
    __syncthreads();
    XcdBarrier bar = xcd_barrier_post((unsigned*)(args.ws + WS_CTL) + 4096 + args.li * XCD_BAR_WORDS, (volatile LAS unsigned*)(ldsl + MISC_OFF) + 8);
#define GRID_BAR() xcd_barrier(bar)
#else
#define GRID_BAR() do {} while (0)
#endif
    const int lo = args.ph_lo, hi_ph = args.ph_hi;
#ifndef PH_MASK
#define PH_MASK 0xFFFFFFu
#endif
#define IN(k) (((PH_MASK >> (k)) & 1u) && lo <= (k) && (k) < hi_ph)
#define SEAM(k) do { if (IN(k) && IN((k) + 1)) GRID_BAR(); } while (0)
#ifndef REPEAT_MASK
#define REPEAT_MASK 0u
#endif
#define NREP(k) (((REPEAT_MASK >> (k)) & 1u) ? 2 : 1)

#define RAW_TO_XN(SRC, SSP) do { \
        for (int m = gw; m < MTOK; m += NGW) { const GAS f32x4* xr = (const GAS f32x4*)((SRC) + (size_t)m * DM) + lane; f32x4 v[8]; float s = 0.f; \
            _Pragma("unroll") for (int j = 0; j < 8; ++j) { v[j] = xr[64 * j]; s += (v[j].x * v[j].x + v[j].y * v[j].y) + (v[j].z * v[j].z + v[j].w * v[j].w); } \
            s = wave_sum(s); if (lane == 0) (SSP)[m] = (unsigned long long)(s * 16777216.f); \
            GAS v2u* o8 = (GAS v2u*)(XN + (size_t)m * DM) + lane; \
            _Pragma("unroll") for (int j = 0; j < 8; ++j) { v2u w; w.x = pk2(v[j].x, v[j].y); w.y = pk2(v[j].z, v[j].w); o8[64 * j] = w; } } } while (0)

#ifndef CT_P5
#define CT_P5 4300
#endif
    constexpr int CT_ABIN = 32 * (AB_IN / 64), CT_SQ = 32 * (DM / 64), CT_CDIN = 32 * (CD_IN / 64), CT_UP = 32 * (DFF2 / 64), CT_DN = (DFF / 64) * (DM / 64);
    constexpr int CT_L0 = CT_ABIN + CT_SQ + CT_UP + CT_DN, CT_ALL = CT_L0 + CT_CDIN + CT_SQ + CT_UP + CT_DN, CT_S1 = CT_L0 + CT_P5, CT_S2 = CT_ALL - CT_DN;
#define CONVERT_TILES(FIRST, LAST, W_ID, N_W) do { \
        LAS unsigned* T = (LAS unsigned*)(ldsl + wave * 9216); \
        const int rp = lane >> 4, cq = lane & 15; \
        struct TileRef { const float* src; bf16* dst; const float* gk; int K, N, perm; }; \
        auto tile_ref = [&](int it, TileRef& t) -> int { \
            int r = it; \
            if (r < CT_ABIN) { t = TileRef{AIN(5), W_ABIN, AIN(1), DM, AB_IN, 0}; return r; } r -= CT_ABIN; \
            if (r < CT_SQ) { t = TileRef{AIN(6), W_ABOUT, nullptr, DM, DM, 0}; return r; } r -= CT_SQ; \
            if (r < CT_UP) { t = TileRef{AIN(16), W_UP0, AIN(2), DM, DFF2, 1}; return r; } r -= CT_UP; \
            if (r < CT_DN) { t = TileRef{AIN(19), W_DN0, nullptr, DFF, DM, 0}; return r; } r -= CT_DN; \
            if (r < CT_CDIN) { t = TileRef{AIN(9), W_CDIN, AIN(1) + DM, DM, CD_IN, 0}; return r; } r -= CT_CDIN; \
            if (r < CT_SQ) { t = TileRef{AIN(10), W_CDOUT, nullptr, DM, DM, 0}; return r; } r -= CT_SQ; \
            if (r < CT_UP) { t = TileRef{AIN(16) + (size_t)DM * DFF2, W_UP1, AIN(2) + DM, DM, DFF2, 1}; return r; } r -= CT_UP; \
            t = TileRef{AIN(19) + (size_t)DFF * DM, W_DN1, nullptr, DFF, DM, 0}; return r; \
        }; \
        f32x4 va[8], vb[8]; float ga[8], gb[8]; \
        auto tile_load = [&](int it) { \
            TileRef t; const int r = tile_ref(it, t); const int nblk = t.N / 64, kb = r / nblk, nb = r % nblk; \
            const float* p = t.src + (size_t)(kb * 64 + 2 * rp) * t.N + nb * 64 + 4 * cq; \
            _Pragma("unroll") \
            for (int i = 0; i < 8; ++i) { va[i] = __builtin_nontemporal_load((const f32x4*)(p + (size_t)(8 * i) * t.N)); vb[i] = __builtin_nontemporal_load((const f32x4*)(p + (size_t)(8 * i + 1) * t.N)); \
                ga[i] = t.gk ? t.gk[kb * 64 + 8 * i + 2 * rp] : 1.f; gb[i] = t.gk ? t.gk[kb * 64 + 8 * i + 2 * rp + 1] : 1.f; } \
        }; \
        const int ct_last = (LAST), ct_step = (N_W); \
        int it = (FIRST) + (W_ID); \
        if (it < ct_last) tile_load(it); \
        while (it < ct_last) { \
            _Pragma("unroll") \
            for (int i = 0; i < 8; ++i) { \
                _Pragma("unroll") \
                for (int j = 0; j < 4; ++j) T[(4 * cq + j) * 36 + 4 * i + rp] = pk2(va[i][j] * ga[i], vb[i][j] * gb[i]); } \
            TileRef t; const int r = tile_ref(it, t); const int nblk = t.N / 64, kb = r / nblk, nb = r % nblk; \
            const int n0_ = nb * 64; const int drow0 = !t.perm ? n0_ : (n0_ < DFF ? (n0_ >> 7) * 256 + (n0_ & 127) : ((n0_ - DFF) >> 7) * 256 + 128 + ((n0_ - DFF) & 127)); \
            const int nxt = it + ct_step; \
            if (nxt < ct_last) tile_load(nxt); \
            LDS_WAIT(); asm volatile("" ::: "memory"); \
            _Pragma("unroll") \
            for (int o = 0; o < 8; ++o) { const int idx = o * 64 + lane, n = idx >> 3, c = idx & 7; \
                const v4u w = *(const LAS v4u*)(T + n * 36 + 4 * c); \
                *(GAS v4u*)(t.dst + (size_t)(drow0 + n) * t.K + kb * 64 + 8 * c) = w; } \
            LDS_WAIT(); asm volatile("" ::: "memory"); \
            it = nxt; \
        } \
    } while (0)

    for (int rep_ = 0; rep_ < NREP(0); ++rep_) if (IN(0)) { if (rep_) GRID_BAR(); PHASE_ENV();
        if (G == 256) { CONVERT_TILES(0, CT_L0, gw, NGW); } else { CONVERT_TILES(0, CT_ALL, gw, NGW); }
        for (int e = gt; e < SEQ * 64; e += NGT) { const int pos = e >> 6, i = e & 63;
            double f = 1.0; for (int k = 0; k < i; ++k) f *= 0.8659643233600653;
            const float ang = (float)pos * (float)f;
            double rev = (double)ang * 0.15915494309189535; rev -= floor(rev);
            const float rv = (float)rev;
            ROPE[e] = make_float2(__builtin_amdgcn_cosf(rv), __builtin_amdgcn_sinf(rv)); }
        if (vcu == 0 && wave == 0) { const float* lv = AIN(7);
            float a = lv[lane] * lv[128 + lane] + lv[64 + lane] * lv[192 + lane]; float b = lv[256 + lane] * lv[384 + lane] + lv[320 + lane] * lv[448 + lane];
            a = wave_sum(a); b = wave_sum(b);
            if (lane == 0) SCAL[0] = expf(a) - expf(b) + 0.2f; }
        RAW_TO_XN(x_in, SS);
    }
    SEAM(0);

    for (int rep_ = 0; rep_ < NREP(1); ++rep_) if (IN(1)) { if (rep_) GRID_BAR(); PHASE_ENV(); pg8::Gemm g{XN, W_ABIN, MTOK, AB_IN, DM}; pg8::StaticOrder S; S.init(MTOK, AB_IN, G, bx);
        pg8::EpiBf16 E{P, AB_IN, SS, nullptr, 0, 0}; pg8::gemm_phase<pg8::EpiBf16, pg8::StaticOrder, true, true>(ldsl, g, S, E, tid); }
    SEAM(1);

    for (int rep_ = 0; rep_ < NREP(2); ++rep_) if (IN(2)) { if (rep_) GRID_BAR(); PHASE_ENV();
#ifndef NO_B
        if (!(ap_->sel & 1)) { const int bh = vcu >> 5, comp = (vcu >> 4) & 1, s = vcu & 15, b = bh >> 2, h = bh & 3;
          float* tb = (float*)(lds + att::B2_TB);
          if (tid < 448) { const int rel = tid - 256 - 127, n = rel < 0 ? -rel : rel; int bucket = (n < 8) ? n : 8 + (31 - __clz((n * n) >> 6)); if (n >= 8 && bucket > 15) bucket = 15; if (rel > 0) bucket += 16;
              const float* rb = AIN(4); tb[tid] = (rel >= -127 && rel <= 63) ? (rb[bucket * 4 + h] - rb[15 * 4 + h]) * (1.f / att::SCALE) : 0.f; }
          __syncthreads();
          const bf16* Pb = P + (size_t)b * SEQ * AB_IN;
          for (int i = 0; i < 2; ++i) { const int q128 = i ? 31 - s : s;
              att::attnB2_unit<AB_IN, 1024>(Pb + (size_t)(128 * q128) * AB_IN + 3072 + h * 256 + comp * 128, Pb, 4096 + h * 256 + comp * 128, 5120 + h * 256,
                                            OBF + (size_t)comp * MTOK * 1024 + (size_t)(b * SEQ + 128 * q128) * 1024 + h * 256, q128, (char*)lds, ap_->sel); } }
#endif
#ifndef NO_A
#ifndef NREP_A
#define NREP_A 1
#endif
        for (int ra_ = 0; ra_ < NREP_A; ++ra_) if (!(ap_->sel & 2))
        { const int bh = vcu >> 4, qb = vcu & 15, b = bh >> 3, h = bh & 7;
          const bf16* Pb = P + (size_t)b * SEQ * AB_IN;
          att::attnA_unit<AB_IN, DM>(Pb + (size_t)(256 * qb) * AB_IN + h * 128, Pb, 1024 + h * 128, 2048 + h * 128, OB16 + (size_t)(b * SEQ + 256 * qb) * DM + h * 128, qb, (char*)lds); }
#endif
    }
    SEAM(2);

    for (int rep_ = 0; rep_ < NREP(3); ++rep_) if (IN(3)) { if (rep_) GRID_BAR(); PHASE_ENV();
        const float lam = SCAL[0]; const float* sg = AIN(8);
        f32x4 g4[4];
#pragma unroll
        for (int q = 0; q < 4; ++q) g4[q] = *(const f32x4*)(sg + (lane & 15) * 16 + q * 4);
        for (int row0 = gw * 2; row0 < MTOK; row0 += NGW * 2) { f32x4 a[2][4], c[2][4];
#pragma unroll
            for (int rr = 0; rr < 2; ++rr)
#pragma unroll
                for (int q = 0; q < 4; ++q) { a[rr][q] = *(const f32x4*)(OBF + (size_t)(row0 + rr) * 1024 + lane * 16 + q * 4); c[rr][q] = *(const f32x4*)(OBF + (size_t)MTOK * 1024 + (size_t)(row0 + rr) * 1024 + lane * 16 + q * 4); }
#pragma unroll
            for (int rr = 0; rr < 2; ++rr) { float ss = 0.f;
#pragma unroll
                for (int q = 0; q < 4; ++q) { a[rr][q] = a[rr][q] - lam * c[rr][q]; ss += (a[rr][q].x * a[rr][q].x + a[rr][q].y * a[rr][q].y) + (a[rr][q].z * a[rr][q].z + a[rr][q].w * a[rr][q].w); }
                ss += __shfl_xor(ss, 1); ss += __shfl_xor(ss, 2); ss += __shfl_xor(ss, 4); ss += __shfl_xor(ss, 8);
                const float rs = rsqrtf(ss * (1.f / 256.f) + EPS) * 0.8f;
                v4u w0, w1;
                w0.x = pk2(a[rr][0].x * rs * g4[0].x, a[rr][0].y * rs * g4[0].y); w0.y = pk2(a[rr][0].z * rs * g4[0].z, a[rr][0].w * rs * g4[0].w);
                w0.z = pk2(a[rr][1].x * rs * g4[1].x, a[rr][1].y * rs * g4[1].y); w0.w = pk2(a[rr][1].z * rs * g4[1].z, a[rr][1].w * rs * g4[1].w);
                w1.x = pk2(a[rr][2].x * rs * g4[2].x, a[rr][2].y * rs * g4[2].y); w1.y = pk2(a[rr][2].z * rs * g4[2].z, a[rr][2].w * rs * g4[2].w);
                w1.z = pk2(a[rr][3].x * rs * g4[3].x, a[rr][3].y * rs * g4[3].y); w1.w = pk2(a[rr][3].z * rs * g4[3].z, a[rr][3].w * rs * g4[3].w);
                bf16* op = OB16 + (size_t)(row0 + rr) * DM + 1024 + lane * 16; *(v4u*)op = w0; *(v4u*)(op + 8) = w1; } }
    }
    SEAM(3);

    for (int rep_ = 0; rep_ < NREP(4); ++rep_) if (IN(4)) { if (rep_) GRID_BAR(); PHASE_ENV(); pg8::Gemm g{OB16, W_ABOUT, MTOK, DM, DM}; pg8::StaticOrder S; S.init(MTOK, DM, G, bx);
        pg8::EpiRes E{nullptr, XN, DM, SS + 1 * MTOK}; pg8::gemm_phase<pg8::EpiRes, pg8::StaticOrder, false, true>(ldsl, g, S, E, tid); }
    SEAM(4);

#define FFN_PHASES(PB, WUP, WDN, L, SSIN, SSOUT) \
    for (int rep_ = 0; rep_ < NREP(PB); ++rep_) if (IN(PB)) { if (rep_) GRID_BAR(); PHASE_ENV(); pg8::Gemm g{XN, WUP, MTOK, DFF2, DM}; pg8::StaticOrder S; S.init(MTOK, DFF2, G, bx); \
        pg8::EpiConv E{ACT, SS + (SSIN) * MTOK, AIN(17) + (size_t)(L) * 3 * DFF2, AIN(18) + (size_t)(L) * DFF2, HALO, ldsl}; \
        pg8::gemm_phase<pg8::EpiConv, pg8::StaticOrder, true, true>(ldsl, g, S, E, tid); \
        if (G == 256 && bx >= 128) { if ((PB) == 5) { CONVERT_TILES(CT_L0, CT_S1, (bx - 128) * NWAVES + wave, 128 * NWAVES); } else { CONVERT_TILES(CT_S2, CT_ALL, (bx - 128) * NWAVES + wave, 128 * NWAVES); } } } \
    SEAM(PB); \
    for (int rep_ = 0; rep_ < NREP(PB + 1); ++rep_) if (IN(PB + 1)) { if (rep_) GRID_BAR(); PHASE_ENV(); conv_fix(HALO, ACT, AIN(17) + (size_t)(L) * 3 * DFF2, AIN(18) + (size_t)(L) * DFF2, gt, NGT); } \
    SEAM(PB + 1); \
    for (int rep_ = 0; rep_ < NREP(PB + 2); ++rep_) if (IN(PB + 2)) { if (rep_) GRID_BAR(); PHASE_ENV(); pg8::Gemm g{ACT, WDN, MTOK, DM, DFF}; pg8::StaticOrder S; S.init(MTOK, DM, G, bx); \
        if ((L) == 1 && G == 256) { pg8::EpiFinal E{XN, DM, SS + (SSOUT) * MTOK, (unsigned*)(ws + WS_CNT), AIN(3), ap_->out}; pg8::gemm_phase<pg8::EpiFinal, pg8::StaticOrder, false, true>(ldsl, g, S, E, tid); } \
        else { pg8::EpiRes E{nullptr, XN, DM, SS + (SSOUT) * MTOK}; pg8::gemm_phase<pg8::EpiRes, pg8::StaticOrder, false, true>(ldsl, g, S, E, tid); } } \
    SEAM(PB + 2);

    auto conv_fix = [&](const bf16* halo, bf16* act, const float* cw, const float* cb, int gt_, int ngt_) {
        constexpr int NCH = DFF / 8;
        for (int task = gt_; task < NCH * 64; task += ngt_) { const int ch = task % NCH, rr = (task / NCH) & 1, pm = task / (2 * NCH), n0 = ch * 8;
            const int pca = (n0 >> 7) * 256 + (n0 & 127); const bool first = (pm & 15) == 0;
            const bf16* H = halo + (size_t)pm * 4 * DFF2; const bf16* Hp = H - (size_t)4 * DFF2;
            float cv[2][8];
#pragma unroll
            for (int bj = 0; bj < 2; ++bj) { const int pc = pca + bj * 128, cc = bj * DFF + n0; const v4u z = {0u, 0u, 0u, 0u};
                const v4u c0 = *(const v4u*)(H + pc), c1 = *(const v4u*)(H + DFF2 + pc);
                const v4u q254 = first ? z : *(const v4u*)(Hp + 2 * DFF2 + pc), q255 = first ? z : *(const v4u*)(Hp + 3 * DFF2 + pc);
                const v4u x2 = rr == 0 ? q254 : q255, x1 = rr == 0 ? q255 : c0, x0 = rr == 0 ? c0 : c1;
#pragma unroll
                for (int q = 0; q < 4; ++q) {
                    cv[bj][2 * q] = cb[cc + 2 * q] + cw[cc + 2 * q] * bflo(x2[q]) + cw[DFF2 + cc + 2 * q] * bflo(x1[q]) + cw[2 * DFF2 + cc + 2 * q] * bflo(x0[q]);
                    cv[bj][2 * q + 1] = cb[cc + 2 * q + 1] + cw[cc + 2 * q + 1] * bfhi(x2[q]) + cw[DFF2 + cc + 2 * q + 1] * bfhi(x1[q]) + cw[2 * DFF2 + cc + 2 * q + 1] * bfhi(x0[q]); } }
            float o[8];
#pragma unroll
            for (int q = 0; q < 8; ++q) o[q] = silu_f(cv[1][q]) * cv[0][q];
            v4u w; w.x = pk2(o[0], o[1]); w.y = pk2(o[2], o[3]); w.z = pk2(o[4], o[5]); w.w = pk2(o[6], o[7]);
            *(v4u*)(act + (size_t)(pm * 256 + rr) * DFF + n0) = w; }
    };

    FFN_PHASES(5, W_UP0, W_DN0, 0, 1, 2)

    for (int rep_ = 0; rep_ < NREP(8); ++rep_) if (IN(8)) { if (rep_) GRID_BAR(); PHASE_ENV(); pg8::Gemm g{XN, W_CDIN, MTOK, CD_IN, DM}; pg8::StaticOrder S; S.init(MTOK, CD_IN, G, bx);
        pg8::EpiBf16 E{P, CD_IN, SS + 2 * MTOK, LNS, 16, 20}; pg8::gemm_phase<pg8::EpiBf16, pg8::StaticOrder, true, true>(ldsl, g, S, E, tid);
        if (G == 256 && bx >= 128) { CONVERT_TILES(CT_S1, CT_S2, (bx - 128) * NWAVES + wave, 128 * NWAVES); } }
    SEAM(8);

    for (int rep_ = 0; rep_ < NREP(9); ++rep_) if (IN(9)) { if (rep_) GRID_BAR(); PHASE_ENV();
        for (int u = vcu; u < 8 * 64; u += G) { const int bh = u >> 6, n = u & 63;
            att::ret_kv_unit<CD_IN>(P, ROPE, KV + ((size_t)bh * 64 + n) * 32768, bh >> 2, bh & 3, n, (char*)lds); }
        for (int u = vcu; u < 256; u += G) { const int g = u & 3, nbk = (u >> 2) & 31, b = u >> 7;
            att::sgu_unit<CD_IN, DM>(P, LNS, AIN(12), AIN(13), AIN(14) + (size_t)g * 128 * 128, AIN(15) + g * 128, OB16, (size_t)b * SEQ + 128 * nbk, g, (char*)lds); }
    }
    SEAM(9);

    for (int rep_ = 0; rep_ < NREP(10); ++rep_) if (IN(10)) { if (rep_) GRID_BAR(); PHASE_ENV();
        if (wave < 4) for (int e4 = (vcu * 4 + wave) * 64 + lane; e4 < 8 * 256 * 128 / 4; e4 += G * 4 * 64) { const int e = e4 * 4; const int bh = e >> 15, h = bh & 3; const int r = e & 32767;
            const float g64 = __expf(64.f * __logf(1.f - exp2f(-5.f - (float)h)));
            const bf16* src = KV + (size_t)bh * 64 * 32768 + r; bf16* dst = PREV + (size_t)bh * 64 * 32768 + r; float st[4] = {0.f, 0.f, 0.f, 0.f};
#pragma unroll 16
            for (int n = 0; n < 64; ++n) { const v2u kv = *(const v2u*)(src + (size_t)n * 32768);
                v2u w; w.x = pk2(st[0], st[1]); w.y = pk2(st[2], st[3]); *(v2u*)(dst + (size_t)n * 32768) = w;
                st[0] = g64 * st[0] + bflo(kv.x); st[1] = g64 * st[1] + bfhi(kv.x); st[2] = g64 * st[2] + bflo(kv.y); st[3] = g64 * st[3] + bfhi(kv.y); } }
    }
    SEAM(10);

    for (int rep_ = 0; rep_ < NREP(11); ++rep_) if (IN(11)) { if (rep_) GRID_BAR(); PHASE_ENV();
        for (int u = vcu; u < 256; u += G) { const int bh = u >> 5, np = u & 31;
            att::ret_out_unit<CD_IN, DM>(P, ROPE, PREV, AIN(11), OB16, bh >> 2, bh & 3, np, (char*)lds); }
    }
    SEAM(11);

    for (int rep_ = 0; rep_ < NREP(12); ++rep_) if (IN(12)) { if (rep_) GRID_BAR(); PHASE_ENV(); pg8::Gemm g{OB16, W_CDOUT, MTOK, DM, DM}; pg8::StaticOrder S; S.init(MTOK, DM, G, bx);
        pg8::EpiRes E{nullptr, XN, DM, SS + 3 * MTOK}; pg8::gemm_phase<pg8::EpiRes, pg8::StaticOrder, false, true>(ldsl, g, S, E, tid); }
    SEAM(12);

    FFN_PHASES(13, W_UP1, W_DN1, 1, 3, 4)

    for (int rep_ = 0; rep_ < NREP(16); ++rep_) if (IN(16) && G != 256) { if (rep_) GRID_BAR(); PHASE_ENV(); const float* fg = AIN(3); const unsigned long long* ss4 = SS + 4 * MTOK;
        for (int m0 = gw * 4; m0 < MTOK; m0 += NGW * 4) { v4u v[4][4]; float rstd[4];
#pragma unroll
            for (int rr = 0; rr < 4; ++rr) { const GAS v4u* xr = (const GAS v4u*)(XN + (size_t)(m0 + rr) * DM) + lane;
#pragma unroll
                for (int j = 0; j < 4; ++j) v[rr][j] = xr[64 * j];
                rstd[rr] = rsqrtf((float)ss4[m0 + rr] * (1.f / 16777216.f / DM) + EPS); }
#pragma unroll
            for (int rr = 0; rr < 4; ++rr) { float* orow = ap_->out + (size_t)(m0 + rr) * DM;
#pragma unroll
                for (int j = 0; j < 4; ++j) { const int c0 = (64 * j + lane) * 8; const f32x4 g0 = *(const f32x4*)(fg + c0), g1 = *(const f32x4*)(fg + c0 + 4); const float r_ = rstd[rr];
                    const f32x4 o0 = {bflo(v[rr][j].x) * r_ * g0.x, bfhi(v[rr][j].x) * r_ * g0.y, bflo(v[rr][j].y) * r_ * g0.z, bfhi(v[rr][j].y) * r_ * g0.w};
                    const f32x4 o1 = {bflo(v[rr][j].z) * r_ * g1.x, bfhi(v[rr][j].z) * r_ * g1.y, bflo(v[rr][j].w) * r_ * g1.z, bfhi(v[rr][j].w) * r_ * g1.w};
                    *(GAS f32x4*)(orow + c0) = o0; *(GAS f32x4*)(orow + c0 + 4) = o1; } } }
    }
#undef IN
#undef SEAM
}

extern "C" void kernel_launch(void* const* d_in, const int* in_sizes, int n_in, void* d_out, int out_size, void* d_ws, size_t ws_size, hipStream_t stream) {
    static int grid = 0;
    if (grid == 0) {
        if (n_in != 20 || in_sizes[0] != MTOK * DM || out_size != MTOK * DM || ws_size < WS_END) {
            fprintf(stderr, "kernel_launch: unexpected shapes: n_in %d in0 %d out %d ws %zu (need >= %zu)\n", n_in, n_in > 0 ? in_sizes[0] : -1, out_size, ws_size, (size_t)WS_END); grid = -1; return; }
        int dev = 0, cus = 0;
        if (hipGetDevice(&dev) != hipSuccess || hipDeviceGetAttribute(&cus, hipDeviceAttributeMultiprocessorCount, dev) != hipSuccess) { grid = -1; return; }
        if (hipFuncSetAttribute((const void*)mega_fwd, hipFuncAttributeMaxDynamicSharedMemorySize, LDS_BYTES) != hipSuccess) { fprintf(stderr, "kernel_launch: hipFuncSetAttribute failed\n"); grid = -1; return; }
        int per_cu = 0;
        if (hipOccupancyMaxActiveBlocksPerMultiprocessor(&per_cu, (const void*)mega_fwd, NWAVES * 64, LDS_BYTES) != hipSuccess || per_cu < 1) { fprintf(stderr, "kernel_launch: occupancy query says %d blocks per CU\n", per_cu); }
        (void)hipGetLastError();
        grid = cus;
    }
    if (grid < 0) return;
    hipMemsetAsync((char*)d_ws + WS_CTL, 0, CTL_ZERO_BYTES, stream);
    Args a{};
    for (int i = 0; i < 20; ++i) a.in[i] = (const float*)d_in[i];
    a.out = (float*)d_out; a.ws = (unsigned char*)d_ws;
#if MK_PER_PHASE
    for (int p = 0; p < N_PHASES; ++p) { a.ph_lo = p; a.ph_hi = p + 1; hipLaunchKernelGGL(mega_fwd, dim3(grid), dim3(NWAVES * 64), LDS_BYTES, stream, a); }
#else
    a.ph_lo = 0; a.ph_hi = (grid == 256) ? N_PHASES - 1 : N_PHASES; hipLaunchKernelGGL         (mega_fwd, dim3(grid), dim3(NWAVES * 64), LDS_BYTES, stream, a);
#if PROBE_PHASE >= 0
    a.ph_lo = PROBE_PHASE; a.ph_hi = PROBE_PHASE + PROBE_NPH; a.sel = PROBE_SEL; a.li = 1; hipLaunchKernelGGL(mega_fwd, dim3(grid), dim3(NWAVES * 64), LDS_BYTES, stream, a);
#endif
#endif
    const hipError_t le = hipPeekAtLastError();
    if (le != hipSuccess) fprintf(stderr, "kernel_launch: launch failed: %s\n", hipGetErrorName(le));
}
```

```cpp
#include <hip/hip_runtime.h>
#include <hip/hip_bf16.h>
#include <cstdio>
#include <cstdint>

#ifndef PROBE_PHASE
#define PROBE_PHASE -1
#endif
#ifndef PROBE_SEL
#define PROBE_SEL 0
#endif
#ifndef PROBE_NPH
#define PROBE_NPH 1
#endif
#ifndef MK_PER_PHASE
#define MK_PER_PHASE 0
#endif

namespace pg8 {
#define PG8_LAS __attribute__((address_space(3)))
typedef unsigned short bf16_t;
typedef short bf16x8 __attribute__((ext_vector_type(8)));
typedef float f32x4 __attribute__((ext_vector_type(4)));
typedef unsigned u32x4 __attribute__((ext_vector_type(4)));
constexpr int BM = 256, BK = 64, HALF = 128, HTB = HALF * BK * 2, STAGE_BYTES = 8 * HTB, NXCD = 8, WGM = 8;

__host__ __device__ __forceinline__ int lds_byte(int r, int c) { const int st = (r >> 4) * 2 + (c >> 5), rr = r & 15, cc = c & 31, ob = rr * 64 + cc * 2; return st * 1024 + (ob ^ (((ob >> 9) & 1) << 5)); }
__host__ __device__ __forceinline__ void stage_rc(int b, int& R, int& C) { const int st = b / 1024, sb = b % 1024, swz = sb ^ (((sb >> 9) & 1) << 5); R = (st >> 1) * 16 + swz / 64; C = (st & 1) * 32 + (swz % 64) / 2; }
__host__ __device__ __forceinline__ int perm32(int rho) { const int n = rho >> 4, i = rho & 15; return 8 * (i >> 2) + 4 * n + (i & 3); }

struct Unit { int pm, pn; };
struct Gemm { const bf16_t* A; const bf16_t* Bt; int M, N, K; };

struct StaticOrder {
    int nM, nN, nwg, G, c;
    __host__ __device__ void init(int M, int N, int G_, int c_) { nM = M / BM; nN = N / BM; nwg = nM * nN; G = G_; c = c_; }
    __host__ __device__ bool next(int i, Unit& u) const {
        const long L = (long)i * G + c; if (L >= nwg) return false;
        int wgid = (int)L; { const int q = nwg / NXCD, r = nwg % NXCD, xcd = wgid % NXCD, off = wgid / NXCD; wgid = (xcd < r ? xcd * (q + 1) : r * (q + 1) + (xcd - r) * q) + off; }
        const int nig = WGM * nN, gid = wgid / nig, fm = gid * WGM, gsz = (nM - fm) < WGM ? (nM - fm) : WGM;
        u.pm = fm + ((wgid % nig) % gsz); u.pn = (wgid % nig) / gsz; return true;
    }
    __device__ __forceinline__ void a_ready(const Unit&) const {}
    __device__ __forceinline__ void done(const Unit&) const {}
};

__device__ __forceinline__ unsigned cvt_pk_bf16(float lo, float hi) { unsigned r; asm volatile("v_cvt_pk_bf16_f32 %0, %1, %2" : "=v"(r) : "v"(lo), "v"(hi)); return r; }

__device__ __forceinline__ float gelu_tanh_e(float x) { const float u = 0.7978845608028654f * (x + 0.044715f * x * x * x); const float t = 1.f - 2.f / (__expf(2.f * u) + 1.f); return 0.5f * x * (1.f + t); }
struct EpiBf16 {
    static constexpr bool PERM = true, AFTER_DRAIN = false;
    bf16_t* O; int ldc; const unsigned long long* ss; unsigned long long* lnsum; int ln_pn0, ln_pn1;
    __device__ __forceinline__ void operator()(const f32x4 (&acc)[2][2][4][2], const Unit& u, int wr, int wc, int fr, int fq) const {
        const int row0 = u.pm * BM + wr * 64 + fr; const int col0 = u.pn * BM + wc * 32 + 8 * fq;
        const bool do_ln = lnsum != nullptr && u.pn >= ln_pn0 && u.pn < ln_pn1;
        unsigned long long ssv[2][4];
#pragma unroll
        for (int ai = 0; ai < 2; ++ai)
#pragma unroll
            for (int m = 0; m < 4; ++m) ssv[ai][m] = ss ? __hip_atomic_load(ss + row0 + ai * HALF + m * 16, __ATOMIC_RELAXED, __HIP_MEMORY_SCOPE_AGENT) : 0ull;
#pragma unroll
        for (int ai = 0; ai < 2; ++ai)
#pragma unroll
            for (int m = 0; m < 4; ++m) { const int row = row0 + ai * HALF + m * 16; bf16_t* rowp = O + (size_t)row * ldc + col0;
                const float sc = ss ? __builtin_amdgcn_rsqf((float)ssv[ai][m] * (1.f / 16777216.f / 2048.f) + 1e-6f) : 1.f;
                float s1 = 0.f, s2 = 0.f;
#pragma unroll
                for (int bj = 0; bj < 2; ++bj) { const f32x4 v0 = acc[ai][bj][m][0] * sc, v1 = acc[ai][bj][m][1] * sc;
                    u32x4 w; w.x = cvt_pk_bf16(v0[0], v0[1]); w.y = cvt_pk_bf16(v0[2], v0[3]); w.z = cvt_pk_bf16(v1[0], v1[1]); w.w = cvt_pk_bf16(v1[2], v1[3]);
                    *(u32x4*)(rowp + bj * HALF) = w;
                    if (do_ln) {
#pragma unroll
                        for (int q = 0; q < 4; ++q) { const float a = gelu_tanh_e(v0[q]), b = gelu_tanh_e(v1[q]); s1 += a + b; s2 += a * a + b * b; } } }
                if (do_ln) { s1 += __shfl_xor(s1, 16); s1 += __shfl_xor(s1, 32); s2 += __shfl_xor(s2, 16); s2 += __shfl_xor(s2, 32);
                    if (fq == 0) { atomicAdd(lnsum + 2 * row, (unsigned long long)(long long)(s1 * 16777216.f)); atomicAdd(lnsum + 2 * row + 1, (unsigned long long)(long long)(s2 * 16777216.f)); } } }
    }
};
struct EpiRes {
    static constexpr bool PERM = true, AFTER_DRAIN = false;
    const float* basef; bf16_t* xb; int ldc; unsigned long long* ss;
    __device__ __forceinline__ void operator()(const f32x4 (&acc)[2][2][4][2], const Unit& u, int wr, int wc, int fr, int fq) const {
        const int row0 = u.pm * BM + wr * 64 + fr; const int col0 = u.pn * BM + wc * 32 + 8 * fq;
        f32x4 b0[2][4][2], b1[2][4][2];
#pragma unroll
        for (int ai = 0; ai < 2; ++ai)
#pragma unroll
            for (int m = 0; m < 4; ++m) { const size_t off = (size_t)(row0 + ai * HALF + m * 16) * ldc + col0;
#pragma unroll
                for (int bj = 0; bj < 2; ++bj) {
                    if (basef) { b0[ai][m][bj] = *(const f32x4*)(basef + off + bj * HALF); b1[ai][m][bj] = *(const f32x4*)(basef + off + bj * HALF + 4); }
                    else { const u32x4 w = *(const u32x4*)(xb + off + bj * HALF);
                        b0[ai][m][bj] = (f32x4){__builtin_bit_cast(float, w.x << 16), __builtin_bit_cast(float, w.x & 0xffff0000u), __builtin_bit_cast(float, w.y << 16), __builtin_bit_cast(float, w.y & 0xffff0000u)};
                        b1[ai][m][bj] = (f32x4){__builtin_bit_cast(float, w.z << 16), __builtin_bit_cast(float, w.z & 0xffff0000u), __builtin_bit_cast(float, w.w << 16), __builtin_bit_cast(float, w.w & 0xffff0000u)}; } } }
#pragma unroll
        for (int ai = 0; ai < 2; ++ai)
#pragma unroll
            for (int m = 0; m < 4; ++m) { const int row = row0 + ai * HALF + m * 16; const size_t off = (size_t)row * ldc + col0; float sq = 0.f;
#pragma unroll
                for (int bj = 0; bj < 2; ++bj) {
                    const f32x4 o0 = b0[ai][m][bj] + acc[ai][bj][m][0], o1 = b1[ai][m][bj] + acc[ai][bj][m][1];
                    u32x4 w; w.x = cvt_pk_bf16(o0[0], o0[1]); w.y = cvt_pk_bf16(o0[2], o0[3]); w.z = cvt_pk_bf16(o1[0], o1[1]); w.w = cvt_pk_bf16(o1[2], o1[3]);
                    *(u32x4*)(xb + off + bj * HALF) = w;
#pragma unroll
                    for (int q = 0; q < 4; ++q) { const unsigned ww = q == 0 ? w.x : q == 1 ? w.y : q == 2 ? w.z : w.w; const float lo = __builtin_bit_cast(float, ww << 16), hi = __builtin_bit_cast(float, ww & 0xffff0000u); sq += lo * lo + hi * hi; } }
                sq += __shfl_xor(sq, 16); sq += __shfl_xor(sq, 32);
                if (fq == 0) atomicAdd(ss + row, (unsigned long long)(sq * 16777216.f)); }
    }
};

struct EpiConv {
    static constexpr bool PERM = true, AFTER_DRAIN = false;
    bf16_t* act; const unsigned long long* ss; const float* cw; const float* cb; bf16_t* halo; PG8_LAS unsigned char* lds0;
    static constexpr int NFF = 5632, NFF2 = 11264;
    static constexpr int HX = STAGE_BYTES + 1024, CPAR = HX + 4096;
    __device__ __forceinline__ static int hxi(int wr, int ai, int rs, int bj, int wc, int fq) { return ((((((wr * 2 + ai) * 2 + rs) * 2 + bj) * 4 + wc) * 4 + fq) * 16); }
    __device__ __forceinline__ static u32x4 bperm4(int addr, u32x4 v) {
        u32x4 r; r.x = (unsigned)__builtin_amdgcn_ds_bpermute(addr, (int)v.x); r.y = (unsigned)__builtin_amdgcn_ds_bpermute(addr, (int)v.y);
        r.z = (unsigned)__builtin_amdgcn_ds_bpermute(addr, (int)v.z); r.w = (unsigned)__builtin_amdgcn_ds_bpermute(addr, (int)v.w); return r; }
    __device__ __forceinline__ void operator()(const f32x4 (&acc)[2][2][4][2], const Unit& u, int wr, int wc, int fr, int fq) const {
        asm volatile("" : "+v"(fr), "+v"(fq));
        typedef float f32x2 __attribute__((ext_vector_type(2)));
        const int lane = fq * 16 + fr, tid = (wr * 4 + wc) * 64 + lane;
        { PG8_LAS unsigned* cp = (PG8_LAS unsigned*)(lds0 + CPAR);
#pragma unroll
          for (int e = 0; e < 2; ++e) { const int idx = tid * 2 + e, bj = idx >> 9, j = (idx >> 7) & 3, c = idx & 127; const int gcol = bj * NFF + u.pn * 128 + c;
              const float f = (j < 3 ? cw[(size_t)j * NFF2 + gcol] : cb[gcol]) * (bj ? -1.4426950408889634f : -0.6931471805599453f);
              const unsigned b = cvt_pk_bf16(f, 0.f) & 0xffffu;
              cp[idx] = j < 3 ? ((c & 1) ? (b << 16) : b) : __builtin_bit_cast(unsigned, f); } }
        u32x4 pk[2][2][4];
        unsigned long long ssv[2][4];
#pragma unroll
        for (int ai = 0; ai < 2; ++ai)
#pragma unroll
            for (int m = 0; m < 4; ++m) ssv[ai][m] = __hip_atomic_load(ss + u.pm * BM + ai * HALF + wr * 64 + m * 16 + fr, __ATOMIC_RELAXED, __HIP_MEMORY_SCOPE_AGENT);
#pragma unroll
        for (int ai = 0; ai < 2; ++ai)
#pragma unroll
            for (int m = 0; m < 4; ++m) {
                const float sc = __builtin_amdgcn_rsqf((float)ssv[ai][m] * (1.f / 16777216.f / 2048.f) + 1e-6f);
#pragma unroll
                for (int bj = 0; bj < 2; ++bj) { const f32x4 v0 = acc[ai][bj][m][0] * sc, v1 = acc[ai][bj][m][1] * sc;
                    pk[ai][bj][m] = (u32x4){cvt_pk_bf16(v0[0], v0[1]), cvt_pk_bf16(v0[2], v0[3]), cvt_pk_bf16(v1[0], v1[1]), cvt_pk_bf16(v1[2], v1[3])}; } }
        const int pcol = u.pn * 256 + wc * 32 + 8 * fq;
        if (fr >= 14) {
#pragma unroll
            for (int ai = 0; ai < 2; ++ai)
#pragma unroll
                for (int bj = 0; bj < 2; ++bj) *(PG8_LAS u32x4*)(lds0 + HX + hxi(wr, ai, fr - 14, bj, wc, fq)) = pk[ai][bj][3];
            if (wr == 1) {
#pragma unroll
                for (int bj = 0; bj < 2; ++bj) *(u32x4*)(halo + ((size_t)u.pm * 4 + 2 + (fr - 14)) * NFF2 + pcol + bj * HALF) = pk[1][bj][3]; } }
        if (wr == 0 && fr < 2) {
#pragma unroll
            for (int bj = 0; bj < 2; ++bj) *(u32x4*)(halo + ((size_t)u.pm * 4 + fr) * NFF2 + pcol + bj * HALF) = pk[0][bj][0]; }
        asm volatile("s_waitcnt lgkmcnt(0)" ::: "memory"); __builtin_amdgcn_s_barrier(); asm volatile("" ::: "memory");
        const int i1 = ((lane & 48) | ((fr + 15) & 15)) * 4, i2 = ((lane & 48) | ((fr + 14) & 15)) * 4;
        const int ca = u.pn * 128 + wc * 32 + 8 * fq;
        typedef __bf16 bf16x2_t __attribute__((ext_vector_type(2)));
#define PG8_W(v_, q_) ((q_) == 0 ? (v_).x : (q_) == 1 ? (v_).y : (q_) == 2 ? (v_).z : (v_).w)
#define PG8_DOT2(x_, w_, c_) __builtin_amdgcn_fdot2_f32_bf16(__builtin_bit_cast(bf16x2_t, (unsigned)(x_)), __builtin_bit_cast(bf16x2_t, (unsigned)(w_)), (c_), false)
        u32x4 wt[2][3][2]; f32x4 bs[2][2];
        { const PG8_LAS unsigned* cpl = (const PG8_LAS unsigned*)(lds0 + CPAR) + wc * 32 + 8 * fq;
#pragma unroll
          for (int bj = 0; bj < 2; ++bj) {
#pragma unroll
              for (int j = 0; j < 3; ++j) { wt[bj][j][0] = *(const PG8_LAS u32x4*)(cpl + bj * 512 + j * 128); wt[bj][j][1] = *(const PG8_LAS u32x4*)(cpl + bj * 512 + j * 128 + 4); }
              bs[bj][0] = *(const PG8_LAS f32x4*)(cpl + bj * 512 + 384); bs[bj][1] = *(const PG8_LAS f32x4*)(cpl + bj * 512 + 388); } }
#pragma unroll
        for (int ai = 0; ai < 2; ++ai) {
            const bool top = (wr == 0 && ai == 0);
            u32x4 q1[2], q2[2];
            if (top) { q1[0] = (u32x4){0u, 0u, 0u, 0u}; q1[1] = q1[0]; q2[0] = q1[0]; q2[1] = q1[0]; }
            else { const int swr = wr == 1 ? 0 : 1, sai = wr == 1 ? ai : 0;
#pragma unroll
                for (int bj = 0; bj < 2; ++bj) { const u32x4 h14 = *(const PG8_LAS u32x4*)(lds0 + HX + hxi(swr, sai, 0, bj, wc, fq)), h15 = *(const PG8_LAS u32x4*)(lds0 + HX + hxi(swr, sai, 1, bj, wc, fq));
                    q1[bj] = h15; q2[bj] = fr == 0 ? h14 : h15; } }
#pragma unroll
            for (int m = 0; m < 4; ++m) {
                float cv[2][8];
#pragma unroll
                for (int bj = 0; bj < 2; ++bj) { const u32x4 cur = pk[ai][bj][m];
                    const u32x4 s1 = bperm4(i1, cur), s2 = bperm4(i2, cur);
                    const u32x4 p1 = fr == 0 ? q1[bj] : s1, p2 = fr < 2 ? q2[bj] : s2;
                    q1[bj] = s1; q2[bj] = s2;
#pragma unroll
                    for (int c = 0; c < 8; ++c) { const int q = c >> 1;
                        float y;
                        asm("v_dot2_f32_bf16 %0, %1, %2, %3" : "=v"(y) : "v"(PG8_W(p2, q)), "v"(PG8_W(wt[bj][0][c >> 2], c & 3)), "v"(bs[bj][c >> 2][c & 3]));
                        y = PG8_DOT2(PG8_W(p1, q), PG8_W(wt[bj][1][c >> 2], c & 3), y);
                        cv[bj][c] = PG8_DOT2(PG8_W(cur, q), PG8_W(wt[bj][2][c >> 2], c & 3), y); } }
                float o[8];
#pragma unroll
                for (int q = 0; q < 4; ++q) { const f32x2 t = {cv[1][2 * q], cv[1][2 * q + 1]}, av = {cv[0][2 * q], cv[0][2 * q + 1]};
                    const f32x2 e = {__builtin_amdgcn_exp2f(t.x), __builtin_amdgcn_exp2f(t.y)}; const f32x2 d = e + 1.f;
                    const f32x2 r = {__builtin_amdgcn_rcpf(d.x), __builtin_amdgcn_rcpf(d.y)}; const f32x2 ov = av * t * r; o[2 * q] = ov.x; o[2 * q + 1] = ov.y; }
                u32x4 out; out.x = cvt_pk_bf16(o[0], o[1]); out.y = cvt_pk_bf16(o[2], o[3]); out.z = cvt_pk_bf16(o[4], o[5]); out.w = cvt_pk_bf16(o[6], o[7]);
                const int row = u.pm * BM + ai * HALF + wr * 64 + m * 16 + fr;
                if (!(top && m == 0 && fr < 2)) *(u32x4*)(act + (size_t)row * NFF + ca) = out;
                __builtin_amdgcn_sched_barrier(0); } }
#undef PG8_DOT2
#undef PG8_W
    }
};

struct EpiFinal {
    static constexpr bool PERM = true, AFTER_DRAIN = true;
    const bf16_t* xb; int ldc; unsigned long long* ss; unsigned* cnt; const float* g; float* out;
    __device__ __forceinline__ void fused(f32x4 (&acc)[2][2][4][2], const Unit& u, int wr, int wc, int fr, int fq, PG8_LAS unsigned char* lds, int wid, int lane) const {
        const int row0 = u.pm * BM + wr * 64 + fr; const int col0 = u.pn * BM + wc * 32 + 8 * fq;
        u32x4 bw[2][4][2];
#pragma unroll
        for (int ai = 0; ai < 2; ++ai)
#pragma unroll
            for (int m = 0; m < 4; ++m)
#pragma unroll
                for (int bj = 0; bj < 2; ++bj) bw[ai][m][bj] = *(const u32x4*)(xb + (size_t)(row0 + ai * HALF + m * 16) * ldc + col0 + bj * HALF);
        float sqv[2][4];
#pragma unroll
        for (int ai = 0; ai < 2; ++ai)
#pragma unroll
            for (int m = 0; m < 4; ++m) { float sq = 0.f;
#pragma unroll
                for (int bj = 0; bj < 2; ++bj) { const u32x4 w = bw[ai][m][bj];
                    const f32x4 b0 = {__builtin_bit_cast(float, w.x << 16), __builtin_bit_cast(float, w.x & 0xffff0000u), __builtin_bit_cast(float, w.y << 16), __builtin_bit_cast(float, w.y & 0xffff0000u)};
                    const f32x4 b1 = {__builtin_bit_cast(float, w.z << 16), __builtin_bit_cast(float, w.z & 0xffff0000u), __builtin_bit_cast(float, w.w << 16), __builtin_bit_cast(float, w.w & 0xffff0000u)};
                    const f32x4 o0 = b0 + acc[ai][bj][m][0], o1 = b1 + acc[ai][bj][m][1]; acc[ai][bj][m][0] = o0; acc[ai][bj][m][1] = o1;
                    sq += (o0[0] * o0[0] + o0[1] * o0[1]) + (o0[2] * o0[2] + o0[3] * o0[3]) + (o1[0] * o1[0] + o1[1] * o1[1]) + (o1[2] * o1[2] + o1[3] * o1[3]); }
                sq += __shfl_xor(sq, 16); sq += __shfl_xor(sq, 32); sqv[ai][m] = sq; }
        unsigned long long keep = 0ull, kr[2][4];
        if (fq == 0) {
#pragma unroll
            for (int ai = 0; ai < 2; ++ai)
#pragma unroll
                for (int m = 0; m < 4; ++m) kr[ai][m] = atomicAdd(ss + row0 + ai * HALF + m * 16, (unsigned long long)(sqv[ai][m] * 16777216.f));
#pragma unroll
            for (int ai = 0; ai < 2; ++ai)
#pragma unroll
                for (int m = 0; m < 4; ++m) keep += kr[ai][m]; }
        asm volatile("s_waitcnt vmcnt(0)" :: "v"((unsigned)keep), "v"((unsigned)(keep >> 32)) : "memory");
        if (lane == 0) __hip_atomic_fetch_add(cnt + 64 * u.pm, 1u, __ATOMIC_RELAXED, __HIP_MEMORY_SCOPE_AGENT);
        if (wid == 0) { unsigned sp = 0;
            while ((unsigned)__builtin_amdgcn_readfirstlane(__hip_atomic_load(cnt + 64 * u.pm, __ATOMIC_RELAXED, __HIP_MEMORY_SCOPE_AGENT)) < 64u) { __builtin_amdgcn_s_sleep(2); if (++sp > (1u << 22)) break; } }
        asm volatile("s_waitcnt vmcnt(0) lgkmcnt(0)" ::: "memory"); __builtin_amdgcn_s_barrier(); asm volatile("" ::: "memory");
        unsigned long long ssv[2][4];
#pragma unroll
        for (int ai = 0; ai < 2; ++ai)
#pragma unroll
            for (int m = 0; m < 4; ++m) ssv[ai][m] = __hip_atomic_load(ss + row0 + ai * HALF + m * 16, __ATOMIC_RELAXED, __HIP_MEMORY_SCOPE_AGENT);
#pragma unroll
        for (int ai = 0; ai < 2; ++ai)
#pragma unroll
            for (int m = 0; m < 4; ++m) { const int row = row0 + ai * HALF + m * 16; const size_t off = (size_t)row * ldc + col0;
                const float rstd = __builtin_amdgcn_rsqf((float)ssv[ai][m] * (1.f / 16777216.f / 2048.f) + 1e-6f);
#pragma unroll
                for (int bj = 0; bj < 2; ++bj) { const f32x4 g0 = *(const f32x4*)(g + col0 + bj * HALF), g1 = *(const f32x4*)(g + col0 + bj * HALF + 4);
                    *(f32x4*)(out + off + bj * HALF) = acc[ai][bj][m][0] * rstd * g0; *(f32x4*)(out + off + bj * HALF + 4) = acc[ai][bj][m][1] * rstd * g1; } }
    }
};

template <class Epi, class Sched, bool ALIGN_EPI = false, bool SP2 = false>
__device__ __forceinline__ void gemm_phase(PG8_LAS unsigned char* lds, const Gemm g, const Sched& S, const Epi& E, const int tid) {
    const int wid = __builtin_amdgcn_readfirstlane(tid >> 6), lane = tid & 63, wr = wid >> 2, wc = wid & 3, fr = lane & 15, fq = lane >> 4;
    const int K = g.K, nt = K / BK;
    unsigned voffA[2], voffB[2];
#pragma unroll
    for (int i = 0; i < 2; ++i) { int R, C; stage_rc(tid * 16 + i * 8192, R, C); const int Rb = Epi::PERM ? ((R & ~31) + perm32(R & 31)) : R;
        voffA[i] = (unsigned)(R * K + C) * 2u; voffB[i] = (unsigned)(Rb * K + C) * 2u; }
    const size_t kstep = (size_t)(BK * 2);
    const size_t hstep = (size_t)HALF * K * 2;
    const size_t tstep = 2 * hstep;
    const unsigned ldsw = (unsigned)wid * 1024u;
    const int aoff = lds_byte(wr * 64 + fr, fq * 8), boff = lds_byte(wc * 32 + fr, fq * 8);
#define PG8_SA(b, h) (((b) * 2 + (h)) * HTB)
#define PG8_SB(b, h) ((4 + (b) * 2 + (h)) * HTB)
#define PG8_STAGE(bufoff, gbase, voff) do { _Pragma("unroll") for (int _i = 0; _i < 2; ++_i) \
        __builtin_amdgcn_global_load_lds((const unsigned*)((const char*)(gbase) + (voff)[_i]), (PG8_LAS unsigned*)(lds + (bufoff) + ldsw + _i * 8192), 16, 0, 0); } while (0)
#define PG8_LDA(dst, b, h) do { _Pragma("unroll") for (int m = 0; m < 4; ++m) _Pragma("unroll") for (int k = 0; k < 2; ++k) dst[m][k] = *(const PG8_LAS bf16x8*)(lds + PG8_SA(b, h) + aoff + m * 2048 + k * 1024); } while (0)
#define PG8_LDB(dst, b, h) do { _Pragma("unroll") for (int n = 0; n < 2; ++n) _Pragma("unroll") for (int k = 0; k < 2; ++k) dst[n][k] = *(const PG8_LAS bf16x8*)(lds + PG8_SB(b, h) + boff + n * 2048 + k * 1024); } while (0)
#define PG8_MMA(ai, bj, At, Bt) do { __builtin_amdgcn_s_setprio(1); _Pragma("unroll") for (int m = 0; m < 4; ++m) _Pragma("unroll") for (int n = 0; n < 2; ++n) _Pragma("unroll") for (int k = 0; k < 2; ++k) \
        acc[ai][bj][m][n] = __builtin_amdgcn_mfma_f32_16x16x32_bf16(Bt[n][k], At[m][k], acc[ai][bj][m][n], 0, 0, 0); __builtin_amdgcn_s_setprio(0); } while (0)
#define PG8_WAIT_V(n) asm volatile("s_waitcnt vmcnt(" #n ")" ::: "memory")
#define PG8_WAIT_L(n) asm volatile("s_waitcnt lgkmcnt(" #n ")" ::: "memory")
#define PG8_BAR __builtin_amdgcn_s_barrier()
#define PG8_SCHED __builtin_amdgcn_sched_barrier(0)
    Unit cur, nxt; int ui = 0;
    if (!S.next(0, cur)) return;
    f32x4 acc[2][2][4][2];
#pragma unroll
    for (int a = 0; a < 2; ++a)
#pragma unroll
        for (int b = 0; b < 2; ++b)
#pragma unroll
            for (int m = 0; m < 4; ++m)
#pragma unroll
                for (int n = 0; n < 2; ++n) acc[a][b][m][n] = (f32x4){0.f, 0.f, 0.f, 0.f};
    bf16x8 At[4][2], B0[2][2], B1[2][2];
    const char* cA = (const char*)g.A + (size_t)cur.pm * tstep; const char* cB = (const char*)g.Bt + (size_t)cur.pn * tstep;
    S.a_ready(cur);
    if constexpr (SP2) {
        PG8_STAGE(PG8_SB(0, 0), cB, voffB); PG8_STAGE(PG8_SB(0, 1), cB + hstep, voffB); PG8_STAGE(PG8_SA(0, 0), cA, voffA); PG8_STAGE(PG8_SA(0, 1), cA + hstep, voffA);
        if (wr == 1) PG8_BAR;
        PG8_WAIT_V(2); PG8_BAR;
        PG8_STAGE(PG8_SB(1, 0), cB + kstep, voffB); PG8_STAGE(PG8_SA(1, 0), cA + kstep, voffA); PG8_STAGE(PG8_SB(1, 1), cB + hstep + kstep, voffB);
        PG8_WAIT_V(6); PG8_BAR;
    } else {
        PG8_STAGE(PG8_SB(0, 0), cB, voffB); PG8_STAGE(PG8_SA(0, 0), cA, voffA); PG8_STAGE(PG8_SB(0, 1), cB + hstep, voffB); PG8_STAGE(PG8_SA(0, 1), cA + hstep, voffA);
        if (wr == 1) PG8_BAR;
        PG8_WAIT_V(4); PG8_BAR;
        PG8_STAGE(PG8_SB(1, 0), cB + kstep, voffB); PG8_STAGE(PG8_SA(1, 0), cA + kstep, voffA); PG8_STAGE(PG8_SB(1, 1), cB + hstep + kstep, voffB);
        PG8_WAIT_V(6); PG8_BAR;
    }
    for (;;) {
        const bool has_next = S.next(ui + 1, nxt);
        const char* nA = has_next ? (const char*)g.A + (size_t)nxt.pm * tstep : cA; const char* nB = has_next ? (const char*)g.Bt + (size_t)nxt.pn * tstep : cB;
        for (int t = 0; t < nt; t += 2) {
            const bool last = (t == nt - 2);
            const char* a1 = cA + (size_t)(t + 1) * kstep;
            const char* a2 = last ? nA : cA + (size_t)(t + 2) * kstep; const char* b2 = last ? nB : cB + (size_t)(t + 2) * kstep;
            const char* a3 = a2 + kstep; const char* b3 = b2 + kstep;
            if (last && has_next) S.a_ready(nxt);
            if constexpr (SP2) {
            PG8_LDB(B0, 0, 0); PG8_LDB(B1, 0, 1); PG8_SCHED; PG8_LDA(At, 0, 0); PG8_STAGE(PG8_SA(1, 1), a1 + hstep, voffA);
            PG8_WAIT_V(8); PG8_WAIT_L(0); PG8_BAR; PG8_MMA(0, 0, At, B0); PG8_MMA(0, 1, At, B1); PG8_BAR; PG8_SCHED;
            PG8_LDA(At, 0, 1); PG8_STAGE(PG8_SB(0, 0), b2, voffB); PG8_STAGE(PG8_SB(0, 1), b2 + hstep, voffB); PG8_STAGE(PG8_SA(0, 0), a2, voffA);
            PG8_WAIT_V(8); PG8_WAIT_L(0); PG8_BAR; PG8_MMA(1, 0, At, B0); PG8_MMA(1, 1, At, B1); PG8_BAR; PG8_SCHED;
            PG8_LDB(B0, 1, 0); PG8_LDB(B1, 1, 1); PG8_SCHED; PG8_LDA(At, 1, 0); PG8_STAGE(PG8_SA(0, 1), a2 + hstep, voffA);
            PG8_WAIT_V(8); PG8_WAIT_L(0); PG8_BAR; PG8_MMA(0, 0, At, B0); PG8_MMA(0, 1, At, B1); PG8_BAR; PG8_SCHED;
            PG8_LDA(At, 1, 1); PG8_STAGE(PG8_SB(1, 0), b3, voffB); PG8_STAGE(PG8_SB(1, 1), b3 + hstep, voffB); PG8_STAGE(PG8_SA(1, 0), a3, voffA);
            PG8_WAIT_V(8); PG8_WAIT_L(0); PG8_BAR; PG8_MMA(1, 0, At, B0); PG8_MMA(1, 1, At, B1); PG8_BAR; PG8_SCHED;
            } else {
            PG8_LDB(B0, 0, 0); PG8_SCHED; PG8_LDA(At, 0, 0); PG8_STAGE(PG8_SA(1, 1), a1 + hstep, voffA);
            PG8_WAIT_L(8); PG8_BAR; PG8_WAIT_L(0); PG8_MMA(0, 0, At, B0); PG8_BAR; PG8_SCHED;
            PG8_LDB(B1, 0, 1); PG8_STAGE(PG8_SB(0, 0), b2, voffB);
            PG8_BAR; PG8_WAIT_L(0); PG8_MMA(0, 1, At, B1); PG8_BAR;
            PG8_LDA(At, 0, 1); PG8_STAGE(PG8_SA(0, 0), a2, voffA);
            PG8_BAR; PG8_WAIT_L(0); PG8_MMA(1, 0, At, B0); PG8_BAR; PG8_SCHED;
            PG8_STAGE(PG8_SB(0, 1), b2 + hstep, voffB);
            PG8_WAIT_V(6); PG8_BAR; PG8_MMA(1, 1, At, B1); PG8_BAR;
            PG8_LDB(B0, 1, 0); PG8_SCHED; PG8_LDA(At, 1, 0); PG8_STAGE(PG8_SA(0, 1), a2 + hstep, voffA);
            PG8_WAIT_L(8); PG8_BAR; PG8_WAIT_L(0); PG8_MMA(0, 0, At, B0); PG8_BAR; PG8_SCHED;
            PG8_LDB(B1, 1, 1); PG8_STAGE(PG8_SB(1, 0), b3, voffB);
            PG8_BAR; PG8_WAIT_L(0); PG8_MMA(0, 1, At, B1); PG8_BAR;
            PG8_LDA(At, 1, 1); PG8_STAGE(PG8_SA(1, 0), a3, voffA);
            PG8_BAR; PG8_WAIT_L(0); PG8_MMA(1, 0, At, B0); PG8_BAR; PG8_SCHED;
            PG8_STAGE(PG8_SB(1, 1), b3 + hstep, voffB);
            PG8_WAIT_V(6); PG8_BAR; PG8_MMA(1, 1, At, B1); PG8_BAR;
            }
        }
        if constexpr (ALIGN_EPI) { if (wr == 0) PG8_BAR; }
        if constexpr (!Epi::AFTER_DRAIN) { E(acc, cur, wr, wc, fr, fq); S.done(cur); }
        if (!has_next) break;
#pragma unroll
        for (int a = 0; a < 2; ++a)
#pragma unroll
            for (int b = 0; b < 2; ++b)
#pragma unroll
                for (int m = 0; m < 4; ++m)
#pragma unroll
                    for (int n = 0; n < 2; ++n) acc[a][b][m][n] = (f32x4){0.f, 0.f, 0.f, 0.f};
        cur = nxt; cA = nA; cB = nB; ++ui;
        if constexpr (ALIGN_EPI) { if (wr == 1) PG8_BAR; }
    }
    PG8_WAIT_V(0);
    if constexpr (!ALIGN_EPI) { if (wr == 0) PG8_BAR; }
    PG8_BAR;
    if constexpr (Epi::AFTER_DRAIN) { E.fused(acc, cur, wr, wc, fr, fq, lds, wid, lane); }
#undef PG8_SA
#undef PG8_SB
#undef PG8_STAGE
#undef PG8_LDA
#undef PG8_LDB
#undef PG8_MMA
#undef PG8_WAIT_V
#undef PG8_WAIT_L
#undef PG8_BAR
#undef PG8_SCHED
}
}

constexpr int DM = 2048, BATCH = 2, SEQ = 4096, MTOK = BATCH * SEQ;
constexpr int AB_IN = 6144, CD_IN = 5120, DFF = 5632, DFF2 = 11264;
constexpr float EPS = 1e-6f;
constexpr int NWAVES = 8;

#define GAS __attribute__((address_space(1)))
#define LAS __attribute__((address_space(3)))
typedef unsigned short bf16;
typedef unsigned v4u __attribute__((ext_vector_type(4)));
typedef unsigned v2u __attribute__((ext_vector_type(2)));
typedef float f32x4 __attribute__((ext_vector_type(4)));
typedef float f32x16 __attribute__((ext_vector_type(16)));
typedef short bf16x8 __attribute__((ext_vector_type(8)));
typedef short s16x4 __attribute__((ext_vector_type(4)));
typedef GAS unsigned gu32;
#define RLX_AGENT __ATOMIC_RELAXED, __HIP_MEMORY_SCOPE_AGENT
#define LDS_WAIT() asm volatile("s_waitcnt lgkmcnt(0)" ::: "memory")
#define VM_WAIT() asm volatile("s_waitcnt vmcnt(0)" ::: "memory")
__device__ __forceinline__ unsigned f2bf(float f) { unsigned u = __builtin_bit_cast(unsigned, f); return (u + 0x7fffu + ((u >> 16) & 1u)) >> 16; }
__device__ __forceinline__ unsigned pk2(float lo, float hi) { return f2bf(lo) | (f2bf(hi) << 16); }
__device__ __forceinline__ float bf2f(unsigned u16) { return __builtin_bit_cast(float, u16 << 16); }
__device__ __forceinline__ float bflo(unsigned w) { return __builtin_bit_cast(float, w << 16); }
__device__ __forceinline__ float bfhi(unsigned w) { return __builtin_bit_cast(float, w & 0xffff0000u); }
__device__ __forceinline__ float wave_sum(float v) {
#pragma unroll
    for (int o = 1; o < 64; o <<= 1) v += __shfl_xor(v, o);
    return v;
}
__device__ __forceinline__ float gelu_tanh(float x) {
    const float u = 0.7978845608028654f * (x + 0.044715f * x * x * x);
    const float t = 1.f - 2.f / (__expf(2.f * u) + 1.f);
    return 0.5f * x * (1.f + t);
}
__device__ __forceinline__ float silu_f(float x) { return x / (1.f + __expf(-x)); }

constexpr size_t MiB = 1u << 20;
constexpr size_t WS_CTL = 0, CTL_ZERO_BYTES = 1 * MiB;
constexpr size_t WS_SS = 128 * 1024;
constexpr size_t WS_LNS = 512 * 1024;
constexpr size_t WS_CNT = 768 * 1024;
constexpr size_t WS_SCAL = 1 * MiB;
constexpr size_t WS_ROPE = 2 * MiB;
constexpr size_t WS_W_ABIN = 4 * MiB;
constexpr size_t WS_W_ABOUT = WS_W_ABIN + 24 * MiB;
constexpr size_t WS_W_CDIN = WS_W_ABOUT + 8 * MiB;
constexpr size_t WS_W_CDOUT = WS_W_CDIN + 20 * MiB;
constexpr size_t WS_W_UP0 = WS_W_CDOUT + 8 * MiB;
constexpr size_t WS_W_UP1 = WS_W_UP0 + 44 * MiB;
constexpr size_t WS_W_DN0 = WS_W_UP1 + 44 * MiB;
constexpr size_t WS_W_DN1 = WS_W_DN0 + 22 * MiB;
constexpr size_t WS_XN = WS_W_DN1 + 22 * MiB;
constexpr size_t WS_O = WS_XN + 32 * MiB;
constexpr size_t WS_X = WS_O + 32 * MiB;
constexpr size_t WS_ACT = WS_X + 64 * MiB;
constexpr size_t WS_R1 = WS_ACT + 88 * MiB;
constexpr size_t WS_P = WS_R1;
constexpr size_t WS_OB = WS_R1 + 96 * MiB;
constexpr size_t WS_KV = WS_R1 + 96 * MiB;
constexpr size_t WS_PREV = WS_KV + 64 * MiB;
constexpr size_t WS_UP = WS_R1;
constexpr size_t WS_HALO = WS_R1 + 192 * MiB;
constexpr size_t WS_SCR = WS_HALO + 4 * MiB;
constexpr size_t WS_END = WS_SCR + 32 * MiB;

constexpr int RING_BYTES = 131072;
constexpr int LDSCTL_OFF = RING_BYTES, MISC_OFF = LDSCTL_OFF + 320;
constexpr int LDS_BYTES = 147456;

#define XB_TMO      128
#define XB_XCNT(j)  (256  + 64 * (j))
#define XB_XSUB(j)  (1280 + 64 * (j))
#define XB_XGEN(j)  (2304 + 64 * (j))
#define XB_TOP      3328
#define XB_TOPGEN   3392
#define XCD_BAR_WORDS 3456
#define XB_SPIN_CAP (1u << 20)
__device__ __forceinline__ unsigned xb_ld(unsigned* p)              { return __hip_atomic_load(p, __ATOMIC_RELAXED, __HIP_MEMORY_SCOPE_AGENT); }
__device__ __forceinline__ unsigned xb_add(unsigned* p, unsigned v) { return __hip_atomic_fetch_add(p, v, __ATOMIC_RELAXED, __HIP_MEMORY_SCOPE_AGENT); }
__device__ __forceinline__ unsigned xb_xcc_id() { return (unsigned)__builtin_amdgcn_s_getreg((3 << 11) | 20) & 0xFu; }
#define XB_SPIN(cond, bar) do { unsigned _sp = 0; while (cond) { __builtin_amdgcn_s_sleep(1); \
    if ((++_sp & 255u) == 0u) { if (xb_ld(&(bar)[XB_TMO])) break; if (_sp > XB_SPIN_CAP) { atomicAdd(&(bar)[XB_TMO], 1u); break; } } } } while (0)
#ifndef XB_FLAT
#define XB_FLAT 0
#endif
struct XcdBarrier { unsigned* bar; unsigned x; volatile LAS unsigned* st; };
#if XB_FLAT == 1
__device__ __forceinline__ XcdBarrier xcd_barrier_post(unsigned* bar, volatile LAS unsigned* st) {
    XcdBarrier b; b.bar = bar; b.x = xb_xcc_id(); b.st = st;
    return b;
}
__device__ __forceinline__ void xcd_barrier(const XcdBarrier& b) {
    asm volatile("s_waitcnt vmcnt(0)" ::: "memory");
    __syncthreads();
    if (threadIdx.x < 64) {
        unsigned* bar = b.bar; const unsigned ln = threadIdx.x;
        const unsigned k = b.st[0];
        const unsigned target = (k + 1u) * (gridDim.x * gridDim.y * gridDim.z);
        if (ln == 0) {
            __builtin_amdgcn_fence(__ATOMIC_RELEASE, "agent");
            asm volatile("s_waitcnt vmcnt(0)" ::: "memory");
            (void)__hip_atomic_fetch_add(&bar[XB_XSUB(b.x)], 1u, __ATOMIC_RELAXED, __HIP_MEMORY_SCOPE_AGENT);
            b.st[0] = k + 1u; }
        unsigned sp = 0u;
        for (;;) {
            unsigned v = ln < 16u ? xb_ld(&bar[XB_XSUB(ln)]) : 0u;
            v += __shfl_xor(v, 1); v += __shfl_xor(v, 2); v += __shfl_xor(v, 4); v += __shfl_xor(v, 8);
            v = __builtin_amdgcn_readfirstlane(v);
            if (v >= target) break;
            __builtin_amdgcn_s_sleep(1);
            if ((++sp & 255u) == 0u) { if (__builtin_amdgcn_readfirstlane(xb_ld(&bar[XB_TMO]))) break; if (sp > XB_SPIN_CAP) { if (ln == 0) atomicAdd(&bar[XB_TMO], 1u); break; } }
        }
        __builtin_amdgcn_fence(__ATOMIC_ACQUIRE, "agent");
        asm volatile("s_waitcnt vmcnt(0)" ::: "memory");
    }
    __syncthreads();
}
#else
__device__ __forceinline__ XcdBarrier xcd_barrier_post(unsigned* bar, volatile LAS unsigned* st) {
    XcdBarrier b; b.bar = bar; b.x = xb_xcc_id(); b.st = st;
    if (threadIdx.x == 0) (void)xb_add(&bar[XB_XCNT(b.x)], 1u);
    return b;
}
__device__ __forceinline__ void xcd_barrier_complete(unsigned* bar, unsigned x, unsigned& nloc, unsigned& nx) {
    const unsigned G = gridDim.x * gridDim.y * gridDim.z;
    unsigned sum, cnt, mine, sp = 0u;
    for (;;) {
        sum = 0u; cnt = 0u; mine = 0u;
#pragma unroll
        for (unsigned j = 0; j < 16; ++j) { const unsigned c = xb_ld(&bar[XB_XCNT(j)]); sum += c; cnt += (c > 0u) ? 1u : 0u; mine = (j == x) ? c : mine; }
        if (sum == G) break;
        __builtin_amdgcn_s_sleep(1);
        if ((++sp & 255u) == 0u) { if (xb_ld(&bar[XB_TMO])) break; if (sp > XB_SPIN_CAP) { atomicAdd(&bar[XB_TMO], 1u); break; } }
    }
    nloc = mine > 0u ? mine : 1u; nx = cnt > 0u ? cnt : 1u;
}
__device__ __forceinline__ void xcd_barrier(const XcdBarrier& b) {
    asm volatile("s_waitcnt vmcnt(0)" ::: "memory");
    __syncthreads();
    if (threadIdx.x == 0) {
        unsigned* bar = b.bar;
        __builtin_amdgcn_s_waitcnt(0);
        unsigned nloc = b.st[0], nx = b.st[1];
        if (nloc == 0u) { xcd_barrier_complete(bar, b.x, nloc, nx); b.st[0] = nloc; b.st[1] = nx; }
        const unsigned old = xb_add(&bar[XB_XSUB(b.x)], 1u);
        const unsigned gen = old / nloc;
#if XB_FLAT == 2
        if (old + 1u == (gen + 1u) * nloc) {
            __builtin_amdgcn_fence(__ATOMIC_RELEASE, "agent");
            asm volatile("s_waitcnt vmcnt(0)" ::: "memory");
            (void)__hip_atomic_fetch_add(&bar[XB_TOP], 1u, __ATOMIC_RELAXED, __HIP_MEMORY_SCOPE_AGENT); }
        { const unsigned target = (gen + 1u) * nx;
          XB_SPIN(xb_ld(&bar[XB_TOP]) < target, bar); }
        __builtin_amdgcn_fence(__ATOMIC_ACQUIRE, "agent");
        asm volatile("s_waitcnt vmcnt(0)" ::: "memory");
#elif XB_FLAT == 3
        if (old + 1u == (gen + 1u) * nloc) {
            __builtin_amdgcn_fence(__ATOMIC_RELEASE, "agent");
            asm volatile("s_waitcnt vmcnt(0)" ::: "memory");
            (void)__hip_atomic_fetch_add(&bar[XB_TOP], 1u, __ATOMIC_RELAXED, __HIP_MEMORY_SCOPE_AGENT);
            { const unsigned target = (gen + 1u) * nx;
              XB_SPIN(xb_ld(&bar[XB_TOP]) < target, bar); }
            __builtin_amdgcn_fence(__ATOMIC_ACQUIRE, "agent");
            (void)__hip_atomic_fetch_add(&bar[XB_XGEN(b.x)], 1u, __ATOMIC_RELAXED, __HIP_MEMORY_SCOPE_AGENT);
            asm volatile("s_waitcnt vmcnt(0)" ::: "memory");
        } else {
            XB_SPIN(xb_ld(&bar[XB_XGEN(b.x)]) == gen, bar);
            __builtin_amdgcn_fence(__ATOMIC_ACQUIRE, "agent");
            asm volatile("s_waitcnt vmcnt(0)" ::: "memory");
        }
#else
        if (old + 1u == (gen + 1u) * nloc) {
            __builtin_amdgcn_fence(__ATOMIC_RELEASE, "agent");
            asm volatile("s_waitcnt vmcnt(0)" ::: "memory");
            const unsigned og = xb_add(&bar[XB_TOP], 1u);
            const unsigned tg = og / nx;
            if (og + 1u == (tg + 1u) * nx) xb_add(&bar[XB_TOPGEN], 1u);
            else XB_SPIN(xb_ld(&bar[XB_TOPGEN]) == tg, bar);
            __builtin_amdgcn_fence(__ATOMIC_ACQUIRE, "agent");
            xb_add(&bar[XB_XGEN(b.x)], 1u);
            asm volatile("s_waitcnt vmcnt(0)" ::: "memory");
        } else {
            XB_SPIN(xb_ld(&bar[XB_XGEN(b.x)]) == gen, bar);
            __builtin_amdgcn_fence(__ATOMIC_ACQUIRE, "agent");
            asm volatile("s_waitcnt vmcnt(0)" ::: "memory");
        }
#endif
    }
    __syncthreads();
}

#endif

#ifndef ATT_SDEPTH
#define ATT_SDEPTH 1
#endif
namespace att {
constexpr int D = 128, QBLK = 32, KVBLK = 64;
constexpr float SCALE = 0.088388347648318440f;
constexpr float THR = 8.f;
constexpr int SHM_V = KVBLK * D * 2, SHM_K = KVBLK * D * 2;
constexpr int OFF_WS = 2 * SHM_V + 2 * SHM_K;
constexpr int OFF_TB = OFF_WS + 8 * 64 * 4;
constexpr int OFF_FLG = OFF_TB + 448 * 4;
#define KSWZ(row, colB) ((row) * 256 + ((colB) ^ (((row) & 7) << 4)))
#define SBAR() __builtin_amdgcn_sched_barrier(0)
__device__ __forceinline__ int crow(int r, int hi) { return (r & 3) + 8 * (r >> 2) + 4 * hi; }
__device__ __forceinline__ unsigned cvtpk(float lo, float hi) { unsigned r; asm volatile("v_cvt_pk_bf16_f32 %0, %1, %2" : "=v"(r) : "v"(lo), "v"(hi)); return r; }

__device__ __forceinline__ void partialSM(f32x16& p0, f32x16& p1, float& m_reg, float& mn, float& alpha) {
  constexpr float C = SCALE * 1.4426950408889634f;
  float pmax = p0[0];
#pragma unroll
  for (int r = 1; r < 16; ++r) pmax = fmaxf(pmax, p0[r]);
#pragma unroll
  for (int r = 0; r < 16; ++r) pmax = fmaxf(pmax, p1[r]);
  { auto rr = __builtin_amdgcn_permlane32_swap(__float_as_uint(pmax), __float_as_uint(pmax), false, false);
    pmax = fmaxf(__uint_as_float(rr[0]), __uint_as_float(rr[1])); }
  if (__builtin_expect(__all(pmax - m_reg <= THR / SCALE), 1)) { mn = m_reg; alpha = 1.f; }
  else { mn = fmaxf(m_reg, pmax); alpha = __builtin_amdgcn_exp2f((m_reg - mn) * C); m_reg = mn; }
  float mnC = -mn * C;
#pragma unroll
  for (int r = 0; r < 16; ++r) p0[r] = fmaf(p0[r], C, mnC);
#pragma unroll
  for (int r = 0; r < 16; ++r) p1[r] = fmaf(p1[r], C, mnC);
#pragma unroll
  for (int r = 0; r < 16; ++r) p0[r] = __builtin_amdgcn_exp2f(p0[r]);
}
#define PK4(P, BASE, OUT) do { unsigned a0 = cvtpk(P[BASE + 0], P[BASE + 1]), a1 = cvtpk(P[BASE + 2], P[BASE + 3]);   \
    unsigned b0 = cvtpk(P[BASE + 4], P[BASE + 5]), b1 = cvtpk(P[BASE + 6], P[BASE + 7]);                              \
    auto r0 = __builtin_amdgcn_permlane32_swap(a0, b0, false, false); auto r1 = __builtin_amdgcn_permlane32_swap(a1, b1, false, false); \
    v4u w = {r0[0], r1[0], r0[1], r1[1]}; OUT = *reinterpret_cast<bf16x8*>(&w); } while (0)
__device__ __forceinline__ void finishSM(f32x16& p0, f32x16& p1, float alpha, float& l_reg, bf16x8& pa0, bf16x8& pa1, bf16x8& pa2, bf16x8& pa3) {
#pragma unroll
  for (int r = 0; r < 16; ++r) p1[r] = __builtin_amdgcn_exp2f(p1[r]);
  float ps = 0;
#pragma unroll
  for (int r = 0; r < 16; ++r) ps += p0[r];
#pragma unroll
  for (int r = 0; r < 16; ++r) ps += p1[r];
  { auto rr = __builtin_amdgcn_permlane32_swap(__float_as_uint(ps), __float_as_uint(ps), false, false);
    ps = __uint_as_float(rr[0]) + __uint_as_float(rr[1]); }
  l_reg = l_reg * alpha + ps;
  PK4(p0, 0, pa0); PK4(p0, 8, pa1); PK4(p1, 0, pa2); PK4(p1, 8, pa3);
}
__device__ __forceinline__ void packP(const f32x16& p0, const f32x16& p1, bf16x8& pa0, bf16x8& pa1, bf16x8& pa2, bf16x8& pa3) {
  PK4(p0, 0, pa0); PK4(p0, 8, pa1); PK4(p1, 0, pa2); PK4(p1, 8, pa3);
}
__device__ __forceinline__ void qkt(f32x16& p0, f32x16& p1, const char* Ks, const bf16x8* qr, int r32, int hi) {
  p0 = f32x16{}; p1 = f32x16{};
#pragma unroll
  for (int d0 = 0; d0 < 8; ++d0) { int cb = (d0 * 16 + hi * 8) * 2;
    bf16x8 b0 = *reinterpret_cast<const bf16x8*>(Ks + KSWZ(r32, cb));
    bf16x8 b1 = *reinterpret_cast<const bf16x8*>(Ks + KSWZ(32 + r32, cb));
    p0 = __builtin_amdgcn_mfma_f32_32x32x16_bf16(b0, qr[d0], p0, 0, 0, 0);
    p1 = __builtin_amdgcn_mfma_f32_32x32x16_bf16(b1, qr[d0], p1, 0, 0, 0); }
}
__device__ __forceinline__ int v_st(int k, int c) { const int kk = (k & ~0xC) | ((k & 4) << 1) | ((k & 8) >> 1); return ((kk >> 3) * 4 + (c >> 5)) * 512 + ((kk & 7) * 32 + (c & 31)) * 2; }
__device__ __forceinline__ int v_rd_base(int lane) { return ((lane & 3) << 3) | (((lane >> 2) & 3) << 6) | (((lane >> 4) & 1) << 5) | (((lane >> 5) & 1) << 8); }
constexpr int v_rd_off(int d0, int ks, int half) { return d0 * 512 + ks * 4096 + half * 2048; }
template <int OFF> __device__ __forceinline__ s16x4 tr_read(int vb) {
  s16x4 r; asm volatile("ds_read_b64_tr_b16 %0, %1 offset:%2" : "=&v"(r) : "v"(vb), "i"(OFF) : "memory"); return r;
}
template <int D0> __device__ __forceinline__ void pv_one(f32x16& od, int vb, bf16x8 pa0, bf16x8 pa1, bf16x8 pa2, bf16x8 pa3) {
  const s16x4 l0 = tr_read<v_rd_off(D0, 0, 0)>(vb), h0 = tr_read<v_rd_off(D0, 0, 1)>(vb), l1 = tr_read<v_rd_off(D0, 1, 0)>(vb), h1 = tr_read<v_rd_off(D0, 1, 1)>(vb);
  const s16x4 l2 = tr_read<v_rd_off(D0, 2, 0)>(vb), h2 = tr_read<v_rd_off(D0, 2, 1)>(vb), l3 = tr_read<v_rd_off(D0, 3, 0)>(vb), h3 = tr_read<v_rd_off(D0, 3, 1)>(vb);
  asm volatile("s_waitcnt lgkmcnt(0)" ::: "memory"); SBAR();
#define PKV(L, H) (bf16x8){L[0], L[1], L[2], L[3], H[0], H[1], H[2], H[3]}
  od = __builtin_amdgcn_mfma_f32_32x32x16_bf16(pa0, PKV(l0, h0), od, 0, 0, 0);
  od = __builtin_amdgcn_mfma_f32_32x32x16_bf16(pa1, PKV(l1, h1), od, 0, 0, 0);
  od = __builtin_amdgcn_mfma_f32_32x32x16_bf16(pa2, PKV(l2, h2), od, 0, 0, 0);
  od = __builtin_amdgcn_mfma_f32_32x32x16_bf16(pa3, PKV(l3, h3), od, 0, 0, 0);
#undef PKV
}
__device__ __forceinline__ void pv_d0(f32x16* o, int vb, bf16x8 pa0, bf16x8 pa1, bf16x8 pa2, bf16x8 pa3) {
  pv_one<0>(o[0], vb, pa0, pa1, pa2, pa3); pv_one<1>(o[1], vb, pa0, pa1, pa2, pa3); pv_one<2>(o[2], vb, pa0, pa1, pa2, pa3); pv_one<3>(o[3], vb, pa0, pa1, pa2, pa3);
}

__device__ __forceinline__ void* uniform_ptr(const void* p) { const unsigned long long v = (unsigned long long)p;
  const unsigned lo = (unsigned)__builtin_amdgcn_readfirstlane((int)(unsigned)v), hi = (unsigned)__builtin_amdgcn_readfirstlane((int)(unsigned)(v >> 32)); return (void*)(((unsigned long long)hi << 32) | lo); }
__device__ __forceinline__ bf16x8 mk8a(s16x4 l, s16x4 h) { return (bf16x8){l[0], l[1], l[2], l[3], h[0], h[1], h[2], h[3]}; }
__device__ __forceinline__ bf16x8 bload16(__amdgpu_buffer_rsrc_t rs, int voff, int soff) {
  const v4u w = __builtin_amdgcn_raw_buffer_load_b128(rs, voff, soff, 0); return __builtin_bit_cast(bf16x8, w); }
template <int LDP, int LDO>
__device__ __forceinline__ void attnB_unit(const bf16* __restrict__ Qb, const bf16* Pbase, int koff, int voff, float* __restrict__ Ob, int qb, char* lds) {
  const __amdgpu_buffer_rsrc_t rs = __builtin_amdgcn_make_buffer_rsrc(uniform_ptr(Pbase), 0, SEQ * LDP * 2, 0x00020000);
  int tid = threadIdx.x; asm volatile("" : "+v"(tid));
  const int wid = tid >> 6, lane = tid & 63, r32 = lane & 31, hi = lane >> 5;
  char* V_lds = lds; char* K_lds = lds + 2 * SHM_V;
  float* ws = (float*)(lds + OFF_WS) + wid * 64; float* li_l = ws; float* al_l = ws + 32;
  const float* tb = (const float*)(lds + OFF_TB);
  float m_reg = -1e30f, l_reg = 0; f32x16 o[4] = {}; bf16x8 qr[8];
  const bf16* Qw = Qb + (long)(wid * QBLK + r32) * LDP + hi * 8;
#pragma unroll
  for (int d0 = 0; d0 < 8; ++d0) qr[d0] = *reinterpret_cast<const bf16x8*>(Qw + d0 * 16);
  const int sr = tid >> 4, sc = (tid & 15) * 8, vst0 = v_st(sr, sc), vst1 = v_st(32 + sr, sc);
  const int vb0 = (int)(uintptr_t)V_lds + v_rd_base(lane);
  constexpr int SDEPTH = ATT_SDEPTH;
  struct { bf16x8 vs0, vs1, ks0, ks1; } sr_[SDEPTH];
  const int vo0 = (sr * LDP + sc) * 2, vo1 = vo0 + 32 * LDP * 2;
#define SLOAD(i, k0) do { const int sV_ = (voff + (k0) * LDP) * 2, sK_ = (koff + (k0) * LDP) * 2; \
    sr_[i].vs0 = bload16(rs, vo0, sV_); sr_[i].vs1 = bload16(rs, vo1, sV_); sr_[i].ks0 = bload16(rs, vo0, sK_); sr_[i].ks1 = bload16(rs, vo1, sK_); } while (0)
#define SWRITE(b, i) do { *(bf16x8*)(V_lds + (b) * SHM_V + vst0) = sr_[i].vs0;          \
    *(bf16x8*)(V_lds + (b) * SHM_V + vst1) = sr_[i].vs1; int kc = sc * 2;               \
    *(bf16x8*)(K_lds + (b) * SHM_K + KSWZ(sr, kc)) = sr_[i].ks0;                       \
    *(bf16x8*)(K_lds + (b) * SHM_K + KSWZ(32 + sr, kc)) = sr_[i].ks1; } while (0)
#define SWAIT() do { if constexpr (SDEPTH == 2) asm volatile("s_waitcnt vmcnt(4)" ::: "memory"); else asm volatile("s_waitcnt vmcnt(0)" ::: "memory"); } while (0)
#define RESC(a) do { if (__any((a) < 1.f)) { if (hi == 0) al_l[r32] = (a); asm volatile("s_waitcnt lgkmcnt(0)" ::: "memory"); \
    _Pragma("unroll") for (int d = 0; d < 4; ++d) _Pragma("unroll") for (int r = 0; r < 16; ++r) o[d][r] *= al_l[crow(r, hi)]; } } while (0)
  const int NT = 4 * qb + 4, chunk_w = 4 * qb + (wid >> 1);
  const int ib0 = 4 * hi - 256 * qb - 32 * wid - r32 + 127 + 256;
#ifdef NO_FIX
#define FIX(P0, P1, j) do {} while (0)
#else
#define FIX(P0, P1, j) do { if ((j) > chunk_w) { _Pragma("unroll") for (int r = 0; r < 16; ++r) { P0[r] = -1e30f; P1[r] = -1e30f; } } \
    else if ((j) >= NT - 6) { const float* tbj = tb + (ib0 + 64 * (j)); \
      _Pragma("unroll") for (int r = 0; r < 16; ++r) { P0[r] += tbj[(r & 3) + 8 * (r >> 2)]; P1[r] += tbj[32 + (r & 3) + 8 * (r >> 2)]; } } } while (0)
#endif
  f32x16 pA0, pA1, pB0, pB1; float mnA, mnB, alA, alB; bf16x8 pa0, pa1, pa2, pa3;
  constexpr int SE = 0, SO = SDEPTH - 1;
  SLOAD(SE, 0); asm volatile("s_waitcnt vmcnt(0)" ::: "memory"); SWRITE(0, SE); __syncthreads();
  qkt(pA0, pA1, K_lds, qr, r32, hi); FIX(pA0, pA1, 0); partialSM(pA0, pA1, m_reg, mnA, alA);
  SLOAD(SO, KVBLK); if constexpr (SDEPTH == 2) { if (2 < NT) SLOAD(SE, 2 * KVBLK); }
  SWAIT(); SWRITE(1, SO); __syncthreads();
  for (int j = 1; j + 1 < NT; j += 2) {
    SBAR(); qkt(pB0, pB1, K_lds + SHM_K, qr, r32, hi);
    finishSM(pA0, pA1, alA, l_reg, pa0, pa1, pa2, pa3); SBAR();
    SLOAD(SO, (j + SDEPTH) * KVBLK); SBAR();
    pv_d0(o, vb0, pa0, pa1, pa2, pa3); FIX(pB0, pB1, j); partialSM(pB0, pB1, m_reg, mnB, alB);
    __syncthreads(); SWAIT(); SWRITE(0, SE);
    RESC(alB); __syncthreads();
    SBAR(); qkt(pA0, pA1, K_lds, qr, r32, hi);
    finishSM(pB0, pB1, alB, l_reg, pa0, pa1, pa2, pa3); SBAR();
    if (SDEPTH == 1 || j + 3 < NT) SLOAD(SE, (j + 1 + SDEPTH) * KVBLK); SBAR();
    pv_d0(o, vb0 + SHM_V, pa0, pa1, pa2, pa3); FIX(pA0, pA1, j + 1); partialSM(pA0, pA1, m_reg, mnA, alA);
    __syncthreads(); SWAIT(); SWRITE(1, SO);
    RESC(alA); __syncthreads();
  }
  SBAR(); qkt(pB0, pB1, K_lds + SHM_K, qr, r32, hi);
  finishSM(pA0, pA1, alA, l_reg, pa0, pa1, pa2, pa3); SBAR();
  pv_d0(o, vb0, pa0, pa1, pa2, pa3); FIX(pB0, pB1, NT - 1); partialSM(pB0, pB1, m_reg, mnB, alB);
  __syncthreads(); RESC(alB);
  finishSM(pB0, pB1, alB, l_reg, pa0, pa1, pa2, pa3); SBAR();
  pv_d0(o, vb0 + SHM_V, pa0, pa1, pa2, pa3);
  if (hi == 0) li_l[r32] = l_reg; asm volatile("s_waitcnt lgkmcnt(0)" ::: "memory");
  float rli[16];
#pragma unroll
  for (int r = 0; r < 16; ++r) rli[r] = __builtin_amdgcn_rcpf(li_l[crow(r, hi)]);
  float* Ow = Ob + (long)(wid * QBLK) * LDO;
#pragma unroll
  for (int r = 0; r < 16; ++r) { int orow = crow(r, hi);
#pragma unroll
    for (int d0 = 0; d0 < 4; ++d0) Ow[(long)orow * LDO + d0 * 32 + r32] = o[d0][r] * rli[r]; }
  __syncthreads();
#undef SLOAD
#undef SWRITE
#undef SWAIT
#undef RESC
#undef FIX
}

__device__ __forceinline__ void glds16_asm(const void* gsrc, unsigned lds_dst) { unsigned keep;
  asm volatile("s_mov_b32 %0, m0\n\ts_mov_b32 m0, %2\n\ts_nop 0\n\tglobal_load_lds_dwordx4 %1, off\n\ts_mov_b32 m0, %0" : "=&s"(keep) : "v"(gsrc), "s"(lds_dst) : "memory"); }
constexpr int B2_K = 0, B2_V = 2 * SHM_K, B2_P = B2_V + 4 * SHM_V, B2_X = 131072 + 1024;
constexpr int B2_AL = B2_X, B2_FL = B2_AL + 1024, B2_LI = B2_FL + 64, B2_TB = B2_LI + 512;
template <int LDP, int LDO>
__device__ __forceinline__ void attnB2_unit(const bf16* __restrict__ Qb, const bf16* Pbase, int koff, int voff, float* __restrict__ Ob, int q128, char* lds, int sel = 0) {
  int tid = threadIdx.x; asm volatile("" : "+v"(tid));
  const int wid = __builtin_amdgcn_readfirstlane(tid >> 6), lane = tid & 63, r32 = lane & 31, hi = lane >> 5, pw = wid & 3;
  const int NT = 2 * q128 + 2;
  const unsigned lbase = (unsigned)__builtin_amdgcn_readfirstlane((int)(uintptr_t)lds);
  const bf16* Ksrc; const bf16* Vsrc[4];
  { const int row0 = 8 * wid + (lane >> 4), row1 = row0 + 4;
    Ksrc = Pbase + koff + (size_t)row0 * LDP + (((lane & 15) ^ (row0 & 7)) << 3);
    (void)row1; }
  const int kx1 = (int)((((lane & 15) ^ ((8 * wid + (lane >> 4) + 4) & 7)) << 3)) - (int)((((lane & 15) ^ ((8 * wid + (lane >> 4)) & 7)) << 3));
#pragma unroll
  for (int q = 0; q < 4; ++q) { const int ci = wid * 4 + q, vt = ci >> 4, cs = ci & 15, st = cs * 2 + (lane >> 5);
    const int kk = (st >> 2) * 8 + ((lane >> 2) & 7), k = (kk & ~0xC) | ((kk & 4) << 1) | ((kk & 8) >> 1), c = vt * 128 + (st & 3) * 32 + (lane & 3) * 8;
    Vsrc[q] = Pbase + voff + (size_t)k * LDP + c; }
#define B2DMA_K(t_, b_) do { const bf16* ks_ = Ksrc + (size_t)(t_) * KVBLK * LDP; const unsigned kd_ = (unsigned)__builtin_amdgcn_readfirstlane((int)(lbase + B2_K + (b_) * SHM_K + wid * 2048)); \
    glds16_asm(ks_, kd_); glds16_asm(ks_ + 4 * LDP + kx1, kd_ + 1024); } while (0)
#define B2DMA_V(t_, b_) do { _Pragma("unroll") for (int q = 0; q < 4; ++q) { const int ci_ = wid * 4 + q; \
      glds16_asm(Vsrc[q] + (size_t)(t_) * KVBLK * LDP, (unsigned)__builtin_amdgcn_readfirstlane((int)(lbase + B2_V + (b_) * 2 * SHM_V + (ci_ >> 4) * SHM_V + (ci_ & 15) * 1024))); } } while (0)
#define B2SYNC() do { asm volatile("s_waitcnt vmcnt(0)" ::: "memory"); __syncthreads(); } while (0)
  typedef __attribute__((address_space(3))) float lds_f32; typedef __attribute__((address_space(3))) int lds_i32;
  lds_f32* al_s = (lds_f32*)(uintptr_t)(lbase + B2_AL); lds_i32* fl_s = (lds_i32*)(uintptr_t)(lbase + B2_FL); lds_f32* li_s = (lds_f32*)(uintptr_t)(lbase + B2_LI);
  B2DMA_K(0, 0); B2DMA_V(0, 0); B2DMA_K(1, 1);
  if (wid < 4) {
    const float* tb = (const float*)(lds + B2_TB);
    const int chunk_w = 2 * q128 + (pw >> 1);
    const int ib0 = 4 * hi - 128 * q128 - 32 * pw - r32 + 127 + 256;
    float m_reg = -1e30f, l_reg = 0.f; bf16x8 qr[8];
    { const bf16* Qw = Qb + (long)(pw * QBLK + r32) * LDP + hi * 8;
#pragma unroll
      for (int d0 = 0; d0 < 8; ++d0) qr[d0] = *reinterpret_cast<const bf16x8*>(Qw + d0 * 16); }
    B2SYNC();
#define B2PROD(t_) do { f32x16 p0, p1; qkt(p0, p1, lds + B2_K + ((t_) & 1) * SHM_K, qr, r32, hi); \
      if ((t_) > chunk_w) { _Pragma("unroll") for (int r = 0; r < 16; ++r) { p0[r] = -1e30f; p1[r] = -1e30f; } } \
      else if ((t_) >= NT - 4) { const float* tbj = tb + (ib0 + 64 * (t_)); \
        _Pragma("unroll") for (int r = 0; r < 16; ++r) { p0[r] += tbj[(r & 3) + 8 * (r >> 2)]; p1[r] += tbj[32 + (r & 3) + 8 * (r >> 2)]; } } \
      float mn_, al_; partialSM(p0, p1, m_reg, mn_, al_); bf16x8 pa0, pa1, pa2, pa3; finishSM(p0, p1, al_, l_reg, pa0, pa1, pa2, pa3); \
      char* pb_ = lds + B2_P + ((((t_) & 1) * 4 + pw) * 4) * 1024 + lane * 16; \
      *(bf16x8*)(pb_) = pa0; *(bf16x8*)(pb_ + 1024) = pa1; *(bf16x8*)(pb_ + 2048) = pa2; *(bf16x8*)(pb_ + 3072) = pa3; \
      if (hi == 0) al_s[(((t_) & 1) * 4 + pw) * 32 + r32] = al_; \
      const int any_ = __any(al_ < 1.f) ? 1 : 0; if (lane == 0) fl_s[((t_) & 1) * 4 + pw] = any_; } while (0)
    B2PROD(0);
    B2SYNC();
    for (int j = 0; j < NT; ++j) {
      if (j + 2 < NT) B2DMA_K(j + 2, j & 1);
      if (j + 1 < NT) B2DMA_V(j + 1, (j + 1) & 1);
      if (j + 1 < NT && !(sel & 4)) B2PROD(j + 1);
      B2SYNC();
    }
    if (hi == 0) li_s[pw * 32 + r32] = __builtin_amdgcn_rcpf(l_reg);
    __syncthreads();
#undef B2PROD
  } else {
    f32x16 o[8] = {};
    const int vb0 = (int)(uintptr_t)(lds + B2_V) + v_rd_base(lane);
    B2SYNC();
    B2SYNC();
    for (int j = 0; j < NT; ++j) {
      if (j + 2 < NT) B2DMA_K(j + 2, j & 1);
      if (j + 1 < NT) B2DMA_V(j + 1, (j + 1) & 1);
      if (!(sel & 8)) { const int bsel = j & 1;
        if (fl_s[bsel * 4 + pw]) { const lds_f32* ap = al_s + (bsel * 4 + pw) * 32;
#pragma unroll
          for (int d = 0; d < 8; ++d)
#pragma unroll
            for (int r = 0; r < 16; ++r) o[d][r] *= ap[crow(r, hi)]; }
        const char* pb_ = lds + B2_P + ((bsel * 4 + pw) * 4) * 1024 + lane * 16;
        const bf16x8 pa0 = *(const bf16x8*)(pb_), pa1 = *(const bf16x8*)(pb_ + 1024), pa2 = *(const bf16x8*)(pb_ + 2048), pa3 = *(const bf16x8*)(pb_ + 3072);
        pv_d0(o, vb0 + bsel * 2 * SHM_V, pa0, pa1, pa2, pa3); pv_d0(o + 4, vb0 + bsel * 2 * SHM_V + SHM_V, pa0, pa1, pa2, pa3); }
      B2SYNC();
    }
    __syncthreads();
    float rli[16];
#pragma unroll
    for (int r = 0; r < 16; ++r) rli[r] = li_s[pw * 32 + crow(r, hi)];
    float* Ow = Ob + (long)(pw * QBLK) * LDO;
#pragma unroll
    for (int r = 0; r < 16; ++r) { const int orow = crow(r, hi);
#pragma unroll
      for (int d = 0; d < 8; ++d) Ow[(long)orow * LDO + d * 32 + r32] = o[d][r] * rli[r]; }
  }
  __syncthreads();
#undef B2DMA_K
#undef B2DMA_V
#undef B2SYNC
}

template <int LDP, int LDO>
__device__ __forceinline__ void attnA_unit(const bf16* __restrict__ Qb, const bf16* Pbase, int koff, int voff, bf16* __restrict__ Ob, int qb, char* lds) {
  const __amdgpu_buffer_rsrc_t rs = __builtin_amdgcn_make_buffer_rsrc(uniform_ptr(Pbase), 0, SEQ * LDP * 2, 0x00020000);
  int tid = threadIdx.x; asm volatile("" : "+v"(tid));
  const int wid = __builtin_amdgcn_readfirstlane(tid >> 6), lane = tid & 63, r32 = lane & 31, hi = lane >> 5;
  char* K_lds = lds + wid * 16384; char* V_lds = K_lds + 8192;
  f32x16 o[4] = {}; bf16x8 qr[8];
  const bf16* Qw = Qb + (long)(wid * QBLK + r32) * LDP + hi * 8;
#pragma unroll
  for (int d0 = 0; d0 < 8; ++d0) qr[d0] = *reinterpret_cast<const bf16x8*>(Qw + d0 * 16);
  const int srow = lane >> 1, scol = (lane & 1) * 64;
  const int vo = (srow * LDP + scol) * 2;
  const int vb0 = (int)(uintptr_t)V_lds + v_rd_base(lane);
  const int krow = lane >> 4, kch = lane & 15;
  const unsigned klds = (unsigned)__builtin_amdgcn_readfirstlane((int)(uintptr_t)K_lds);
  const bf16* Ksrc = Pbase + koff;
  float R = 0.f;
  const int htd = 8 * qb + wid;
  bf16x8 tv[8];
#define AKDMA(ht_) do { _Pragma("unroll") for (int j = 0; j < 8; ++j) { const int row_ = 4 * j + krow; \
      __builtin_amdgcn_global_load_lds((const unsigned*)(Ksrc + (size_t)((ht_) * 32 + row_) * LDP + ((kch ^ (row_ & 7)) << 3)), (__attribute__((address_space(3))) unsigned*)(uintptr_t)(klds + j * 1024), 16, 0, 0); } } while (0)
#define AVLOAD(ht_) do { const int sV_ = __builtin_amdgcn_readfirstlane((voff + (ht_) * 32 * LDP) * 2); _Pragma("unroll") for (int j = 0; j < 8; ++j) tv[j] = bload16(rs, vo + 16 * j, sV_); } while (0)
  AKDMA(htd); AVLOAD(htd);
  for (int ht = htd; ht >= 0; --ht) {
    asm volatile("s_waitcnt vmcnt(0)" ::: "memory");
#pragma unroll
    for (int j = 0; j < 8; ++j) *(bf16x8*)(V_lds + v_st(srow, scol + 8 * j)) = tv[j];
    if (ht > 0) AVLOAD(ht - 1);
    asm volatile("s_waitcnt lgkmcnt(0)" ::: "memory");
    f32x16 p0 = f32x16{};
#pragma unroll
    for (int d0 = 0; d0 < 8; ++d0) { const int cb = (d0 * 16 + hi * 8) * 2;
      const bf16x8 b0 = *reinterpret_cast<const bf16x8*>(K_lds + KSWZ(r32, cb));
      p0 = __builtin_amdgcn_mfma_f32_32x32x16_bf16(b0, qr[d0], p0, 0, 0, 0); }
    asm volatile("s_waitcnt lgkmcnt(0)" : "+v"(p0) :: "memory");
    if (ht > 0) AKDMA(ht - 1);
    const int lim = (ht == htd) ? r32 : 32;
    float qs[4], oq[4]; f32x16 Ln;
#pragma unroll
    for (int g = 0; g < 4; ++g) { float s_ = 0.f;
#pragma unroll
      for (int i = 0; i < 4; ++i) { const int r = 4 * g + i; const float x = p0[r] * SCALE; p0[r] = x;
        const float sp = __logf(1.f + __expf(-fabsf(x))); const float ln = (crow(r, hi) < lim) ? -(fmaxf(x, 0.f) + sp) : 0.f;
        Ln[r] = ln; s_ += ln; }
      qs[g] = s_; }
#pragma unroll
    for (int g = 0; g < 4; ++g) oq[g] = __shfl_xor(qs[g], 32);
    float run = 0.f;
#pragma unroll
    for (int g = 3; g >= 0; --g) { float E = R + run + (hi == 0 ? oq[g] : 0.f);
#pragma unroll
      for (int i = 3; i >= 0; --i) { const int r = 4 * g + i;
        const bool valid = crow(r, hi) < lim;
        const float w = valid ? __expf(Ln[r] + p0[r] + E) : 0.f; E += Ln[r]; p0[r] = w; }
      run += qs[g] + oq[g]; }
    R += run;
    bf16x8 pa0, pa1; PK4(p0, 0, pa0); PK4(p0, 8, pa1);
#define AV_ONE(D0) do { const s16x4 l0 = tr_read<v_rd_off(D0, 0, 0)>(vb0), h0 = tr_read<v_rd_off(D0, 0, 1)>(vb0), l1 = tr_read<v_rd_off(D0, 1, 0)>(vb0), h1 = tr_read<v_rd_off(D0, 1, 1)>(vb0); \
      asm volatile("s_waitcnt lgkmcnt(0)" ::: "memory"); SBAR(); \
      o[D0] = __builtin_amdgcn_mfma_f32_32x32x16_bf16(pa0, mk8a(l0, h0), o[D0], 0, 0, 0); o[D0] = __builtin_amdgcn_mfma_f32_32x32x16_bf16(pa1, mk8a(l1, h1), o[D0], 0, 0, 0); } while (0)
    AV_ONE(0); AV_ONE(1); AV_ONE(2); AV_ONE(3);
#undef AV_ONE
    if (__all(R < -104.f)) break;
  }
#undef AKDMA
#undef AVLOAD
  asm volatile("s_waitcnt vmcnt(0)" ::: "memory");
  bf16* Ow = Ob + (long)(wid * QBLK) * LDO;
#pragma unroll
  for (int r = 0; r < 16; ++r) { const int orow = crow(r, hi);
#pragma unroll
    for (int d0 = 0; d0 < 4; ++d0) Ow[(long)orow * LDO + d0 * 32 + r32] = (bf16)f2bf(o[d0][r]); }
  __syncthreads();
}
__device__ __forceinline__ bf16x8 mk8(s16x4 l, s16x4 h) { return (bf16x8){l[0], l[1], l[2], l[3], h[0], h[1], h[2], h[3]}; }
__device__ __forceinline__ v4u pack8(const float* f) { v4u w; w.x = cvtpk(f[0], f[1]); w.y = cvtpk(f[2], f[3]); w.z = cvtpk(f[4], f[5]); w.w = cvtpk(f[6], f[7]); return w; }
__device__ __forceinline__ void rot8(v4u lo4, v4u hi4, const float2* cs, float mul, float* ol, float* oh) {
#pragma unroll
  for (int q = 0; q < 4; ++q) { const float2 c0 = cs[2 * q], c1 = cs[2 * q + 1];
    const float l0 = bflo(lo4[q]), l1 = bfhi(lo4[q]), h0 = bflo(hi4[q]), h1 = bfhi(hi4[q]);
    ol[2 * q] = (l0 * c0.x - h0 * c0.y) * mul; ol[2 * q + 1] = (l1 * c1.x - h1 * c1.y) * mul;
    oh[2 * q] = (h0 * c0.x + l0 * c0.y) * mul; oh[2 * q + 1] = (h1 * c1.x + l1 * c1.y) * mul; }
}
template <int LDP>
__device__ __forceinline__ void ret_kv_unit(const bf16* __restrict__ P, const float2* __restrict__ ROPE, bf16* __restrict__ kvo, int b, int h, int n, char* lds) {
  int tid = threadIdx.x; asm volatile("" : "+v"(tid));
  const int wid = tid >> 6, lane = tid & 63, r32 = lane & 31, hi = lane >> 5;
  char* Vt = lds; char* Kt = lds + 2 * SHM_V;
  const size_t t0 = (size_t)b * SEQ + 64 * n;
  const float lg = __logf(1.f - exp2f(-5.f - (float)h));
  {
    bf16x8 vv[4];
#pragma unroll
    for (int it = 0; it < 4; ++it) { const int task = it * 512 + tid, vt = task >> 10, row = (task >> 4) & 63, sc = (task & 15) * 8;
      vv[it] = *reinterpret_cast<const bf16x8*>(P + (t0 + row) * LDP + 1024 + h * 256 + vt * 128 + sc); }
    const int m = tid >> 3, dc = (tid & 7) * 8; const bf16* kr = P + (t0 + m) * LDP + 512 + h * 128;
    const v4u lo4 = *(const v4u*)(kr + dc), hi4 = *(const v4u*)(kr + 64 + dc);
    float2 csv[8]; { const float2* cs = ROPE + (size_t)(64 * n + m) * 64 + dc;
#pragma unroll
      for (int q = 0; q < 8; ++q) csv[q] = cs[q]; }
#pragma unroll
    for (int it = 0; it < 4; ++it) { const int task = it * 512 + tid, vt = task >> 10, row = (task >> 4) & 63, sc = (task & 15) * 8;
      *(bf16x8*)(Vt + vt * SHM_V + v_st(row, sc)) = vv[it]; }
    float ol[8], oh[8]; rot8(lo4, hi4, csv, __expf(lg * (float)(63 - m)), ol, oh);
    *(v4u*)(Kt + v_st(m, dc)) = pack8(ol); *(v4u*)(Kt + v_st(m, 64 + dc)) = pack8(oh); }
  __syncthreads();
  const int vbA = (int)(uintptr_t)(Vt + (wid >> 2) * SHM_V) + v_rd_base(lane) + (wid & 3) * 512;
  const int vbB = (int)(uintptr_t)Kt + v_rd_base(lane);
  bf16x8 a[4];
  { const s16x4 l0 = tr_read<v_rd_off(0, 0, 0)>(vbA), h0 = tr_read<v_rd_off(0, 0, 1)>(vbA), l1 = tr_read<v_rd_off(0, 1, 0)>(vbA), h1 = tr_read<v_rd_off(0, 1, 1)>(vbA);
    const s16x4 l2 = tr_read<v_rd_off(0, 2, 0)>(vbA), h2 = tr_read<v_rd_off(0, 2, 1)>(vbA), l3 = tr_read<v_rd_off(0, 3, 0)>(vbA), h3 = tr_read<v_rd_off(0, 3, 1)>(vbA);
    asm volatile("s_waitcnt lgkmcnt(0)" ::: "memory"); SBAR();
    a[0] = mk8(l0, h0); a[1] = mk8(l1, h1); a[2] = mk8(l2, h2); a[3] = mk8(l3, h3); }
  f32x16 acc[4] = {};
  pv_one<0>(acc[0], vbB, a[0], a[1], a[2], a[3]); pv_one<1>(acc[1], vbB, a[0], a[1], a[2], a[3]); pv_one<2>(acc[2], vbB, a[0], a[1], a[2], a[3]); pv_one<3>(acc[3], vbB, a[0], a[1], a[2], a[3]);
#pragma unroll
  for (int db = 0; db < 4; ++db)
#pragma unroll
    for (int r = 0; r < 16; ++r) kvo[(size_t)(32 * wid + crow(r, hi)) * 128 + 32 * db + r32] = (bf16)f2bf(acc[db][r]);
  __syncthreads();
}
template <int LDP, int LDO>
__device__ __forceinline__ void ret_out_unit(const bf16* __restrict__ P, const float2* __restrict__ ROPE, const bf16* __restrict__ PREV, const float* __restrict__ rg, bf16* __restrict__ O, int b, int h, int np, char* lds) {
  int tid = threadIdx.x; asm volatile("" : "+v"(tid));
  const int wid = tid >> 6, lane = tid & 63, r32 = lane & 31, hi = lane >> 5;
  const int cw = wid >> 2, qh = (wid >> 1) & 1, eh = wid & 1, bh = b * 4 + h;
  constexpr int CH = 3 * SHM_V;
  float* red = (float*)(lds + 2 * CH);
  const float lg = __logf(1.f - exp2f(-5.f - (float)h));
  { v4u klo[2], khi[2]; float2 csv[2][8]; bf16x8 vv[2][4]; const int m = tid >> 3, dc = (tid & 7) * 8;
#pragma unroll
    for (int cc = 0; cc < 2; ++cc) { const int n = 2 * np + cc; const size_t t0 = (size_t)b * SEQ + 64 * n;
      const bf16* kr = P + (t0 + m) * LDP + 512 + h * 128; klo[cc] = *(const v4u*)(kr + dc); khi[cc] = *(const v4u*)(kr + 64 + dc);
      const float2* cs = ROPE + (size_t)(64 * n + m) * 64 + dc;
#pragma unroll
      for (int q = 0; q < 8; ++q) csv[cc][q] = cs[q];
#pragma unroll
      for (int it = 0; it < 4; ++it) { const int task = it * 512 + tid, vt = task >> 10, row = (task >> 4) & 63, sc = (task & 15) * 8;
        vv[cc][it] = *reinterpret_cast<const bf16x8*>(P + (t0 + row) * LDP + 1024 + h * 256 + vt * 128 + sc); } }
#pragma unroll
    for (int cc = 0; cc < 2; ++cc) { float ol[8], oh[8]; rot8(klo[cc], khi[cc], csv[cc], 1.f, ol, oh);
      *(v4u*)(lds + cc * CH + KSWZ(m, dc * 2)) = pack8(ol); *(v4u*)(lds + cc * CH + KSWZ(m, (64 + dc) * 2)) = pack8(oh);
#pragma unroll
      for (int it = 0; it < 4; ++it) { const int task = it * 512 + tid, vt = task >> 10, row = (task >> 4) & 63, sc = (task & 15) * 8;
        *(bf16x8*)(lds + cc * CH + SHM_V + vt * SHM_V + v_st(row, sc)) = vv[cc][it]; } } }
  const int n = 2 * np + cw; const size_t tq = (size_t)b * SEQ + 64 * n + 32 * qh + r32;
  bf16x8 qr[8];
  { const bf16* qrow = P + tq * LDP + h * 128 + hi * 8; const float2* cs = ROPE + (size_t)(64 * n + 32 * qh + r32) * 64 + hi * 8;
#pragma unroll
    for (int d0 = 0; d0 < 4; ++d0) { const v4u lo4 = *(const v4u*)(qrow + d0 * 16), hi4 = *(const v4u*)(qrow + 64 + d0 * 16);
      float ol[8], oh[8]; rot8(lo4, hi4, cs + d0 * 16, SCALE, ol, oh);
      const v4u wl = pack8(ol), wh = pack8(oh); qr[d0] = __builtin_bit_cast(bf16x8, wl); qr[d0 + 4] = __builtin_bit_cast(bf16x8, wh); } }
  f32x16 o[4] = {};
  { const bf16* pv = PREV + ((size_t)bh * 64 + n) * 32768 + (size_t)(128 * eh + r32) * 128 + hi * 8;
    bf16x8 bc[8], bn[8];
#pragma unroll
    for (int ks = 0; ks < 8; ++ks) bc[ks] = *reinterpret_cast<const bf16x8*>(pv + ks * 16);
#pragma unroll
    for (int d0 = 0; d0 < 4; ++d0) {
      if (d0 < 3) {
#pragma unroll
        for (int ks = 0; ks < 8; ++ks) bn[ks] = *reinterpret_cast<const bf16x8*>(pv + (size_t)(32 * (d0 + 1)) * 128 + ks * 16); }
      __builtin_amdgcn_sched_barrier(0);
#pragma unroll
      for (int ks = 0; ks < 8; ++ks) o[d0] = __builtin_amdgcn_mfma_f32_32x32x16_bf16(qr[ks], bc[ks], o[d0], 0, 0, 0);
      __builtin_amdgcn_sched_barrier(0);
      if (d0 < 3) {
#pragma unroll
        for (int ks = 0; ks < 8; ++ks) bc[ks] = bn[ks]; } } }
#pragma unroll
  for (int r = 0; r < 16; ++r) { const float qd = __expf(lg * (float)(32 * qh + crow(r, hi) + 1));
#pragma unroll
    for (int d0 = 0; d0 < 4; ++d0) o[d0][r] *= qd; }
  __syncthreads();
  { f32x16 p0, p1; qkt(p0, p1, lds + cw * CH, qr, r32, hi);
    const int c = 32 * qh + r32;
#pragma unroll
    for (int r = 0; r < 16; ++r) { const int m0 = crow(r, hi), m1 = m0 + 32; const int d0_ = c > m0 ? c - m0 : m0 - c, d1_ = c > m1 ? c - m1 : m1 - c;
      p0[r] *= __expf(lg * (float)d0_); p1[r] *= __expf(lg * (float)d1_); }
    bf16x8 pa0, pa1, pa2, pa3; packP(p0, p1, pa0, pa1, pa2, pa3);
    pv_d0(o, (int)(uintptr_t)(lds + cw * CH + SHM_V + eh * SHM_V) + v_rd_base(lane), pa0, pa1, pa2, pa3); }
  { float ssq[16];
#pragma unroll
    for (int r = 0; r < 16; ++r) { float s_ = (o[0][r] * o[0][r] + o[1][r] * o[1][r]) + (o[2][r] * o[2][r] + o[3][r] * o[3][r]);
      s_ += __shfl_xor(s_, 1); s_ += __shfl_xor(s_, 2); s_ += __shfl_xor(s_, 4); s_ += __shfl_xor(s_, 8); s_ += __shfl_xor(s_, 16); ssq[r] = s_; }
    if (r32 == 0) {
#pragma unroll
      for (int r = 0; r < 16; ++r) red[wid * 32 + crow(r, hi)] = ssq[r]; }
    __syncthreads();
    const size_t trow0 = (size_t)b * SEQ + 64 * n + 32 * qh;
    bf16 gv[16][4];
#pragma unroll
    for (int r = 0; r < 16; ++r)
#pragma unroll
      for (int d0 = 0; d0 < 4; ++d0) gv[r][d0] = P[(trow0 + crow(r, hi)) * LDP + 2048 + h * 256 + 128 * eh + 32 * d0 + r32];
#pragma unroll
    for (int r = 0; r < 16; ++r) { const int rl = crow(r, hi); const float tot = red[wid * 32 + rl] + red[(wid ^ 1) * 32 + rl]; const float rstd = rsqrtf(tot * (1.f / 256.f) + 1e-6f);
      const size_t row = trow0 + rl;
#pragma unroll
      for (int d0 = 0; d0 < 4; ++d0) { const int e = 128 * eh + 32 * d0 + r32;
        const float gate = silu_f(bf2f(gv[r][d0]));
        O[row * LDO + h * 256 + e] = (bf16)f2bf(o[d0][r] * rstd * rg[e] * gate); } } }
  __syncthreads();
}
template <int LDP, int LDO>
__device__ __forceinline__ void sgu_unit(const bf16* __restrict__ P, const unsigned long long* __restrict__ lnsum, const float* __restrict__ lng, const float* __restrict__ lnb, const float* __restrict__ Wg, const float* __restrict__ bs,
                                         bf16* __restrict__ O, size_t t0, int g, char* lds) {
  int tid = threadIdx.x; asm volatile("" : "+v"(tid));
  const int wid = tid >> 6, lane = tid & 63, r32 = lane & 31, hi = lane >> 5;
  { const int cc = (tid & 31) * 8;
    v4u vin[8]; unsigned long long s1v[8], s2v[8];
#pragma unroll
    for (int it = 0; it < 8; ++it) { const int j = it * 16 + (tid >> 5);
      vin[it] = *(const v4u*)(P + (t0 + j) * LDP + 4096 + g * 256 + cc); s1v[it] = lnsum[2 * (t0 + j)]; s2v[it] = lnsum[2 * (t0 + j) + 1]; }
    const f32x4 g0 = *(const f32x4*)(lng + g * 256 + cc), g1 = *(const f32x4*)(lng + g * 256 + cc + 4), b0 = *(const f32x4*)(lnb + g * 256 + cc), b1 = *(const f32x4*)(lnb + g * 256 + cc + 4);
#pragma unroll
    for (int it = 0; it < 8; ++it) { const int j = it * 16 + (tid >> 5); const v4u v4 = vin[it];
      const float s1 = (float)(long long)s1v[it] * (1.f / 16777216.f), s2 = (float)(long long)s2v[it] * (1.f / 16777216.f); const float mean = s1 * (1.f / 1024.f); const float rstd = rsqrtf(fmaxf(s2 * (1.f / 1024.f) - mean * mean, 0.f) + 1e-6f);
      float y[8];
#pragma unroll
      for (int q = 0; q < 4; ++q) { y[2 * q] = gelu_tanh(bflo(v4[q])); y[2 * q + 1] = gelu_tanh(bfhi(v4[q])); }
#pragma unroll
      for (int q = 0; q < 4; ++q) { y[q] = (y[q] - mean) * rstd * g0[q] + b0[q]; y[4 + q] = (y[4 + q] - mean) * rstd * g1[q] + b1[q]; }
      *(v4u*)(lds + ((j >> 6) * 2 + (cc >> 7)) * SHM_V + v_st(j & 63, cc & 127)) = pack8(y); } }
  const int ib = wid & 3, ct = wid >> 2;
  bf16x8 wa[8];
  { const float* wr = Wg + (size_t)(32 * ib + r32) * 128 + hi * 8;
#pragma unroll
    for (int ks = 0; ks < 8; ++ks) { if (ks < 4 || ib >= 2) { const f32x4 a0 = *(const f32x4*)(wr + ks * 16), a1 = *(const f32x4*)(wr + ks * 16 + 4);
        v4u w; w.x = cvtpk(a0[0], a0[1]); w.y = cvtpk(a0[2], a0[3]); w.z = cvtpk(a1[0], a1[1]); w.w = cvtpk(a1[2], a1[3]); wa[ks] = __builtin_bit_cast(bf16x8, w); }
      else wa[ks] = (bf16x8){0, 0, 0, 0, 0, 0, 0, 0}; } }
  __syncthreads();
  f32x16 o[4] = {};
  pv_d0(o, (int)(uintptr_t)(lds + (0 * 2 + ct) * SHM_V) + v_rd_base(lane), wa[0], wa[1], wa[2], wa[3]);
  if (ib >= 2) pv_d0(o, (int)(uintptr_t)(lds + (1 * 2 + ct) * SHM_V) + v_rd_base(lane), wa[4], wa[5], wa[6], wa[7]);
  { bf16 uv[16][4];
#pragma unroll
    for (int r = 0; r < 16; ++r)
#pragma unroll
      for (int d0 = 0; d0 < 4; ++d0) uv[r][d0] = P[(t0 + 32 * ib + crow(r, hi)) * LDP + 3072 + g * 256 + 128 * ct + 32 * d0 + r32];
#pragma unroll
    for (int r = 0; r < 16; ++r) { const int i = 32 * ib + crow(r, hi); const float bi = bs[i]; const size_t row = t0 + i;
#pragma unroll
      for (int d0 = 0; d0 < 4; ++d0) { const int c = 128 * ct + 32 * d0 + r32;
        const float uu = gelu_tanh(bf2f(uv[r][d0]));
        O[row * LDO + 1024 + g * 256 + c] = (bf16)f2bf(uu * (o[d0][r] + bi)); } } }
  __syncthreads();
}
#undef SBAR
}

__device__ __forceinline__ f32x4 mma16(bf16x8 a, bf16x8 b, f32x4 c) { return __builtin_amdgcn_mfma_f32_16x16x32_bf16(a, b, c, 0, 0, 0); }

struct Args { const float* in[20]; float* out; unsigned char* ws; int ph_lo, ph_hi, sel, li; };

constexpr int N_PHASES = 17;

__global__ void __launch_bounds__(NWAVES * 64, 2) mega_fwd(Args args) {
    extern __shared__ __attribute__((aligned(16))) unsigned char lds[];
    LAS unsigned char* ldsl = (LAS unsigned char*)lds;
    const int G = gridDim.x; const int bx = blockIdx.x;
    const int vcu = (G % 8 == 0) ? (bx % 8) * (G / 8) + bx / 8 : bx;
#define PHASE_ENV() \
    const __attribute__((address_space(4))) Args* ap_ = (const __attribute__((address_space(4))) Args*)__builtin_amdgcn_kernarg_segment_ptr(); asm volatile("" : "+s"(ap_)); \
    int tid = threadIdx.x; asm volatile("" : "+v"(tid)); const int lane = tid & 63, wave = __builtin_amdgcn_readfirstlane(tid >> 6); (void)lane; \
    unsigned char* const ws = ap_->ws; const int gw = vcu * NWAVES + wave, NGW = G * NWAVES; const int gt = vcu * (NWAVES * 64) + tid, NGT = G * NWAVES * 64; \
    const float* const x_in = ap_->in[0]; \
    bf16* const W_ABIN = (bf16*)(ws + WS_W_ABIN); bf16* const W_ABOUT = (bf16*)(ws + WS_W_ABOUT); bf16* const W_CDIN = (bf16*)(ws + WS_W_CDIN); bf16* const W_CDOUT = (bf16*)(ws + WS_W_CDOUT); \
    bf16* const W_UP0 = (bf16*)(ws + WS_W_UP0); bf16* const W_UP1 = (bf16*)(ws + WS_W_UP1); bf16* const W_DN0 = (bf16*)(ws + WS_W_DN0); bf16* const W_DN1 = (bf16*)(ws + WS_W_DN1); \
    bf16* const XN = (bf16*)(ws + WS_XN); bf16* const OB16 = (bf16*)(ws + WS_O); float* const X = (float*)(ws + WS_X); bf16* const ACT = (bf16*)(ws + WS_ACT); \
    bf16* const P = (bf16*)(ws + WS_P); float* const OBF = (float*)(ws + WS_OB); bf16* const KV = (bf16*)(ws + WS_KV); bf16* const PREV = (bf16*)(ws + WS_PREV); bf16* const UP = (bf16*)(ws + WS_UP); \
    unsigned long long* const SS = (unsigned long long*)(ws + WS_SS); (void)SS; unsigned long long* const LNS = (unsigned long long*)(ws + WS_LNS); (void)LNS; bf16* const HALO = (bf16*)(ws + WS_HALO); (void)HALO; bf16* const SCR = (bf16*)(ws + WS_SCR); (void)SCR; float* const SCAL = (float*)(ws + WS_SCAL); float2* const ROPE = (float2*)(ws + WS_ROPE); \
    (void)gw; (void)NGW; (void)gt; (void)NGT; (void)x_in; (void)W_ABIN; (void)W_ABOUT; (void)W_CDIN; (void)W_CDOUT; (void)W_UP0; (void)W_UP1; (void)W_DN0; (void)W_DN1; (void)XN; (void)OB16; (void)X; (void)ACT; (void)P; (void)OBF; (void)KV; (void)PREV; (void)UP; (void)SCAL; (void)ROPE;
#define AIN(k) (ap_->in[k])

#if !MK_PER_PHASE
    for (int u = threadIdx.x; u < (LDS_BYTES - LDSCTL_OFF) / 4; u += NWAVES * 64) ((LAS unsigned*)(ldsl + LDSCTL_OFF))[u] = 0u;
    __syncthreads();
    XcdBarrier bar = xcd_barrier_post((unsigned*)(args.ws + WS_CTL) + 4096 + args.li * XCD_BAR_WORDS, (volatile LAS unsigned*)(ldsl + MISC_OFF) + 8);
#define GRID_BAR() xcd_barrier(bar)
#else
#define GRID_BAR() do {} while (0)
#endif
    const int lo = args.ph_lo, hi_ph = args.ph_hi;
#ifndef PH_MASK
#define PH_MASK 0xFFFFFFu
#endif
#define IN(k) (((PH_MASK >> (k)) & 1u) && lo <= (k) && (k) < hi_ph)
#define SEAM(k) do { if (IN(k) && IN((k) + 1)) GRID_BAR(); } while (0)
#ifndef REPEAT_MASK
#define REPEAT_MASK 0u
#endif
#define NREP(k) (((REPEAT_MASK >> (k)) & 1u) ? 2 : 1)

#define RAW_TO_XN(SRC, SSP) do { \
        for (int m = gw; m < MTOK; m += NGW) { const GAS f32x4* xr = (const GAS f32x4*)((SRC) + (size_t)m * DM) + lane; f32x4 v[8]; float s = 0.f; \
            _Pragma("unroll") for (int j = 0; j < 8; ++j) { v[j] = xr[64 * j]; s += (v[j].x * v[j].x + v[j].y * v[j].y) + (v[j].z * v[j].z + v[j].w * v[j].w); } \
            s = wave_sum(s); if (lane == 0) (SSP)[m] = (unsigned long long)(s * 16777216.f); \
            GAS v2u* o8 = (GAS v2u*)(XN + (size_t)m * DM) + lane; \
            _Pragma("unroll") for (int j = 0; j < 8; ++j) { v2u w; w.x = pk2(v[j].x, v[j].y); w.y = pk2(v[j].z, v[j].w); o8[64 * j] = w; } } } while (0)

#ifndef CT_P5
#define CT_P5 4300
#endif
    constexpr int CT_ABIN = 32 * (AB_IN / 64), CT_SQ = 32 * (DM / 64), CT_CDIN = 32 * (CD_IN / 64), CT_UP = 32 * (DFF2 / 64), CT_DN = (DFF / 64) * (DM / 64);
    constexpr int CT_L0 = CT_ABIN + CT_SQ + CT_UP + CT_DN, CT_ALL = CT_L0 + CT_CDIN + CT_SQ + CT_UP + CT_DN, CT_S1 = CT_L0 + CT_P5, CT_S2 = CT_ALL - CT_DN;
#define CONVERT_TILES(FIRST, LAST, W_ID, N_W) do { \
        LAS unsigned* T = (LAS unsigned*)(ldsl + wave * 9216); \
        const int rp = lane >> 4, cq = lane & 15; \
        struct TileRef { const float* src; bf16* dst; const float* gk; int K, N, perm; }; \
        auto tile_ref = [&](int it, TileRef& t) -> int { \
            int r = it; \
            if (r < CT_ABIN) { t = TileRef{AIN(5), W_ABIN, AIN(1), DM, AB_IN, 0}; return r; } r -= CT_ABIN; \
            if (r < CT_SQ) { t = TileRef{AIN(6), W_ABOUT, nullptr, DM, DM, 0}; return r; } r -= CT_SQ; \
            if (r < CT_UP) { t = TileRef{AIN(16), W_UP0, AIN(2), DM, DFF2, 1}; return r; } r -= CT_UP; \
            if (r < CT_DN) { t = TileRef{AIN(19), W_DN0, nullptr, DFF, DM, 0}; return r; } r -= CT_DN; \
            if (r < CT_CDIN) { t = TileRef{AIN(9), W_CDIN, AIN(1) + DM, DM, CD_IN, 0}; return r; } r -= CT_CDIN; \
            if (r < CT_SQ) { t = TileRef{AIN(10), W_CDOUT, nullptr, DM, DM, 0}; return r; } r -= CT_SQ; \
            if (r < CT_UP) { t = TileRef{AIN(16) + (size_t)DM * DFF2, W_UP1, AIN(2) + DM, DM, DFF2, 1}; return r; } r -= CT_UP; \
            t = TileRef{AIN(19) + (size_t)DFF * DM, W_DN1, nullptr, DFF, DM, 0}; return r; \
        }; \
        f32x4 va[8], vb[8]; float ga[8], gb[8]; \
        auto tile_load = [&](int it) { \
            TileRef t; const int r = tile_ref(it, t); const int nblk = t.N / 64, kb = r / nblk, nb = r % nblk; \
            const float* p = t.src + (size_t)(kb * 64 + 2 * rp) * t.N + nb * 64 + 4 * cq; \
            _Pragma("unroll") \
            for (int i = 0; i < 8; ++i) { va[i] = __builtin_nontemporal_load((const f32x4*)(p + (size_t)(8 * i) * t.N)); vb[i] = __builtin_nontemporal_load((const f32x4*)(p + (size_t)(8 * i + 1) * t.N)); \
                ga[i] = t.gk ? t.gk[kb * 64 + 8 * i + 2 * rp] : 1.f; gb[i] = t.gk ? t.gk[kb * 64 + 8 * i + 2 * rp + 1] : 1.f; } \
        }; \
        const int ct_last = (LAST), ct_step = (N_W); \
        int it = (FIRST) + (W_ID); \
        if (it < ct_last) tile_load(it); \
        while (it < ct_last) { \
            _Pragma("unroll") \
            for (int i = 0; i < 8; ++i) { \
                _Pragma("unroll") \
                for (int j = 0; j < 4; ++j) T[(4 * cq + j) * 36 + 4 * i + rp] = pk2(va[i][j] * ga[i], vb[i][j] * gb[i]); } \
            TileRef t; const int r = tile_ref(it, t); const int nblk = t.N / 64, kb = r / nblk, nb = r % nblk; \
            const int n0_ = nb * 64; const int drow0 = !t.perm ? n0_ : (n0_ < DFF ? (n0_ >> 7) * 256 + (n0_ & 127) : ((n0_ - DFF) >> 7) * 256 + 128 + ((n0_ - DFF) & 127)); \
            const int nxt = it + ct_step; \
            if (nxt < ct_last) tile_load(nxt); \
            LDS_WAIT(); asm volatile("" ::: "memory"); \
            _Pragma("unroll") \
            for (int o = 0; o < 8; ++o) { const int idx = o * 64 + lane, n = idx >> 3, c = idx & 7; \
                const v4u w = *(const LAS v4u*)(T + n * 36 + 4 * c); \
                *(GAS v4u*)(t.dst + (size_t)(drow0 + n) * t.K + kb * 64 + 8 * c) = w; } \
            LDS_WAIT(); asm volatile("" ::: "memory"); \
            it = nxt; \
        } \
    } while (0)

    for (int rep_ = 0; rep_ < NREP(0); ++rep_) if (IN(0)) { if (rep_) GRID_BAR(); PHASE_ENV();
        if (G == 256) { CONVERT_TILES(0, CT_L0, gw, NGW); } else { CONVERT_TILES(0, CT_ALL, gw, NGW); }
        for (int e = gt; e < SEQ * 64; e += NGT) { const int pos = e >> 6, i = e & 63;
            double f = 1.0; for (int k = 0; k < i; ++k) f *= 0.8659643233600653;
            const float ang = (float)pos * (float)f;
            double rev = (double)ang * 0.15915494309189535; rev -= floor(rev);
            const float rv = (float)rev;
            ROPE[e] = make_float2(__builtin_amdgcn_cosf(rv), __builtin_amdgcn_sinf(rv)); }
        if (vcu == 0 && wave == 0) { const float* lv = AIN(7);
            float a = lv[lane] * lv[128 + lane] + lv[64 + lane] * lv[192 + lane]; float b = lv[256 + lane] * lv[384 + lane] + lv[320 + lane] * lv[448 + lane];
            a = wave_sum(a); b = wave_sum(b);
            if (lane == 0) SCAL[0] = expf(a) - expf(b) + 0.2f; }
        RAW_TO_XN(x_in, SS);
    }
    SEAM(0);

    for (int rep_ = 0; rep_ < NREP(1); ++rep_) if (IN(1)) { if (rep_) GRID_BAR(); PHASE_ENV(); pg8::Gemm g{XN, W_ABIN, MTOK, AB_IN, DM}; pg8::StaticOrder S; S.init(MTOK, AB_IN, G, bx);
        pg8::EpiBf16 E{P, AB_IN, SS, nullptr, 0, 0}; pg8::gemm_phase<pg8::EpiBf16, pg8::StaticOrder, true, true>(ldsl, g, S, E, tid); }
    SEAM(1);

    for (int rep_ = 0; rep_ < NREP(2); ++rep_) if (IN(2)) { if (rep_) GRID_BAR(); PHASE_ENV();
#ifndef NO_B
        if (!(ap_->sel & 1)) { const int bh = vcu >> 5, comp = (vcu >> 4) & 1, s = vcu & 15, b = bh >> 2, h = bh & 3;
          float* tb = (float*)(lds + att::B2_TB);
          if (tid < 448) { const int rel = tid - 256 - 127, n = rel < 0 ? -rel : rel; int bucket = (n < 8) ? n : 8 + (31 - __clz((n * n) >> 6)); if (n >= 8 && bucket > 15) bucket = 15; if (rel > 0) bucket += 16;
              const float* rb = AIN(4); tb[tid] = (rel >= -127 && rel <= 63) ? (rb[bucket * 4 + h] - rb[15 * 4 + h]) * (1.f / att::SCALE) : 0.f; }
          __syncthreads();
          const bf16* Pb = P + (size_t)b * SEQ * AB_IN;
          for (int i = 0; i < 2; ++i) { const int q128 = i ? 31 - s : s;
              att::attnB2_unit<AB_IN, 1024>(Pb + (size_t)(128 * q128) * AB_IN + 3072 + h * 256 + comp * 128, Pb, 4096 + h * 256 + comp * 128, 5120 + h * 256,
                                            OBF + (size_t)comp * MTOK * 1024 + (size_t)(b * SEQ + 128 * q128) * 1024 + h * 256, q128, (char*)lds, ap_->sel); } }
#endif
#ifndef NO_A
#ifndef NREP_A
#define NREP_A 1
#endif
        for (int ra_ = 0; ra_ < NREP_A; ++ra_) if (!(ap_->sel & 2))
        { const int bh = vcu >> 4, qb = vcu & 15, b = bh >> 3, h = bh & 7;
          const bf16* Pb = P + (size_t)b * SEQ * AB_IN;
          att::attnA_unit<AB_IN, DM>(Pb + (size_t)(256 * qb) * AB_IN + h * 128, Pb, 1024 + h * 128, 2048 + h * 128, OB16 + (size_t)(b * SEQ + 256 * qb) * DM + h * 128, qb, (char*)lds); }
#endif
    }
    SEAM(2);

    for (int rep_ = 0; rep_ < NREP(3); ++rep_) if (IN(3)) { if (rep_) GRID_BAR(); PHASE_ENV();
        const float lam = SCAL[0]; const float* sg = AIN(8);
        f32x4 g4[4];
#pragma unroll
        for (int q = 0; q < 4; ++q) g4[q] = *(const f32x4*)(sg + (lane & 15) * 16 + q * 4);
        for (int row0 = gw * 2; row0 < MTOK; row0 += NGW * 2) { f32x4 a[2][4], c[2][4];
#pragma unroll
            for (int rr = 0; rr < 2; ++rr)
#pragma unroll
                for (int q = 0; q < 4; ++q) { a[rr][q] = *(const f32x4*)(OBF + (size_t)(row0 + rr) * 1024 + lane * 16 + q * 4); c[rr][q] = *(const f32x4*)(OBF + (size_t)MTOK * 1024 + (size_t)(row0 + rr) * 1024 + lane * 16 + q * 4); }
#pragma unroll
            for (int rr = 0; rr < 2; ++rr) { float ss = 0.f;
#pragma unroll
                for (int q = 0; q < 4; ++q) { a[rr][q] = a[rr][q] - lam * c[rr][q]; ss += (a[rr][q].x * a[rr][q].x + a[rr][q].y * a[rr][q].y) + (a[rr][q].z * a[rr][q].z + a[rr][q].w * a[rr][q].w); }
                ss += __shfl_xor(ss, 1); ss += __shfl_xor(ss, 2); ss += __shfl_xor(ss, 4); ss += __shfl_xor(ss, 8);
                const float rs = rsqrtf(ss * (1.f / 256.f) + EPS) * 0.8f;
                v4u w0, w1;
                w0.x = pk2(a[rr][0].x * rs * g4[0].x, a[rr][0].y * rs * g4[0].y); w0.y = pk2(a[rr][0].z * rs * g4[0].z, a[rr][0].w * rs * g4[0].w);
                w0.z = pk2(a[rr][1].x * rs * g4[1].x, a[rr][1].y * rs * g4[1].y); w0.w = pk2(a[rr][1].z * rs * g4[1].z, a[rr][1].w * rs * g4[1].w);
                w1.x = pk2(a[rr][2].x * rs * g4[2].x, a[rr][2].y * rs * g4[2].y); w1.y = pk2(a[rr][2].z * rs * g4[2].z, a[rr][2].w * rs * g4[2].w);
                w1.z = pk2(a[rr][3].x * rs * g4[3].x, a[rr][3].y * rs * g4[3].y); w1.w = pk2(a[rr][3].z * rs * g4[3].z, a[rr][3].w * rs * g4[3].w);
                bf16* op = OB16 + (size_t)(row0 + rr) * DM + 1024 + lane * 16; *(v4u*)op = w0; *(v4u*)(op + 8) = w1; } }
    }
    SEAM(3);

    for (int rep_ = 0; rep_ < NREP(4); ++rep_) if (IN(4)) { if (rep_) GRID_BAR(); PHASE_ENV(); pg8::Gemm g{OB16, W_ABOUT, MTOK, DM, DM}; pg8::StaticOrder S; S.init(MTOK, DM, G, bx);
        pg8::EpiRes E{nullptr, XN, DM, SS + 1 * MTOK}; pg8::gemm_phase<pg8::EpiRes, pg8::StaticOrder, false, true>(ldsl, g, S, E, tid); }
    SEAM(4);

#define FFN_PHASES(PB, WUP, WDN, L, SSIN, SSOUT) \
    for (int rep_ = 0; rep_ < NREP(PB); ++rep_) if (IN(PB)) { if (rep_) GRID_BAR(); PHASE_ENV(); pg8::Gemm g{XN, WUP, MTOK, DFF2, DM}; pg8::StaticOrder S; S.init(MTOK, DFF2, G, bx); \
        pg8::EpiConv E{ACT, SS + (SSIN) * MTOK, AIN(17) + (size_t)(L) * 3 * DFF2, AIN(18) + (size_t)(L) * DFF2, HALO, ldsl}; \
        pg8::gemm_phase<pg8::EpiConv, pg8::StaticOrder, true, true>(ldsl, g, S, E, tid); \
        if (G == 256 && bx >= 128) { if ((PB) == 5) { CONVERT_TILES(CT_L0, CT_S1, (bx - 128) * NWAVES + wave, 128 * NWAVES); } else { CONVERT_TILES(CT_S2, CT_ALL, (bx - 128) * NWAVES + wave, 128 * NWAVES); } } } \
    SEAM(PB); \
    for (int rep_ = 0; rep_ < NREP(PB + 1); ++rep_) if (IN(PB + 1)) { if (rep_) GRID_BAR(); PHASE_ENV(); conv_fix(HALO, ACT, AIN(17) + (size_t)(L) * 3 * DFF2, AIN(18) + (size_t)(L) * DFF2, gt, NGT); } \
    SEAM(PB + 1); \
    for (int rep_ = 0; rep_ < NREP(PB + 2); ++rep_) if (IN(PB + 2)) { if (rep_) GRID_BAR(); PHASE_ENV(); pg8::Gemm g{ACT, WDN, MTOK, DM, DFF}; pg8::StaticOrder S; S.init(MTOK, DM, G, bx); \
        if ((L) == 1 && G == 256) { pg8::EpiFinal E{XN, DM, SS + (SSOUT) * MTOK, (unsigned*)(ws + WS_CNT), AIN(3), ap_->out}; pg8::gemm_phase<pg8::EpiFinal, pg8::StaticOrder, false, true>(ldsl, g, S, E, tid); } \
        else { pg8::EpiRes E{nullptr, XN, DM, SS + (SSOUT) * MTOK}; pg8::gemm_phase<pg8::EpiRes, pg8::StaticOrder, false, true>(ldsl, g, S, E, tid); } } \
    SEAM(PB + 2);

    auto conv_fix = [&](const bf16* halo, bf16* act, const float* cw, const float* cb, int gt_, int ngt_) {
        constexpr int NCH = DFF / 8;
        for (int task = gt_; task < NCH * 64; task += ngt_) { const int ch = task % NCH, rr = (task / NCH) & 1, pm = task / (2 * NCH), n0 = ch * 8;
            const int pca = (n0 >> 7) * 256 + (n0 & 127); const bool first = (pm & 15) == 0;
            const bf16* H = halo + (size_t)pm * 4 * DFF2; const bf16* Hp = H - (size_t)4 * DFF2;
            float cv[2][8];
#pragma unroll
            for (int bj = 0; bj < 2; ++bj) { const int pc = pca + bj * 128, cc = bj * DFF + n0; const v4u z = {0u, 0u, 0u, 0u};
                const v4u c0 = *(const v4u*)(H + pc), c1 = *(const v4u*)(H + DFF2 + pc);
                const v4u q254 = first ? z : *(const v4u*)(Hp + 2 * DFF2 + pc), q255 = first ? z : *(const v4u*)(Hp + 3 * DFF2 + pc);
                const v4u x2 = rr == 0 ? q254 : q255, x1 = rr == 0 ? q255 : c0, x0 = rr == 0 ? c0 : c1;
#pragma unroll
                for (int q = 0; q < 4; ++q) {
                    cv[bj][2 * q] = cb[cc + 2 * q] + cw[cc + 2 * q] * bflo(x2[q]) + cw[DFF2 + cc + 2 * q] * bflo(x1[q]) + cw[2 * DFF2 + cc + 2 * q] * bflo(x0[q]);
                    cv[bj][2 * q + 1] = cb[cc + 2 * q + 1] + cw[cc + 2 * q + 1] * bfhi(x2[q]) + cw[DFF2 + cc + 2 * q + 1] * bfhi(x1[q]) + cw[2 * DFF2 + cc + 2 * q + 1] * bfhi(x0[q]); } }
            float o[8];
#pragma unroll
            for (int q = 0; q < 8; ++q) o[q] = silu_f(cv[1][q]) * cv[0][q];
            v4u w; w.x = pk2(o[0], o[1]); w.y = pk2(o[2], o[3]); w.z = pk2(o[4], o[5]); w.w = pk2(o[6], o[7]);
            *(v4u*)(act + (size_t)(pm * 256 + rr) * DFF + n0) = w; }
    };

    FFN_PHASES(5, W_UP0, W_DN0, 0, 1, 2)

    for (int rep_ = 0; rep_ < NREP(8); ++rep_) if (IN(8)) { if (rep_) GRID_BAR(); PHASE_ENV(); pg8::Gemm g{XN, W_CDIN, MTOK, CD_IN, DM}; pg8::StaticOrder S; S.init(MTOK, CD_IN, G, bx);
        pg8::EpiBf16 E{P, CD_IN, SS + 2 * MTOK, LNS, 16, 20}; pg8::gemm_phase<pg8::EpiBf16, pg8::StaticOrder, true, true>(ldsl, g, S, E, tid);
        if (G == 256 && bx >= 128) { CONVERT_TILES(CT_S1, CT_S2, (bx - 128) * NWAVES + wave, 128 * NWAVES); } }
    SEAM(8);

    for (int rep_ = 0; rep_ < NREP(9); ++rep_) if (IN(9)) { if (rep_) GRID_BAR(); PHASE_ENV();
        for (int u = vcu; u < 8 * 64; u += G) { const int bh = u >> 6, n = u & 63;
            att::ret_kv_unit<CD_IN>(P, ROPE, KV + ((size_t)bh * 64 + n) * 32768, bh >> 2, bh & 3, n, (char*)lds); }
        for (int u = vcu; u < 256; u += G) { const int g = u & 3, nbk = (u >> 2) & 31, b = u >> 7;
            att::sgu_unit<CD_IN, DM>(P, LNS, AIN(12), AIN(13), AIN(14) + (size_t)g * 128 * 128, AIN(15) + g * 128, OB16, (size_t)b * SEQ + 128 * nbk, g, (char*)lds); }
    }
    SEAM(9);

    for (int rep_ = 0; rep_ < NREP(10); ++rep_) if (IN(10)) { if (rep_) GRID_BAR(); PHASE_ENV();
        if (wave < 4) for (int e4 = (vcu * 4 + wave) * 64 + lane; e4 < 8 * 256 * 128 / 4; e4 += G * 4 * 64) { const int e = e4 * 4; const int bh = e >> 15, h = bh & 3; const int r = e & 32767;
            const float g64 = __expf(64.f * __logf(1.f - exp2f(-5.f - (float)h)));
            const bf16* src = KV + (size_t)bh * 64 * 32768 + r; bf16* dst = PREV + (size_t)bh * 64 * 32768 + r; float st[4] = {0.f, 0.f, 0.f, 0.f};
#pragma unroll 16
            for (int n = 0; n < 64; ++n) { const v2u kv = *(const v2u*)(src + (size_t)n * 32768);
                v2u w; w.x = pk2(st[0], st[1]); w.y = pk2(st[2], st[3]); *(v2u*)(dst + (size_t)n * 32768) = w;
                st[0] = g64 * st[0] + bflo(kv.x); st[1] = g64 * st[1] + bfhi(kv.x); st[2] = g64 * st[2] + bflo(kv.y); st[3] = g64 * st[3] + bfhi(kv.y); } }
    }
    SEAM(10);

    for (int rep_ = 0; rep_ < NREP(11); ++rep_) if (IN(11)) { if (rep_) GRID_BAR(); PHASE_ENV();
        for (int u = vcu; u < 256; u += G) { const int bh = u >> 5, np = u & 31;
            att::ret_out_unit<CD_IN, DM>(P, ROPE, PREV, AIN(11), OB16, bh >> 2, bh & 3, np, (char*)lds); }
    }
    SEAM(11);

    for (int rep_ = 0; rep_ < NREP(12); ++rep_) if (IN(12)) { if (rep_) GRID_BAR(); PHASE_ENV(); pg8::Gemm g{OB16, W_CDOUT, MTOK, DM, DM}; pg8::StaticOrder S; S.init(MTOK, DM, G, bx);
        pg8::EpiRes E{nullptr, XN, DM, SS + 3 * MTOK}; pg8::gemm_phase<pg8::EpiRes, pg8::StaticOrder, false, true>(ldsl, g, S, E, tid); }
    SEAM(12);

    FFN_PHASES(13, W_UP1, W_DN1, 1, 3, 4)

    for (int rep_ = 0; rep_ < NREP(16); ++rep_) if (IN(16) && G != 256) { if (rep_) GRID_BAR(); PHASE_ENV(); const float* fg = AIN(3); const unsigned long long* ss4 = SS + 4 * MTOK;
        for (int m0 = gw * 4; m0 < MTOK; m0 += NGW * 4) { v4u v[4][4]; float rstd[4];
#pragma unroll
            for (int rr = 0; rr < 4; ++rr) { const GAS v4u* xr = (const GAS v4u*)(XN + (size_t)(m0 + rr) * DM) + lane;
#pragma unroll
                for (int j = 0; j < 4; ++j) v[rr][j] = xr[64 * j];
                rstd[rr] = rsqrtf((float)ss4[m0 + rr] * (1.f / 16777216.f / DM) + EPS); }
#pragma unroll
            for (int rr = 0; rr < 4; ++rr) { float* orow = ap_->out + (size_t)(m0 + rr) * DM;
#pragma unroll
                for (int j = 0; j < 4; ++j) { const int c0 = (64 * j + lane) * 8; const f32x4 g0 = *(const f32x4*)(fg + c0), g1 = *(const f32x4*)(fg + c0 + 4); const float r_ = rstd[rr];
                    const f32x4 o0 = {bflo(v[rr][j].x) * r_ * g0.x, bfhi(v[rr][j].x) * r_ * g0.y, bflo(v[rr][j].y) * r_ * g0.z, bfhi(v[rr][j].y) * r_ * g0.w};
                    const f32x4 o1 = {bflo(v[rr][j].z) * r_ * g1.x, bfhi(v[rr][j].z) * r_ * g1.y, bflo(v[rr][j].w) * r_ * g1.z, bfhi(v[rr][j].w) * r_ * g1.w};
                    *(GAS f32x4*)(orow + c0) = o0; *(GAS f32x4*)(orow + c0 + 4) = o1; } } }
    }
#undef IN
#undef SEAM
}

extern "C" void kernel_launch(void* const* d_in, const int* in_sizes, int n_in, void* d_out, int out_size, void* d_ws, size_t ws_size, hipStream_t stream) {
    static int grid = 0;
    if (grid == 0) {
        if (n_in != 20 || in_sizes[0] != MTOK * DM || out_size != MTOK * DM || ws_size < WS_END) {
            fprintf(stderr, "kernel_launch: unexpected shapes: n_in %d in0 %d out %d ws %zu (need >= %zu)\n", n_in, n_in > 0 ? in_sizes[0] : -1, out_size, ws_size, (size_t)WS_END); grid = -1; return; }
        int dev = 0, cus = 0;
        if (hipGetDevice(&dev) != hipSuccess || hipDeviceGetAttribute(&cus, hipDeviceAttributeMultiprocessorCount, dev) != hipSuccess) { grid = -1; return; }
        if (hipFuncSetAttribute((const void*)mega_fwd, hipFuncAttributeMaxDynamicSharedMemorySize, LDS_BYTES) != hipSuccess) { fprintf(stderr, "kernel_launch: hipFuncSetAttribute failed\n"); grid = -1; return; }
        int per_cu = 0;
        if (hipOccupancyMaxActiveBlocksPerMultiprocessor(&per_cu, (const void*)mega_fwd, NWAVES * 64, LDS_BYTES) != hipSuccess || per_cu < 1) { fprintf(stderr, "kernel_launch: occupancy query says %d blocks per CU\n", per_cu); }
        (void)hipGetLastError();
        grid = cus;
    }
    if (grid < 0) return;
    hipMemsetAsync((char*)d_ws + WS_CTL, 0, CTL_ZERO_BYTES, stream);
    Args a{};
    for (int i = 0; i < 20; ++i) a.in[i] = (const float*)d_in[i];
    a.out = (float*)d_out; a.ws = (unsigned char*)d_ws;
#if MK_PER_PHASE
    for (int p = 0; p < N_PHASES; ++p) { a.ph_lo = p; a.ph_hi = p + 1; hipLaunchKernelGGL(mega_fwd, dim3(grid), dim3(NWAVES * 64), LDS_BYTES, stream, a); }
#else
    a.ph_lo = 0; a.ph_hi = (grid == 256) ? N_PHASES - 1 : N_PHASES; hipLaunchKernelGGL         (mega_fwd, dim3(grid), dim3(NWAVES * 64), LDS_BYTES, stream, a);
#if PROBE_PHASE >= 0
    a.ph_lo = PROBE_PHASE; a.ph_hi = PROBE_PHASE + PROBE_NPH; a.sel = PROBE_SEL; a.li = 1; hipLaunchKernelGGL(mega_fwd, dim3(grid), dim3(NWAVES * 64), LDS_BYTES, stream, a);
#endif
#endif
    const hipError_t le = hipPeekAtLastError();
    if (le != hipSuccess) fprintf(stderr, "kernel_launch: launch failed: %s\n", hipGetErrorName(le));
}
```

```cpp
#include <hip/hip_runtime.h>
#include <hip/hip_bf16.h>
#include <cstdio>
#include <cstdint>

#ifndef PROBE_PHASE
#define PROBE_PHASE -1
#endif
#ifndef PROBE_SEL
#define PROBE_SEL 0
#endif
#ifndef PROBE_NPH
#define PROBE_NPH 1
#endif
#ifndef MK_PER_PHASE
#define MK_PER_PHASE 0
#endif

namespace pg8 {
#define PG8_LAS __attribute__((address_space(3)))
typedef unsigned short bf16_t;
typedef short bf16x8 __attribute__((ext_vector_type(8)));
typedef float f32x4 __attribute__((ext_vector_type(4)));
typedef unsigned u32x4 __attribute__((ext_vector_type(4)));
constexpr int BM = 256, BK = 64, HALF = 128, HTB = HALF * BK * 2, STAGE_BYTES = 8 * HTB, NXCD = 8, WGM = 8;

__host__ __device__ __forceinline__ int lds_byte(int r, int c) { const int st = (r >> 4) * 2 + (c >> 5), rr = r & 15, cc = c & 31, ob = rr * 64 + cc * 2; return st * 1024 + (ob ^ (((ob >> 9) & 1) << 5)); }
__host__ __device__ __forceinline__ void stage_rc(int b, int& R, int& C) { const int st = b / 1024, sb = b % 1024, swz = sb ^ (((sb >> 9) & 1) << 5); R = (st >> 1) * 16 + swz / 64; C = (st & 1) * 32 + (swz % 64) / 2; }
__host__ __device__ __forceinline__ int perm32(int rho) { const int n = rho >> 4, i = rho & 15; return 8 * (i >> 2) + 4 * n + (i & 3); }

struct Unit { int pm, pn; };
struct Gemm { const bf16_t* A; const bf16_t* Bt; int M, N, K; };

struct StaticOrder {
    int nM, nN, nwg, G, c;
    __host__ __device__ void init(int M, int N, int G_, int c_) { nM = M / BM; nN = N / BM; nwg = nM * nN; G = G_; c = c_; }
    __host__ __device__ __attribute__((always_inline)) bool next(int i, Unit& u) const {
        const long L = (long)i * G + c; if (L >= nwg) return false;
        int wgid = (int)L; { const int q = nwg / NXCD, r = nwg % NXCD, xcd = wgid % NXCD, off = wgid / NXCD; wgid = (xcd < r ? xcd * (q + 1) : r * (q + 1) + (xcd - r) * q) + off; }
        const int nig = WGM * nN, gid = wgid / nig, fm = gid * WGM, gsz = (nM - fm) < WGM ? (nM - fm) : WGM;
        u.pm = fm + ((wgid % nig) % gsz); u.pn = (wgid % nig) / gsz; return true;
    }
    __device__ __forceinline__ void a_ready(const Unit&) const {}
    __device__ __forceinline__ void done(const Unit&) const {}
};

__device__ __forceinline__ unsigned cvt_pk_bf16(float lo, float hi) { unsigned r; asm volatile("v_cvt_pk_bf16_f32 %0, %1, %2" : "=v"(r) : "v"(lo), "v"(hi)); return r; }

__device__ __forceinline__ float gelu_tanh_e(float x) { const float u = 0.7978845608028654f * (x + 0.044715f * x * x * x); const float t = 1.f - 2.f / (__expf(2.f * u) + 1.f); return 0.5f * x * (1.f + t); }
struct EpiBf16 {
    static constexpr bool PERM = true, AFTER_DRAIN = false;
    bf16_t* O; int ldc; const unsigned long long* ss; unsigned long long* lnsum; int ln_pn0, ln_pn1;
    __device__ __forceinline__ void operator()(const f32x4 (&acc)[2][2][4][2], const Unit& u, int wr, int wc, int fr, int fq) const {
        const int row0 = u.pm * BM + wr * 64 + fr; const int col0 = u.pn * BM + wc * 32 + 8 * fq;
        const bool do_ln = lnsum != nullptr && u.pn >= ln_pn0 && u.pn < ln_pn1;
        unsigned long long ssv[2][4];
#pragma unroll
        for (int ai = 0; ai < 2; ++ai)
#pragma unroll
            for (int m = 0; m < 4; ++m) ssv[ai][m] = ss ? __hip_atomic_load(ss + row0 + ai * HALF + m * 16, __ATOMIC_RELAXED, __HIP_MEMORY_SCOPE_AGENT) : 0ull;
#pragma unroll
        for (int ai = 0; ai < 2; ++ai)
#pragma unroll
            for (int m = 0; m < 4; ++m) { const int row = row0 + ai * HALF + m * 16; bf16_t* rowp = O + (size_t)row * ldc + col0;
                const float sc = ss ? __builtin_amdgcn_rsqf((float)ssv[ai][m] * (1.f / 16777216.f / 2048.f) + 1e-6f) : 1.f;
                float s1 = 0.f, s2 = 0.f;
#pragma unroll
                for (int bj = 0; bj < 2; ++bj) { const f32x4 v0 = acc[ai][bj][m][0] * sc, v1 = acc[ai][bj][m][1] * sc;
                    u32x4 w; w.x = cvt_pk_bf16(v0[0], v0[1]); w.y = cvt_pk_bf16(v0[2], v0[3]); w.z = cvt_pk_bf16(v1[0], v1[1]); w.w = cvt_pk_bf16(v1[2], v1[3]);
                    *(u32x4*)(rowp + bj * HALF) = w;
                    if (do_ln) {
#pragma unroll
                        for (int q = 0; q < 4; ++q) { const float a = gelu_tanh_e(v0[q]), b = gelu_tanh_e(v1[q]); s1 += a + b; s2 += a * a + b * b; } } }
                if (do_ln) { s1 += __shfl_xor(s1, 16); s1 += __shfl_xor(s1, 32); s2 += __shfl_xor(s2, 16); s2 += __shfl_xor(s2, 32);
                    if (fq == 0) { atomicAdd(lnsum + 2 * row, (unsigned long long)(long long)(s1 * 16777216.f)); atomicAdd(lnsum + 2 * row + 1, (unsigned long long)(long long)(s2 * 16777216.f)); } } }
    }
};
struct EpiRes {
    static constexpr bool PERM = true, AFTER_DRAIN = false;
    const float* basef; bf16_t* xb; int ldc; unsigned long long* ss;
    __device__ __forceinline__ void operator()(const f32x4 (&acc)[2][2][4][2], const Unit& u, int wr, int wc, int fr, int fq) const {
        const int row0 = u.pm * BM + wr * 64 + fr; const int col0 = u.pn * BM + wc * 32 + 8 * fq;
        f32x4 b0[2][4][2], b1[2][4][2];
#pragma unroll
        for (int ai = 0; ai < 2; ++ai)
#pragma unroll
            for (int m = 0; m < 4; ++m) { const size_t off = (size_t)(row0 + ai * HALF + m * 16) * ldc + col0;
#pragma unroll
                for (int bj = 0; bj < 2; ++bj) {
                    if (basef) { b0[ai][m][bj] = *(const f32x4*)(basef + off + bj * HALF); b1[ai][m][bj] = *(const f32x4*)(basef + off + bj * HALF + 4); }
                    else { const u32x4 w = *(const u32x4*)(xb + off + bj * HALF);
                        b0[ai][m][bj] = (f32x4){__builtin_bit_cast(float, w.x << 16), __builtin_bit_cast(float, w.x & 0xffff0000u), __builtin_bit_cast(float, w.y << 16), __builtin_bit_cast(float, w.y & 0xffff0000u)};
                        b1[ai][m][bj] = (f32x4){__builtin_bit_cast(float, w.z << 16), __builtin_bit_cast(float, w.z & 0xffff0000u), __builtin_bit_cast(float, w.w << 16), __builtin_bit_cast(float, w.w & 0xffff0000u)}; } } }
#pragma unroll
        for (int ai = 0; ai < 2; ++ai)
#pragma unroll
            for (int m = 0; m < 4; ++m) { const int row = row0 + ai * HALF + m * 16; const size_t off = (size_t)row * ldc + col0; float sq = 0.f;
#pragma unroll
                for (int bj = 0; bj < 2; ++bj) {
                    const f32x4 o0 = b0[ai][m][bj] + acc[ai][bj][m][0], o1 = b1[ai][m][bj] + acc[ai][bj][m][1];
                    u32x4 w; w.x = cvt_pk_bf16(o0[0], o0[1]); w.y = cvt_pk_bf16(o0[2], o0[3]); w.z = cvt_pk_bf16(o1[0], o1[1]); w.w = cvt_pk_bf16(o1[2], o1[3]);
                    *(u32x4*)(xb + off + bj * HALF) = w;
#pragma unroll
                    for (int q = 0; q < 4; ++q) { const unsigned ww = q == 0 ? w.x : q == 1 ? w.y : q == 2 ? w.z : w.w; const float lo = __builtin_bit_cast(float, ww << 16), hi = __builtin_bit_cast(float, ww & 0xffff0000u); sq += lo * lo + hi * hi; } }
                sq += __shfl_xor(sq, 16); sq += __shfl_xor(sq, 32);
                if (fq == 0) atomicAdd(ss + row, (unsigned long long)(sq * 16777216.f)); }
    }
};

struct EpiConv {
    static constexpr bool PERM = true, AFTER_DRAIN = false;
    bf16_t* act; const unsigned long long* ss; const float* cw; const float* cb; bf16_t* halo; PG8_LAS unsigned char* lds0;
    static constexpr int NFF = 5632, NFF2 = 11264;
    static constexpr int HX = STAGE_BYTES + 1024, CPAR = HX + 4096;
    __device__ __forceinline__ static int hxi(int wr, int ai, int rs, int bj, int wc, int fq) { return ((((((wr * 2 + ai) * 2 + rs) * 2 + bj) * 4 + wc) * 4 + fq) * 16); }
    __device__ __forceinline__ static u32x4 bperm4(int addr, u32x4 v) {
        u32x4 r; r.x = (unsigned)__builtin_amdgcn_ds_bpermute(addr, (int)v.x); r.y = (unsigned)__builtin_amdgcn_ds_bpermute(addr, (int)v.y);
        r.z = (unsigned)__builtin_amdgcn_ds_bpermute(addr, (int)v.z); r.w = (unsigned)__builtin_amdgcn_ds_bpermute(addr, (int)v.w); return r; }
    __device__ __forceinline__ void operator()(const f32x4 (&acc)[2][2][4][2], const Unit& u, int wr, int wc, int fr, int fq) const {
        asm volatile("" : "+v"(fr), "+v"(fq));
        typedef float f32x2 __attribute__((ext_vector_type(2)));
        const int lane = fq * 16 + fr, tid = (wr * 4 + wc) * 64 + lane;
        { PG8_LAS unsigned* cp = (PG8_LAS unsigned*)(lds0 + CPAR);
#pragma unroll
          for (int e = 0; e < 2; ++e) { const int idx = tid * 2 + e, bj = idx >> 9, j = (idx >> 7) & 3, c = idx & 127; const int gcol = bj * NFF + u.pn * 128 + c;
              const float f = (j < 3 ? cw[(size_t)j * NFF2 + gcol] : cb[gcol]) * (bj ? -1.4426950408889634f : -0.6931471805599453f);
              const unsigned b = cvt_pk_bf16(f, 0.f) & 0xffffu;
              cp[idx] = j < 3 ? ((c & 1) ? (b << 16) : b) : __builtin_bit_cast(unsigned, f); } }
        u32x4 pk[2][2][4];
        unsigned long long ssv[2][4];
#pragma unroll
        for (int ai = 0; ai < 2; ++ai)
#pragma unroll
            for (int m = 0; m < 4; ++m) ssv[ai][m] = __hip_atomic_load(ss + u.pm * BM + ai * HALF + wr * 64 + m * 16 + fr, __ATOMIC_RELAXED, __HIP_MEMORY_SCOPE_AGENT);
#pragma unroll
        for (int ai = 0; ai < 2; ++ai)
#pragma unroll
            for (int m = 0; m < 4; ++m) {
                const float sc = __builtin_amdgcn_rsqf((float)ssv[ai][m] * (1.f / 16777216.f / 2048.f) + 1e-6f);
#pragma unroll
                for (int bj = 0; bj < 2; ++bj) { const f32x4 v0 = acc[ai][bj][m][0] * sc, v1 = acc[ai][bj][m][1] * sc;
                    pk[ai][bj][m] = (u32x4){cvt_pk_bf16(v0[0], v0[1]), cvt_pk_bf16(v0[2], v0[3]), cvt_pk_bf16(v1[0], v1[1]), cvt_pk_bf16(v1[2], v1[3])}; } }
        const int pcol = u.pn * 256 + wc * 32 + 8 * fq;
        if (fr >= 14) {
#pragma unroll
            for (int ai = 0; ai < 2; ++ai)
#pragma unroll
                for (int bj = 0; bj < 2; ++bj) *(PG8_LAS u32x4*)(lds0 + HX + hxi(wr, ai, fr - 14, bj, wc, fq)) = pk[ai][bj][3];
            if (wr == 1) {
#pragma unroll
                for (int bj = 0; bj < 2; ++bj) *(u32x4*)(halo + ((size_t)u.pm * 4 + 2 + (fr - 14)) * NFF2 + pcol + bj * HALF) = pk[1][bj][3]; } }
        if (wr == 0 && fr < 2) {
#pragma unroll
            for (int bj = 0; bj < 2; ++bj) *(u32x4*)(halo + ((size_t)u.pm * 4 + fr) * NFF2 + pcol + bj * HALF) = pk[0][bj][0]; }
        asm volatile("s_waitcnt lgkmcnt(0)" ::: "memory"); __builtin_amdgcn_s_barrier(); asm volatile("" ::: "memory");
        const int i1 = ((lane & 48) | ((fr + 15) & 15)) * 4, i2 = ((lane & 48) | ((fr + 14) & 15)) * 4;
        const int ca = u.pn * 128 + wc * 32 + 8 * fq;
        typedef __bf16 bf16x2_t __attribute__((ext_vector_type(2)));
#define PG8_W(v_, q_) ((q_) == 0 ? (v_).x : (q_) == 1 ? (v_).y : (q_) == 2 ? (v_).z : (v_).w)
#define PG8_DOT2(x_, w_, c_) __builtin_amdgcn_fdot2_f32_bf16(__builtin_bit_cast(bf16x2_t, (unsigned)(x_)), __builtin_bit_cast(bf16x2_t, (unsigned)(w_)), (c_), false)
        u32x4 wt[2][3][2]; f32x4 bs[2][2];
        { const PG8_LAS unsigned* cpl = (const PG8_LAS unsigned*)(lds0 + CPAR) + wc * 32 + 8 * fq;
#pragma unroll
          for (int bj = 0; bj < 2; ++bj) {
#pragma unroll
              for (int j = 0; j < 3; ++j) { wt[bj][j][0] = *(const PG8_LAS u32x4*)(cpl + bj * 512 + j * 128); wt[bj][j][1] = *(const PG8_LAS u32x4*)(cpl + bj * 512 + j * 128 + 4); }
              bs[bj][0] = *(const PG8_LAS f32x4*)(cpl + bj * 512 + 384); bs[bj][1] = *(const PG8_LAS f32x4*)(cpl + bj * 512 + 388); } }
#pragma unroll
        for (int ai = 0; ai < 2; ++ai) {
            const bool top = (wr == 0 && ai == 0);
            u32x4 q1[2], q2[2];
            if (top) { q1[0] = (u32x4){0u, 0u, 0u, 0u}; q1[1] = q1[0]; q2[0] = q1[0]; q2[1] = q1[0]; }
            else { const int swr = wr == 1 ? 0 : 1, sai = wr == 1 ? ai : 0;
#pragma unroll
                for (int bj = 0; bj < 2; ++bj) { const u32x4 h14 = *(const PG8_LAS u32x4*)(lds0 + HX + hxi(swr, sai, 0, bj, wc, fq)), h15 = *(const PG8_LAS u32x4*)(lds0 + HX + hxi(swr, sai, 1, bj, wc, fq));
                    q1[bj] = h15; q2[bj] = fr == 0 ? h14 : h15; } }
#pragma unroll
            for (int m = 0; m < 4; ++m) {
                float cv[2][8];
#pragma unroll
                for (int bj = 0; bj < 2; ++bj) { const u32x4 cur = pk[ai][bj][m];
                    const u32x4 s1 = bperm4(i1, cur), s2 = bperm4(i2, cur);
                    const u32x4 p1 = fr == 0 ? q1[bj] : s1, p2 = fr < 2 ? q2[bj] : s2;
                    q1[bj] = s1; q2[bj] = s2;
#pragma unroll
                    for (int c = 0; c < 8; ++c) { const int q = c >> 1;
                        float y;
                        asm("v_dot2_f32_bf16 %0, %1, %2, %3" : "=v"(y) : "v"(PG8_W(p2, q)), "v"(PG8_W(wt[bj][0][c >> 2], c & 3)), "v"(bs[bj][c >> 2][c & 3]));
                        y = PG8_DOT2(PG8_W(p1, q), PG8_W(wt[bj][1][c >> 2], c & 3), y);
                        cv[bj][c] = PG8_DOT2(PG8_W(cur, q), PG8_W(wt[bj][2][c >> 2], c & 3), y); } }
                float o[8];
#pragma unroll
                for (int q = 0; q < 4; ++q) { const f32x2 t = {cv[1][2 * q], cv[1][2 * q + 1]}, av = {cv[0][2 * q], cv[0][2 * q + 1]};
                    const f32x2 e = {__builtin_amdgcn_exp2f(t.x), __builtin_amdgcn_exp2f(t.y)}; const f32x2 d = e + 1.f;
                    const f32x2 r = {__builtin_amdgcn_rcpf(d.x), __builtin_amdgcn_rcpf(d.y)}; const f32x2 ov = av * t * r; o[2 * q] = ov.x; o[2 * q + 1] = ov.y; }
                u32x4 out; out.x = cvt_pk_bf16(o[0], o[1]); out.y = cvt_pk_bf16(o[2], o[3]); out.z = cvt_pk_bf16(o[4], o[5]); out.w = cvt_pk_bf16(o[6], o[7]);
                const int row = u.pm * BM + ai * HALF + wr * 64 + m * 16 + fr;
                if (!(top && m == 0 && fr < 2)) *(u32x4*)(act + (size_t)row * NFF + ca) = out;
                __builtin_amdgcn_sched_barrier(0); } }
#undef PG8_DOT2
#undef PG8_W
    }
};

struct EpiFinal {
    static constexpr bool PERM = true, AFTER_DRAIN = true;
    const bf16_t* xb; int ldc; unsigned long long* ss; unsigned* cnt; const float* g; float* out;
    __device__ __forceinline__ void fused(f32x4 (&acc)[2][2][4][2], const Unit& u, int wr, int wc, int fr, int fq, PG8_LAS unsigned char* lds, int wid, int lane) const {
        const int row0 = u.pm * BM + wr * 64 + fr; const int col0 = u.pn * BM + wc * 32 + 8 * fq;
        u32x4 bw[2][4][2];
#pragma unroll
        for (int ai = 0; ai < 2; ++ai)
#pragma unroll
            for (int m = 0; m < 4; ++m)
#pragma unroll
                for (int bj = 0; bj < 2; ++bj) bw[ai][m][bj] = *(const u32x4*)(xb + (size_t)(row0 + ai * HALF + m * 16) * ldc + col0 + bj * HALF);
        float sqv[2][4];
#pragma unroll
        for (int ai = 0; ai < 2; ++ai)
#pragma unroll
            for (int m = 0; m < 4; ++m) { float sq = 0.f;
#pragma unroll
                for (int bj = 0; bj < 2; ++bj) { const u32x4 w = bw[ai][m][bj];
                    const f32x4 b0 = {__builtin_bit_cast(float, w.x << 16), __builtin_bit_cast(float, w.x & 0xffff0000u), __builtin_bit_cast(float, w.y << 16), __builtin_bit_cast(float, w.y & 0xffff0000u)};
                    const f32x4 b1 = {__builtin_bit_cast(float, w.z << 16), __builtin_bit_cast(float, w.z & 0xffff0000u), __builtin_bit_cast(float, w.w << 16), __builtin_bit_cast(float, w.w & 0xffff0000u)};
                    const f32x4 o0 = b0 + acc[ai][bj][m][0], o1 = b1 + acc[ai][bj][m][1]; acc[ai][bj][m][0] = o0; acc[ai][bj][m][1] = o1;
                    sq += (o0[0] * o0[0] + o0[1] * o0[1]) + (o0[2] * o0[2] + o0[3] * o0[3]) + (o1[0] * o1[0] + o1[1] * o1[1]) + (o1[2] * o1[2] + o1[3] * o1[3]); }
                sq += __shfl_xor(sq, 16); sq += __shfl_xor(sq, 32); sqv[ai][m] = sq; }
        unsigned long long keep = 0ull, kr[2][4];
        if (fq == 0) {
#pragma unroll
            for (int ai = 0; ai < 2; ++ai)
#pragma unroll
                for (int m = 0; m < 4; ++m) kr[ai][m] = atomicAdd(ss + row0 + ai * HALF + m * 16, (unsigned long long)(sqv[ai][m] * 16777216.f));
#pragma unroll
            for (int ai = 0; ai < 2; ++ai)
#pragma unroll
                for (int m = 0; m < 4; ++m) keep += kr[ai][m]; }
        asm volatile("s_waitcnt vmcnt(0)" :: "v"((unsigned)keep), "v"((unsigned)(keep >> 32)) : "memory");
        if (lane == 0) __hip_atomic_fetch_add(cnt + 64 * u.pm, 1u, __ATOMIC_RELAXED, __HIP_MEMORY_SCOPE_AGENT);
        if (wid == 0) { unsigned sp = 0;
            while ((unsigned)__builtin_amdgcn_readfirstlane(__hip_atomic_load(cnt + 64 * u.pm, __ATOMIC_RELAXED, __HIP_MEMORY_SCOPE_AGENT)) < 64u) { __builtin_amdgcn_s_sleep(2); if (++sp > (1u << 22)) break; } }
        asm volatile("s_waitcnt vmcnt(0) lgkmcnt(0)" ::: "memory"); __builtin_amdgcn_s_barrier(); asm volatile("" ::: "memory");
        unsigned long long ssv[2][4];
#pragma unroll
        for (int ai = 0; ai < 2; ++ai)
#pragma unroll
            for (int m = 0; m < 4; ++m) ssv[ai][m] = __hip_atomic_load(ss + row0 + ai * HALF + m * 16, __ATOMIC_RELAXED, __HIP_MEMORY_SCOPE_AGENT);
#pragma unroll
        for (int ai = 0; ai < 2; ++ai)
#pragma unroll
            for (int m = 0; m < 4; ++m) { const int row = row0 + ai * HALF + m * 16; const size_t off = (size_t)row * ldc + col0;
                const float rstd = __builtin_amdgcn_rsqf((float)ssv[ai][m] * (1.f / 16777216.f / 2048.f) + 1e-6f);
#pragma unroll
                for (int bj = 0; bj < 2; ++bj) { const f32x4 g0 = *(const f32x4*)(g + col0 + bj * HALF), g1 = *(const f32x4*)(g + col0 + bj * HALF + 4);
                    *(f32x4*)(out + off + bj * HALF) = acc[ai][bj][m][0] * rstd * g0; *(f32x4*)(out + off + bj * HALF + 4) = acc[ai][bj][m][1] * rstd * g1; } }
    }
};

template <class Epi, class Sched, bool ALIGN_EPI = false, bool SP2 = false>
__device__ __forceinline__ void gemm_phase(PG8_LAS unsigned char* lds, const Gemm g, const Sched& S, const Epi& E, const int tid) {
    const int wid = __builtin_amdgcn_readfirstlane(tid >> 6), lane = tid & 63, wr = wid >> 2, wc = wid & 3, fr = lane & 15, fq = lane >> 4;
    const int K = g.K, nt = K / BK;
    unsigned voffA[2], voffB[2];
#pragma unroll
    for (int i = 0; i < 2; ++i) { int R, C; stage_rc(tid * 16 + i * 8192, R, C); const int Rb = Epi::PERM ? ((R & ~31) + perm32(R & 31)) : R;
        voffA[i] = (unsigned)(R * K + C) * 2u; voffB[i] = (unsigned)(Rb * K + C) * 2u; }
    const size_t kstep = (size_t)(BK * 2);
    const size_t hstep = (size_t)HALF * K * 2;
    const size_t tstep = 2 * hstep;
    const unsigned ldsw = (unsigned)wid * 1024u;
    const int aoff = lds_byte(wr * 64 + fr, fq * 8), boff = lds_byte(wc * 32 + fr, fq * 8);
#define PG8_SA(b, h) (((b) * 2 + (h)) * HTB)
#define PG8_SB(b, h) ((4 + (b) * 2 + (h)) * HTB)
#define PG8_STAGE(bufoff, gbase, voff) do { _Pragma("unroll") for (int _i = 0; _i < 2; ++_i) \
        __builtin_amdgcn_global_load_lds((const unsigned*)((const char*)(gbase) + (voff)[_i]), (PG8_LAS unsigned*)(lds + (bufoff) + ldsw + _i * 8192), 16, 0, 0); } while (0)
#define PG8_LDA(dst, b, h) do { _Pragma("unroll") for (int m = 0; m < 4; ++m) _Pragma("unroll") for (int k = 0; k < 2; ++k) dst[m][k] = *(const PG8_LAS bf16x8*)(lds + PG8_SA(b, h) + aoff + m * 2048 + k * 1024); } while (0)
#define PG8_LDB(dst, b, h) do { _Pragma("unroll") for (int n = 0; n < 2; ++n) _Pragma("unroll") for (int k = 0; k < 2; ++k) dst[n][k] = *(const PG8_LAS bf16x8*)(lds + PG8_SB(b, h) + boff + n * 2048 + k * 1024); } while (0)
#define PG8_MMA(ai, bj, At, Bt) do { __builtin_amdgcn_s_setprio(1); _Pragma("unroll") for (int m = 0; m < 4; ++m) _Pragma("unroll") for (int n = 0; n < 2; ++n) _Pragma("unroll") for (int k = 0; k < 2; ++k) \
        acc[ai][bj][m][n] = __builtin_amdgcn_mfma_f32_16x16x32_bf16(Bt[n][k], At[m][k], acc[ai][bj][m][n], 0, 0, 0); __builtin_amdgcn_s_setprio(0); } while (0)
#define PG8_WAIT_V(n) asm volatile("s_waitcnt vmcnt(" #n ")" ::: "memory")
#define PG8_WAIT_L(n) asm volatile("s_waitcnt lgkmcnt(" #n ")" ::: "memory")
#define PG8_BAR __builtin_amdgcn_s_barrier()
#define PG8_SCHED __builtin_amdgcn_sched_barrier(0)
    Unit cur, nxt; int ui = 0;
    if (!S.next(0, cur)) return;
    f32x4 acc[2][2][4][2];
#pragma unroll
    for (int a = 0; a < 2; ++a)
#pragma unroll
        for (int b = 0; b < 2; ++b)
#pragma unroll
            for (int m = 0; m < 4; ++m)
#pragma unroll
                for (int n = 0; n < 2; ++n) acc[a][b][m][n] = (f32x4){0.f, 0.f, 0.f, 0.f};
    bf16x8 At[4][2], B0[2][2], B1[2][2];
    const char* cA = (const char*)g.A + (size_t)cur.pm * tstep; const char* cB = (const char*)g.Bt + (size_t)cur.pn * tstep;
    S.a_ready(cur);
    if constexpr (SP2) {
        PG8_STAGE(PG8_SB(0, 0), cB, voffB); PG8_STAGE(PG8_SB(0, 1), cB + hstep, voffB); PG8_STAGE(PG8_SA(0, 0), cA, voffA); PG8_STAGE(PG8_SA(0, 1), cA + hstep, voffA);
        if (wr == 1) PG8_BAR;
        PG8_WAIT_V(2); PG8_BAR;
        PG8_STAGE(PG8_SB(1, 0), cB + kstep, voffB); PG8_STAGE(PG8_SA(1, 0), cA + kstep, voffA); PG8_STAGE(PG8_SB(1, 1), cB + hstep + kstep, voffB);
        PG8_WAIT_V(6); PG8_BAR;
    } else {
        PG8_STAGE(PG8_SB(0, 0), cB, voffB); PG8_STAGE(PG8_SA(0, 0), cA, voffA); PG8_STAGE(PG8_SB(0, 1), cB + hstep, voffB); PG8_STAGE(PG8_SA(0, 1), cA + hstep, voffA);
        if (wr == 1) PG8_BAR;
        PG8_WAIT_V(4); PG8_BAR;
        PG8_STAGE(PG8_SB(1, 0), cB + kstep, voffB); PG8_STAGE(PG8_SA(1, 0), cA + kstep, voffA); PG8_STAGE(PG8_SB(1, 1), cB + hstep + kstep, voffB);
        PG8_WAIT_V(6); PG8_BAR;
    }
    for (;;) {
        const bool has_next = S.next(ui + 1, nxt);
        const char* nA = has_next ? (const char*)g.A + (size_t)nxt.pm * tstep : cA; const char* nB = has_next ? (const char*)g.Bt + (size_t)nxt.pn * tstep : cB;
        for (int t = 0; t < nt; t += 2) {
            const bool last = (t == nt - 2);
            const char* a1 = cA + (size_t)(t + 1) * kstep;
            const char* a2 = last ? nA : cA + (size_t)(t + 2) * kstep; const char* b2 = last ? nB : cB + (size_t)(t + 2) * kstep;
            const char* a3 = a2 + kstep; const char* b3 = b2 + kstep;
            if (last && has_next) S.a_ready(nxt);
            if constexpr (SP2) {
            PG8_LDB(B0, 0, 0); PG8_LDB(B1, 0, 1); PG8_SCHED; PG8_LDA(At, 0, 0); PG8_STAGE(PG8_SA(1, 1), a1 + hstep, voffA);
            PG8_WAIT_V(8); PG8_WAIT_L(0); PG8_BAR; PG8_MMA(0, 0, At, B0); PG8_MMA(0, 1, At, B1); PG8_BAR; PG8_SCHED;
            PG8_LDA(At, 0, 1); PG8_STAGE(PG8_SB(0, 0), b2, voffB); PG8_STAGE(PG8_SB(0, 1), b2 + hstep, voffB); PG8_STAGE(PG8_SA(0, 0), a2, voffA);
            PG8_WAIT_V(8); PG8_WAIT_L(0); PG8_BAR; PG8_MMA(1, 0, At, B0); PG8_MMA(1, 1, At, B1); PG8_BAR; PG8_SCHED;
            PG8_LDB(B0, 1, 0); PG8_LDB(B1, 1, 1); PG8_SCHED; PG8_LDA(At, 1, 0); PG8_STAGE(PG8_SA(0, 1), a2 + hstep, voffA);
            PG8_WAIT_V(8); PG8_WAIT_L(0); PG8_BAR; PG8_MMA(0, 0, At, B0); PG8_MMA(0, 1, At, B1); PG8_BAR; PG8_SCHED;
            PG8_LDA(At, 1, 1); PG8_STAGE(PG8_SB(1, 0), b3, voffB); PG8_STAGE(PG8_SB(1, 1), b3 + hstep, voffB); PG8_STAGE(PG8_SA(1, 0), a3, voffA);
            PG8_WAIT_V(8); PG8_WAIT_L(0); PG8_BAR; PG8_MMA(1, 0, At, B0); PG8_MMA(1, 1, At, B1); PG8_BAR; PG8_SCHED;
            } else {
            PG8_LDB(B0, 0, 0); PG8_SCHED; PG8_LDA(At, 0, 0); PG8_STAGE(PG8_SA(1, 1), a1 + hstep, voffA);
            PG8_WAIT_L(8); PG8_BAR; PG8_WAIT_L(0); PG8_MMA(0, 0, At, B0); PG8_BAR; PG8_SCHED;
            PG8_LDB(B1, 0, 1); PG8_STAGE(PG8_SB(0, 0), b2, voffB);
            PG8_BAR; PG8_WAIT_L(0); PG8_MMA(0, 1, At, B1); PG8_BAR;
            PG8_LDA(At, 0, 1); PG8_STAGE(PG8_SA(0, 0), a2, voffA);
            PG8_BAR; PG8_WAIT_L(0); PG8_MMA(1, 0, At, B0); PG8_BAR; PG8_SCHED;
            PG8_STAGE(PG8_SB(0, 1), b2 + hstep, voffB);
            PG8_WAIT_V(6); PG8_BAR; PG8_MMA(1, 1, At, B1); PG8_BAR;
            PG8_LDB(B0, 1, 0); PG8_SCHED; PG8_LDA(At, 1, 0); PG8_STAGE(PG8_SA(0, 1), a2 + hstep, voffA);
            PG8_WAIT_L(8); PG8_BAR; PG8_WAIT_L(0); PG8_MMA(0, 0, At, B0); PG8_BAR; PG8_SCHED;
            PG8_LDB(B1, 1, 1); PG8_STAGE(PG8_SB(1, 0), b3, voffB);
            PG8_BAR; PG8_WAIT_L(0); PG8_MMA(0, 1, At, B1); PG8_BAR;
            PG8_LDA(At, 1, 1); PG8_STAGE(PG8_SA(1, 0), a3, voffA);
            PG8_BAR; PG8_WAIT_L(0); PG8_MMA(1, 0, At, B0); PG8_BAR; PG8_SCHED;
            PG8_STAGE(PG8_SB(1, 1), b3 + hstep, voffB);
            PG8_WAIT_V(6); PG8_BAR; PG8_MMA(1, 1, At, B1); PG8_BAR;
            }
        }
        if constexpr (ALIGN_EPI) { if (wr == 0) PG8_BAR; }
        if constexpr (!Epi::AFTER_DRAIN) { E(acc, cur, wr, wc, fr, fq); S.done(cur); }
        if (!has_next) break;
#pragma unroll
        for (int a = 0; a < 2; ++a)
#pragma unroll
            for (int b = 0; b < 2; ++b)
#pragma unroll
                for (int m = 0; m < 4; ++m)
#pragma unroll
                    for (int n = 0; n < 2; ++n) acc[a][b][m][n] = (f32x4){0.f, 0.f, 0.f, 0.f};
        cur = nxt; cA = nA; cB = nB; ++ui;
        if constexpr (ALIGN_EPI) { if (wr == 1) PG8_BAR; }
    }
    PG8_WAIT_V(0);
    if constexpr (!ALIGN_EPI) { if (wr == 0) PG8_BAR; }
    PG8_BAR;
    if constexpr (Epi::AFTER_DRAIN) { E.fused(acc, cur, wr, wc, fr, fq, lds, wid, lane); }
#undef PG8_SA
#undef PG8_SB
#undef PG8_STAGE
#undef PG8_LDA
#undef PG8_LDB
#undef PG8_MMA
#undef PG8_WAIT_V
#undef PG8_WAIT_L
#undef PG8_BAR
#undef PG8_SCHED
}
}

constexpr int DM = 2048, BATCH = 2, SEQ = 4096, MTOK = BATCH * SEQ;
constexpr int AB_IN = 6144, CD_IN = 5120, DFF = 5632, DFF2 = 11264;
constexpr float EPS = 1e-6f;
constexpr int NWAVES = 8;

#define GAS __attribute__((address_space(1)))
#define LAS __attribute__((address_space(3)))
typedef unsigned short bf16;
typedef unsigned v4u __attribute__((ext_vector_type(4)));
typedef unsigned v2u __attribute__((ext_vector_type(2)));
typedef float f32x4 __attribute__((ext_vector_type(4)));
typedef float f32x16 __attribute__((ext_vector_type(16)));
typedef short bf16x8 __attribute__((ext_vector_type(8)));
typedef short s16x4 __attribute__((ext_vector_type(4)));
typedef GAS unsigned gu32;
#define RLX_AGENT __ATOMIC_RELAXED, __HIP_MEMORY_SCOPE_AGENT
#define LDS_WAIT() asm volatile("s_waitcnt lgkmcnt(0)" ::: "memory")
#define VM_WAIT() asm volatile("s_waitcnt vmcnt(0)" ::: "memory")
__device__ __forceinline__ unsigned f2bf(float f) { unsigned u = __builtin_bit_cast(unsigned, f); return (u + 0x7fffu + ((u >> 16) & 1u)) >> 16; }
__device__ __forceinline__ unsigned pk2(float lo, float hi) { return f2bf(lo) | (f2bf(hi) << 16); }
__device__ __forceinline__ float bf2f(unsigned u16) { return __builtin_bit_cast(float, u16 << 16); }
__device__ __forceinline__ float bflo(unsigned w) { return __builtin_bit_cast(float, w << 16); }
__device__ __forceinline__ float bfhi(unsigned w) { return __builtin_bit_cast(float, w & 0xffff0000u); }
__device__ __forceinline__ float wave_sum(float v) {
#pragma unroll
    for (int o = 1; o < 64; o <<= 1) v += __shfl_xor(v, o);
    return v;
}
__device__ __forceinline__ float gelu_tanh(float x) {
    const float u = 0.7978845608028654f * (x + 0.044715f * x * x * x);
    const float t = 1.f - 2.f / (__expf(2.f * u) + 1.f);
    return 0.5f * x * (1.f + t);
}
__device__ __forceinline__ float silu_f(float x) { return x / (1.f + __expf(-x)); }

constexpr size_t MiB = 1u << 20;
constexpr size_t WS_CTL = 0, CTL_ZERO_BYTES = 1 * MiB;
constexpr size_t WS_SS = 128 * 1024;
constexpr size_t WS_LNS = 512 * 1024;
constexpr size_t WS_CNT = 768 * 1024;
constexpr size_t WS_SCAL = 1 * MiB;
constexpr size_t WS_ROPE = 2 * MiB;
constexpr size_t WS_W_ABIN = 4 * MiB;
constexpr size_t WS_W_ABOUT = WS_W_ABIN + 24 * MiB;
constexpr size_t WS_W_CDIN = WS_W_ABOUT + 8 * MiB;
constexpr size_t WS_W_CDOUT = WS_W_CDIN + 20 * MiB;
constexpr size_t WS_W_UP0 = WS_W_CDOUT + 8 * MiB;
constexpr size_t WS_W_UP1 = WS_W_UP0 + 44 * MiB;
constexpr size_t WS_W_DN0 = WS_W_UP1 + 44 * MiB;
constexpr size_t WS_W_DN1 = WS_W_DN0 + 22 * MiB;
constexpr size_t WS_XN = WS_W_DN1 + 22 * MiB;
constexpr size_t WS_O = WS_XN + 32 * MiB;
constexpr size_t WS_X = WS_O + 32 * MiB;
constexpr size_t WS_ACT = WS_X + 64 * MiB;
constexpr size_t WS_R1 = WS_ACT + 88 * MiB;
constexpr size_t WS_P = WS_R1;
constexpr size_t WS_OB = WS_R1 + 96 * MiB;
constexpr size_t WS_KV = WS_R1 + 96 * MiB;
constexpr size_t WS_PREV = WS_KV + 64 * MiB;
constexpr size_t WS_UP = WS_R1;
constexpr size_t WS_HALO = WS_R1 + 192 * MiB;
constexpr size_t WS_SCR = WS_HALO + 4 * MiB;
constexpr size_t WS_END = WS_SCR + 32 * MiB;

constexpr int RING_BYTES = 131072;
constexpr int LDSCTL_OFF = RING_BYTES, MISC_OFF = LDSCTL_OFF + 320;
constexpr int LDS_BYTES = 147456;

#define XB_TMO      128
#define XB_XCNT(j)  (256  + 64 * (j))
#define XB_XSUB(j)  (1280 + 64 * (j))
#define XB_XGEN(j)  (2304 + 64 * (j))
#define XB_TOP      3328
#define XB_TOPGEN   3392
#define XCD_BAR_WORDS 3456
#define XB_SPIN_CAP (1u << 20)
__device__ __forceinline__ unsigned xb_ld(unsigned* p)              { return __hip_atomic_load(p, __ATOMIC_RELAXED, __HIP_MEMORY_SCOPE_AGENT); }
__device__ __forceinline__ unsigned xb_add(unsigned* p, unsigned v) { return __hip_atomic_fetch_add(p, v, __ATOMIC_RELAXED, __HIP_MEMORY_SCOPE_AGENT); }
__device__ __forceinline__ unsigned xb_xcc_id() { return (unsigned)__builtin_amdgcn_s_getreg((3 << 11) | 20) & 0xFu; }
#define XB_SPIN(cond, bar) do { unsigned _sp = 0; while (cond) { __builtin_amdgcn_s_sleep(1); \
    if ((++_sp & 255u) == 0u) { if (xb_ld(&(bar)[XB_TMO])) break; if (_sp > XB_SPIN_CAP) { atomicAdd(&(bar)[XB_TMO], 1u); break; } } } } while (0)
#ifndef XB_FLAT
#define XB_FLAT 0
#endif
struct XcdBarrier { unsigned* bar; unsigned x; volatile LAS unsigned* st; };
#if XB_FLAT == 1
__device__ __forceinline__ XcdBarrier xcd_barrier_post(unsigned* bar, volatile LAS unsigned* st) {
    XcdBarrier b; b.bar = bar; b.x = xb_xcc_id(); b.st = st;
    return b;
}
__device__ __forceinline__ void xcd_barrier(const XcdBarrier& b) {
    asm volatile("s_waitcnt vmcnt(0)" ::: "memory");
    __syncthreads();
    if (threadIdx.x < 64) {
        unsigned* bar = b.bar; const unsigned ln = threadIdx.x;
        const unsigned k = b.st[0];
        const unsigned target = (k + 1u) * (gridDim.x * gridDim.y * gridDim.z);
        if (ln == 0) {
            __builtin_amdgcn_fence(__ATOMIC_RELEASE, "agent");
            asm volatile("s_waitcnt vmcnt(0)" ::: "memory");
            (void)__hip_atomic_fetch_add(&bar[XB_XSUB(b.x)], 1u, __ATOMIC_RELAXED, __HIP_MEMORY_SCOPE_AGENT);
            b.st[0] = k + 1u; }
        unsigned sp = 0u;
        for (;;) {
            unsigned v = ln < 16u ? xb_ld(&bar[XB_XSUB(ln)]) : 0u;
            v += __shfl_xor(v, 1); v += __shfl_xor(v, 2); v += __shfl_xor(v, 4); v += __shfl_xor(v, 8);
            v = __builtin_amdgcn_readfirstlane(v);
            if (v >= target) break;
            __builtin_amdgcn_s_sleep(1);
            if ((++sp & 255u) == 0u) { if (__builtin_amdgcn_readfirstlane(xb_ld(&bar[XB_TMO]))) break; if (sp > XB_SPIN_CAP) { if (ln == 0) atomicAdd(&bar[XB_TMO], 1u); break; } }
        }
        __builtin_amdgcn_fence(__ATOMIC_ACQUIRE, "agent");
        asm volatile("s_waitcnt vmcnt(0)" ::: "memory");
    }
    __syncthreads();
}
#else
__device__ __forceinline__ XcdBarrier xcd_barrier_post(unsigned* bar, volatile LAS unsigned* st) {
    XcdBarrier b; b.bar = bar; b.x = xb_xcc_id(); b.st = st;
    if (threadIdx.x == 0) (void)xb_add(&bar[XB_XCNT(b.x)], 1u);
    return b;
}
__device__ __forceinline__ void xcd_barrier_complete(unsigned* bar, unsigned x, unsigned& nloc, unsigned& nx) {
    const unsigned G = gridDim.x * gridDim.y * gridDim.z;
    unsigned sum, cnt, mine, sp = 0u;
    for (;;) {
        sum = 0u; cnt = 0u; mine = 0u;
#pragma unroll
        for (unsigned j = 0; j < 16; ++j) { const unsigned c = xb_ld(&bar[XB_XCNT(j)]); sum += c; cnt += (c > 0u) ? 1u : 0u; mine = (j == x) ? c : mine; }
        if (sum == G) break;
        __builtin_amdgcn_s_sleep(1);
        if ((++sp & 255u) == 0u) { if (xb_ld(&bar[XB_TMO])) break; if (sp > XB_SPIN_CAP) { atomicAdd(&bar[XB_TMO], 1u); break; } }
    }
    nloc = mine > 0u ? mine : 1u; nx = cnt > 0u ? cnt : 1u;
}
__device__ __forceinline__ void xcd_barrier(const XcdBarrier& b) {
    asm volatile("s_waitcnt vmcnt(0)" ::: "memory");
    __syncthreads();
    if (threadIdx.x == 0) {
        unsigned* bar = b.bar;
        __builtin_amdgcn_s_waitcnt(0);
        unsigned nloc = b.st[0], nx = b.st[1];
        if (nloc == 0u) { xcd_barrier_complete(bar, b.x, nloc, nx); b.st[0] = nloc; b.st[1] = nx; }
        const unsigned old = xb_add(&bar[XB_XSUB(b.x)], 1u);
        const unsigned gen = old / nloc;
#if XB_FLAT == 2
        if (old + 1u == (gen + 1u) * nloc) {
            __builtin_amdgcn_fence(__ATOMIC_RELEASE, "agent");
            asm volatile("s_waitcnt vmcnt(0)" ::: "memory");
            (void)__hip_atomic_fetch_add(&bar[XB_TOP], 1u, __ATOMIC_RELAXED, __HIP_MEMORY_SCOPE_AGENT); }
        { const unsigned target = (gen + 1u) * nx;
          XB_SPIN(xb_ld(&bar[XB_TOP]) < target, bar); }
        __builtin_amdgcn_fence(__ATOMIC_ACQUIRE, "agent");
        asm volatile("s_waitcnt vmcnt(0)" ::: "memory");
#elif XB_FLAT == 3
        if (old + 1u == (gen + 1u) * nloc) {
            __builtin_amdgcn_fence(__ATOMIC_RELEASE, "agent");
            asm volatile("s_waitcnt vmcnt(0)" ::: "memory");
            (void)__hip_atomic_fetch_add(&bar[XB_TOP], 1u, __ATOMIC_RELAXED, __HIP_MEMORY_SCOPE_AGENT);
            { const unsigned target = (gen + 1u) * nx;
              XB_SPIN(xb_ld(&bar[XB_TOP]) < target, bar); }
            __builtin_amdgcn_fence(__ATOMIC_ACQUIRE, "agent");
            (void)__hip_atomic_fetch_add(&bar[XB_XGEN(b.x)], 1u, __ATOMIC_RELAXED, __HIP_MEMORY_SCOPE_AGENT);
            asm volatile("s_waitcnt vmcnt(0)" ::: "memory");
        } else {
            XB_SPIN(xb_ld(&bar[XB_XGEN(b.x)]) == gen, bar);
            __builtin_amdgcn_fence(__ATOMIC_ACQUIRE, "agent");
            asm volatile("s_waitcnt vmcnt(0)" ::: "memory");
        }
#else
        if (old + 1u == (gen + 1u) * nloc) {
            __builtin_amdgcn_fence(__ATOMIC_RELEASE, "agent");
            asm volatile("s_waitcnt vmcnt(0)" ::: "memory");
            const unsigned og = xb_add(&bar[XB_TOP], 1u);
            const unsigned tg = og / nx;
            if (og + 1u == (tg + 1u) * nx) xb_add(&bar[XB_TOPGEN], 1u);
            else XB_SPIN(xb_ld(&bar[XB_TOPGEN]) == tg, bar);
            __builtin_amdgcn_fence(__ATOMIC_ACQUIRE, "agent");
            xb_add(&bar[XB_XGEN(b.x)], 1u);
            asm volatile("s_waitcnt vmcnt(0)" ::: "memory");
        } else {
            XB_SPIN(xb_ld(&bar[XB_XGEN(b.x)]) == gen, bar);
            __builtin_amdgcn_fence(__ATOMIC_ACQUIRE, "agent");
            asm volatile("s_waitcnt vmcnt(0)" ::: "memory");
        }
#endif
    }
    __syncthreads();
}

#endif

#ifndef ATT_SDEPTH
#define ATT_SDEPTH 1
#endif
namespace att {
constexpr int D = 128, QBLK = 32, KVBLK = 64;
constexpr float SCALE = 0.088388347648318440f;
constexpr float THR = 8.f;
constexpr int SHM_V = KVBLK * D * 2, SHM_K = KVBLK * D * 2;
constexpr int OFF_WS = 2 * SHM_V + 2 * SHM_K;
constexpr int OFF_TB = OFF_WS + 8 * 64 * 4;
constexpr int OFF_FLG = OFF_TB + 448 * 4;
#define KSWZ(row, colB) ((row) * 256 + ((colB) ^ (((row) & 7) << 4)))
#define SBAR() __builtin_amdgcn_sched_barrier(0)
__device__ __forceinline__ int crow(int r, int hi) { return (r & 3) + 8 * (r >> 2) + 4 * hi; }
__device__ __forceinline__ unsigned cvtpk(float lo, float hi) { unsigned r; asm volatile("v_cvt_pk_bf16_f32 %0, %1, %2" : "=v"(r) : "v"(lo), "v"(hi)); return r; }

__device__ __forceinline__ void partialSM(f32x16& p0, f32x16& p1, float& m_reg, float& mn, float& alpha) {
  constexpr float C = SCALE * 1.4426950408889634f;
  float pmax = p0[0];
#pragma unroll
  for (int r = 1; r < 16; ++r) pmax = fmaxf(pmax, p0[r]);
#pragma unroll
  for (int r = 0; r < 16; ++r) pmax = fmaxf(pmax, p1[r]);
  { auto rr = __builtin_amdgcn_permlane32_swap(__float_as_uint(pmax), __float_as_uint(pmax), false, false);
    pmax = fmaxf(__uint_as_float(rr[0]), __uint_as_float(rr[1])); }
  if (__builtin_expect(__all(pmax - m_reg <= THR / SCALE), 1)) { mn = m_reg; alpha = 1.f; }
  else { mn = fmaxf(m_reg, pmax); alpha = __builtin_amdgcn_exp2f((m_reg - mn) * C); m_reg = mn; }
  float mnC = -mn * C;
#pragma unroll
  for (int r = 0; r < 16; ++r) p0[r] = fmaf(p0[r], C, mnC);
#pragma unroll
  for (int r = 0; r < 16; ++r) p1[r] = fmaf(p1[r], C, mnC);
#pragma unroll
  for (int r = 0; r < 16; ++r) p0[r] = __builtin_amdgcn_exp2f(p0[r]);
}
#define PK4(P, BASE, OUT) do { unsigned a0 = cvtpk(P[BASE + 0], P[BASE + 1]), a1 = cvtpk(P[BASE + 2], P[BASE + 3]);   \
    unsigned b0 = cvtpk(P[BASE + 4], P[BASE + 5]), b1 = cvtpk(P[BASE + 6], P[BASE + 7]);                              \
    auto r0 = __builtin_amdgcn_permlane32_swap(a0, b0, false, false); auto r1 = __builtin_amdgcn_permlane32_swap(a1, b1, false, false); \
    v4u w = {r0[0], r1[0], r0[1], r1[1]}; OUT = *reinterpret_cast<bf16x8*>(&w); } while (0)
__device__ __forceinline__ void finishSM(f32x16& p0, f32x16& p1, float alpha, float& l_reg, bf16x8& pa0, bf16x8& pa1, bf16x8& pa2, bf16x8& pa3) {
#pragma unroll
  for (int r = 0; r < 16; ++r) p1[r] = __builtin_amdgcn_exp2f(p1[r]);
  float ps = 0;
#pragma unroll
  for (int r = 0; r < 16; ++r) ps += p0[r];
#pragma unroll
  for (int r = 0; r < 16; ++r) ps += p1[r];
  { auto rr = __builtin_amdgcn_permlane32_swap(__float_as_uint(ps), __float_as_uint(ps), false, false);
    ps = __uint_as_float(rr[0]) + __uint_as_float(rr[1]); }
  l_reg = l_reg * alpha + ps;
  PK4(p0, 0, pa0); PK4(p0, 8, pa1); PK4(p1, 0, pa2); PK4(p1, 8, pa3);
}
__device__ __forceinline__ void packP(const f32x16& p0, const f32x16& p1, bf16x8& pa0, bf16x8& pa1, bf16x8& pa2, bf16x8& pa3) {
  PK4(p0, 0, pa0); PK4(p0, 8, pa1); PK4(p1, 0, pa2); PK4(p1, 8, pa3);
}
__device__ __forceinline__ void qkt(f32x16& p0, f32x16& p1, const char* Ks, const bf16x8* qr, int r32, int hi) {
  p0 = f32x16{}; p1 = f32x16{};
#pragma unroll
  for (int d0 = 0; d0 < 8; ++d0) { int cb = (d0 * 16 + hi * 8) * 2;
    bf16x8 b0 = *reinterpret_cast<const bf16x8*>(Ks + KSWZ(r32, cb));
    bf16x8 b1 = *reinterpret_cast<const bf16x8*>(Ks + KSWZ(32 + r32, cb));
    p0 = __builtin_amdgcn_mfma_f32_32x32x16_bf16(b0, qr[d0], p0, 0, 0, 0);
    p1 = __builtin_amdgcn_mfma_f32_32x32x16_bf16(b1, qr[d0], p1, 0, 0, 0); }
}
__device__ __forceinline__ int v_st(int k, int c) { const int kk = (k & ~0xC) | ((k & 4) << 1) | ((k & 8) >> 1); return ((kk >> 3) * 4 + (c >> 5)) * 512 + ((kk & 7) * 32 + (c & 31)) * 2; }
__device__ __forceinline__ int v_rd_base(int lane) { return ((lane & 3) << 3) | (((lane >> 2) & 3) << 6) | (((lane >> 4) & 1) << 5) | (((lane >> 5) & 1) << 8); }
constexpr int v_rd_off(int d0, int ks, int half) { return d0 * 512 + ks * 4096 + half * 2048; }
template <int OFF> __device__ __forceinline__ s16x4 tr_read(int vb) {
  s16x4 r; asm volatile("ds_read_b64_tr_b16 %0, %1 offset:%2" : "=&v"(r) : "v"(vb), "i"(OFF) : "memory"); return r;
}
template <int D0> __device__ __forceinline__ void pv_one(f32x16& od, int vb, bf16x8 pa0, bf16x8 pa1, bf16x8 pa2, bf16x8 pa3) {
  const s16x4 l0 = tr_read<v_rd_off(D0, 0, 0)>(vb), h0 = tr_read<v_rd_off(D0, 0, 1)>(vb), l1 = tr_read<v_rd_off(D0, 1, 0)>(vb), h1 = tr_read<v_rd_off(D0, 1, 1)>(vb);
  const s16x4 l2 = tr_read<v_rd_off(D0, 2, 0)>(vb), h2 = tr_read<v_rd_off(D0, 2, 1)>(vb), l3 = tr_read<v_rd_off(D0, 3, 0)>(vb), h3 = tr_read<v_rd_off(D0, 3, 1)>(vb);
  asm volatile("s_waitcnt lgkmcnt(0)" ::: "memory"); SBAR();
#define PKV(L, H) (bf16x8){L[0], L[1], L[2], L[3], H[0], H[1], H[2], H[3]}
  od = __builtin_amdgcn_mfma_f32_32x32x16_bf16(pa0, PKV(l0, h0), od, 0, 0, 0);
  od = __builtin_amdgcn_mfma_f32_32x32x16_bf16(pa1, PKV(l1, h1), od, 0, 0, 0);
  od = __builtin_amdgcn_mfma_f32_32x32x16_bf16(pa2, PKV(l2, h2), od, 0, 0, 0);
  od = __builtin_amdgcn_mfma_f32_32x32x16_bf16(pa3, PKV(l3, h3), od, 0, 0, 0);
#undef PKV
}
__device__ __forceinline__ void pv_d0(f32x16* o, int vb, bf16x8 pa0, bf16x8 pa1, bf16x8 pa2, bf16x8 pa3) {
  pv_one<0>(o[0], vb, pa0, pa1, pa2, pa3); pv_one<1>(o[1], vb, pa0, pa1, pa2, pa3); pv_one<2>(o[2], vb, pa0, pa1, pa2, pa3); pv_one<3>(o[3], vb, pa0, pa1, pa2, pa3);
}

__device__ __forceinline__ void* uniform_ptr(const void* p) { const unsigned long long v = (unsigned long long)p;
  const unsigned lo = (unsigned)__builtin_amdgcn_readfirstlane((int)(unsigned)v), hi = (unsigned)__builtin_amdgcn_readfirstlane((int)(unsigned)(v >> 32)); return (void*)(((unsigned long long)hi << 32) | lo); }
__device__ __forceinline__ bf16x8 mk8a(s16x4 l, s16x4 h) { return (bf16x8){l[0], l[1], l[2], l[3], h[0], h[1], h[2], h[3]}; }
__device__ __forceinline__ bf16x8 bload16(__amdgpu_buffer_rsrc_t rs, int voff, int soff) {
  const v4u w = __builtin_amdgcn_raw_buffer_load_b128(rs, voff, soff, 0); return __builtin_bit_cast(bf16x8, w); }
template <int LDP, int LDO>
__device__ __forceinline__ void attnB_unit(const bf16* __restrict__ Qb, const bf16* Pbase, int koff, int voff, float* __restrict__ Ob, int qb, char* lds) {
  const __amdgpu_buffer_rsrc_t rs = __builtin_amdgcn_make_buffer_rsrc(uniform_ptr(Pbase), 0, SEQ * LDP * 2, 0x00020000);
  int tid = threadIdx.x; asm volatile("" : "+v"(tid));
  const int wid = tid >> 6, lane = tid & 63, r32 = lane & 31, hi = lane >> 5;
  char* V_lds = lds; char* K_lds = lds + 2 * SHM_V;
  float* ws = (float*)(lds + OFF_WS) + wid * 64; float* li_l = ws; float* al_l = ws + 32;
  const float* tb = (const float*)(lds + OFF_TB);
  float m_reg = -1e30f, l_reg = 0; f32x16 o[4] = {}; bf16x8 qr[8];
  const bf16* Qw = Qb + (long)(wid * QBLK + r32) * LDP + hi * 8;
#pragma unroll
  for (int d0 = 0; d0 < 8; ++d0) qr[d0] = *reinterpret_cast<const bf16x8*>(Qw + d0 * 16);
  const int sr = tid >> 4, sc = (tid & 15) * 8, vst0 = v_st(sr, sc), vst1 = v_st(32 + sr, sc);
  const int vb0 = (int)(uintptr_t)V_lds + v_rd_base(lane);
  constexpr int SDEPTH = ATT_SDEPTH;
  struct { bf16x8 vs0, vs1, ks0, ks1; } sr_[SDEPTH];
  const int vo0 = (sr * LDP + sc) * 2, vo1 = vo0 + 32 * LDP * 2;
#define SLOAD(i, k0) do { const int sV_ = (voff + (k0) * LDP) * 2, sK_ = (koff + (k0) * LDP) * 2; \
    sr_[i].vs0 = bload16(rs, vo0, sV_); sr_[i].vs1 = bload16(rs, vo1, sV_); sr_[i].ks0 = bload16(rs, vo0, sK_); sr_[i].ks1 = bload16(rs, vo1, sK_); } while (0)
#define SWRITE(b, i) do { *(bf16x8*)(V_lds + (b) * SHM_V + vst0) = sr_[i].vs0;          \
    *(bf16x8*)(V_lds + (b) * SHM_V + vst1) = sr_[i].vs1; int kc = sc * 2;               \
    *(bf16x8*)(K_lds + (b) * SHM_K + KSWZ(sr, kc)) = sr_[i].ks0;                       \
    *(bf16x8*)(K_lds + (b) * SHM_K + KSWZ(32 + sr, kc)) = sr_[i].ks1; } while (0)
#define SWAIT() do { if constexpr (SDEPTH == 2) asm volatile("s_waitcnt vmcnt(4)" ::: "memory"); else asm volatile("s_waitcnt vmcnt(0)" ::: "memory"); } while (0)
#define RESC(a) do { if (__any((a) < 1.f)) { if (hi == 0) al_l[r32] = (a); asm volatile("s_waitcnt lgkmcnt(0)" ::: "memory"); \
    _Pragma("unroll") for (int d = 0; d < 4; ++d) _Pragma("unroll") for (int r = 0; r < 16; ++r) o[d][r] *= al_l[crow(r, hi)]; } } while (0)
  const int NT = 4 * qb + 4, chunk_w = 4 * qb + (wid >> 1);
  const int ib0 = 4 * hi - 256 * qb - 32 * wid - r32 + 127 + 256;
#ifdef NO_FIX
#define FIX(P0, P1, j) do {} while (0)
#else
#define FIX(P0, P1, j) do { if ((j) > chunk_w) { _Pragma("unroll") for (int r = 0; r < 16; ++r) { P0[r] = -1e30f; P1[r] = -1e30f; } } \
    else if ((j) >= NT - 6) { const float* tbj = tb + (ib0 + 64 * (j)); \
      _Pragma("unroll") for (int r = 0; r < 16; ++r) { P0[r] += tbj[(r & 3) + 8 * (r >> 2)]; P1[r] += tbj[32 + (r & 3) + 8 * (r >> 2)]; } } } while (0)
#endif
  f32x16 pA0, pA1, pB0, pB1; float mnA, mnB, alA, alB; bf16x8 pa0, pa1, pa2, pa3;
  constexpr int SE = 0, SO = SDEPTH - 1;
  SLOAD(SE, 0); asm volatile("s_waitcnt vmcnt(0)" ::: "memory"); SWRITE(0, SE); __syncthreads();
  qkt(pA0, pA1, K_lds, qr, r32, hi); FIX(pA0, pA1, 0); partialSM(pA0, pA1, m_reg, mnA, alA);
  SLOAD(SO, KVBLK); if constexpr (SDEPTH == 2) { if (2 < NT) SLOAD(SE, 2 * KVBLK); }
  SWAIT(); SWRITE(1, SO); __syncthreads();
  for (int j = 1; j + 1 < NT; j += 2) {
    SBAR(); qkt(pB0, pB1, K_lds + SHM_K, qr, r32, hi);
    finishSM(pA0, pA1, alA, l_reg, pa0, pa1, pa2, pa3); SBAR();
    SLOAD(SO, (j + SDEPTH) * KVBLK); SBAR();
    pv_d0(o, vb0, pa0, pa1, pa2, pa3); FIX(pB0, pB1, j); partialSM(pB0, pB1, m_reg, mnB, alB);
    __syncthreads(); SWAIT(); SWRITE(0, SE);
    RESC(alB); __syncthreads();
    SBAR(); qkt(pA0, pA1, K_lds, qr, r32, hi);
    finishSM(pB0, pB1, alB, l_reg, pa0, pa1, pa2, pa3); SBAR();
    if (SDEPTH == 1 || j + 3 < NT) SLOAD(SE, (j + 1 + SDEPTH) * KVBLK); SBAR();
    pv_d0(o, vb0 + SHM_V, pa0, pa1, pa2, pa3); FIX(pA0, pA1, j + 1); partialSM(pA0, pA1, m_reg, mnA, alA);
    __syncthreads(); SWAIT(); SWRITE(1, SO);
    RESC(alA); __syncthreads();
  }
  SBAR(); qkt(pB0, pB1, K_lds + SHM_K, qr, r32, hi);
  finishSM(pA0, pA1, alA, l_reg, pa0, pa1, pa2, pa3); SBAR();
  pv_d0(o, vb0, pa0, pa1, pa2, pa3); FIX(pB0, pB1, NT - 1); partialSM(pB0, pB1, m_reg, mnB, alB);
  __syncthreads(); RESC(alB);
  finishSM(pB0, pB1, alB, l_reg, pa0, pa1, pa2, pa3); SBAR();
  pv_d0(o, vb0 + SHM_V, pa0, pa1, pa2, pa3);
  if (hi == 0) li_l[r32] = l_reg; asm volatile("s_waitcnt lgkmcnt(0)" ::: "memory");
  float rli[16];
#pragma unroll
  for (int r = 0; r < 16; ++r) rli[r] = __builtin_amdgcn_rcpf(li_l[crow(r, hi)]);
  float* Ow = Ob + (long)(wid * QBLK) * LDO;
#pragma unroll
  for (int r = 0; r < 16; ++r) { int orow = crow(r, hi);
#pragma unroll
    for (int d0 = 0; d0 < 4; ++d0) Ow[(long)orow * LDO + d0 * 32 + r32] = o[d0][r] * rli[r]; }
  __syncthreads();
#undef SLOAD
#undef SWRITE
#undef SWAIT
#undef RESC
#undef FIX
}

__device__ __forceinline__ void glds16_asm(const void* gsrc, unsigned lds_dst) { unsigned keep;
  asm volatile("s_mov_b32 %0, m0\n\ts_mov_b32 m0, %2\n\ts_nop 0\n\tglobal_load_lds_dwordx4 %1, off\n\ts_mov_b32 m0, %0" : "=&s"(keep) : "v"(gsrc), "s"(lds_dst) : "memory"); }
constexpr int B2_K = 0, B2_V = 2 * SHM_K, B2_P = B2_V + 4 * SHM_V, B2_X = 131072 + 1024;
constexpr int B2_AL = B2_X, B2_FL = B2_AL + 1024, B2_LI = B2_FL + 64, B2_TB = B2_LI + 512;
template <int LDP, int LDO>
__device__ __forceinline__ void attnB2_unit(const bf16* __restrict__ Qb, const bf16* Pbase, int koff, int voff, float* __restrict__ Ob, int q128, char* lds, int sel = 0) {
  int tid = threadIdx.x; asm volatile("" : "+v"(tid));
  const int wid = __builtin_amdgcn_readfirstlane(tid >> 6), lane = tid & 63, r32 = lane & 31, hi = lane >> 5, pw = wid & 3;
  const int NT = 2 * q128 + 2;
  const unsigned lbase = (unsigned)__builtin_amdgcn_readfirstlane((int)(uintptr_t)lds);
  const bf16* Ksrc; const bf16* Vsrc[4];
  { const int row0 = 8 * wid + (lane >> 4), row1 = row0 + 4;
    Ksrc = Pbase + koff + (size_t)row0 * LDP + (((lane & 15) ^ (row0 & 7)) << 3);
    (void)row1; }
  const int kx1 = (int)((((lane & 15) ^ ((8 * wid + (lane >> 4) + 4) & 7)) << 3)) - (int)((((lane & 15) ^ ((8 * wid + (lane >> 4)) & 7)) << 3));
#pragma unroll
  for (int q = 0; q < 4; ++q) { const int ci = wid * 4 + q, vt = ci >> 4, cs = ci & 15, st = cs * 2 + (lane >> 5);
    const int kk = (st >> 2) * 8 + ((lane >> 2) & 7), k = (kk & ~0xC) | ((kk & 4) << 1) | ((kk & 8) >> 1), c = vt * 128 + (st & 3) * 32 + (lane & 3) * 8;
    Vsrc[q] = Pbase + voff + (size_t)k * LDP + c; }
#define B2DMA_K(t_, b_) do { const bf16* ks_ = Ksrc + (size_t)(t_) * KVBLK * LDP; const unsigned kd_ = (unsigned)__builtin_amdgcn_readfirstlane((int)(lbase + B2_K + (b_) * SHM_K + wid * 2048)); \
    glds16_asm(ks_, kd_); glds16_asm(ks_ + 4 * LDP + kx1, kd_ + 1024); } while (0)
#define B2DMA_V(t_, b_) do { _Pragma("unroll") for (int q = 0; q < 4; ++q) { const int ci_ = wid * 4 + q; \
      glds16_asm(Vsrc[q] + (size_t)(t_) * KVBLK * LDP, (unsigned)__builtin_amdgcn_readfirstlane((int)(lbase + B2_V + (b_) * 2 * SHM_V + (ci_ >> 4) * SHM_V + (ci_ & 15) * 1024))); } } while (0)
#define B2SYNC() do { asm volatile("s_waitcnt vmcnt(0)" ::: "memory"); __syncthreads(); } while (0)
  typedef __attribute__((address_space(3))) float lds_f32; typedef __attribute__((address_space(3))) int lds_i32;
  lds_f32* al_s = (lds_f32*)(uintptr_t)(lbase + B2_AL); lds_i32* fl_s = (lds_i32*)(uintptr_t)(lbase + B2_FL); lds_f32* li_s = (lds_f32*)(uintptr_t)(lbase + B2_LI);
  B2DMA_K(0, 0); B2DMA_V(0, 0); B2DMA_K(1, 1);
  if (wid < 4) {
    const float* tb = (const float*)(lds + B2_TB);
    const int chunk_w = 2 * q128 + (pw >> 1);
    const int ib0 = 4 * hi - 128 * q128 - 32 * pw - r32 + 127 + 256;
    float m_reg = -1e30f, l_reg = 0.f; bf16x8 qr[8];
    { const bf16* Qw = Qb + (long)(pw * QBLK + r32) * LDP + hi * 8;
#pragma unroll
      for (int d0 = 0; d0 < 8; ++d0) qr[d0] = *reinterpret_cast<const bf16x8*>(Qw + d0 * 16); }
    B2SYNC();
#define B2PROD(t_) do { f32x16 p0, p1; qkt(p0, p1, lds + B2_K + ((t_) & 1) * SHM_K, qr, r32, hi); \
      if ((t_) > chunk_w) { _Pragma("unroll") for (int r = 0; r < 16; ++r) { p0[r] = -1e30f; p1[r] = -1e30f; } } \
      else if ((t_) >= NT - 4) { const float* tbj = tb + (ib0 + 64 * (t_)); \
        _Pragma("unroll") for (int r = 0; r < 16; ++r) { p0[r] += tbj[(r & 3) + 8 * (r >> 2)]; p1[r] += tbj[32 + (r & 3) + 8 * (r >> 2)]; } } \
      float mn_, al_; partialSM(p0, p1, m_reg, mn_, al_); bf16x8 pa0, pa1, pa2, pa3; finishSM(p0, p1, al_, l_reg, pa0, pa1, pa2, pa3); \
      char* pb_ = lds + B2_P + ((((t_) & 1) * 4 + pw) * 4) * 1024 + lane * 16; \
      *(bf16x8*)(pb_) = pa0; *(bf16x8*)(pb_ + 1024) = pa1; *(bf16x8*)(pb_ + 2048) = pa2; *(bf16x8*)(pb_ + 3072) = pa3; \
      if (hi == 0) al_s[(((t_) & 1) * 4 + pw) * 32 + r32] = al_; \
      const int any_ = __any(al_ < 1.f) ? 1 : 0; if (lane == 0) fl_s[((t_) & 1) * 4 + pw] = any_; } while (0)
    B2PROD(0);
    B2SYNC();
    for (int j = 0; j < NT; ++j) {
      if (j + 2 < NT) B2DMA_K(j + 2, j & 1);
      if (j + 1 < NT) B2DMA_V(j + 1, (j + 1) & 1);
      if (j + 1 < NT && !(sel & 4)) B2PROD(j + 1);
      B2SYNC();
    }
    if (hi == 0) li_s[pw * 32 + r32] = __builtin_amdgcn_rcpf(l_reg);
    __syncthreads();
#undef B2PROD
  } else {
    f32x16 o[8] = {};
    const int vb0 = (int)(uintptr_t)(lds + B2_V) + v_rd_base(lane);
    B2SYNC();
    B2SYNC();
    for (int j = 0; j < NT; ++j) {
      if (j + 2 < NT) B2DMA_K(j + 2, j & 1);
      if (j + 1 < NT) B2DMA_V(j + 1, (j + 1) & 1);
      if (!(sel & 8)) { const int bsel = j & 1;
        if (fl_s[bsel * 4 + pw]) { const lds_f32* ap = al_s + (bsel * 4 + pw) * 32;
#pragma unroll
          for (int d = 0; d < 8; ++d)
#pragma unroll
            for (int r = 0; r < 16; ++r) o[d][r] *= ap[crow(r, hi)]; }
        const char* pb_ = lds + B2_P + ((bsel * 4 + pw) * 4) * 1024 + lane * 16;
        const bf16x8 pa0 = *(const bf16x8*)(pb_), pa1 = *(const bf16x8*)(pb_ + 1024), pa2 = *(const bf16x8*)(pb_ + 2048), pa3 = *(const bf16x8*)(pb_ + 3072);
        pv_d0(o, vb0 + bsel * 2 * SHM_V, pa0, pa1, pa2, pa3); pv_d0(o + 4, vb0 + bsel * 2 * SHM_V + SHM_V, pa0, pa1, pa2, pa3); }
      B2SYNC();
    }
    __syncthreads();
    float rli[16];
#pragma unroll
    for (int r = 0; r < 16; ++r) rli[r] = li_s[pw * 32 + crow(r, hi)];
    float* Ow = Ob + (long)(pw * QBLK) * LDO;
#pragma unroll
    for (int r = 0; r < 16; ++r) { const int orow = crow(r, hi);
#pragma unroll
      for (int d = 0; d < 8; ++d) Ow[(long)orow * LDO + d * 32 + r32] = o[d][r] * rli[r]; }
  }
  __syncthreads();
#undef B2DMA_K
#undef B2DMA_V
#undef B2SYNC
}

template <int LDP, int LDO>
__device__ __forceinline__ void attnA_unit(const bf16* __restrict__ Qb, const bf16* Pbase, int koff, int voff, bf16* __restrict__ Ob, int qb, char* lds) {
  const __amdgpu_buffer_rsrc_t rs = __builtin_amdgcn_make_buffer_rsrc(uniform_ptr(Pbase), 0, SEQ * LDP * 2, 0x00020000);
  int tid = threadIdx.x; asm volatile("" : "+v"(tid));
  const int wid = __builtin_amdgcn_readfirstlane(tid >> 6), lane = tid & 63, r32 = lane & 31, hi = lane >> 5;
  char* K_lds = lds + wid * 16384; char* V_lds = K_lds + 8192;
  f32x16 o[4] = {}; bf16x8 qr[8];
  const bf16* Qw = Qb + (long)(wid * QBLK + r32) * LDP + hi * 8;
#pragma unroll
  for (int d0 = 0; d0 < 8; ++d0) qr[d0] = *reinterpret_cast<const bf16x8*>(Qw + d0 * 16);
  const int srow = lane >> 1, scol = (lane & 1) * 64;
  const int vo = (srow * LDP + scol) * 2;
  const int vb0 = (int)(uintptr_t)V_lds + v_rd_base(lane);
  const int krow = lane >> 4, kch = lane & 15;
  const unsigned klds = (unsigned)__builtin_amdgcn_readfirstlane((int)(uintptr_t)K_lds);
  const bf16* Ksrc = Pbase + koff;
  float R = 0.f;
  const int htd = 8 * qb + wid;
  bf16x8 tv[8];
#define AKDMA(ht_) do { _Pragma("unroll") for (int j = 0; j < 8; ++j) { const int row_ = 4 * j + krow; \
      __builtin_amdgcn_global_load_lds((const unsigned*)(Ksrc + (size_t)((ht_) * 32 + row_) * LDP + ((kch ^ (row_ & 7)) << 3)), (__attribute__((address_space(3))) unsigned*)(uintptr_t)(klds + j * 1024), 16, 0, 0); } } while (0)
#define AVLOAD(ht_) do { const int sV_ = __builtin_amdgcn_readfirstlane((voff + (ht_) * 32 * LDP) * 2); _Pragma("unroll") for (int j = 0; j < 8; ++j) tv[j] = bload16(rs, vo + 16 * j, sV_); } while (0)
  AKDMA(htd); AVLOAD(htd);
  for (int ht = htd; ht >= 0; --ht) {
    asm volatile("s_waitcnt vmcnt(0)" ::: "memory");
#pragma unroll
    for (int j = 0; j < 8; ++j) *(bf16x8*)(V_lds + v_st(srow, scol + 8 * j)) = tv[j];
    if (ht > 0) AVLOAD(ht - 1);
    asm volatile("s_waitcnt lgkmcnt(0)" ::: "memory");
    f32x16 p0 = f32x16{};
#pragma unroll
    for (int d0 = 0; d0 < 8; ++d0) { const int cb = (d0 * 16 + hi * 8) * 2;
      const bf16x8 b0 = *reinterpret_cast<const bf16x8*>(K_lds + KSWZ(r32, cb));
      p0 = __builtin_amdgcn_mfma_f32_32x32x16_bf16(b0, qr[d0], p0, 0, 0, 0); }
    asm volatile("s_waitcnt lgkmcnt(0)" : "+v"(p0) :: "memory");
    if (ht > 0) AKDMA(ht - 1);
    const int lim = (ht == htd) ? r32 : 32;
    float qs[4], oq[4]; f32x16 Ln;
#pragma unroll
    for (int g = 0; g < 4; ++g) { float s_ = 0.f;
#pragma unroll
      for (int i = 0; i < 4; ++i) { const int r = 4 * g + i; const float x = p0[r] * SCALE; p0[r] = x;
        const float sp = __logf(1.f + __expf(-fabsf(x))); const float ln = (crow(r, hi) < lim) ? -(fmaxf(x, 0.f) + sp) : 0.f;
        Ln[r] = ln; s_ += ln; }
      qs[g] = s_; }
#pragma unroll
    for (int g = 0; g < 4; ++g) oq[g] = __shfl_xor(qs[g], 32);
    float run = 0.f;
#pragma unroll
    for (int g = 3; g >= 0; --g) { float E = R + run + (hi == 0 ? oq[g] : 0.f);
#pragma unroll
      for (int i = 3; i >= 0; --i) { const int r = 4 * g + i;
        const bool valid = crow(r, hi) < lim;
        const float w = valid ? __expf(Ln[r] + p0[r] + E) : 0.f; E += Ln[r]; p0[r] = w; }
      run += qs[g] + oq[g]; }
    R += run;
    bf16x8 pa0, pa1; PK4(p0, 0, pa0); PK4(p0, 8, pa1);
#define AV_ONE(D0) do { const s16x4 l0 = tr_read<v_rd_off(D0, 0, 0)>(vb0), h0 = tr_read<v_rd_off(D0, 0, 1)>(vb0), l1 = tr_read<v_rd_off(D0, 1, 0)>(vb0), h1 = tr_read<v_rd_off(D0, 1, 1)>(vb0); \
      asm volatile("s_waitcnt lgkmcnt(0)" ::: "memory"); SBAR(); \
      o[D0] = __builtin_amdgcn_mfma_f32_32x32x16_bf16(pa0, mk8a(l0, h0), o[D0], 0, 0, 0); o[D0] = __builtin_amdgcn_mfma_f32_32x32x16_bf16(pa1, mk8a(l1, h1), o[D0], 0, 0, 0); } while (0)
    AV_ONE(0); AV_ONE(1); AV_ONE(2); AV_ONE(3);
#undef AV_ONE
    if (__all(R < -104.f)) break;
  }
#undef AKDMA
#undef AVLOAD
  asm volatile("s_waitcnt vmcnt(0)" ::: "memory");
  bf16* Ow = Ob + (long)(wid * QBLK) * LDO;
#pragma unroll
  for (int r = 0; r < 16; ++r) { const int orow = crow(r, hi);
#pragma unroll
    for (int d0 = 0; d0 < 4; ++d0) Ow[(long)orow * LDO + d0 * 32 + r32] = (bf16)f2bf(o[d0][r]); }
  __syncthreads();
}
__device__ __forceinline__ bf16x8 mk8(s16x4 l, s16x4 h) { return (bf16x8){l[0], l[1], l[2], l[3], h[0], h[1], h[2], h[3]}; }
__device__ __forceinline__ v4u pack8(const float* f) { v4u w; w.x = cvtpk(f[0], f[1]); w.y = cvtpk(f[2], f[3]); w.z = cvtpk(f[4], f[5]); w.w = cvtpk(f[6], f[7]); return w; }
__device__ __forceinline__ void rot8(v4u lo4, v4u hi4, const float2* cs, float mul, float* ol, float* oh) {
#pragma unroll
  for (int q = 0; q < 4; ++q) { const float2 c0 = cs[2 * q], c1 = cs[2 * q + 1];
    const float l0 = bflo(lo4[q]), l1 = bfhi(lo4[q]), h0 = bflo(hi4[q]), h1 = bfhi(hi4[q]);
    ol[2 * q] = (l0 * c0.x - h0 * c0.y) * mul; ol[2 * q + 1] = (l1 * c1.x - h1 * c1.y) * mul;
    oh[2 * q] = (h0 * c0.x + l0 * c0.y) * mul; oh[2 * q + 1] = (h1 * c1.x + l1 * c1.y) * mul; }
}
template <int LDP>
__device__ __forceinline__ void ret_kv_unit(const bf16* __restrict__ P, const float2* __restrict__ ROPE, bf16* __restrict__ kvo, int b, int h, int n, char* lds) {
  int tid = threadIdx.x; asm volatile("" : "+v"(tid));
  const int wid = tid >> 6, lane = tid & 63, r32 = lane & 31, hi = lane >> 5;
  char* Vt = lds; char* Kt = lds + 2 * SHM_V;
  const size_t t0 = (size_t)b * SEQ + 64 * n;
  const float lg = __logf(1.f - exp2f(-5.f - (float)h));
  {
    bf16x8 vv[4];
#pragma unroll
    for (int it = 0; it < 4; ++it) { const int task = it * 512 + tid, vt = task >> 10, row = (task >> 4) & 63, sc = (task & 15) * 8;
      vv[it] = *reinterpret_cast<const bf16x8*>(P + (t0 + row) * LDP + 1024 + h * 256 + vt * 128 + sc); }
    const int m = tid >> 3, dc = (tid & 7) * 8; const bf16* kr = P + (t0 + m) * LDP + 512 + h * 128;
    const v4u lo4 = *(const v4u*)(kr + dc), hi4 = *(const v4u*)(kr + 64 + dc);
    float2 csv[8]; { const float2* cs = ROPE + (size_t)(64 * n + m) * 64 + dc;
#pragma unroll
      for (int q = 0; q < 8; ++q) csv[q] = cs[q]; }
#pragma unroll
    for (int it = 0; it < 4; ++it) { const int task = it * 512 + tid, vt = task >> 10, row = (task >> 4) & 63, sc = (task & 15) * 8;
      *(bf16x8*)(Vt + vt * SHM_V + v_st(row, sc)) = vv[it]; }
    float ol[8], oh[8]; rot8(lo4, hi4, csv, __expf(lg * (float)(63 - m)), ol, oh);
    *(v4u*)(Kt + v_st(m, dc)) = pack8(ol); *(v4u*)(Kt + v_st(m, 64 + dc)) = pack8(oh); }
  __syncthreads();
  const int vbA = (int)(uintptr_t)(Vt + (wid >> 2) * SHM_V) + v_rd_base(lane) + (wid & 3) * 512;
  const int vbB = (int)(uintptr_t)Kt + v_rd_base(lane);
  bf16x8 a[4];
  { const s16x4 l0 = tr_read<v_rd_off(0, 0, 0)>(vbA), h0 = tr_read<v_rd_off(0, 0, 1)>(vbA), l1 = tr_read<v_rd_off(0, 1, 0)>(vbA), h1 = tr_read<v_rd_off(0, 1, 1)>(vbA);
    const s16x4 l2 = tr_read<v_rd_off(0, 2, 0)>(vbA), h2 = tr_read<v_rd_off(0, 2, 1)>(vbA), l3 = tr_read<v_rd_off(0, 3, 0)>(vbA), h3 = tr_read<v_rd_off(0, 3, 1)>(vbA);
    asm volatile("s_waitcnt lgkmcnt(0)" ::: "memory"); SBAR();
    a[0] = mk8(l0, h0); a[1] = mk8(l1, h1); a[2] = mk8(l2, h2); a[3] = mk8(l3, h3); }
  f32x16 acc[4] = {};
  pv_one<0>(acc[0], vbB, a[0], a[1], a[2], a[3]); pv_one<1>(acc[1], vbB, a[0], a[1], a[2], a[3]); pv_one<2>(acc[2], vbB, a[0], a[1], a[2], a[3]); pv_one<3>(acc[3], vbB, a[0], a[1], a[2], a[3]);
#pragma unroll
  for (int db = 0; db < 4; ++db)
#pragma unroll
    for (int r = 0; r < 16; ++r) kvo[(size_t)(32 * wid + crow(r, hi)) * 128 + 32 * db + r32] = (bf16)f2bf(acc[db][r]);
  __syncthreads();
}
template <int LDP, int LDO>
__device__ __forceinline__ void ret_out_unit(const bf16* __restrict__ P, const float2* __restrict__ ROPE, const bf16* __restrict__ PREV, const float* __restrict__ rg, bf16* __restrict__ O, int b, int h, int np, char* lds) {
  int tid = threadIdx.x; asm volatile("" : "+v"(tid));
  const int wid = tid >> 6, lane = tid & 63, r32 = lane & 31, hi = lane >> 5;
  const int cw = wid >> 2, qh = (wid >> 1) & 1, eh = wid & 1, bh = b * 4 + h;
  constexpr int CH = 3 * SHM_V;
  float* red = (float*)(lds + 2 * CH);
  const float lg = __logf(1.f - exp2f(-5.f - (float)h));
  { v4u klo[2], khi[2]; float2 csv[2][8]; bf16x8 vv[2][4]; const int m = tid >> 3, dc = (tid & 7) * 8;
#pragma unroll
    for (int cc = 0; cc < 2; ++cc) { const int n = 2 * np + cc; const size_t t0 = (size_t)b * SEQ + 64 * n;
      const bf16* kr = P + (t0 + m) * LDP + 512 + h * 128; klo[cc] = *(const v4u*)(kr + dc); khi[cc] = *(const v4u*)(kr + 64 + dc);
      const float2* cs = ROPE + (size_t)(64 * n + m) * 64 + dc;
#pragma unroll
      for (int q = 0; q < 8; ++q) csv[cc][q] = cs[q];
#pragma unroll
      for (int it = 0; it < 4; ++it) { const int task = it * 512 + tid, vt = task >> 10, row = (task >> 4) & 63, sc = (task & 15) * 8;
        vv[cc][it] = *reinterpret_cast<const bf16x8*>(P + (t0 + row) * LDP + 1024 + h * 256 + vt * 128 + sc); } }
#pragma unroll
    for (int cc = 0; cc < 2; ++cc) { float ol[8], oh[8]; rot8(klo[cc], khi[cc], csv[cc], 1.f, ol, oh);
      *(v4u*)(lds + cc * CH + KSWZ(m, dc * 2)) = pack8(ol); *(v4u*)(lds + cc * CH + KSWZ(m, (64 + dc) * 2)) = pack8(oh);
#pragma unroll
      for (int it = 0; it < 4; ++it) { const int task = it * 512 + tid, vt = task >> 10, row = (task >> 4) & 63, sc = (task & 15) * 8;
        *(bf16x8*)(lds + cc * CH + SHM_V + vt * SHM_V + v_st(row, sc)) = vv[cc][it]; } } }
  const int n = 2 * np + cw; const size_t tq = (size_t)b * SEQ + 64 * n + 32 * qh + r32;
  bf16x8 qr[8];
  { const bf16* qrow = P + tq * LDP + h * 128 + hi * 8; const float2* cs = ROPE + (size_t)(64 * n + 32 * qh + r32) * 64 + hi * 8;
#pragma unroll
    for (int d0 = 0; d0 < 4; ++d0) { const v4u lo4 = *(const v4u*)(qrow + d0 * 16), hi4 = *(const v4u*)(qrow + 64 + d0 * 16);
      float ol[8], oh[8]; rot8(lo4, hi4, cs + d0 * 16, SCALE, ol, oh);
      const v4u wl = pack8(ol), wh = pack8(oh); qr[d0] = __builtin_bit_cast(bf16x8, wl); qr[d0 + 4] = __builtin_bit_cast(bf16x8, wh); } }
  f32x16 o[4] = {};
  { const bf16* pv = PREV + ((size_t)bh * 64 + n) * 32768 + (size_t)(128 * eh + r32) * 128 + hi * 8;
    bf16x8 bc[8], bn[8];
#pragma unroll
    for (int ks = 0; ks < 8; ++ks) bc[ks] = *reinterpret_cast<const bf16x8*>(pv + ks * 16);
#pragma unroll
    for (int d0 = 0; d0 < 4; ++d0) {
      if (d0 < 3) {
#pragma unroll
        for (int ks = 0; ks < 8; ++ks) bn[ks] = *reinterpret_cast<const bf16x8*>(pv + (size_t)(32 * (d0 + 1)) * 128 + ks * 16); }
      __builtin_amdgcn_sched_barrier(0);
#pragma unroll
      for (int ks = 0; ks < 8; ++ks) o[d0] = __builtin_amdgcn_mfma_f32_32x32x16_bf16(qr[ks], bc[ks], o[d0], 0, 0, 0);
      __builtin_amdgcn_sched_barrier(0);
      if (d0 < 3) {
#pragma unroll
        for (int ks = 0; ks < 8; ++ks) bc[ks] = bn[ks]; } } }
#pragma unroll
  for (int r = 0; r < 16; ++r) { const float qd = __expf(lg * (float)(32 * qh + crow(r, hi) + 1));
#pragma unroll
    for (int d0 = 0; d0 < 4; ++d0) o[d0][r] *= qd; }
  __syncthreads();
  { f32x16 p0, p1; qkt(p0, p1, lds + cw * CH, qr, r32, hi);
    const int c = 32 * qh + r32;
#pragma unroll
    for (int r = 0; r < 16; ++r) { const int m0 = crow(r, hi), m1 = m0 + 32; const int d0_ = c > m0 ? c - m0 : m0 - c, d1_ = c > m1 ? c - m1 : m1 - c;
      p0[r] *= __expf(lg * (float)d0_); p1[r] *= __expf(lg * (float)d1_); }
    bf16x8 pa0, pa1, pa2, pa3; packP(p0, p1, pa0, pa1, pa2, pa3);
    pv_d0(o, (int)(uintptr_t)(lds + cw * CH + SHM_V + eh * SHM_V) + v_rd_base(lane), pa0, pa1, pa2, pa3); }
  { float ssq[16];
#pragma unroll
    for (int r = 0; r < 16; ++r) { float s_ = (o[0][r] * o[0][r] + o[1][r] * o[1][r]) + (o[2][r] * o[2][r] + o[3][r] * o[3][r]);
      s_ += __shfl_xor(s_, 1); s_ += __shfl_xor(s_, 2); s_ += __shfl_xor(s_, 4); s_ += __shfl_xor(s_, 8); s_ += __shfl_xor(s_, 16); ssq[r] = s_; }
    if (r32 == 0) {
#pragma unroll
      for (int r = 0; r < 16; ++r) red[wid * 32 + crow(r, hi)] = ssq[r]; }
    __syncthreads();
    const size_t trow0 = (size_t)b * SEQ + 64 * n + 32 * qh;
    bf16 gv[16][4];
#pragma unroll
    for (int r = 0; r < 16; ++r)
#pragma unroll
      for (int d0 = 0; d0 < 4; ++d0) gv[r][d0] = P[(trow0 + crow(r, hi)) * LDP + 2048 + h * 256 + 128 * eh + 32 * d0 + r32];
#pragma unroll
    for (int r = 0; r < 16; ++r) { const int rl = crow(r, hi); const float tot = red[wid * 32 + rl] + red[(wid ^ 1) * 32 + rl]; const float rstd = rsqrtf(tot * (1.f / 256.f) + 1e-6f);
      const size_t row = trow0 + rl;
#pragma unroll
      for (int d0 = 0; d0 < 4; ++d0) { const int e = 128 * eh + 32 * d0 + r32;
        const float gate = silu_f(bf2f(gv[r][d0]));
        O[row * LDO + h * 256 + e] = (bf16)f2bf(o[d0][r] * rstd * rg[e] * gate); } } }
  __syncthreads();
}
template <int LDP, int LDO>
__device__ __forceinline__ void sgu_unit(const bf16* __restrict__ P, const unsigned long long* __restrict__ lnsum, const float* __restrict__ lng, const float* __restrict__ lnb, const float* __restrict__ Wg, const float* __restrict__ bs,
                                         bf16* __restrict__ O, size_t t0, int g, char* lds) {
  int tid = threadIdx.x; asm volatile("" : "+v"(tid));
  const int wid = tid >> 6, lane = tid & 63, r32 = lane & 31, hi = lane >> 5;
  { const int cc = (tid & 31) * 8;
    v4u vin[8]; unsigned long long s1v[8], s2v[8];
#pragma unroll
    for (int it = 0; it < 8; ++it) { const int j = it * 16 + (tid >> 5);
      vin[it] = *(const v4u*)(P + (t0 + j) * LDP + 4096 + g * 256 + cc); s1v[it] = lnsum[2 * (t0 + j)]; s2v[it] = lnsum[2 * (t0 + j) + 1]; }
    const f32x4 g0 = *(const f32x4*)(lng + g * 256 + cc), g1 = *(const f32x4*)(lng + g * 256 + cc + 4), b0 = *(const f32x4*)(lnb + g * 256 + cc), b1 = *(const f32x4*)(lnb + g * 256 + cc + 4);
#pragma unroll
    for (int it = 0; it < 8; ++it) { const int j = it * 16 + (tid >> 5); const v4u v4 = vin[it];
      const float s1 = (float)(long long)s1v[it] * (1.f / 16777216.f), s2 = (float)(long long)s2v[it] * (1.f / 16777216.f); const float mean = s1 * (1.f / 1024.f); const float rstd = rsqrtf(fmaxf(s2 * (1.f / 1024.f) - mean * mean, 0.f) + 1e-6f);
      float y[8];
#pragma unroll
      for (int q = 0; q < 4; ++q) { y[2 * q] = gelu_tanh(bflo(v4[q])); y[2 * q + 1] = gelu_tanh(bfhi(v4[q])); }
#pragma unroll
      for (int q = 0; q < 4; ++q) { y[q] = (y[q] - mean) * rstd * g0[q] + b0[q]; y[4 + q] = (y[4 + q] - mean) * rstd * g1[q] + b1[q]; }
      *(v4u*)(lds + ((j >> 6) * 2 + (cc >> 7)) * SHM_V + v_st(j & 63, cc & 127)) = pack8(y); } }
  const int ib = wid & 3, ct = wid >> 2;
  bf16x8 wa[8];
  { const float* wr = Wg + (size_t)(32 * ib + r32) * 128 + hi * 8;
#pragma unroll
    for (int ks = 0; ks < 8; ++ks) { if (ks < 4 || ib >= 2) { const f32x4 a0 = *(const f32x4*)(wr + ks * 16), a1 = *(const f32x4*)(wr + ks * 16 + 4);
        v4u w; w.x = cvtpk(a0[0], a0[1]); w.y = cvtpk(a0[2], a0[3]); w.z = cvtpk(a1[0], a1[1]); w.w = cvtpk(a1[2], a1[3]); wa[ks] = __builtin_bit_cast(bf16x8, w); }
      else wa[ks] = (bf16x8){0, 0, 0, 0, 0, 0, 0, 0}; } }
  __syncthreads();
  f32x16 o[4] = {};
  pv_d0(o, (int)(uintptr_t)(lds + (0 * 2 + ct) * SHM_V) + v_rd_base(lane), wa[0], wa[1], wa[2], wa[3]);
  if (ib >= 2) pv_d0(o, (int)(uintptr_t)(lds + (1 * 2 + ct) * SHM_V) + v_rd_base(lane), wa[4], wa[5], wa[6], wa[7]);
  { bf16 uv[16][4];
#pragma unroll
    for (int r = 0; r < 16; ++r)
#pragma unroll
      for (int d0 = 0; d0 < 4; ++d0) uv[r][d0] = P[(t0 + 32 * ib + crow(r, hi)) * LDP + 3072 + g * 256 + 128 * ct + 32 * d0 + r32];
#pragma unroll
    for (int r = 0; r < 16; ++r) { const int i = 32 * ib + crow(r, hi); const float bi = bs[i]; const size_t row = t0 + i;
#pragma unroll
      for (int d0 = 0; d0 < 4; ++d0) { const int c = 128 * ct + 32 * d0 + r32;
        const float uu = gelu_tanh(bf2f(uv[r][d0]));
        O[row * LDO + 1024 + g * 256 + c] = (bf16)f2bf(uu * (o[d0][r] + bi)); } } }
  __syncthreads();
}
#undef SBAR
}

__device__ __forceinline__ f32x4 mma16(bf16x8 a, bf16x8 b, f32x4 c) { return __builtin_amdgcn_mfma_f32_16x16x32_bf16(a, b, c, 0, 0, 0); }

struct Args { const float* in[20]; float* out; unsigned char* ws; int ph_lo, ph_hi, sel, li; };

constexpr int N_PHASES = 17;

__global__ void __launch_bounds__(NWAVES * 64, 2) mega_fwd(Args args) {
    extern __shared__ __attribute__((aligned(16))) unsigned char lds[];
    LAS unsigned char* ldsl = (LAS unsigned char*)lds;
    const int G = gridDim.x; const int bx = blockIdx.x;
    const int vcu = (G % 8 == 0) ? (bx % 8) * (G / 8) + bx / 8 : bx;
#define PHASE_ENV() \
    const __attribute__((address_space(4))) Args* ap_ = (const __attribute__((address_space(4))) Args*)__builtin_amdgcn_kernarg_segment_ptr(); asm volatile("" : "+s"(ap_)); \
    int tid = threadIdx.x; asm volatile("" : "+v"(tid)); const int lane = tid & 63, wave = __builtin_amdgcn_readfirstlane(tid >> 6); (void)lane; \
    unsigned char* const ws = ap_->ws; const int gw = vcu * NWAVES + wave, NGW = G * NWAVES; const int gt = vcu * (NWAVES * 64) + tid, NGT = G * NWAVES * 64; \
    const float* const x_in = ap_->in[0]; \
    bf16* const W_ABIN = (bf16*)(ws + WS_W_ABIN); bf16* const W_ABOUT = (bf16*)(ws + WS_W_ABOUT); bf16* const W_CDIN = (bf16*)(ws + WS_W_CDIN); bf16* const W_CDOUT = (bf16*)(ws + WS_W_CDOUT); \
    bf16* const W_UP0 = (bf16*)(ws + WS_W_UP0); bf16* const W_UP1 = (bf16*)(ws + WS_W_UP1); bf16* const W_DN0 = (bf16*)(ws + WS_W_DN0); bf16* const W_DN1 = (bf16*)(ws + WS_W_DN1); \
    bf16* const XN = (bf16*)(ws + WS_XN); bf16* const OB16 = (bf16*)(ws + WS_O); float* const X = (float*)(ws + WS_X); bf16* const ACT = (bf16*)(ws + WS_ACT); \
    bf16* const P = (bf16*)(ws + WS_P); float* const OBF = (float*)(ws + WS_OB); bf16* const KV = (bf16*)(ws + WS_KV); bf16* const PREV = (bf16*)(ws + WS_PREV); bf16* const UP = (bf16*)(ws + WS_UP); \
    unsigned long long* const SS = (unsigned long long*)(ws + WS_SS); (void)SS; unsigned long long* const LNS = (unsigned long long*)(ws + WS_LNS); (void)LNS; bf16* const HALO = (bf16*)(ws + WS_HALO); (void)HALO; bf16* const SCR = (bf16*)(ws + WS_SCR); (void)SCR; float* const SCAL = (float*)(ws + WS_SCAL); float2* const ROPE = (float2*)(ws + WS_ROPE); \
    (void)gw; (void)NGW; (void)gt; (void)NGT; (void)x_in; (void)W_ABIN; (void)W_ABOUT; (void)W_CDIN; (void)W_CDOUT; (void)W_UP0; (void)W_UP1; (void)W_DN0; (void)W_DN1; (void)XN; (void)OB16; (void)X; (void)ACT; (void)P; (void)OBF; (void)KV; (void)PREV; (void)UP; (void)SCAL; (void)ROPE;
#define AIN(k) (ap_->in[k])

#if !MK_PER_PHASE
    for (int u = threadIdx.x; u < (LDS_BYTES - LDSCTL_OFF) / 4; u += NWAVES * 64) ((LAS unsigned*)(ldsl + LDSCTL_OFF))[u] = 0u;
    __syncthreads();
    XcdBarrier bar = xcd_barrier_post((unsigned*)(args.ws + WS_CTL) + 4096 + args.li * XCD_BAR_WORDS, (volatile LAS unsigned*)(ldsl + MISC_OFF) + 8);
#define GRID_BAR() xcd_barrier(bar)
#else
#define GRID_BAR() do {} while (0)
#endif
    const int lo = args.ph_lo, hi_ph = args.ph_hi;
#ifndef PH_MASK
#define PH_MASK 0xFFFFFFu
#endif
#define IN(k) (((PH_MASK >> (k)) & 1u) && lo <= (k) && (k) < hi_ph)
#define SEAM(k) do { if (IN(k) && IN((k) + 1)) GRID_BAR(); } while (0)
#ifndef REPEAT_MASK
#define REPEAT_MASK 0u
#endif
#define NREP(k) (((REPEAT_MASK >> (k)) & 1u) ? 2 : 1)

#define RAW_TO_XN(SRC, SSP) do { \
        for (int m = gw; m < MTOK; m += NGW) { const GAS f32x4* xr = (const GAS f32x4*)((SRC) + (size_t)m * DM) + lane; f32x4 v[8]; float s = 0.f; \
            _Pragma("unroll") for (int j = 0; j < 8; ++j) { v[j] = xr[64 * j]; s += (v[j].x * v[j].x + v[j].y * v[j].y) + (v[j].z * v[j].z + v[j].w * v[j].w); } \
            s = wave_sum(s); if (lane == 0) (SSP)[m] = (unsigned long long)(s * 16777216.f); \
            GAS v2u* o8 = (GAS v2u*)(XN + (size_t)m * DM) + lane; \
            _Pragma("unroll") for (int j = 0; j < 8; ++j) { v2u w; w.x = pk2(v[j].x, v[j].y); w.y = pk2(v[j].z, v[j].w); o8[64 * j] = w; } } } while (0)

#ifndef CT_P5
#define CT_P5 4300
#endif
    constexpr int CT_ABIN = 32 * (AB_IN / 64), CT_SQ = 32 * (DM / 64), CT_CDIN = 32 * (CD_IN / 64), CT_UP = 32 * (DFF2 / 64), CT_DN = (DFF / 64) * (DM / 64);
    constexpr int CT_L0 = CT_ABIN + CT_SQ + CT_UP + CT_DN, CT_ALL = CT_L0 + CT_CDIN + CT_SQ + CT_UP + CT_DN, CT_S1 = CT_L0 + CT_P5, CT_S2 = CT_ALL - CT_DN;
#define CONVERT_TILES(FIRST, LAST, W_ID, N_W) do { \
        LAS unsigned* T = (LAS unsigned*)(ldsl + wave * 9216); \
        const int rp = lane >> 4, cq = lane & 15; \
        struct TileRef { const float* src; bf16* dst; const float* gk; int K, N, perm; }; \
        auto tile_ref = [&](int it, TileRef& t) -> int { \
            int r = it; \
            if (r < CT_ABIN) { t = TileRef{AIN(5), W_ABIN, AIN(1), DM, AB_IN, 0}; return r; } r -= CT_ABIN; \
            if (r < CT_SQ) { t = TileRef{AIN(6), W_ABOUT, nullptr, DM, DM, 0}; return r; } r -= CT_SQ; \
            if (r < CT_UP) { t = TileRef{AIN(16), W_UP0, AIN(2), DM, DFF2, 1}; return r; } r -= CT_UP; \
            if (r < CT_DN) { t = TileRef{AIN(19), W_DN0, nullptr, DFF, DM, 0}; return r; } r -= CT_DN; \
            if (r < CT_CDIN) { t = TileRef{AIN(9), W_CDIN, AIN(1) + DM, DM, CD_IN, 0}; return r; } r -= CT_CDIN; \
            if (r < CT_SQ) { t = TileRef{AIN(10), W_CDOUT, nullptr, DM, DM, 0}; return r; } r -= CT_SQ; \
            if (r < CT_UP) { t = TileRef{AIN(16) + (size_t)DM * DFF2, W_UP1, AIN(2) + DM, DM, DFF2, 1}; return r; } r -= CT_UP; \
            t = TileRef{AIN(19) + (size_t)DFF * DM, W_DN1, nullptr, DFF, DM, 0}; return r; \
        }; \
        f32x4 va[8], vb[8]; float ga[8], gb[8]; \
        auto tile_load = [&](int it) { \
            TileRef t; const int r = tile_ref(it, t); const int nblk = t.N / 64, kb = r / nblk, nb = r % nblk; \
            const float* p = t.src + (size_t)(kb * 64 + 2 * rp) * t.N + nb * 64 + 4 * cq; \
            _Pragma("unroll") \
            for (int i = 0; i < 8; ++i) { va[i] = __builtin_nontemporal_load((const f32x4*)(p + (size_t)(8 * i) * t.N)); vb[i] = __builtin_nontemporal_load((const f32x4*)(p + (size_t)(8 * i + 1) * t.N)); \
                ga[i] = t.gk ? t.gk[kb * 64 + 8 * i + 2 * rp] : 1.f; gb[i] = t.gk ? t.gk[kb * 64 + 8 * i + 2 * rp + 1] : 1.f; } \
        }; \
        const int ct_last = (LAST), ct_step = (N_W); \
        int it = (FIRST) + (W_ID); \
        if (it < ct_last) tile_load(it); \
        while (it < ct_last) { \
            _Pragma("unroll") \
            for (int i = 0; i < 8; ++i) { \
                _Pragma("unroll") \
                for (int j = 0; j < 4; ++j) T[(4 * cq + j) * 36 + 4 * i + rp] = pk2(va[i][j] * ga[i], vb[i][j] * gb[i]); } \
            TileRef t; const int r = tile_ref(it, t); const int nblk = t.N / 64, kb = r / nblk, nb = r % nblk; \
            const int n0_ = nb * 64; const int drow0 = !t.perm ? n0_ : (n0_ < DFF ? (n0_ >> 7) * 256 + (n0_ & 127) : ((n0_ - DFF) >> 7) * 256 + 128 + ((n0_ - DFF) & 127)); \
            const int nxt = it + ct_step; \
            if (nxt < ct_last) tile_load(nxt); \
            LDS_WAIT(); asm volatile("" ::: "memory"); \
            _Pragma("unroll") \
            for (int o = 0; o < 8; ++o) { const int idx = o * 64 + lane, n = idx >> 3, c = idx & 7; \
                const v4u w = *(const LAS v4u*)(T + n * 36 + 4 * c); \
                *(GAS v4u*)(t.dst + (size_t)(drow0 + n) * t.K + kb * 64 + 8 * c) = w; } \
            LDS_WAIT(); asm volatile("" ::: "memory"); \
            it = nxt; \
        } \
    } while (0)

    for (int rep_ = 0; rep_ < NREP(0); ++rep_) if (IN(0)) { if (rep_) GRID_BAR(); PHASE_ENV();
        if (G == 256) { CONVERT_TILES(0, CT_L0, gw, NGW); } else { CONVERT_TILES(0, CT_ALL, gw, NGW); }
        for (int e = gt; e < SEQ * 64; e += NGT) { const int pos = e >> 6, i = e & 63;
            double f = 1.0; for (int k = 0; k < i; ++k) f *= 0.8659643233600653;
            const float ang = (float)pos * (float)f;
            double rev = (double)ang * 0.15915494309189535; rev -= floor(rev);
            const float rv = (float)rev;
            ROPE[e] = make_float2(__builtin_amdgcn_cosf(rv), __builtin_amdgcn_sinf(rv)); }
        if (vcu == 0 && wave == 0) { const float* lv = AIN(7);
            float a = lv[lane] * lv[128 + lane] + lv[64 + lane] * lv[192 + lane]; float b = lv[256 + lane] * lv[384 + lane] + lv[320 + lane] * lv[448 + lane];
            a = wave_sum(a); b = wave_sum(b);
            if (lane == 0) SCAL[0] = expf(a) - expf(b) + 0.2f; }
        RAW_TO_XN(x_in, SS);
    }
    SEAM(0);

    for (int rep_ = 0; rep_ < NREP(1); ++rep_) if (IN(1)) { if (rep_) GRID_BAR(); PHASE_ENV(); pg8::Gemm g{XN, W_ABIN, MTOK, AB_IN, DM}; pg8::StaticOrder S; S.init(MTOK, AB_IN, G, bx);
        pg8::EpiBf16 E{P, AB_IN, SS, nullptr, 0, 0}; pg8::gemm_phase<pg8::EpiBf16, pg8::StaticOrder, true, true>(ldsl, g, S, E, tid); }
    SEAM(1);

    for (int rep_ = 0; rep_ < NREP(2); ++rep_) if (IN(2)) { if (rep_) GRID_BAR(); PHASE_ENV();
#ifndef NO_B
        if (!(ap_->sel & 1)) { const int bh = vcu >> 5, comp = (vcu >> 4) & 1, s = vcu & 15, b = bh >> 2, h = bh & 3;
          float* tb = (float*)(lds + att::B2_TB);
          if (tid < 448) { const int rel = tid - 256 - 127, n = rel < 0 ? -rel : rel; int bucket = (n < 8) ? n : 8 + (31 - __clz((n * n) >> 6)); if (n >= 8 && bucket > 15) bucket = 15; if (rel > 0) bucket += 16;
              const float* rb = AIN(4); tb[tid] = (rel >= -127 && rel <= 63) ? (rb[bucket * 4 + h] - rb[15 * 4 + h]) * (1.f / att::SCALE) : 0.f; }
          __syncthreads();
          const bf16* Pb = P + (size_t)b * SEQ * AB_IN;
          for (int i = 0; i < 2; ++i) { const int q128 = i ? 31 - s : s;
              att::attnB2_unit<AB_IN, 1024>(Pb + (size_t)(128 * q128) * AB_IN + 3072 + h * 256 + comp * 128, Pb, 4096 + h * 256 + comp * 128, 5120 + h * 256,
                                            OBF + (size_t)comp * MTOK * 1024 + (size_t)(b * SEQ + 128 * q128) * 1024 + h * 256, q128, (char*)lds, ap_->sel); } }
#endif
#ifndef NO_A
#ifndef NREP_A
#define NREP_A 1
#endif
        for (int ra_ = 0; ra_ < NREP_A; ++ra_) if (!(ap_->sel & 2))
        { const int bh = vcu >> 4, qb = vcu & 15, b = bh >> 3, h = bh & 7;
          const bf16* Pb = P + (size_t)b * SEQ * AB_IN;
          att::attnA_unit<AB_IN, DM>(Pb + (size_t)(256 * qb) * AB_IN + h * 128, Pb, 1024 + h * 128, 2048 + h * 128, OB16 + (size_t)(b * SEQ + 256 * qb) * DM + h * 128, qb, (char*)lds); }
#endif
    }
    SEAM(2);

    for (int rep_ = 0; rep_ < NREP(3); ++rep_) if (IN(3)) { if (rep_) GRID_BAR(); PHASE_ENV();
        const float lam = SCAL[0]; const float* sg = AIN(8);
        f32x4 g4[4];
#pragma unroll
        for (int q = 0; q < 4; ++q) g4[q] = *(const f32x4*)(sg + (lane & 15) * 16 + q * 4);
        for (int row0 = gw * 2; row0 < MTOK; row0 += NGW * 2) { f32x4 a[2][4], c[2][4];
#pragma unroll
            for (int rr = 0; rr < 2; ++rr)
#pragma unroll
                for (int q = 0; q < 4; ++q) { a[rr][q] = *(const f32x4*)(OBF + (size_t)(row0 + rr) * 1024 + lane * 16 + q * 4); c[rr][q] = *(const f32x4*)(OBF + (size_t)MTOK * 1024 + (size_t)(row0 + rr) * 1024 + lane * 16 + q * 4); }
#pragma unroll
            for (int rr = 0; rr < 2; ++rr) { float ss = 0.f;
#pragma unroll
                for (int q = 0; q < 4; ++q) { a[rr][q] = a[rr][q] - lam * c[rr][q]; ss += (a[rr][q].x * a[rr][q].x + a[rr][q].y * a[rr][q].y) + (a[rr][q].z * a[rr][q].z + a[rr][q].w * a[rr][q].w); }
                ss += __shfl_xor(ss, 1); ss += __shfl_xor(ss, 2); ss += __shfl_xor(ss, 4); ss += __shfl_xor(ss, 8);
                const float rs = rsqrtf(ss * (1.f / 256.f) + EPS) * 0.8f;
                v4u w0, w1;
                w0.x = pk2(a[rr][0].x * rs * g4[0].x, a[rr][0].y * rs * g4[0].y); w0.y = pk2(a[rr][0].z * rs * g4[0].z, a[rr][0].w * rs * g4[0].w);
                w0.z = pk2(a[rr][1].x * rs * g4[1].x, a[rr][1].y * rs * g4[1].y); w0.w = pk2(a[rr][1].z * rs * g4[1].z, a[rr][1].w * rs * g4[1].w);
                w1.x = pk2(a[rr][2].x * rs * g4[2].x, a[rr][2].y * rs * g4[2].y); w1.y = pk2(a[rr][2].z * rs * g4[2].z, a[rr][2].w * rs * g4[2].w);
                w1.z = pk2(a[rr][3].x * rs * g4[3].x, a[rr][3].y * rs * g4[3].y); w1.w = pk2(a[rr][3].z * rs * g4[3].z, a[rr][3].w * rs * g4[3].w);
                bf16* op = OB16 + (size_t)(row0 + rr) * DM + 1024 + lane * 16; *(v4u*)op = w0; *(v4u*)(op + 8) = w1; } }
    }
    SEAM(3);

    for (int rep_ = 0; rep_ < NREP(4); ++rep_) if (IN(4)) { if (rep_) GRID_BAR(); PHASE_ENV(); pg8::Gemm g{OB16, W_ABOUT, MTOK, DM, DM}; pg8::StaticOrder S; S.init(MTOK, DM, G, bx);
        pg8::EpiRes E{nullptr, XN, DM, SS + 1 * MTOK}; pg8::gemm_phase<pg8::EpiRes, pg8::StaticOrder, false, true>(ldsl, g, S, E, tid); }
    SEAM(4);

#ifndef FIX_IN_DOWN
#define FIX_IN_DOWN 1
#endif
#if FIX_IN_DOWN
#define FIX_PHASE(PB, L) if (IN(PB) && !IN(PB + 1) && IN(PB + 2)) GRID_BAR();
#define FIX_LOCAL(L) { pg8::Unit fu; for (int fi = 0; S.next(fi, fu); ++fi) conv_fix_panel(HALO, ACT, AIN(17) + (size_t)(L) * 3 * DFF2, AIN(18) + (size_t)(L) * DFF2, fu.pm, tid); \
          asm volatile("s_waitcnt vmcnt(0)" ::: "memory"); __syncthreads(); }
#else
#define FIX_PHASE(PB, L) \
    for (int rep_ = 0; rep_ < NREP(PB + 1); ++rep_) if (IN(PB + 1)) { if (rep_) GRID_BAR(); PHASE_ENV(); conv_fix(HALO, ACT, AIN(17) + (size_t)(L) * 3 * DFF2, AIN(18) + (size_t)(L) * DFF2, gt, NGT); } \
    SEAM(PB + 1);
#define FIX_LOCAL(L)
#endif
#define FFN_PHASES(PB, WUP, WDN, L, SSIN, SSOUT) \
    for (int rep_ = 0; rep_ < NREP(PB); ++rep_) if (IN(PB)) { if (rep_) GRID_BAR(); PHASE_ENV(); pg8::Gemm g{XN, WUP, MTOK, DFF2, DM}; pg8::StaticOrder S; S.init(MTOK, DFF2, G, bx); \
        pg8::EpiConv E{ACT, SS + (SSIN) * MTOK, AIN(17) + (size_t)(L) * 3 * DFF2, AIN(18) + (size_t)(L) * DFF2, HALO, ldsl}; \
        pg8::gemm_phase<pg8::EpiConv, pg8::StaticOrder, true, true>(ldsl, g, S, E, tid); \
        if (G == 256 && bx >= 128) { if ((PB) == 5) { CONVERT_TILES(CT_L0, CT_S1, (bx - 128) * NWAVES + wave, 128 * NWAVES); } else { CONVERT_TILES(CT_S2, CT_ALL, (bx - 128) * NWAVES + wave, 128 * NWAVES); } } } \
    SEAM(PB); \
    FIX_PHASE(PB, L) \
    for (int rep_ = 0; rep_ < NREP(PB + 2); ++rep_) if (IN(PB + 2)) { if (rep_) GRID_BAR(); PHASE_ENV(); pg8::Gemm g{ACT, WDN, MTOK, DM, DFF}; pg8::StaticOrder S; S.init(MTOK, DM, G, bx); \
        FIX_LOCAL(L) \
        if ((L) == 1 && G == 256) { pg8::EpiFinal E{XN, DM, SS + (SSOUT) * MTOK, (unsigned*)(ws + WS_CNT), AIN(3), ap_->out}; pg8::gemm_phase<pg8::EpiFinal, pg8::StaticOrder, false, true>(ldsl, g, S, E, tid); } \
        else { pg8::EpiRes E{nullptr, XN, DM, SS + (SSOUT) * MTOK}; pg8::gemm_phase<pg8::EpiRes, pg8::StaticOrder, false, true>(ldsl, g, S, E, tid); } } \
    SEAM(PB + 2);

    auto conv_fix = [&](const bf16* halo, bf16* act, const float* cw, const float* cb, int gt_, int ngt_) {
        constexpr int NCH = DFF / 8;
        for (int task = gt_; task < NCH * 64; task += ngt_) { const int ch = task % NCH, rr = (task / NCH) & 1, pm = task / (2 * NCH), n0 = ch * 8;
            const int pca = (n0 >> 7) * 256 + (n0 & 127); const bool first = (pm & 15) == 0;
            const bf16* H = halo + (size_t)pm * 4 * DFF2; const bf16* Hp = H - (size_t)4 * DFF2;
            float cv[2][8];
#pragma unroll
            for (int bj = 0; bj < 2; ++bj) { const int pc = pca + bj * 128, cc = bj * DFF + n0; const v4u z = {0u, 0u, 0u, 0u};
                const v4u c0 = *(const v4u*)(H + pc), c1 = *(const v4u*)(H + DFF2 + pc);
                const v4u q254 = first ? z : *(const v4u*)(Hp + 2 * DFF2 + pc), q255 = first ? z : *(const v4u*)(Hp + 3 * DFF2 + pc);
                const v4u x2 = rr == 0 ? q254 : q255, x1 = rr == 0 ? q255 : c0, x0 = rr == 0 ? c0 : c1;
#pragma unroll
                for (int q = 0; q < 4; ++q) {
                    cv[bj][2 * q] = cb[cc + 2 * q] + cw[cc + 2 * q] * bflo(x2[q]) + cw[DFF2 + cc + 2 * q] * bflo(x1[q]) + cw[2 * DFF2 + cc + 2 * q] * bflo(x0[q]);
                    cv[bj][2 * q + 1] = cb[cc + 2 * q + 1] + cw[cc + 2 * q + 1] * bfhi(x2[q]) + cw[DFF2 + cc + 2 * q + 1] * bfhi(x1[q]) + cw[2 * DFF2 + cc + 2 * q + 1] * bfhi(x0[q]); } }
            float o[8];
#pragma unroll
            for (int q = 0; q < 8; ++q) o[q] = silu_f(cv[1][q]) * cv[0][q];
            v4u w; w.x = pk2(o[0], o[1]); w.y = pk2(o[2], o[3]); w.z = pk2(o[4], o[5]); w.w = pk2(o[6], o[7]);
            *(v4u*)(act + (size_t)(pm * 256 + rr) * DFF + n0) = w; }
    };

    auto conv_fix_panel = [&](const bf16* halo, bf16* act, const float* cw, const float* cb, int pm, int t_) __attribute__((always_inline)) {
        constexpr int NCH = DFF / 8; const bool first = (pm & 15) == 0;
        const bf16* H = halo + (size_t)pm * 4 * DFF2; const bf16* Hp = H - (size_t)4 * DFF2;
        for (int ch = t_; ch < NCH; ch += NWAVES * 64) { const int n0 = ch * 8, pca = (n0 >> 7) * 256 + (n0 & 127);
            float cv[2][2][8];
#pragma unroll
            for (int bj = 0; bj < 2; ++bj) { const int pc = pca + bj * 128, cc = bj * DFF + n0; const v4u z = {0u, 0u, 0u, 0u};
                const v4u c0 = *(const v4u*)(H + pc), c1 = *(const v4u*)(H + DFF2 + pc);
                const v4u q254 = first ? z : *(const v4u*)(Hp + 2 * DFF2 + pc), q255 = first ? z : *(const v4u*)(Hp + 3 * DFF2 + pc);
                float w0[8], w1[8], w2[8], bb[8];
#pragma unroll
                for (int hf = 0; hf < 2; ++hf) { const f32x4 a0 = *(const f32x4*)(cw + cc + 4 * hf), a1 = *(const f32x4*)(cw + DFF2 + cc + 4 * hf), a2 = *(const f32x4*)(cw + 2 * DFF2 + cc + 4 * hf), a3 = *(const f32x4*)(cb + cc + 4 * hf);
                    w0[4 * hf] = a0.x; w0[4 * hf + 1] = a0.y; w0[4 * hf + 2] = a0.z; w0[4 * hf + 3] = a0.w; w1[4 * hf] = a1.x; w1[4 * hf + 1] = a1.y; w1[4 * hf + 2] = a1.z; w1[4 * hf + 3] = a1.w;
                    w2[4 * hf] = a2.x; w2[4 * hf + 1] = a2.y; w2[4 * hf + 2] = a2.z; w2[4 * hf + 3] = a2.w; bb[4 * hf] = a3.x; bb[4 * hf + 1] = a3.y; bb[4 * hf + 2] = a3.z; bb[4 * hf + 3] = a3.w; }
#pragma unroll
                for (int q = 0; q < 4; ++q) { const int e0 = 2 * q, e1 = 2 * q + 1;
                    cv[0][bj][e0] = bb[e0] + w0[e0] * bflo(q254[q]) + w1[e0] * bflo(q255[q]) + w2[e0] * bflo(c0[q]);
                    cv[0][bj][e1] = bb[e1] + w0[e1] * bfhi(q254[q]) + w1[e1] * bfhi(q255[q]) + w2[e1] * bfhi(c0[q]);
                    cv[1][bj][e0] = bb[e0] + w0[e0] * bflo(q255[q]) + w1[e0] * bflo(c0[q]) + w2[e0] * bflo(c1[q]);
                    cv[1][bj][e1] = bb[e1] + w0[e1] * bfhi(q255[q]) + w1[e1] * bfhi(c0[q]) + w2[e1] * bfhi(c1[q]); } }
#pragma unroll
            for (int rr = 0; rr < 2; ++rr) { float o[8];
#pragma unroll
                for (int q = 0; q < 8; ++q) o[q] = silu_f(cv[rr][1][q]) * cv[rr][0][q];
                v4u w; w.x = pk2(o[0], o[1]); w.y = pk2(o[2], o[3]); w.z = pk2(o[4], o[5]); w.w = pk2(o[6], o[7]);
                *(v4u*)(act + (size_t)(pm * 256 + rr) * DFF + n0) = w; } }
    };

    FFN_PHASES(5, W_UP0, W_DN0, 0, 1, 2)

    for (int rep_ = 0; rep_ < NREP(8); ++rep_) if (IN(8)) { if (rep_) GRID_BAR(); PHASE_ENV(); pg8::Gemm g{XN, W_CDIN, MTOK, CD_IN, DM}; pg8::StaticOrder S; S.init(MTOK, CD_IN, G, bx);
        pg8::EpiBf16 E{P, CD_IN, SS + 2 * MTOK, LNS, 16, 20}; pg8::gemm_phase<pg8::EpiBf16, pg8::StaticOrder, true, true>(ldsl, g, S, E, tid);
        if (G == 256 && bx >= 128) { CONVERT_TILES(CT_S1, CT_S2, (bx - 128) * NWAVES + wave, 128 * NWAVES); } }
    SEAM(8);

    for (int rep_ = 0; rep_ < NREP(9); ++rep_) if (IN(9)) { if (rep_) GRID_BAR(); PHASE_ENV();
        for (int u = vcu; u < 8 * 64; u += G) { const int bh = u >> 6, n = u & 63;
            att::ret_kv_unit<CD_IN>(P, ROPE, KV + ((size_t)bh * 64 + n) * 32768, bh >> 2, bh & 3, n, (char*)lds); }
        for (int u = vcu; u < 256; u += G) { const int g = u & 3, nbk = (u >> 2) & 31, b = u >> 7;
            att::sgu_unit<CD_IN, DM>(P, LNS, AIN(12), AIN(13), AIN(14) + (size_t)g * 128 * 128, AIN(15) + g * 128, OB16, (size_t)b * SEQ + 128 * nbk, g, (char*)lds); }
    }
    SEAM(9);

    for (int rep_ = 0; rep_ < NREP(10); ++rep_) if (IN(10)) { if (rep_) GRID_BAR(); PHASE_ENV();
        if (wave < 4) for (int e4 = (vcu * 4 + wave) * 64 + lane; e4 < 8 * 256 * 128 / 4; e4 += G * 4 * 64) { const int e = e4 * 4; const int bh = e >> 15, h = bh & 3; const int r = e & 32767;
            const float g64 = __expf(64.f * __logf(1.f - exp2f(-5.f - (float)h)));
            const bf16* src = KV + (size_t)bh * 64 * 32768 + r; bf16* dst = PREV + (size_t)bh * 64 * 32768 + r; float st[4] = {0.f, 0.f, 0.f, 0.f};
#pragma unroll 16
            for (int n = 0; n < 64; ++n) { const v2u kv = *(const v2u*)(src + (size_t)n * 32768);
                v2u w; w.x = pk2(st[0], st[1]); w.y = pk2(st[2], st[3]); *(v2u*)(dst + (size_t)n * 32768) = w;
                st[0] = g64 * st[0] + bflo(kv.x); st[1] = g64 * st[1] + bfhi(kv.x); st[2] = g64 * st[2] + bflo(kv.y); st[3] = g64 * st[3] + bfhi(kv.y); } }
    }
    SEAM(10);

    for (int rep_ = 0; rep_ < NREP(11); ++rep_) if (IN(11)) { if (rep_) GRID_BAR(); PHASE_ENV();
        for (int u = vcu; u < 256; u += G) { const int bh = u >> 5, np = u & 31;
            att::ret_out_unit<CD_IN, DM>(P, ROPE, PREV, AIN(11), OB16, bh >> 2, bh & 3, np, (char*)lds); }
    }
    SEAM(11);

    for (int rep_ = 0; rep_ < NREP(12); ++rep_) if (IN(12)) { if (rep_) GRID_BAR(); PHASE_ENV(); pg8::Gemm g{OB16, W_CDOUT, MTOK, DM, DM}; pg8::StaticOrder S; S.init(MTOK, DM, G, bx);
        pg8::EpiRes E{nullptr, XN, DM, SS + 3 * MTOK}; pg8::gemm_phase<pg8::EpiRes, pg8::StaticOrder, false, true>(ldsl, g, S, E, tid); }
    SEAM(12);

    FFN_PHASES(13, W_UP1, W_DN1, 1, 3, 4)

    for (int rep_ = 0; rep_ < NREP(16); ++rep_) if (IN(16) && G != 256) { if (rep_) GRID_BAR(); PHASE_ENV(); const float* fg = AIN(3); const unsigned long long* ss4 = SS + 4 * MTOK;
        for (int m0 = gw * 4; m0 < MTOK; m0 += NGW * 4) { v4u v[4][4]; float rstd[4];
#pragma unroll
            for (int rr = 0; rr < 4; ++rr) { const GAS v4u* xr = (const GAS v4u*)(XN + (size_t)(m0 + rr) * DM) + lane;
#pragma unroll
                for (int j = 0; j < 4; ++j) v[rr][j] = xr[64 * j];
                rstd[rr] = rsqrtf((float)ss4[m0 + rr] * (1.f / 16777216.f / DM) + EPS); }
#pragma unroll
            for (int rr = 0; rr < 4; ++rr) { float* orow = ap_->out + (size_t)(m0 + rr) * DM;
#pragma unroll
                for (int j = 0; j < 4; ++j) { const int c0 = (64 * j + lane) * 8; const f32x4 g0 = *(const f32x4*)(fg + c0), g1 = *(const f32x4*)(fg + c0 + 4); const float r_ = rstd[rr];
                    const f32x4 o0 = {bflo(v[rr][j].x) * r_ * g0.x, bfhi(v[rr][j].x) * r_ * g0.y, bflo(v[rr][j].y) * r_ * g0.z, bfhi(v[rr][j].y) * r_ * g0.w};
                    const f32x4 o1 = {bflo(v[rr][j].z) * r_ * g1.x, bfhi(v[rr][j].z) * r_ * g1.y, bflo(v[rr][j].w) * r_ * g1.z, bfhi(v[rr][j].w) * r_ * g1.w};
                    *(GAS f32x4*)(orow + c0) = o0; *(GAS f32x4*)(orow + c0 + 4) = o1; } } }
    }
#undef IN
#undef SEAM
}

extern "C" void kernel_launch(void* const* d_in, const int* in_sizes, int n_in, void* d_out, int out_size, void* d_ws, size_t ws_size, hipStream_t stream) {
    static int grid = 0;
    if (grid == 0) {
        if (n_in != 20 || in_sizes[0] != MTOK * DM || out_size != MTOK * DM || ws_size < WS_END) {
            fprintf(stderr, "kernel_launch: unexpected shapes: n_in %d in0 %d out %d ws %zu (need >= %zu)\n", n_in, n_in > 0 ? in_sizes[0] : -1, out_size, ws_size, (size_t)WS_END); grid = -1; return; }
        int dev = 0, cus = 0;
        if (hipGetDevice(&dev) != hipSuccess || hipDeviceGetAttribute(&cus, hipDeviceAttributeMultiprocessorCount, dev) != hipSuccess) { grid = -1; return; }
        if (hipFuncSetAttribute((const void*)mega_fwd, hipFuncAttributeMaxDynamicSharedMemorySize, LDS_BYTES) != hipSuccess) { fprintf(stderr, "kernel_launch: hipFuncSetAttribute failed\n"); grid = -1; return; }
        int per_cu = 0;
        if (hipOccupancyMaxActiveBlocksPerMultiprocessor(&per_cu, (const void*)mega_fwd, NWAVES * 64, LDS_BYTES) != hipSuccess || per_cu < 1) { fprintf(stderr, "kernel_launch: occupancy query says %d blocks per CU\n", per_cu); }
        (void)hipGetLastError();
        grid = cus;
    }
    if (grid < 0) return;
    hipMemsetAsync((char*)d_ws + WS_CTL, 0, CTL_ZERO_BYTES, stream);
    Args a{};
    for (int i = 0; i < 20; ++i) a.in[i] = (const float*)d_in[i];
    a.out = (float*)d_out; a.ws = (unsigned char*)d_ws;
#if MK_PER_PHASE
    for (int p = 0; p < N_PHASES; ++p) { a.ph_lo = p; a.ph_hi = p + 1; hipLaunchKernelGGL(mega_fwd, dim3(grid), dim3(NWAVES * 64), LDS_BYTES, stream, a); }
#else
    a.ph_lo = 0; a.ph_hi = (grid == 256) ? N_PHASES - 1 : N_PHASES; hipLaunchKernelGGL         (mega_fwd, dim3(grid), dim3(NWAVES * 64), LDS_BYTES, stream, a);
#if PROBE_PHASE >= 0
    a.ph_lo = PROBE_PHASE; a.ph_hi = PROBE_PHASE + PROBE_NPH; a.sel = PROBE_SEL; a.li = 1; hipLaunchKernelGGL(mega_fwd, dim3(grid), dim3(NWAVES * 64), LDS_BYTES, stream, a);
#endif
#endif
    const hipError_t le = hipPeekAtLastError();
    if (le != hipSuccess) fprintf(stderr, "kernel_launch: launch failed: %s\n", hipGetErrorName(le));
}
```

```cpp
#include <hip/hip_runtime.h>
#include <hip/hip_bf16.h>
#include <cstdio>
#include <cstdint>

#ifndef PROBE_PHASE
#define PROBE_PHASE -1
#endif
#ifndef PROBE_SEL
#define PROBE_SEL 0
#endif
#ifndef PROBE_NPH
#define PROBE_NPH 1
#endif
#ifndef MK_PER_PHASE
#define MK_PER_PHASE 0
#endif

namespace pg8 {
#define PG8_LAS __attribute__((address_space(3)))
typedef unsigned short bf16_t;
typedef short bf16x8 __attribute__((ext_vector_type(8)));
typedef float f32x4 __attribute__((ext_vector_type(4)));
typedef unsigned u32x4 __attribute__((ext_vector_type(4)));
constexpr int BM = 256, BK = 64, HALF = 128, HTB = HALF * BK * 2, STAGE_BYTES = 8 * HTB, NXCD = 8, WGM = 8;

__host__ __device__ __forceinline__ int lds_byte(int r, int c) { const int st = (r >> 4) * 2 + (c >> 5), rr = r & 15, cc = c & 31, ob = rr * 64 + cc * 2; return st * 1024 + (ob ^ (((ob >> 9) & 1) << 5)); }
__host__ __device__ __forceinline__ void stage_rc(int b, int& R, int& C) { const int st = b / 1024, sb = b % 1024, swz = sb ^ (((sb >> 9) & 1) << 5); R = (st >> 1) * 16 + swz / 64; C = (st & 1) * 32 + (swz % 64) / 2; }
__host__ __device__ __forceinline__ int perm32(int rho) { const int n = rho >> 4, i = rho & 15; return 8 * (i >> 2) + 4 * n + (i & 3); }

struct Unit { int pm, pn; };
struct Gemm { const bf16_t* A; const bf16_t* Bt; int M, N, K; };

struct StaticOrder {
    int nM, nN, nwg, G, c;
    __host__ __device__ void init(int M, int N, int G_, int c_) { nM = M / BM; nN = N / BM; nwg = nM * nN; G = G_; c = c_; }
    __host__ __device__ __attribute__((always_inline)) bool next(int i, Unit& u) const {
        const long L = (long)i * G + c; if (L >= nwg) return false;
        int wgid = (int)L; { const int q = nwg / NXCD, r = nwg % NXCD, xcd = wgid % NXCD, off = wgid / NXCD; wgid = (xcd < r ? xcd * (q + 1) : r * (q + 1) + (xcd - r) * q) + off; }
        const int nig = WGM * nN, gid = wgid / nig, fm = gid * WGM, gsz = (nM - fm) < WGM ? (nM - fm) : WGM;
        u.pm = fm + ((wgid % nig) % gsz); u.pn = (wgid % nig) / gsz; return true;
    }
    __device__ __forceinline__ void a_ready(const Unit&) const {}
    __device__ __forceinline__ void done(const Unit&) const {}
};

__device__ __forceinline__ unsigned cvt_pk_bf16(float lo, float hi) { unsigned r; asm volatile("v_cvt_pk_bf16_f32 %0, %1, %2" : "=v"(r) : "v"(lo), "v"(hi)); return r; }

__device__ __forceinline__ float gelu_tanh_e(float x) { const float t = fmaf(x * x, 0.10294324f, 2.3022082f); return x * __builtin_amdgcn_rcpf(1.f + __builtin_amdgcn_exp2f(-x * t)); }
struct EpiBf16 {
    static constexpr bool PERM = true, AFTER_DRAIN = false, ACC_INIT = false, HAS_PRE = true;
    struct Pre { unsigned long long ssv[2][4]; };
    bf16_t* O; int ldc; const unsigned long long* ss; unsigned long long* lnsum; int ln_pn0, ln_pn1; int blk_rows = 0;
    __device__ __forceinline__ void pre_load(Pre& p, const Unit& u, int wr, int wc, int fr, int fq) const {
        const int row0 = u.pm * BM + wr * 64 + fr;
#pragma unroll
        for (int ai = 0; ai < 2; ++ai)
#pragma unroll
            for (int m = 0; m < 4; ++m) p.ssv[ai][m] = ss ? __hip_atomic_load(ss + row0 + ai * HALF + m * 16, __ATOMIC_RELAXED, __HIP_MEMORY_SCOPE_AGENT) : 0ull;
    }
    __device__ __forceinline__ void operator()(const f32x4 (&acc)[2][2][4][2], const Unit& u, int wr, int wc, int fr, int fq, Pre& p, bool has_next, const Unit& nxt) const {
        const int row0 = u.pm * BM + wr * 64 + fr; const int col0 = u.pn * BM + wc * 32 + 8 * fq;
        const bool do_ln = lnsum != nullptr && u.pn >= ln_pn0 && u.pn < ln_pn1;
        unsigned long long ssv[2][4];
#pragma unroll
        for (int ai = 0; ai < 2; ++ai)
#pragma unroll
            for (int m = 0; m < 4; ++m) ssv[ai][m] = p.ssv[ai][m];
        if (has_next) pre_load(p, nxt, wr, wc, fr, fq);
#pragma unroll
        for (int ai = 0; ai < 2; ++ai)
#pragma unroll
            for (int m = 0; m < 4; ++m) { const int row = row0 + ai * HALF + m * 16; bf16_t* rowp = blk_rows ? O + ((size_t)u.pn * blk_rows + row) * BM + wc * 32 + 8 * fq : O + (size_t)row * ldc + col0;
                const float sc = ss ? __builtin_amdgcn_rsqf((float)ssv[ai][m] * (1.f / 16777216.f / 2048.f) + 1e-6f) : 1.f;
                float s1 = 0.f, s2 = 0.f;
#pragma unroll
                for (int bj = 0; bj < 2; ++bj) { const f32x4 v0 = acc[ai][bj][m][0] * sc, v1 = acc[ai][bj][m][1] * sc;
                    u32x4 w; w.x = cvt_pk_bf16(v0[0], v0[1]); w.y = cvt_pk_bf16(v0[2], v0[3]); w.z = cvt_pk_bf16(v1[0], v1[1]); w.w = cvt_pk_bf16(v1[2], v1[3]);
                    *(u32x4*)(rowp + bj * HALF) = w;
                    if (do_ln) {
#pragma unroll
                        for (int q = 0; q < 4; ++q) { const float a = gelu_tanh_e(v0[q]), b = gelu_tanh_e(v1[q]); s1 += a + b; s2 += a * a + b * b; } } }
                if (do_ln) { s1 += __shfl_xor(s1, 16); s1 += __shfl_xor(s1, 32); s2 += __shfl_xor(s2, 16); s2 += __shfl_xor(s2, 32);
                    if (fq == 0) { atomicAdd(lnsum + 2 * row, (unsigned long long)(long long)(s1 * 16777216.f)); atomicAdd(lnsum + 2 * row + 1, (unsigned long long)(long long)(s2 * 16777216.f)); } } }
    }
};
struct EpiRes {
    static constexpr bool PERM = true, AFTER_DRAIN = false, ACC_INIT = true, HAS_PRE = false;
    struct Pre {};
    const float* basef; bf16_t* xb; int ldc; unsigned long long* ss;
    __device__ __forceinline__ void init_load(u32x4 (&bw)[2][4][2], const Unit& u, int wr, int wc, int fr, int fq) const {
        const int row0 = u.pm * BM + wr * 64 + fr; const int col0 = u.pn * BM + wc * 32 + 8 * fq;
#pragma unroll
        for (int ai = 0; ai < 2; ++ai)
#pragma unroll
            for (int m = 0; m < 4; ++m)
#pragma unroll
                for (int bj = 0; bj < 2; ++bj) bw[ai][m][bj] = *(const u32x4*)(xb + (size_t)(row0 + ai * HALF + m * 16) * ldc + col0 + bj * HALF);
    }
    __device__ __forceinline__ static void init_apply(f32x4 (&acc)[2][2][4][2], const u32x4 (&bw)[2][4][2]) {
#pragma unroll
        for (int ai = 0; ai < 2; ++ai)
#pragma unroll
            for (int m = 0; m < 4; ++m)
#pragma unroll
                for (int bj = 0; bj < 2; ++bj) { const u32x4 w = bw[ai][m][bj];
                    acc[ai][bj][m][0] = (f32x4){__builtin_bit_cast(float, w.x << 16), __builtin_bit_cast(float, w.x & 0xffff0000u), __builtin_bit_cast(float, w.y << 16), __builtin_bit_cast(float, w.y & 0xffff0000u)};
                    acc[ai][bj][m][1] = (f32x4){__builtin_bit_cast(float, w.z << 16), __builtin_bit_cast(float, w.z & 0xffff0000u), __builtin_bit_cast(float, w.w << 16), __builtin_bit_cast(float, w.w & 0xffff0000u)}; }
    }
    __device__ __forceinline__ void operator()(const f32x4 (&acc)[2][2][4][2], const Unit& u, int wr, int wc, int fr, int fq) const {
        const int row0 = u.pm * BM + wr * 64 + fr; const int col0 = u.pn * BM + wc * 32 + 8 * fq;
#pragma unroll
        for (int ai = 0; ai < 2; ++ai)
#pragma unroll
            for (int m = 0; m < 4; ++m) { const int row = row0 + ai * HALF + m * 16; const size_t off = (size_t)row * ldc + col0; float sq = 0.f;
#pragma unroll
                for (int bj = 0; bj < 2; ++bj) {
                    const f32x4 o0 = acc[ai][bj][m][0], o1 = acc[ai][bj][m][1];
                    u32x4 w; w.x = cvt_pk_bf16(o0[0], o0[1]); w.y = cvt_pk_bf16(o0[2], o0[3]); w.z = cvt_pk_bf16(o1[0], o1[1]); w.w = cvt_pk_bf16(o1[2], o1[3]);
                    *(u32x4*)(xb + off + bj * HALF) = w;
#pragma unroll
                    for (int q = 0; q < 4; ++q) { const unsigned ww = q == 0 ? w.x : q == 1 ? w.y : q == 2 ? w.z : w.w; typedef __bf16 bfp2 __attribute__((ext_vector_type(2))); const bfp2 wv = __builtin_bit_cast(bfp2, ww); sq = __builtin_amdgcn_fdot2_f32_bf16(wv, wv, sq, false); } }
                sq += __shfl_xor(sq, 16); sq += __shfl_xor(sq, 32);
                if (fq == 0) atomicAdd(ss + row, (unsigned long long)(sq * 16777216.f)); }
    }
};

struct EpiConv {
    static constexpr bool PERM = true, AFTER_DRAIN = false, ACC_INIT = false, HAS_PRE = true;
    struct Pre { unsigned long long ssv[2][4]; float cpv[2]; };
    bf16_t* act; const unsigned long long* ss; const float* cw; const float* cb; bf16_t* halo; PG8_LAS unsigned char* lds0;
    static constexpr int NFF = 5632, NFF2 = 11264;
    static constexpr int HX = STAGE_BYTES + 1024, CPAR = HX + 4096;
    __device__ __forceinline__ static int hxi(int wr, int ai, int rs, int bj, int wc, int fq) { return ((((((wr * 2 + ai) * 2 + rs) * 2 + bj) * 4 + wc) * 4 + fq) * 16); }
    __device__ __forceinline__ static u32x4 bperm4(int addr, u32x4 v) {
        u32x4 r; r.x = (unsigned)__builtin_amdgcn_ds_bpermute(addr, (int)v.x); r.y = (unsigned)__builtin_amdgcn_ds_bpermute(addr, (int)v.y);
        r.z = (unsigned)__builtin_amdgcn_ds_bpermute(addr, (int)v.z); r.w = (unsigned)__builtin_amdgcn_ds_bpermute(addr, (int)v.w); return r; }
    __device__ __forceinline__ void pre_load(Pre& p, const Unit& u, int wr, int wc, int fr, int fq) const {
        const int lane = fq * 16 + fr, tid = (wr * 4 + wc) * 64 + lane;
#pragma unroll
        for (int ai = 0; ai < 2; ++ai)
#pragma unroll
            for (int m = 0; m < 4; ++m) p.ssv[ai][m] = __hip_atomic_load(ss + u.pm * BM + ai * HALF + wr * 64 + m * 16 + fr, __ATOMIC_RELAXED, __HIP_MEMORY_SCOPE_AGENT);
#pragma unroll
        for (int e = 0; e < 2; ++e) { const int idx = tid * 2 + e, bj = idx >> 9, j = (idx >> 7) & 3, c = idx & 127; const int gcol = bj * NFF + u.pn * 128 + c;
            p.cpv[e] = j < 3 ? cw[(size_t)j * NFF2 + gcol] : cb[gcol]; }
    }
    __device__ __forceinline__ void operator()(const f32x4 (&acc)[2][2][4][2], const Unit& u, int wr, int wc, int fr, int fq, Pre& p, bool has_next, const Unit& nxt) const {
        asm volatile("" : "+v"(fr), "+v"(fq));
        typedef float f32x2 __attribute__((ext_vector_type(2)));
        const int lane = fq * 16 + fr, tid = (wr * 4 + wc) * 64 + lane;
        { PG8_LAS unsigned* cp = (PG8_LAS unsigned*)(lds0 + CPAR);
#pragma unroll
          for (int e = 0; e < 2; ++e) { const int idx = tid * 2 + e, bj = idx >> 9, j = (idx >> 7) & 3, c = idx & 127;
              const float f = p.cpv[e] * (bj ? -1.4426950408889634f : -0.6931471805599453f);
              const unsigned b = cvt_pk_bf16(f, 0.f) & 0xffffu;
              cp[idx] = j < 3 ? ((c & 1) ? (b << 16) : b) : __builtin_bit_cast(unsigned, f); } }
        u32x4 pk[2][2][4];
        unsigned long long ssv[2][4];
#pragma unroll
        for (int ai = 0; ai < 2; ++ai)
#pragma unroll
            for (int m = 0; m < 4; ++m) ssv[ai][m] = p.ssv[ai][m];
        if (has_next) pre_load(p, nxt, wr, wc, fr, fq);
#pragma unroll
        for (int ai = 0; ai < 2; ++ai)
#pragma unroll
            for (int m = 0; m < 4; ++m) {
                const float sc = __builtin_amdgcn_rsqf((float)ssv[ai][m] * (1.f / 16777216.f / 2048.f) + 1e-6f);
#pragma unroll
                for (int bj = 0; bj < 2; ++bj) { const f32x4 v0 = acc[ai][bj][m][0] * sc, v1 = acc[ai][bj][m][1] * sc;
                    pk[ai][bj][m] = (u32x4){cvt_pk_bf16(v0[0], v0[1]), cvt_pk_bf16(v0[2], v0[3]), cvt_pk_bf16(v1[0], v1[1]), cvt_pk_bf16(v1[2], v1[3])}; } }
        const int pcol = u.pn * 256 + wc * 32 + 8 * fq;
        if (fr >= 14) {
#pragma unroll
            for (int ai = 0; ai < 2; ++ai)
#pragma unroll
                for (int bj = 0; bj < 2; ++bj) *(PG8_LAS u32x4*)(lds0 + HX + hxi(wr, ai, fr - 14, bj, wc, fq)) = pk[ai][bj][3];
            if (wr == 1) {
#pragma unroll
                for (int bj = 0; bj < 2; ++bj) *(u32x4*)(halo + ((size_t)u.pm * 4 + 2 + (fr - 14)) * NFF2 + pcol + bj * HALF) = pk[1][bj][3]; } }
        if (wr == 0 && fr < 2) {
#pragma unroll
            for (int bj = 0; bj < 2; ++bj) *(u32x4*)(halo + ((size_t)u.pm * 4 + fr) * NFF2 + pcol + bj * HALF) = pk[0][bj][0]; }
        asm volatile("s_waitcnt lgkmcnt(0)" ::: "memory"); __builtin_amdgcn_s_barrier(); asm volatile("" ::: "memory");
        const int i1 = ((lane & 48) | ((fr + 15) & 15)) * 4, i2 = ((lane & 48) | ((fr + 14) & 15)) * 4;
        const int ca = u.pn * 128 + wc * 32 + 8 * fq;
        typedef __bf16 bf16x2_t __attribute__((ext_vector_type(2)));
#define PG8_W(v_, q_) ((q_) == 0 ? (v_).x : (q_) == 1 ? (v_).y : (q_) == 2 ? (v_).z : (v_).w)
#define PG8_DOT2(x_, w_, c_) __builtin_amdgcn_fdot2_f32_bf16(__builtin_bit_cast(bf16x2_t, (unsigned)(x_)), __builtin_bit_cast(bf16x2_t, (unsigned)(w_)), (c_), false)
        u32x4 wt[2][3][2]; f32x4 bs[2][2];
        { const PG8_LAS unsigned* cpl = (const PG8_LAS unsigned*)(lds0 + CPAR) + wc * 32 + 8 * fq;
#pragma unroll
          for (int bj = 0; bj < 2; ++bj) {
#pragma unroll
              for (int j = 0; j < 3; ++j) { wt[bj][j][0] = *(const PG8_LAS u32x4*)(cpl + bj * 512 + j * 128); wt[bj][j][1] = *(const PG8_LAS u32x4*)(cpl + bj * 512 + j * 128 + 4); }
              bs[bj][0] = *(const PG8_LAS f32x4*)(cpl + bj * 512 + 384); bs[bj][1] = *(const PG8_LAS f32x4*)(cpl + bj * 512 + 388); } }
#pragma unroll
        for (int ai = 0; ai < 2; ++ai) {
            const bool top = (wr == 0 && ai == 0);
            u32x4 q1[2], q2[2];
            if (top) { q1[0] = (u32x4){0u, 0u, 0u, 0u}; q1[1] = q1[0]; q2[0] = q1[0]; q2[1] = q1[0]; }
            else { const int swr = wr == 1 ? 0 : 1, sai = wr == 1 ? ai : 0;
#pragma unroll
                for (int bj = 0; bj < 2; ++bj) { const u32x4 h14 = *(const PG8_LAS u32x4*)(lds0 + HX + hxi(swr, sai, 0, bj, wc, fq)), h15 = *(const PG8_LAS u32x4*)(lds0 + HX + hxi(swr, sai, 1, bj, wc, fq));
                    q1[bj] = h15; q2[bj] = fr == 0 ? h14 : h15; } }
#pragma unroll
            for (int m = 0; m < 4; ++m) {
                float cv[2][8];
#pragma unroll
                for (int bj = 0; bj < 2; ++bj) { const u32x4 cur = pk[ai][bj][m];
                    const u32x4 s1 = bperm4(i1, cur), s2 = bperm4(i2, cur);
                    const u32x4 p1 = fr == 0 ? q1[bj] : s1, p2 = fr < 2 ? q2[bj] : s2;
                    q1[bj] = s1; q2[bj] = s2;
#pragma unroll
                    for (int c = 0; c < 8; ++c) { const int q = c >> 1;
                        float y;
                        asm("v_dot2_f32_bf16 %0, %1, %2, %3" : "=v"(y) : "v"(PG8_W(p2, q)), "v"(PG8_W(wt[bj][0][c >> 2], c & 3)), "v"(bs[bj][c >> 2][c & 3]));
                        y = PG8_DOT2(PG8_W(p1, q), PG8_W(wt[bj][1][c >> 2], c & 3), y);
                        cv[bj][c] = PG8_DOT2(PG8_W(cur, q), PG8_W(wt[bj][2][c >> 2], c & 3), y); } }
                float o[8];
#pragma unroll
                for (int q = 0; q < 4; ++q) { const f32x2 t = {cv[1][2 * q], cv[1][2 * q + 1]}, av = {cv[0][2 * q], cv[0][2 * q + 1]};
                    const f32x2 e = {__builtin_amdgcn_exp2f(t.x), __builtin_amdgcn_exp2f(t.y)}; const f32x2 d = e + 1.f;
                    const f32x2 r = {__builtin_amdgcn_rcpf(d.x), __builtin_amdgcn_rcpf(d.y)}; const f32x2 ov = av * t * r; o[2 * q] = ov.x; o[2 * q + 1] = ov.y; }
                u32x4 out; out.x = cvt_pk_bf16(o[0], o[1]); out.y = cvt_pk_bf16(o[2], o[3]); out.z = cvt_pk_bf16(o[4], o[5]); out.w = cvt_pk_bf16(o[6], o[7]);
                const int row = u.pm * BM + ai * HALF + wr * 64 + m * 16 + fr;
                if (!(top && m == 0 && fr < 2)) *(u32x4*)(act + (size_t)row * NFF + ca) = out;
                __builtin_amdgcn_sched_barrier(0); } }
#undef PG8_DOT2
#undef PG8_W
    }
};

struct EpiFinal {
    static constexpr bool PERM = true, AFTER_DRAIN = true, ACC_INIT = true, HAS_PRE = false;
    struct Pre {};
    const bf16_t* xb; int ldc; unsigned long long* ss; unsigned* cnt; const float* g; float* out;
    __device__ __forceinline__ void init_load(u32x4 (&bw)[2][4][2], const Unit& u, int wr, int wc, int fr, int fq) const {
        const int row0 = u.pm * BM + wr * 64 + fr; const int col0 = u.pn * BM + wc * 32 + 8 * fq;
#pragma unroll
        for (int ai = 0; ai < 2; ++ai)
#pragma unroll
            for (int m = 0; m < 4; ++m)
#pragma unroll
                for (int bj = 0; bj < 2; ++bj) bw[ai][m][bj] = *(const u32x4*)(xb + (size_t)(row0 + ai * HALF + m * 16) * ldc + col0 + bj * HALF);
    }
    __device__ __forceinline__ static void init_apply(f32x4 (&acc)[2][2][4][2], const u32x4 (&bw)[2][4][2]) { EpiRes::init_apply(acc, bw); }
    __device__ __forceinline__ void fused(f32x4 (&acc)[2][2][4][2], const Unit& u, int wr, int wc, int fr, int fq, PG8_LAS unsigned char* lds, int wid, int lane) const {
        const int row0 = u.pm * BM + wr * 64 + fr; const int col0 = u.pn * BM + wc * 32 + 8 * fq;
        float sqv[2][4];
#pragma unroll
        for (int ai = 0; ai < 2; ++ai)
#pragma unroll
            for (int m = 0; m < 4; ++m) { float sq = 0.f;
#pragma unroll
                for (int bj = 0; bj < 2; ++bj) { const f32x4 o0 = acc[ai][bj][m][0], o1 = acc[ai][bj][m][1];
                    sq += (o0[0] * o0[0] + o0[1] * o0[1]) + (o0[2] * o0[2] + o0[3] * o0[3]) + (o1[0] * o1[0] + o1[1] * o1[1]) + (o1[2] * o1[2] + o1[3] * o1[3]); }
                sq += __shfl_xor(sq, 16); sq += __shfl_xor(sq, 32); sqv[ai][m] = sq; }
        f32x4 gq[2][2];
#pragma unroll
        for (int bj = 0; bj < 2; ++bj) { gq[bj][0] = *(const f32x4*)(g + col0 + bj * HALF); gq[bj][1] = *(const f32x4*)(g + col0 + bj * HALF + 4); }
        unsigned long long keep = 0ull, kr[2][4];
        if (fq == 0) {
#pragma unroll
            for (int ai = 0; ai < 2; ++ai)
#pragma unroll
                for (int m = 0; m < 4; ++m) kr[ai][m] = atomicAdd(ss + row0 + ai * HALF + m * 16, (unsigned long long)(sqv[ai][m] * 16777216.f));
#pragma unroll
            for (int ai = 0; ai < 2; ++ai)
#pragma unroll
                for (int m = 0; m < 4; ++m) keep += kr[ai][m]; }
        asm volatile("s_waitcnt vmcnt(0)" :: "v"((unsigned)keep), "v"((unsigned)(keep >> 32)) : "memory");
        if (lane == 0) __hip_atomic_fetch_add(cnt + 64 * u.pm, 1u, __ATOMIC_RELAXED, __HIP_MEMORY_SCOPE_AGENT);
        if (wid == 0) { unsigned sp = 0;
            while ((unsigned)__builtin_amdgcn_readfirstlane(__hip_atomic_load(cnt + 64 * u.pm, __ATOMIC_RELAXED, __HIP_MEMORY_SCOPE_AGENT)) < 64u) { __builtin_amdgcn_s_sleep(2); if (++sp > (1u << 22)) break; } }
        asm volatile("s_waitcnt vmcnt(0) lgkmcnt(0)" ::: "memory"); __builtin_amdgcn_s_barrier(); asm volatile("" ::: "memory");
        unsigned long long ssv[2][4];
#pragma unroll
        for (int ai = 0; ai < 2; ++ai)
#pragma unroll
            for (int m = 0; m < 4; ++m) ssv[ai][m] = __hip_atomic_load(ss + row0 + ai * HALF + m * 16, __ATOMIC_RELAXED, __HIP_MEMORY_SCOPE_AGENT);
#pragma unroll
        for (int ai = 0; ai < 2; ++ai)
#pragma unroll
            for (int m = 0; m < 4; ++m) { const int row = row0 + ai * HALF + m * 16; const size_t off = (size_t)row * ldc + col0;
                const float rstd = __builtin_amdgcn_rsqf((float)ssv[ai][m] * (1.f / 16777216.f / 2048.f) + 1e-6f);
#pragma unroll
                for (int bj = 0; bj < 2; ++bj) { const f32x4 g0 = gq[bj][0], g1 = gq[bj][1];
                    *(f32x4*)(out + off + bj * HALF) = acc[ai][bj][m][0] * rstd * g0; *(f32x4*)(out + off + bj * HALF + 4) = acc[ai][bj][m][1] * rstd * g1; } }
    }
};

struct NoHook { __device__ __forceinline__ void operator()() const {} };
template <class Epi, class Sched, bool ALIGN_EPI = false, bool SP2 = false, class Hook = NoHook>
__device__ __forceinline__ void gemm_phase(PG8_LAS unsigned char* lds, const Gemm g, const Sched& S, const Epi& E, const int tid, const Hook& before_a = Hook()) {
    const int wid = __builtin_amdgcn_readfirstlane(tid >> 6), lane = tid & 63, wr = wid >> 2, wc = wid & 3, fr = lane & 15, fq = lane >> 4;
    const int K = g.K, nt = K / BK;
    unsigned voffA[2], voffB[2];
#pragma unroll
    for (int i = 0; i < 2; ++i) { int R, C; stage_rc(tid * 16 + i * 8192, R, C); const int Rb = Epi::PERM ? ((R & ~31) + perm32(R & 31)) : R;
        voffA[i] = (unsigned)(R * K + C) * 2u; voffB[i] = (unsigned)(Rb * K + C) * 2u; }
    const size_t kstep = (size_t)(BK * 2);
    const size_t hstep = (size_t)HALF * K * 2;
    const size_t tstep = 2 * hstep;
    const unsigned ldsw = (unsigned)wid * 1024u;
    const int aoff = lds_byte(wr * 64 + fr, fq * 8), boff = lds_byte(wc * 32 + fr, fq * 8);
#define PG8_SA(b, h) (((b) * 2 + (h)) * HTB)
#define PG8_SB(b, h) ((4 + (b) * 2 + (h)) * HTB)
#define PG8_STAGE(bufoff, gbase, voff) do { _Pragma("unroll") for (int _i = 0; _i < 2; ++_i) \
        __builtin_amdgcn_global_load_lds((const unsigned*)((const char*)(gbase) + (voff)[_i]), (PG8_LAS unsigned*)(lds + (bufoff) + ldsw + _i * 8192), 16, 0, 0); } while (0)
#define PG8_LDA(dst, b, h) do { _Pragma("unroll") for (int m = 0; m < 4; ++m) _Pragma("unroll") for (int k = 0; k < 2; ++k) dst[m][k] = *(const PG8_LAS bf16x8*)(lds + PG8_SA(b, h) + aoff + m * 2048 + k * 1024); } while (0)
#define PG8_LDB(dst, b, h) do { _Pragma("unroll") for (int n = 0; n < 2; ++n) _Pragma("unroll") for (int k = 0; k < 2; ++k) dst[n][k] = *(const PG8_LAS bf16x8*)(lds + PG8_SB(b, h) + boff + n * 2048 + k * 1024); } while (0)
#define PG8_MMA(ai, bj, At, Bt) do { __builtin_amdgcn_s_setprio(1); _Pragma("unroll") for (int m = 0; m < 4; ++m) _Pragma("unroll") for (int n = 0; n < 2; ++n) _Pragma("unroll") for (int k = 0; k < 2; ++k) \
        acc[ai][bj][m][n] = __builtin_amdgcn_mfma_f32_16x16x32_bf16(Bt[n][k], At[m][k], acc[ai][bj][m][n], 0, 0, 0); __builtin_amdgcn_s_setprio(0); } while (0)
#define PG8_WAIT_V(n) asm volatile("s_waitcnt vmcnt(" #n ")" ::: "memory")
#define PG8_WAIT_L(n) asm volatile("s_waitcnt lgkmcnt(" #n ")" ::: "memory")
#define PG8_BAR __builtin_amdgcn_s_barrier()
#define PG8_SCHED __builtin_amdgcn_sched_barrier(0)
    Unit cur, nxt; int ui = 0;
    if (!S.next(0, cur)) return;
    typename Epi::Pre pre; (void)pre;
    if constexpr (Epi::HAS_PRE) E.pre_load(pre, cur, wr, wc, fr, fq);
    f32x4 acc[2][2][4][2];
    u32x4 ibw[2][4][2];
    if constexpr (Epi::ACC_INIT) { static_assert(SP2, "ACC_INIT needs the SP2 prologue"); E.init_load(ibw, cur, wr, wc, fr, fq); }
    else {
#pragma unroll
    for (int a = 0; a < 2; ++a)
#pragma unroll
        for (int b = 0; b < 2; ++b)
#pragma unroll
            for (int m = 0; m < 4; ++m)
#pragma unroll
                for (int n = 0; n < 2; ++n) acc[a][b][m][n] = (f32x4){0.f, 0.f, 0.f, 0.f};
    }
    bf16x8 At[4][2], B0[2][2], B1[2][2];
    const char* cA = (const char*)g.A + (size_t)cur.pm * tstep; const char* cB = (const char*)g.Bt + (size_t)cur.pn * tstep;
    S.a_ready(cur);
    if constexpr (SP2) {
        PG8_STAGE(PG8_SB(0, 0), cB, voffB); PG8_STAGE(PG8_SB(0, 1), cB + hstep, voffB); before_a(); PG8_STAGE(PG8_SA(0, 0), cA, voffA); PG8_STAGE(PG8_SA(0, 1), cA + hstep, voffA);
        if (wr == 1) PG8_BAR;
        PG8_WAIT_V(2); if constexpr (Epi::ACC_INIT) Epi::init_apply(acc, ibw); PG8_BAR;
        PG8_STAGE(PG8_SB(1, 0), cB + kstep, voffB); PG8_STAGE(PG8_SA(1, 0), cA + kstep, voffA); PG8_STAGE(PG8_SB(1, 1), cB + hstep + kstep, voffB);
        PG8_WAIT_V(6); PG8_BAR;
    } else {
        PG8_STAGE(PG8_SB(0, 0), cB, voffB); PG8_STAGE(PG8_SA(0, 0), cA, voffA); PG8_STAGE(PG8_SB(0, 1), cB + hstep, voffB); PG8_STAGE(PG8_SA(0, 1), cA + hstep, voffA);
        if (wr == 1) PG8_BAR;
        PG8_WAIT_V(4); PG8_BAR;
        PG8_STAGE(PG8_SB(1, 0), cB + kstep, voffB); PG8_STAGE(PG8_SA(1, 0), cA + kstep, voffA); PG8_STAGE(PG8_SB(1, 1), cB + hstep + kstep, voffB);
        PG8_WAIT_V(6); PG8_BAR;
    }
    for (;;) {
        const bool has_next = S.next(ui + 1, nxt);
        const char* nA = has_next ? (const char*)g.A + (size_t)nxt.pm * tstep : cA; const char* nB = has_next ? (const char*)g.Bt + (size_t)nxt.pn * tstep : cB;
        for (int t = 0; t < nt; t += 2) {
            const bool last = (t == nt - 2);
            const char* a1 = cA + (size_t)(t + 1) * kstep;
            const char* a2 = last ? nA : cA + (size_t)(t + 2) * kstep; const char* b2 = last ? nB : cB + (size_t)(t + 2) * kstep;
            const char* a3 = a2 + kstep; const char* b3 = b2 + kstep;
            if (last && has_next) S.a_ready(nxt);
            if constexpr (SP2) {
            PG8_LDB(B0, 0, 0); PG8_LDB(B1, 0, 1); PG8_SCHED; PG8_LDA(At, 0, 0); PG8_STAGE(PG8_SA(1, 1), a1 + hstep, voffA);
            PG8_WAIT_V(8); PG8_WAIT_L(0); PG8_BAR; PG8_MMA(0, 0, At, B0); PG8_MMA(0, 1, At, B1); PG8_BAR; PG8_SCHED;
            PG8_LDA(At, 0, 1); PG8_STAGE(PG8_SB(0, 0), b2, voffB); PG8_STAGE(PG8_SB(0, 1), b2 + hstep, voffB); PG8_STAGE(PG8_SA(0, 0), a2, voffA);
            PG8_WAIT_V(8); PG8_WAIT_L(0); PG8_BAR; PG8_MMA(1, 0, At, B0); PG8_MMA(1, 1, At, B1); PG8_BAR; PG8_SCHED;
            PG8_LDB(B0, 1, 0); PG8_LDB(B1, 1, 1); PG8_SCHED; PG8_LDA(At, 1, 0); PG8_STAGE(PG8_SA(0, 1), a2 + hstep, voffA);
            PG8_WAIT_V(8); PG8_WAIT_L(0); PG8_BAR; PG8_MMA(0, 0, At, B0); PG8_MMA(0, 1, At, B1); PG8_BAR; PG8_SCHED;
            PG8_LDA(At, 1, 1); PG8_STAGE(PG8_SB(1, 0), b3, voffB); PG8_STAGE(PG8_SB(1, 1), b3 + hstep, voffB); PG8_STAGE(PG8_SA(1, 0), a3, voffA);
            PG8_WAIT_V(8); PG8_WAIT_L(0); PG8_BAR; PG8_MMA(1, 0, At, B0); PG8_MMA(1, 1, At, B1); PG8_BAR; PG8_SCHED;
            } else {
            PG8_LDB(B0, 0, 0); PG8_SCHED; PG8_LDA(At, 0, 0); PG8_STAGE(PG8_SA(1, 1), a1 + hstep, voffA);
            PG8_WAIT_L(8); PG8_BAR; PG8_WAIT_L(0); PG8_MMA(0, 0, At, B0); PG8_BAR; PG8_SCHED;
            PG8_LDB(B1, 0, 1); PG8_STAGE(PG8_SB(0, 0), b2, voffB);
            PG8_BAR; PG8_WAIT_L(0); PG8_MMA(0, 1, At, B1); PG8_BAR;
            PG8_LDA(At, 0, 1); PG8_STAGE(PG8_SA(0, 0), a2, voffA);
            PG8_BAR; PG8_WAIT_L(0); PG8_MMA(1, 0, At, B0); PG8_BAR; PG8_SCHED;
            PG8_STAGE(PG8_SB(0, 1), b2 + hstep, voffB);
            PG8_WAIT_V(6); PG8_BAR; PG8_MMA(1, 1, At, B1); PG8_BAR;
            PG8_LDB(B0, 1, 0); PG8_SCHED; PG8_LDA(At, 1, 0); PG8_STAGE(PG8_SA(0, 1), a2 + hstep, voffA);
            PG8_WAIT_L(8); PG8_BAR; PG8_WAIT_L(0); PG8_MMA(0, 0, At, B0); PG8_BAR; PG8_SCHED;
            PG8_LDB(B1, 1, 1); PG8_STAGE(PG8_SB(1, 0), b3, voffB);
            PG8_BAR; PG8_WAIT_L(0); PG8_MMA(0, 1, At, B1); PG8_BAR;
            PG8_LDA(At, 1, 1); PG8_STAGE(PG8_SA(1, 0), a3, voffA);
            PG8_BAR; PG8_WAIT_L(0); PG8_MMA(1, 0, At, B0); PG8_BAR; PG8_SCHED;
            PG8_STAGE(PG8_SB(1, 1), b3 + hstep, voffB);
            PG8_WAIT_V(6); PG8_BAR; PG8_MMA(1, 1, At, B1); PG8_BAR;
            }
        }
        if constexpr (ALIGN_EPI) { if (wr == 0) PG8_BAR; }
        if constexpr (!Epi::AFTER_DRAIN) { if constexpr (Epi::HAS_PRE) E(acc, cur, wr, wc, fr, fq, pre, has_next, nxt); else E(acc, cur, wr, wc, fr, fq); S.done(cur); }
        if (!has_next) break;
        if constexpr (Epi::ACC_INIT) { E.init_load(ibw, nxt, wr, wc, fr, fq); Epi::init_apply(acc, ibw); }
        else {
#pragma unroll
        for (int a = 0; a < 2; ++a)
#pragma unroll
            for (int b = 0; b < 2; ++b)
#pragma unroll
                for (int m = 0; m < 4; ++m)
#pragma unroll
                    for (int n = 0; n < 2; ++n) acc[a][b][m][n] = (f32x4){0.f, 0.f, 0.f, 0.f};
        }
        cur = nxt; cA = nA; cB = nB; ++ui;
        if constexpr (ALIGN_EPI) { if (wr == 1) PG8_BAR; }
    }
    PG8_WAIT_V(0);
    if constexpr (!ALIGN_EPI) { if (wr == 0) PG8_BAR; }
    PG8_BAR;
    if constexpr (Epi::AFTER_DRAIN) { E.fused(acc, cur, wr, wc, fr, fq, lds, wid, lane); }
#undef PG8_SA
#undef PG8_SB
#undef PG8_STAGE
#undef PG8_LDA
#undef PG8_LDB
#undef PG8_MMA
#undef PG8_WAIT_V
#undef PG8_WAIT_L
#undef PG8_BAR
#undef PG8_SCHED
}
}

constexpr int DM = 2048, BATCH = 2, SEQ = 4096, MTOK = BATCH * SEQ;
constexpr int AB_IN = 6144, CD_IN = 5120, DFF = 5632, DFF2 = 11264;
constexpr float EPS = 1e-6f;
constexpr int NWAVES = 8;

#define GAS __attribute__((address_space(1)))
#define LAS __attribute__((address_space(3)))
typedef unsigned short bf16;
typedef unsigned v4u __attribute__((ext_vector_type(4)));
typedef unsigned v2u __attribute__((ext_vector_type(2)));
typedef float f32x4 __attribute__((ext_vector_type(4)));
typedef float f32x16 __attribute__((ext_vector_type(16)));
typedef short bf16x8 __attribute__((ext_vector_type(8)));
typedef short s16x4 __attribute__((ext_vector_type(4)));
typedef GAS unsigned gu32;
#define RLX_AGENT __ATOMIC_RELAXED, __HIP_MEMORY_SCOPE_AGENT
#define LDS_WAIT() asm volatile("s_waitcnt lgkmcnt(0)" ::: "memory")
#define VM_WAIT() asm volatile("s_waitcnt vmcnt(0)" ::: "memory")
__device__ __forceinline__ unsigned f2bf(float f) { unsigned r; asm("v_cvt_pk_bf16_f32 %0, %1, %1" : "=v"(r) : "v"(f)); return r; }
__device__ __forceinline__ unsigned pk2(float lo, float hi) { unsigned r; asm("v_cvt_pk_bf16_f32 %0, %1, %2" : "=v"(r) : "v"(lo), "v"(hi)); return r; }
__device__ __forceinline__ float bf2f(unsigned u16) { return __builtin_bit_cast(float, u16 << 16); }
__device__ __forceinline__ float bflo(unsigned w) { return __builtin_bit_cast(float, w << 16); }
__device__ __forceinline__ float bfhi(unsigned w) { return __builtin_bit_cast(float, w & 0xffff0000u); }
__device__ __forceinline__ float wave_sum(float v) {
#pragma unroll
    for (int o = 1; o < 64; o <<= 1) v += __shfl_xor(v, o);
    return v;
}
__device__ __forceinline__ float gelu_tanh(float x) {
    const float t = fmaf(x * x, 0.10294324f, 2.3022082f);
    return x * __builtin_amdgcn_rcpf(1.f + __builtin_amdgcn_exp2f(-x * t));
}
__device__ __forceinline__ float silu_f(float x) { return x * __builtin_amdgcn_rcpf(1.f + __builtin_amdgcn_exp2f(-1.4426950408889634f * x)); }

constexpr size_t MiB = 1u << 20;
constexpr size_t WS_W_CDIN = 0;
constexpr size_t WS_W_CDOUT = WS_W_CDIN + 20 * MiB;
constexpr size_t WS_W_UP1 = WS_W_CDOUT + 8 * MiB;
constexpr size_t WS_W_DN0 = WS_W_UP1 + 44 * MiB;
constexpr size_t WS_W_DN1 = WS_W_DN0 + 22 * MiB;
constexpr size_t WS_ACT = WS_W_DN1 + 22 * MiB;
constexpr size_t WS_OB = WS_ACT + 88 * MiB;
constexpr size_t WS_KV = WS_OB;
constexpr size_t WS_PREV = WS_KV + 64 * MiB;
constexpr size_t WS_HALO = WS_PREV + 32 * MiB;
constexpr size_t WS_O = WS_HALO + 4 * MiB;
constexpr size_t WS_R1 = WS_O + 32 * MiB;
constexpr size_t WS_P = WS_R1;
constexpr size_t WS_XN = WS_P + 96 * MiB;
constexpr size_t WS_W_UP0 = WS_XN + 32 * MiB;
constexpr size_t WS_W_ABOUT = WS_W_UP0 + 44 * MiB;
constexpr size_t WS_W_ABIN = WS_W_ABOUT + 8 * MiB;
constexpr size_t WS_ROPE = WS_W_ABIN + 24 * MiB;
constexpr size_t WS_CTL = WS_ROPE + 2 * MiB, CTL_ZERO_BYTES = 1 * MiB;
constexpr size_t WS_SS = WS_CTL + 128 * 1024;
constexpr size_t WS_LNS = WS_CTL + 512 * 1024;
constexpr size_t WS_CNT = WS_CTL + 768 * 1024;
constexpr size_t WS_SCAL = WS_CTL + 1 * MiB;
constexpr size_t WS_X = WS_ACT, WS_UP = WS_ACT, WS_SCR = WS_ACT;
constexpr size_t WS_END = WS_SCAL + 1 * MiB;

constexpr int RING_BYTES = 131072;
constexpr int LDSCTL_OFF = RING_BYTES, MISC_OFF = LDSCTL_OFF + 320;
constexpr int LDS_BYTES = 147456;

#define XB_TMO      128
#define XB_XCNT(j)  (256  + 64 * (j))
#define XB_XSUB(j)  (1280 + 64 * (j))
#define XB_XGEN(j)  (2304 + 64 * (j))
#define XB_TOP      3328
#define XB_TOPGEN   3392
#define XCD_BAR_WORDS 3456
#define XB_SPIN_CAP (1u << 20)
__device__ __forceinline__ unsigned xb_ld(unsigned* p)              { return __hip_atomic_load(p, __ATOMIC_RELAXED, __HIP_MEMORY_SCOPE_AGENT); }
__device__ __forceinline__ unsigned xb_add(unsigned* p, unsigned v) { return __hip_atomic_fetch_add(p, v, __ATOMIC_RELAXED, __HIP_MEMORY_SCOPE_AGENT); }
__device__ __forceinline__ unsigned xb_xcc_id() { return (unsigned)__builtin_amdgcn_s_getreg((3 << 11) | 20) & 0xFu; }
#define XB_SPIN(cond, bar) do { unsigned _sp = 0; while (cond) { __builtin_amdgcn_s_sleep(1); \
    if ((++_sp & 255u) == 0u) { if (xb_ld(&(bar)[XB_TMO])) break; if (_sp > XB_SPIN_CAP) { atomicAdd(&(bar)[XB_TMO], 1u); break; } } } } while (0)
#ifndef XB_FLAT
#define XB_FLAT 0
#endif
struct XcdBarrier { unsigned* bar; unsigned x; volatile LAS unsigned* st; };
#if XB_FLAT == 1
__device__ __forceinline__ XcdBarrier xcd_barrier_post(unsigned* bar, volatile LAS unsigned* st) {
    XcdBarrier b; b.bar = bar; b.x = xb_xcc_id(); b.st = st;
    return b;
}
__device__ __forceinline__ void xcd_barrier(const XcdBarrier& b) {
    asm volatile("s_waitcnt vmcnt(0)" ::: "memory");
    __syncthreads();
    if (threadIdx.x < 64) {
        unsigned* bar = b.bar; const unsigned ln = threadIdx.x;
        const unsigned k = b.st[0];
        const unsigned target = (k + 1u) * (gridDim.x * gridDim.y * gridDim.z);
        if (ln == 0) {
            __builtin_amdgcn_fence(__ATOMIC_RELEASE, "agent");
            asm volatile("s_waitcnt vmcnt(0)" ::: "memory");
            (void)__hip_atomic_fetch_add(&bar[XB_XSUB(b.x)], 1u, __ATOMIC_RELAXED, __HIP_MEMORY_SCOPE_AGENT);
            b.st[0] = k + 1u; }
        unsigned sp = 0u;
        for (;;) {
            unsigned v = ln < 16u ? xb_ld(&bar[XB_XSUB(ln)]) : 0u;
            v += __shfl_xor(v, 1); v += __shfl_xor(v, 2); v += __shfl_xor(v, 4); v += __shfl_xor(v, 8);
            v = __builtin_amdgcn_readfirstlane(v);
            if (v >= target) break;
            __builtin_amdgcn_s_sleep(1);
            if ((++sp & 255u) == 0u) { if (__builtin_amdgcn_readfirstlane(xb_ld(&bar[XB_TMO]))) break; if (sp > XB_SPIN_CAP) { if (ln == 0) atomicAdd(&bar[XB_TMO], 1u); break; } }
        }
        __builtin_amdgcn_fence(__ATOMIC_ACQUIRE, "agent");
        asm volatile("s_waitcnt vmcnt(0)" ::: "memory");
    }
    __syncthreads();
}
#else
__device__ __forceinline__ XcdBarrier xcd_barrier_post(unsigned* bar, volatile LAS unsigned* st) {
    XcdBarrier b; b.bar = bar; b.x = xb_xcc_id(); b.st = st;
    if (threadIdx.x == 0) (void)xb_add(&bar[XB_XCNT(b.x)], 1u);
    return b;
}
__device__ __forceinline__ void xcd_barrier_complete(unsigned* bar, unsigned x, unsigned& nloc, unsigned& nx) {
    const unsigned G = gridDim.x * gridDim.y * gridDim.z;
    unsigned sum, cnt, mine, sp = 0u;
    for (;;) {
        sum = 0u; cnt = 0u; mine = 0u;
#pragma unroll
        for (unsigned j = 0; j < 16; ++j) { const unsigned c = xb_ld(&bar[XB_XCNT(j)]); sum += c; cnt += (c > 0u) ? 1u : 0u; mine = (j == x) ? c : mine; }
        if (sum == G) break;
        __builtin_amdgcn_s_sleep(1);
        if ((++sp & 255u) == 0u) { if (xb_ld(&bar[XB_TMO])) break; if (sp > XB_SPIN_CAP) { atomicAdd(&bar[XB_TMO], 1u); break; } }
    }
    nloc = mine > 0u ? mine : 1u; nx = cnt > 0u ? cnt : 1u;
}
__device__ __forceinline__ void xcd_barrier(const XcdBarrier& b) {
    asm volatile("s_waitcnt vmcnt(0)" ::: "memory");
    __syncthreads();
    if (threadIdx.x == 0) {
        unsigned* bar = b.bar;
        __builtin_amdgcn_s_waitcnt(0);
        unsigned nloc = b.st[0], nx = b.st[1];
        if (nloc == 0u) { xcd_barrier_complete(bar, b.x, nloc, nx); b.st[0] = nloc; b.st[1] = nx; }
        const unsigned old = xb_add(&bar[XB_XSUB(b.x)], 1u);
        const unsigned gen = old / nloc;
#if XB_FLAT == 2
        if (old + 1u == (gen + 1u) * nloc) {
            __builtin_amdgcn_fence(__ATOMIC_RELEASE, "agent");
            asm volatile("s_waitcnt vmcnt(0)" ::: "memory");
            (void)__hip_atomic_fetch_add(&bar[XB_TOP], 1u, __ATOMIC_RELAXED, __HIP_MEMORY_SCOPE_AGENT); }
        { const unsigned target = (gen + 1u) * nx;
          XB_SPIN(xb_ld(&bar[XB_TOP]) < target, bar); }
        __builtin_amdgcn_fence(__ATOMIC_ACQUIRE, "agent");
        asm volatile("s_waitcnt vmcnt(0)" ::: "memory");
#elif XB_FLAT == 3
        if (old + 1u == (gen + 1u) * nloc) {
            __builtin_amdgcn_fence(__ATOMIC_RELEASE, "agent");
            asm volatile("s_waitcnt vmcnt(0)" ::: "memory");
            (void)__hip_atomic_fetch_add(&bar[XB_TOP], 1u, __ATOMIC_RELAXED, __HIP_MEMORY_SCOPE_AGENT);
            { const unsigned target = (gen + 1u) * nx;
              XB_SPIN(xb_ld(&bar[XB_TOP]) < target, bar); }
            __builtin_amdgcn_fence(__ATOMIC_ACQUIRE, "agent");
            (void)__hip_atomic_fetch_add(&bar[XB_XGEN(b.x)], 1u, __ATOMIC_RELAXED, __HIP_MEMORY_SCOPE_AGENT);
            asm volatile("s_waitcnt vmcnt(0)" ::: "memory");
        } else {
            XB_SPIN(xb_ld(&bar[XB_XGEN(b.x)]) == gen, bar);
            __builtin_amdgcn_fence(__ATOMIC_ACQUIRE, "agent");
            asm volatile("s_waitcnt vmcnt(0)" ::: "memory");
        }
#else
        if (old + 1u == (gen + 1u) * nloc) {
            __builtin_amdgcn_fence(__ATOMIC_RELEASE, "agent");
            asm volatile("s_waitcnt vmcnt(0)" ::: "memory");
            const unsigned og = xb_add(&bar[XB_TOP], 1u);
            const unsigned tg = og / nx;
            if (og + 1u == (tg + 1u) * nx) xb_add(&bar[XB_TOPGEN], 1u);
            else XB_SPIN(xb_ld(&bar[XB_TOPGEN]) == tg, bar);
            __builtin_amdgcn_fence(__ATOMIC_ACQUIRE, "agent");
            xb_add(&bar[XB_XGEN(b.x)], 1u);
            asm volatile("s_waitcnt vmcnt(0)" ::: "memory");
        } else {
            XB_SPIN(xb_ld(&bar[XB_XGEN(b.x)]) == gen, bar);
            __builtin_amdgcn_fence(__ATOMIC_ACQUIRE, "agent");
            asm volatile("s_waitcnt vmcnt(0)" ::: "memory");
        }
#endif
    }
    __syncthreads();
}

#endif

#ifndef ATT_SDEPTH
#define ATT_SDEPTH 1
#endif
namespace att {
constexpr int D = 128, QBLK = 32, KVBLK = 64;
constexpr float SCALE = 0.088388347648318440f;
constexpr float THR = 8.f;
constexpr int SHM_V = KVBLK * D * 2, SHM_K = KVBLK * D * 2;
constexpr int OFF_WS = 2 * SHM_V + 2 * SHM_K;
constexpr int OFF_TB = OFF_WS + 8 * 64 * 4;
constexpr int OFF_FLG = OFF_TB + 448 * 4;
__device__ __forceinline__ size_t pblk(size_t row, int col) { return ((size_t)(col >> 8) * MTOK + row) * 256 + (col & 255); }
#define KSWZ(row, colB) ((row) * 256 + ((colB) ^ (((row) & 7) << 4)))
#define SBAR() __builtin_amdgcn_sched_barrier(0)
__device__ __forceinline__ int crow(int r, int hi) { return (r & 3) + 8 * (r >> 2) + 4 * hi; }
__device__ __forceinline__ unsigned cvtpk(float lo, float hi) { unsigned r; asm volatile("v_cvt_pk_bf16_f32 %0, %1, %2" : "=v"(r) : "v"(lo), "v"(hi)); return r; }

__device__ __forceinline__ void partialSM(f32x16& p0, f32x16& p1, float& m_reg, float& mn, float& alpha) {
  constexpr float C = SCALE * 1.4426950408889634f;
  float pmax = p0[0];
#pragma unroll
  for (int r = 1; r < 16; ++r) pmax = fmaxf(pmax, p0[r]);
#pragma unroll
  for (int r = 0; r < 16; ++r) pmax = fmaxf(pmax, p1[r]);
  { auto rr = __builtin_amdgcn_permlane32_swap(__float_as_uint(pmax), __float_as_uint(pmax), false, false);
    pmax = fmaxf(__uint_as_float(rr[0]), __uint_as_float(rr[1])); }
  if (__builtin_expect(__all(pmax - m_reg <= THR / SCALE), 1)) { mn = m_reg; alpha = 1.f; }
  else { mn = fmaxf(m_reg, pmax); alpha = __builtin_amdgcn_exp2f((m_reg - mn) * C); m_reg = mn; }
  float mnC = -mn * C;
#pragma unroll
  for (int r = 0; r < 16; ++r) p0[r] = fmaf(p0[r], C, mnC);
#pragma unroll
  for (int r = 0; r < 16; ++r) p1[r] = fmaf(p1[r], C, mnC);
#pragma unroll
  for (int r = 0; r < 16; ++r) p0[r] = __builtin_amdgcn_exp2f(p0[r]);
}
#define PK4(P, BASE, OUT) do { unsigned a0 = cvtpk(P[BASE + 0], P[BASE + 1]), a1 = cvtpk(P[BASE + 2], P[BASE + 3]);   \
    unsigned b0 = cvtpk(P[BASE + 4], P[BASE + 5]), b1 = cvtpk(P[BASE + 6], P[BASE + 7]);                              \
    auto r0 = __builtin_amdgcn_permlane32_swap(a0, b0, false, false); auto r1 = __builtin_amdgcn_permlane32_swap(a1, b1, false, false); \
    v4u w = {r0[0], r1[0], r0[1], r1[1]}; OUT = *reinterpret_cast<bf16x8*>(&w); } while (0)
__device__ __forceinline__ void finishSM(f32x16& p0, f32x16& p1, float alpha, float& l_reg, bf16x8& pa0, bf16x8& pa1, bf16x8& pa2, bf16x8& pa3) {
#pragma unroll
  for (int r = 0; r < 16; ++r) p1[r] = __builtin_amdgcn_exp2f(p1[r]);
  float ps = 0;
#pragma unroll
  for (int r = 0; r < 16; ++r) ps += p0[r];
#pragma unroll
  for (int r = 0; r < 16; ++r) ps += p1[r];
  { auto rr = __builtin_amdgcn_permlane32_swap(__float_as_uint(ps), __float_as_uint(ps), false, false);
    ps = __uint_as_float(rr[0]) + __uint_as_float(rr[1]); }
  l_reg = l_reg * alpha + ps;
  PK4(p0, 0, pa0); PK4(p0, 8, pa1); PK4(p1, 0, pa2); PK4(p1, 8, pa3);
}
__device__ __forceinline__ void packP(const f32x16& p0, const f32x16& p1, bf16x8& pa0, bf16x8& pa1, bf16x8& pa2, bf16x8& pa3) {
  PK4(p0, 0, pa0); PK4(p0, 8, pa1); PK4(p1, 0, pa2); PK4(p1, 8, pa3);
}
__device__ __forceinline__ void qkt(f32x16& p0, f32x16& p1, const char* Ks, const bf16x8* qr, int r32, int hi) {
  p0 = f32x16{}; p1 = f32x16{};
#pragma unroll
  for (int d0 = 0; d0 < 8; ++d0) { int cb = (d0 * 16 + hi * 8) * 2;
    bf16x8 b0 = *reinterpret_cast<const bf16x8*>(Ks + KSWZ(r32, cb));
    bf16x8 b1 = *reinterpret_cast<const bf16x8*>(Ks + KSWZ(32 + r32, cb));
    p0 = __builtin_amdgcn_mfma_f32_32x32x16_bf16(b0, qr[d0], p0, 0, 0, 0);
    p1 = __builtin_amdgcn_mfma_f32_32x32x16_bf16(b1, qr[d0], p1, 0, 0, 0); }
}
__device__ __forceinline__ int v_st(int k, int c) { const int kk = (k & ~0xC) | ((k & 4) << 1) | ((k & 8) >> 1); return ((kk >> 3) * 4 + (c >> 5)) * 512 + ((kk & 7) * 32 + (c & 31)) * 2; }
__device__ __forceinline__ int v_rd_base(int lane) { return ((lane & 3) << 3) | (((lane >> 2) & 3) << 6) | (((lane >> 4) & 1) << 5) | (((lane >> 5) & 1) << 8); }
constexpr int v_rd_off(int d0, int ks, int half) { return d0 * 512 + ks * 4096 + half * 2048; }
template <int OFF> __device__ __forceinline__ s16x4 tr_read(int vb) {
  s16x4 r; asm volatile("ds_read_b64_tr_b16 %0, %1 offset:%2" : "=&v"(r) : "v"(vb), "i"(OFF) : "memory"); return r;
}
template <int D0> __device__ __forceinline__ void pv_one(f32x16& od, int vb, bf16x8 pa0, bf16x8 pa1, bf16x8 pa2, bf16x8 pa3) {
  const s16x4 l0 = tr_read<v_rd_off(D0, 0, 0)>(vb), h0 = tr_read<v_rd_off(D0, 0, 1)>(vb), l1 = tr_read<v_rd_off(D0, 1, 0)>(vb), h1 = tr_read<v_rd_off(D0, 1, 1)>(vb);
  const s16x4 l2 = tr_read<v_rd_off(D0, 2, 0)>(vb), h2 = tr_read<v_rd_off(D0, 2, 1)>(vb), l3 = tr_read<v_rd_off(D0, 3, 0)>(vb), h3 = tr_read<v_rd_off(D0, 3, 1)>(vb);
  asm volatile("s_waitcnt lgkmcnt(0)" ::: "memory"); SBAR();
#define PKV(L, H) (bf16x8){L[0], L[1], L[2], L[3], H[0], H[1], H[2], H[3]}
  od = __builtin_amdgcn_mfma_f32_32x32x16_bf16(pa0, PKV(l0, h0), od, 0, 0, 0);
  od = __builtin_amdgcn_mfma_f32_32x32x16_bf16(pa1, PKV(l1, h1), od, 0, 0, 0);
  od = __builtin_amdgcn_mfma_f32_32x32x16_bf16(pa2, PKV(l2, h2), od, 0, 0, 0);
  od = __builtin_amdgcn_mfma_f32_32x32x16_bf16(pa3, PKV(l3, h3), od, 0, 0, 0);
#undef PKV
}
__device__ __forceinline__ void pv_d0(f32x16* o, int vb, bf16x8 pa0, bf16x8 pa1, bf16x8 pa2, bf16x8 pa3) {
  pv_one<0>(o[0], vb, pa0, pa1, pa2, pa3); pv_one<1>(o[1], vb, pa0, pa1, pa2, pa3); pv_one<2>(o[2], vb, pa0, pa1, pa2, pa3); pv_one<3>(o[3], vb, pa0, pa1, pa2, pa3);
}

__device__ __forceinline__ void* uniform_ptr(const void* p) { const unsigned long long v = (unsigned long long)p;
  const unsigned lo = (unsigned)__builtin_amdgcn_readfirstlane((int)(unsigned)v), hi = (unsigned)__builtin_amdgcn_readfirstlane((int)(unsigned)(v >> 32)); return (void*)(((unsigned long long)hi << 32) | lo); }
__device__ __forceinline__ bf16x8 mk8a(s16x4 l, s16x4 h) { return (bf16x8){l[0], l[1], l[2], l[3], h[0], h[1], h[2], h[3]}; }
__device__ __forceinline__ bf16x8 bload16(__amdgpu_buffer_rsrc_t rs, int voff, int soff) {
  const v4u w = __builtin_amdgcn_raw_buffer_load_b128(rs, voff, soff, 0); return __builtin_bit_cast(bf16x8, w); }
template <int LDP, int LDO>
__device__ __forceinline__ void attnB_unit(const bf16* __restrict__ Qb, const bf16* Pbase, int koff, int voff, float* __restrict__ Ob, int qb, char* lds) {
  const __amdgpu_buffer_rsrc_t rs = __builtin_amdgcn_make_buffer_rsrc(uniform_ptr(Pbase), 0, SEQ * LDP * 2, 0x00020000);
  int tid = threadIdx.x; asm volatile("" : "+v"(tid));
  const int wid = tid >> 6, lane = tid & 63, r32 = lane & 31, hi = lane >> 5;
  char* V_lds = lds; char* K_lds = lds + 2 * SHM_V;
  float* ws = (float*)(lds + OFF_WS) + wid * 64; float* li_l = ws; float* al_l = ws + 32;
  const float* tb = (const float*)(lds + OFF_TB);
  float m_reg = -1e30f, l_reg = 0; f32x16 o[4] = {}; bf16x8 qr[8];
  const bf16* Qw = Qb + (long)(wid * QBLK + r32) * LDP + hi * 8;
#pragma unroll
  for (int d0 = 0; d0 < 8; ++d0) qr[d0] = *reinterpret_cast<const bf16x8*>(Qw + d0 * 16);
  const int sr = tid >> 4, sc = (tid & 15) * 8, vst0 = v_st(sr, sc), vst1 = v_st(32 + sr, sc);
  const int vb0 = (int)(uintptr_t)V_lds + v_rd_base(lane);
  constexpr int SDEPTH = ATT_SDEPTH;
  struct { bf16x8 vs0, vs1, ks0, ks1; } sr_[SDEPTH];
  const int vo0 = (sr * LDP + sc) * 2, vo1 = vo0 + 32 * LDP * 2;
#define SLOAD(i, k0) do { const int sV_ = (voff + (k0) * LDP) * 2, sK_ = (koff + (k0) * LDP) * 2; \
    sr_[i].vs0 = bload16(rs, vo0, sV_); sr_[i].vs1 = bload16(rs, vo1, sV_); sr_[i].ks0 = bload16(rs, vo0, sK_); sr_[i].ks1 = bload16(rs, vo1, sK_); } while (0)
#define SWRITE(b, i) do { *(bf16x8*)(V_lds + (b) * SHM_V + vst0) = sr_[i].vs0;          \
    *(bf16x8*)(V_lds + (b) * SHM_V + vst1) = sr_[i].vs1; int kc = sc * 2;               \
    *(bf16x8*)(K_lds + (b) * SHM_K + KSWZ(sr, kc)) = sr_[i].ks0;                       \
    *(bf16x8*)(K_lds + (b) * SHM_K + KSWZ(32 + sr, kc)) = sr_[i].ks1; } while (0)
#define SWAIT() do { if constexpr (SDEPTH == 2) asm volatile("s_waitcnt vmcnt(4)" ::: "memory"); else asm volatile("s_waitcnt vmcnt(0)" ::: "memory"); } while (0)
#define RESC(a) do { if (__any((a) < 1.f)) { if (hi == 0) al_l[r32] = (a); asm volatile("s_waitcnt lgkmcnt(0)" ::: "memory"); \
    _Pragma("unroll") for (int d = 0; d < 4; ++d) _Pragma("unroll") for (int r = 0; r < 16; ++r) o[d][r] *= al_l[crow(r, hi)]; } } while (0)
  const int NT = 4 * qb + 4, chunk_w = 4 * qb + (wid >> 1);
  const int ib0 = 4 * hi - 256 * qb - 32 * wid - r32 + 127 + 256;
#ifdef NO_FIX
#define FIX(P0, P1, j) do {} while (0)
#else
#define FIX(P0, P1, j) do { if ((j) > chunk_w) { _Pragma("unroll") for (int r = 0; r < 16; ++r) { P0[r] = -1e30f; P1[r] = -1e30f; } } \
    else if ((j) >= NT - 6) { const float* tbj = tb + (ib0 + 64 * (j)); \
      _Pragma("unroll") for (int r = 0; r < 16; ++r) { P0[r] += tbj[(r & 3) + 8 * (r >> 2)]; P1[r] += tbj[32 + (r & 3) + 8 * (r >> 2)]; } } } while (0)
#endif
  f32x16 pA0, pA1, pB0, pB1; float mnA, mnB, alA, alB; bf16x8 pa0, pa1, pa2, pa3;
  constexpr int SE = 0, SO = SDEPTH - 1;
  SLOAD(SE, 0); asm volatile("s_waitcnt vmcnt(0)" ::: "memory"); SWRITE(0, SE); __syncthreads();
  qkt(pA0, pA1, K_lds, qr, r32, hi); FIX(pA0, pA1, 0); partialSM(pA0, pA1, m_reg, mnA, alA);
  SLOAD(SO, KVBLK); if constexpr (SDEPTH == 2) { if (2 < NT) SLOAD(SE, 2 * KVBLK); }
  SWAIT(); SWRITE(1, SO); __syncthreads();
  for (int j = 1; j + 1 < NT; j += 2) {
    SBAR(); qkt(pB0, pB1, K_lds + SHM_K, qr, r32, hi);
    finishSM(pA0, pA1, alA, l_reg, pa0, pa1, pa2, pa3); SBAR();
    SLOAD(SO, (j + SDEPTH) * KVBLK); SBAR();
    pv_d0(o, vb0, pa0, pa1, pa2, pa3); FIX(pB0, pB1, j); partialSM(pB0, pB1, m_reg, mnB, alB);
    __syncthreads(); SWAIT(); SWRITE(0, SE);
    RESC(alB); __syncthreads();
    SBAR(); qkt(pA0, pA1, K_lds, qr, r32, hi);
    finishSM(pB0, pB1, alB, l_reg, pa0, pa1, pa2, pa3); SBAR();
    if (SDEPTH == 1 || j + 3 < NT) SLOAD(SE, (j + 1 + SDEPTH) * KVBLK); SBAR();
    pv_d0(o, vb0 + SHM_V, pa0, pa1, pa2, pa3); FIX(pA0, pA1, j + 1); partialSM(pA0, pA1, m_reg, mnA, alA);
    __syncthreads(); SWAIT(); SWRITE(1, SO);
    RESC(alA); __syncthreads();
  }
  SBAR(); qkt(pB0, pB1, K_lds + SHM_K, qr, r32, hi);
  finishSM(pA0, pA1, alA, l_reg, pa0, pa1, pa2, pa3); SBAR();
  pv_d0(o, vb0, pa0, pa1, pa2, pa3); FIX(pB0, pB1, NT - 1); partialSM(pB0, pB1, m_reg, mnB, alB);
  __syncthreads(); RESC(alB);
  finishSM(pB0, pB1, alB, l_reg, pa0, pa1, pa2, pa3); SBAR();
  pv_d0(o, vb0 + SHM_V, pa0, pa1, pa2, pa3);
  if (hi == 0) li_l[r32] = l_reg; asm volatile("s_waitcnt lgkmcnt(0)" ::: "memory");
  float rli[16];
#pragma unroll
  for (int r = 0; r < 16; ++r) rli[r] = __builtin_amdgcn_rcpf(li_l[crow(r, hi)]);
  float* Ow = Ob + (long)(wid * QBLK) * LDO;
#pragma unroll
  for (int r = 0; r < 16; ++r) { int orow = crow(r, hi);
#pragma unroll
    for (int d0 = 0; d0 < 4; ++d0) Ow[(long)orow * LDO + d0 * 32 + r32] = o[d0][r] * rli[r]; }
  __syncthreads();
#undef SLOAD
#undef SWRITE
#undef SWAIT
#undef RESC
#undef FIX
}

__device__ __forceinline__ void glds16_asm(const void* gsrc, unsigned lds_dst) { unsigned keep;
  asm volatile("s_mov_b32 %0, m0\n\ts_mov_b32 m0, %2\n\ts_nop 0\n\tglobal_load_lds_dwordx4 %1, off\n\ts_mov_b32 m0, %0" : "=&s"(keep) : "v"(gsrc), "s"(lds_dst) : "memory"); }
constexpr int B2_K = 0, B2_V = 2 * SHM_K, B2_P = B2_V + 4 * SHM_V, B2_X = 131072 + 1024;
constexpr int B2_AL = B2_X, B2_FL = B2_AL + 1024, B2_LI = B2_FL + 64, B2_TB = B2_LI + 512;
template <int LDP, int LDO>
__device__ __forceinline__ void attnB2_unit(const bf16* __restrict__ Qb, const bf16* Pbase, int koff, int voff, bf16* __restrict__ Ob, int q128, char* lds, int sel = 0) {
  int tid = threadIdx.x; asm volatile("" : "+v"(tid));
  const int wid = __builtin_amdgcn_readfirstlane(tid >> 6), lane = tid & 63, r32 = lane & 31, hi = lane >> 5, pw = wid & 3;
  const int NT = 2 * q128 + 2;
  const unsigned lbase = (unsigned)__builtin_amdgcn_readfirstlane((int)(uintptr_t)lds);
  const bf16* Ksrc; const bf16* Vsrc[4];
  { const int row0 = 8 * wid + (lane >> 4), row1 = row0 + 4;
    Ksrc = Pbase + koff + (size_t)row0 * LDP + (((lane & 15) ^ (row0 & 7)) << 3);
    (void)row1; }
  const int kx1 = (int)((((lane & 15) ^ ((8 * wid + (lane >> 4) + 4) & 7)) << 3)) - (int)((((lane & 15) ^ ((8 * wid + (lane >> 4)) & 7)) << 3));
#pragma unroll
  for (int q = 0; q < 4; ++q) { const int ci = wid * 4 + q, vt = ci >> 4, cs = ci & 15, st = cs * 2 + (lane >> 5);
    const int kk = (st >> 2) * 8 + ((lane >> 2) & 7), k = (kk & ~0xC) | ((kk & 4) << 1) | ((kk & 8) >> 1), c = vt * 128 + (st & 3) * 32 + (lane & 3) * 8;
    Vsrc[q] = Pbase + voff + (size_t)k * LDP + c; }
#define B2DMA_K(t_, b_) do { const bf16* ks_ = Ksrc + (size_t)(t_) * KVBLK * LDP; const unsigned kd_ = (unsigned)__builtin_amdgcn_readfirstlane((int)(lbase + B2_K + (b_) * SHM_K + wid * 2048)); \
    glds16_asm(ks_, kd_); glds16_asm(ks_ + 4 * LDP + kx1, kd_ + 1024); } while (0)
#define B2DMA_V(t_, b_) do { _Pragma("unroll") for (int q = 0; q < 4; ++q) { const int ci_ = wid * 4 + q; \
      glds16_asm(Vsrc[q] + (size_t)(t_) * KVBLK * LDP, (unsigned)__builtin_amdgcn_readfirstlane((int)(lbase + B2_V + (b_) * 2 * SHM_V + (ci_ >> 4) * SHM_V + (ci_ & 15) * 1024))); } } while (0)
#define B2SYNC() do { asm volatile("s_waitcnt vmcnt(0)" ::: "memory"); __syncthreads(); } while (0)
  typedef __attribute__((address_space(3))) float lds_f32; typedef __attribute__((address_space(3))) int lds_i32;
  lds_f32* al_s = (lds_f32*)(uintptr_t)(lbase + B2_AL); lds_i32* fl_s = (lds_i32*)(uintptr_t)(lbase + B2_FL); lds_f32* li_s = (lds_f32*)(uintptr_t)(lbase + B2_LI);
  B2DMA_K(0, 0); B2DMA_V(0, 0); B2DMA_K(1, 1);
  if (wid < 4) {
    const float* tb = (const float*)(lds + B2_TB);
    const int chunk_w = 2 * q128 + (pw >> 1);
    const int ib0 = 4 * hi - 128 * q128 - 32 * pw - r32 + 127 + 256;
    float m_reg = -1e30f, l_reg = 0.f; bf16x8 qr[8];
    { const bf16* Qw = Qb + (long)(pw * QBLK + r32) * LDP + hi * 8;
#pragma unroll
      for (int d0 = 0; d0 < 8; ++d0) qr[d0] = *reinterpret_cast<const bf16x8*>(Qw + d0 * 16); }
    B2SYNC();
#define B2PROD(t_) do { char* pb_ = lds + B2_P + ((((t_) & 1) * 4 + pw) * 4) * 1024 + lane * 16; \
      if ((t_) > chunk_w) {                                          \
        const bf16x8 z_ = {0, 0, 0, 0, 0, 0, 0, 0}; *(bf16x8*)(pb_) = z_; *(bf16x8*)(pb_ + 1024) = z_; *(bf16x8*)(pb_ + 2048) = z_; *(bf16x8*)(pb_ + 3072) = z_; \
        if (hi == 0) al_s[(((t_) & 1) * 4 + pw) * 32 + r32] = 1.f; if (lane == 0) fl_s[((t_) & 1) * 4 + pw] = 0; \
      } else { f32x16 p0, p1; qkt(p0, p1, lds + B2_K + ((t_) & 1) * SHM_K, qr, r32, hi); \
        if ((t_) >= NT - 4) { const float* tbj = tb + (ib0 + 64 * (t_)); \
          _Pragma("unroll") for (int r = 0; r < 16; ++r) { p0[r] += tbj[(r & 3) + 8 * (r >> 2)]; p1[r] += tbj[32 + (r & 3) + 8 * (r >> 2)]; } } \
        float mn_, al_; partialSM(p0, p1, m_reg, mn_, al_); bf16x8 pa0, pa1, pa2, pa3; finishSM(p0, p1, al_, l_reg, pa0, pa1, pa2, pa3); \
        *(bf16x8*)(pb_) = pa0; *(bf16x8*)(pb_ + 1024) = pa1; *(bf16x8*)(pb_ + 2048) = pa2; *(bf16x8*)(pb_ + 3072) = pa3; \
        if (hi == 0) al_s[(((t_) & 1) * 4 + pw) * 32 + r32] = al_; \
        const int any_ = __any(al_ < 1.f) ? 1 : 0; if (lane == 0) fl_s[((t_) & 1) * 4 + pw] = any_; } } while (0)
    B2PROD(0);
    B2SYNC();
    for (int j = 0; j < NT; ++j) {
      if (j + 2 < NT) B2DMA_K(j + 2, j & 1);
      if (j + 1 < NT) B2DMA_V(j + 1, (j + 1) & 1);
      if (j + 1 < NT && !(sel & 4)) B2PROD(j + 1);
      B2SYNC();
    }
    if (hi == 0) li_s[pw * 32 + r32] = __builtin_amdgcn_rcpf(l_reg);
    __syncthreads();
#undef B2PROD
  } else {
    f32x16 o[8] = {};
    const int vb0 = (int)(uintptr_t)(lds + B2_V) + v_rd_base(lane);
    B2SYNC();
    B2SYNC();
    for (int j = 0; j < NT; ++j) {
      if (j + 2 < NT) B2DMA_K(j + 2, j & 1);
      if (j + 1 < NT) B2DMA_V(j + 1, (j + 1) & 1);
      if (!(sel & 8)) { const int bsel = j & 1;
        if (fl_s[bsel * 4 + pw]) { const lds_f32* ap = al_s + (bsel * 4 + pw) * 32;
#pragma unroll
          for (int d = 0; d < 8; ++d)
#pragma unroll
            for (int r = 0; r < 16; ++r) o[d][r] *= ap[crow(r, hi)]; }
        const char* pb_ = lds + B2_P + ((bsel * 4 + pw) * 4) * 1024 + lane * 16;
        const bf16x8 pa0 = *(const bf16x8*)(pb_), pa1 = *(const bf16x8*)(pb_ + 1024), pa2 = *(const bf16x8*)(pb_ + 2048), pa3 = *(const bf16x8*)(pb_ + 3072);
        pv_d0(o, vb0 + bsel * 2 * SHM_V, pa0, pa1, pa2, pa3); pv_d0(o + 4, vb0 + bsel * 2 * SHM_V + SHM_V, pa0, pa1, pa2, pa3); }
      B2SYNC();
    }
    __syncthreads();
    float rli[16];
#pragma unroll
    for (int r = 0; r < 16; ++r) rli[r] = li_s[pw * 32 + crow(r, hi)];
    bf16* Ow = Ob + (long)(pw * QBLK) * LDO;
#pragma unroll
    for (int r = 0; r < 16; ++r) { const int orow = crow(r, hi);
#pragma unroll
      for (int d = 0; d < 8; ++d) Ow[(long)orow * LDO + d * 32 + r32] = (bf16)f2bf(o[d][r] * rli[r]); }
  }
  __syncthreads();
#undef B2DMA_K
#undef B2DMA_V
#undef B2SYNC
}

template <int LDP, int LDO>
__device__ __forceinline__ void attnA_unit(const bf16* __restrict__ Qb, const bf16* Pbase, int koff, int voff, bf16* __restrict__ Ob, int qb, char* lds) {
  const __amdgpu_buffer_rsrc_t rs = __builtin_amdgcn_make_buffer_rsrc(uniform_ptr(Pbase), 0, SEQ * LDP * 2, 0x00020000);
  int tid = threadIdx.x; asm volatile("" : "+v"(tid));
  const int wid = __builtin_amdgcn_readfirstlane(tid >> 6), lane = tid & 63, r32 = lane & 31, hi = lane >> 5;
  char* K_lds = lds + wid * 16384; char* V_lds = K_lds + 8192;
  f32x16 o[4] = {}; bf16x8 qr[8];
  const bf16* Qw = Qb + (long)(wid * QBLK + r32) * LDP + hi * 8;
#pragma unroll
  for (int d0 = 0; d0 < 8; ++d0) qr[d0] = *reinterpret_cast<const bf16x8*>(Qw + d0 * 16);
  const int srow = lane >> 4, scol = (lane & 15) * 8;
  const int vo = (srow * LDP + scol) * 2;
  const int vb0 = (int)(uintptr_t)V_lds + v_rd_base(lane);
  const int krow = lane >> 4, kch = lane & 15;
  const unsigned klds = (unsigned)__builtin_amdgcn_readfirstlane((int)(uintptr_t)K_lds);
  const bf16* Ksrc = Pbase + koff;
  float R = 0.f;
  const int htd = 8 * qb + wid;
  bf16x8 tv[8];
#define AKDMA(ht_) do { _Pragma("unroll") for (int j = 0; j < 8; ++j) { const int row_ = 4 * j + krow; \
      __builtin_amdgcn_global_load_lds((const unsigned*)(Ksrc + (size_t)((ht_) * 32 + row_) * LDP + ((kch ^ (row_ & 7)) << 3)), (__attribute__((address_space(3))) unsigned*)(uintptr_t)(klds + j * 1024), 16, 0, 0); } } while (0)
#define AVLOAD(ht_) do { const int sV_ = __builtin_amdgcn_readfirstlane((voff + (ht_) * 32 * LDP) * 2); _Pragma("unroll") for (int j = 0; j < 8; ++j) tv[j] = bload16(rs, vo + j * (4 * LDP * 2), sV_); } while (0)
  AKDMA(htd); AVLOAD(htd);
  for (int ht = htd; ht >= 0; --ht) {
    asm volatile("s_waitcnt vmcnt(0)" ::: "memory");
#pragma unroll
    for (int j = 0; j < 8; ++j) *(bf16x8*)(V_lds + v_st(4 * j + srow, scol)) = tv[j];
    if (ht > 0) AVLOAD(ht - 1);
    asm volatile("s_waitcnt lgkmcnt(0)" ::: "memory");
    f32x16 p0 = f32x16{};
#pragma unroll
    for (int d0 = 0; d0 < 8; ++d0) { const int cb = (d0 * 16 + hi * 8) * 2;
      const bf16x8 b0 = *reinterpret_cast<const bf16x8*>(K_lds + KSWZ(r32, cb));
      p0 = __builtin_amdgcn_mfma_f32_32x32x16_bf16(b0, qr[d0], p0, 0, 0, 0); }
    asm volatile("s_waitcnt lgkmcnt(0)" : "+v"(p0) :: "memory");
    if (ht > 0) AKDMA(ht - 1);
    const int lim = (ht == htd) ? r32 : 32;
    float qs[4], oq[4]; f32x16 Ln;
#pragma unroll
    for (int g = 0; g < 4; ++g) { float s_ = 0.f;
#pragma unroll
      for (int i = 0; i < 4; ++i) { const int r = 4 * g + i; const float x = p0[r] * (SCALE * 1.4426950408889634f); p0[r] = x;
        const float sp = __builtin_amdgcn_logf(1.f + __builtin_amdgcn_exp2f(-fabsf(x))); const float ln = (crow(r, hi) < lim) ? -(fmaxf(x, 0.f) + sp) : 0.f;
        Ln[r] = ln; s_ += ln; }
      qs[g] = s_; }
#pragma unroll
    for (int g = 0; g < 4; ++g) oq[g] = __shfl_xor(qs[g], 32);
    float run = 0.f;
#pragma unroll
    for (int g = 3; g >= 0; --g) { float E = R + run + (hi == 0 ? oq[g] : 0.f);
#pragma unroll
      for (int i = 3; i >= 0; --i) { const int r = 4 * g + i;
        const bool valid = crow(r, hi) < lim;
        const float w = valid ? __builtin_amdgcn_exp2f(Ln[r] + p0[r] + E) : 0.f; E += Ln[r]; p0[r] = w; }
      run += qs[g] + oq[g]; }
    R += run;
    bf16x8 pa0, pa1; PK4(p0, 0, pa0); PK4(p0, 8, pa1);
#define AV_ONE(D0) do { const s16x4 l0 = tr_read<v_rd_off(D0, 0, 0)>(vb0), h0 = tr_read<v_rd_off(D0, 0, 1)>(vb0), l1 = tr_read<v_rd_off(D0, 1, 0)>(vb0), h1 = tr_read<v_rd_off(D0, 1, 1)>(vb0); \
      asm volatile("s_waitcnt lgkmcnt(0)" ::: "memory"); SBAR(); \
      o[D0] = __builtin_amdgcn_mfma_f32_32x32x16_bf16(pa0, mk8a(l0, h0), o[D0], 0, 0, 0); o[D0] = __builtin_amdgcn_mfma_f32_32x32x16_bf16(pa1, mk8a(l1, h1), o[D0], 0, 0, 0); } while (0)
    AV_ONE(0); AV_ONE(1); AV_ONE(2); AV_ONE(3);
#undef AV_ONE
    if (__all(R < -150.04f)) break;
  }
#undef AKDMA
#undef AVLOAD
  asm volatile("s_waitcnt vmcnt(0)" ::: "memory");
  bf16* Ow = Ob + (long)(wid * QBLK) * LDO;
#pragma unroll
  for (int r = 0; r < 16; ++r) { const int orow = crow(r, hi);
#pragma unroll
    for (int d0 = 0; d0 < 4; ++d0) Ow[(long)orow * LDO + d0 * 32 + r32] = (bf16)f2bf(o[d0][r]); }
  __syncthreads();
}
__device__ __forceinline__ bf16x8 mk8(s16x4 l, s16x4 h) { return (bf16x8){l[0], l[1], l[2], l[3], h[0], h[1], h[2], h[3]}; }
__device__ __forceinline__ v4u pack8(const float* f) { v4u w; w.x = cvtpk(f[0], f[1]); w.y = cvtpk(f[2], f[3]); w.z = cvtpk(f[4], f[5]); w.w = cvtpk(f[6], f[7]); return w; }
__device__ __forceinline__ void rot8(v4u lo4, v4u hi4, const float2* cs, float mul, float* ol, float* oh) {
#pragma unroll
  for (int q = 0; q < 4; ++q) { const float2 c0 = cs[2 * q], c1 = cs[2 * q + 1];
    const float l0 = bflo(lo4[q]), l1 = bfhi(lo4[q]), h0 = bflo(hi4[q]), h1 = bfhi(hi4[q]);
    ol[2 * q] = (l0 * c0.x - h0 * c0.y) * mul; ol[2 * q + 1] = (l1 * c1.x - h1 * c1.y) * mul;
    oh[2 * q] = (h0 * c0.x + l0 * c0.y) * mul; oh[2 * q + 1] = (h1 * c1.x + l1 * c1.y) * mul; }
}
template <int LDP>
__device__ __forceinline__ void ret_kv_unit(const bf16* __restrict__ P, const float2* __restrict__ ROPE, bf16* __restrict__ kvo, int b, int h, int n, char* lds) {
  int tid = threadIdx.x; asm volatile("" : "+v"(tid));
  const int wid = tid >> 6, lane = tid & 63, r32 = lane & 31, hi = lane >> 5;
  char* Vt = lds; char* Kt = lds + 2 * SHM_V;
  const size_t t0 = (size_t)b * SEQ + 64 * n;
  const float lg = __logf(1.f - exp2f(-5.f - (float)h));
  {
    bf16x8 vv[4];
#pragma unroll
    for (int it = 0; it < 4; ++it) { const int task = it * 512 + tid, vt = task >> 10, row = (task >> 4) & 63, sc = (task & 15) * 8;
      vv[it] = *reinterpret_cast<const bf16x8*>(P + pblk(t0 + row, 1024 + h * 256 + vt * 128 + sc)); }
    const int m = tid >> 3, dc = (tid & 7) * 8; const bf16* kr = P + pblk(t0 + m, 512 + h * 128);
    const v4u lo4 = *(const v4u*)(kr + dc), hi4 = *(const v4u*)(kr + 64 + dc);
    float2 csv[8]; { const float2* cs = ROPE + (size_t)(64 * n + m) * 64 + dc;
#pragma unroll
      for (int q = 0; q < 8; ++q) csv[q] = cs[q]; }
#pragma unroll
    for (int it = 0; it < 4; ++it) { const int task = it * 512 + tid, vt = task >> 10, row = (task >> 4) & 63, sc = (task & 15) * 8;
      *(bf16x8*)(Vt + vt * SHM_V + v_st(row, sc)) = vv[it]; }
    float ol[8], oh[8]; rot8(lo4, hi4, csv, __expf(lg * (float)(63 - m)), ol, oh);
    *(v4u*)(Kt + v_st(m, dc)) = pack8(ol); *(v4u*)(Kt + v_st(m, 64 + dc)) = pack8(oh); }
  __syncthreads();
  const int vbA = (int)(uintptr_t)(Vt + (wid >> 2) * SHM_V) + v_rd_base(lane) + (wid & 3) * 512;
  const int vbB = (int)(uintptr_t)Kt + v_rd_base(lane);
  bf16x8 a[4];
  { const s16x4 l0 = tr_read<v_rd_off(0, 0, 0)>(vbA), h0 = tr_read<v_rd_off(0, 0, 1)>(vbA), l1 = tr_read<v_rd_off(0, 1, 0)>(vbA), h1 = tr_read<v_rd_off(0, 1, 1)>(vbA);
    const s16x4 l2 = tr_read<v_rd_off(0, 2, 0)>(vbA), h2 = tr_read<v_rd_off(0, 2, 1)>(vbA), l3 = tr_read<v_rd_off(0, 3, 0)>(vbA), h3 = tr_read<v_rd_off(0, 3, 1)>(vbA);
    asm volatile("s_waitcnt lgkmcnt(0)" ::: "memory"); SBAR();
    a[0] = mk8(l0, h0); a[1] = mk8(l1, h1); a[2] = mk8(l2, h2); a[3] = mk8(l3, h3); }
  f32x16 acc[4] = {};
  pv_one<0>(acc[0], vbB, a[0], a[1], a[2], a[3]); pv_one<1>(acc[1], vbB, a[0], a[1], a[2], a[3]); pv_one<2>(acc[2], vbB, a[0], a[1], a[2], a[3]); pv_one<3>(acc[3], vbB, a[0], a[1], a[2], a[3]);
#pragma unroll
  for (int db = 0; db < 4; ++db)
#pragma unroll
    for (int r = 0; r < 16; ++r) kvo[(size_t)(32 * wid + crow(r, hi)) * 128 + 32 * db + r32] = (bf16)f2bf(acc[db][r]);
  __syncthreads();
}
template <int LDP, int LDO>
__device__ __forceinline__ void ret_out_unit(const bf16* __restrict__ P, const float2* __restrict__ ROPE, const bf16* __restrict__ PREV, const float* __restrict__ rg, bf16* __restrict__ O, int b, int h, int np, char* lds) {
  int tid = threadIdx.x; asm volatile("" : "+v"(tid));
  const int wid = tid >> 6, lane = tid & 63, r32 = lane & 31, hi = lane >> 5;
  const int cw = wid >> 2, qh = (wid >> 1) & 1, eh = wid & 1, bh = b * 4 + h;
  constexpr int CH = 3 * SHM_V;
  float* red = (float*)(lds + 2 * CH);
  const float lg = __logf(1.f - exp2f(-5.f - (float)h));
  { v4u klo[2], khi[2]; float2 csv[2][8]; bf16x8 vv[2][4]; const int m = tid >> 3, dc = (tid & 7) * 8;
#pragma unroll
    for (int cc = 0; cc < 2; ++cc) { const int n = 2 * np + cc; const size_t t0 = (size_t)b * SEQ + 64 * n;
      const bf16* kr = P + pblk(t0 + m, 512 + h * 128); klo[cc] = *(const v4u*)(kr + dc); khi[cc] = *(const v4u*)(kr + 64 + dc);
      const float2* cs = ROPE + (size_t)(64 * n + m) * 64 + dc;
#pragma unroll
      for (int q = 0; q < 8; ++q) csv[cc][q] = cs[q];
#pragma unroll
      for (int it = 0; it < 4; ++it) { const int task = it * 512 + tid, vt = task >> 10, row = (task >> 4) & 63, sc = (task & 15) * 8;
        vv[cc][it] = *reinterpret_cast<const bf16x8*>(P + pblk(t0 + row, 1024 + h * 256 + vt * 128 + sc)); } }
#pragma unroll
    for (int cc = 0; cc < 2; ++cc) { float ol[8], oh[8]; rot8(klo[cc], khi[cc], csv[cc], 1.f, ol, oh);
      *(v4u*)(lds + cc * CH + KSWZ(m, dc * 2)) = pack8(ol); *(v4u*)(lds + cc * CH + KSWZ(m, (64 + dc) * 2)) = pack8(oh);
#pragma unroll
      for (int it = 0; it < 4; ++it) { const int task = it * 512 + tid, vt = task >> 10, row = (task >> 4) & 63, sc = (task & 15) * 8;
        *(bf16x8*)(lds + cc * CH + SHM_V + vt * SHM_V + v_st(row, sc)) = vv[cc][it]; } } }
  const int n = 2 * np + cw; const size_t tq = (size_t)b * SEQ + 64 * n + 32 * qh + r32;
  bf16x8 qr[8];
  { const bf16* qrow = P + pblk(tq, h * 128) + hi * 8; const float2* cs = ROPE + (size_t)(64 * n + 32 * qh + r32) * 64 + hi * 8;
#pragma unroll
    for (int d0 = 0; d0 < 4; ++d0) { const v4u lo4 = *(const v4u*)(qrow + d0 * 16), hi4 = *(const v4u*)(qrow + 64 + d0 * 16);
      float ol[8], oh[8]; rot8(lo4, hi4, cs + d0 * 16, SCALE, ol, oh);
      const v4u wl = pack8(ol), wh = pack8(oh); qr[d0] = __builtin_bit_cast(bf16x8, wl); qr[d0 + 4] = __builtin_bit_cast(bf16x8, wh); } }
  f32x16 o[4] = {};
  { const bf16* pv = PREV + ((size_t)bh * 64 + n) * 32768 + (size_t)(128 * eh + r32) * 128 + hi * 8;
    bf16x8 bc[8], bn[8];
#pragma unroll
    for (int ks = 0; ks < 8; ++ks) bc[ks] = *reinterpret_cast<const bf16x8*>(pv + ks * 16);
#pragma unroll
    for (int d0 = 0; d0 < 4; ++d0) {
      if (d0 < 3) {
#pragma unroll
        for (int ks = 0; ks < 8; ++ks) bn[ks] = *reinterpret_cast<const bf16x8*>(pv + (size_t)(32 * (d0 + 1)) * 128 + ks * 16); }
      __builtin_amdgcn_sched_barrier(0);
#pragma unroll
      for (int ks = 0; ks < 8; ++ks) o[d0] = __builtin_amdgcn_mfma_f32_32x32x16_bf16(qr[ks], bc[ks], o[d0], 0, 0, 0);
      __builtin_amdgcn_sched_barrier(0);
      if (d0 < 3) {
#pragma unroll
        for (int ks = 0; ks < 8; ++ks) bc[ks] = bn[ks]; } } }
#pragma unroll
  for (int r = 0; r < 16; ++r) { const float qd = __expf(lg * (float)(32 * qh + crow(r, hi) + 1));
#pragma unroll
    for (int d0 = 0; d0 < 4; ++d0) o[d0][r] *= qd; }
  __syncthreads();
  { f32x16 p0, p1; qkt(p0, p1, lds + cw * CH, qr, r32, hi);
    const int c = 32 * qh + r32;
#pragma unroll
    for (int r = 0; r < 16; ++r) { const int m0 = crow(r, hi), m1 = m0 + 32; const int d0_ = c > m0 ? c - m0 : m0 - c, d1_ = c > m1 ? c - m1 : m1 - c;
      p0[r] *= __expf(lg * (float)d0_); p1[r] *= __expf(lg * (float)d1_); }
    bf16x8 pa0, pa1, pa2, pa3; packP(p0, p1, pa0, pa1, pa2, pa3);
    pv_d0(o, (int)(uintptr_t)(lds + cw * CH + SHM_V + eh * SHM_V) + v_rd_base(lane), pa0, pa1, pa2, pa3); }
  { float ssq[16];
#pragma unroll
    for (int r = 0; r < 16; ++r) { float s_ = (o[0][r] * o[0][r] + o[1][r] * o[1][r]) + (o[2][r] * o[2][r] + o[3][r] * o[3][r]);
      s_ += __shfl_xor(s_, 1); s_ += __shfl_xor(s_, 2); s_ += __shfl_xor(s_, 4); s_ += __shfl_xor(s_, 8); s_ += __shfl_xor(s_, 16); ssq[r] = s_; }
    if (r32 == 0) {
#pragma unroll
      for (int r = 0; r < 16; ++r) red[wid * 32 + crow(r, hi)] = ssq[r]; }
    __syncthreads();
    const size_t trow0 = (size_t)b * SEQ + 64 * n + 32 * qh;
    bf16 gv[16][4];
#pragma unroll
    for (int r = 0; r < 16; ++r)
#pragma unroll
      for (int d0 = 0; d0 < 4; ++d0) gv[r][d0] = P[pblk(trow0 + crow(r, hi), 2048 + h * 256 + 128 * eh + 32 * d0 + r32)];
#pragma unroll
    for (int r = 0; r < 16; ++r) { const int rl = crow(r, hi); const float tot = red[wid * 32 + rl] + red[(wid ^ 1) * 32 + rl]; const float rstd = rsqrtf(tot * (1.f / 256.f) + 1e-6f);
      const size_t row = trow0 + rl;
#pragma unroll
      for (int d0 = 0; d0 < 4; ++d0) { const int e = 128 * eh + 32 * d0 + r32;
        const float gate = silu_f(bf2f(gv[r][d0]));
        O[row * LDO + h * 256 + e] = (bf16)f2bf(o[d0][r] * rstd * rg[e] * gate); } } }
  __syncthreads();
}
template <int LDP, int LDO>
__device__ __forceinline__ void sgu_unit(const bf16* __restrict__ P, const unsigned long long* __restrict__ lnsum, const float* __restrict__ lng, const float* __restrict__ lnb, const float* __restrict__ Wg, const float* __restrict__ bs,
                                         bf16* __restrict__ O, size_t t0, int g, char* lds) {
  int tid = threadIdx.x; asm volatile("" : "+v"(tid));
  const int wid = tid >> 6, lane = tid & 63, r32 = lane & 31, hi = lane >> 5;
  { const int cc = (tid & 31) * 8;
    v4u vin[8]; unsigned long long s1v[8], s2v[8];
#pragma unroll
    for (int it = 0; it < 8; ++it) { const int j = it * 16 + (tid >> 5);
      vin[it] = *(const v4u*)(P + pblk(t0 + j, 4096 + g * 256 + cc)); s1v[it] = lnsum[2 * (t0 + j)]; s2v[it] = lnsum[2 * (t0 + j) + 1]; }
    const f32x4 g0 = *(const f32x4*)(lng + g * 256 + cc), g1 = *(const f32x4*)(lng + g * 256 + cc + 4), b0 = *(const f32x4*)(lnb + g * 256 + cc), b1 = *(const f32x4*)(lnb + g * 256 + cc + 4);
#pragma unroll
    for (int it = 0; it < 8; ++it) { const int j = it * 16 + (tid >> 5); const v4u v4 = vin[it];
      const float s1 = (float)(long long)s1v[it] * (1.f / 16777216.f), s2 = (float)(long long)s2v[it] * (1.f / 16777216.f); const float mean = s1 * (1.f / 1024.f); const float rstd = rsqrtf(fmaxf(s2 * (1.f / 1024.f) - mean * mean, 0.f) + 1e-6f);
      float y[8];
#pragma unroll
      for (int q = 0; q < 4; ++q) { y[2 * q] = gelu_tanh(bflo(v4[q])); y[2 * q + 1] = gelu_tanh(bfhi(v4[q])); }
#pragma unroll
      for (int q = 0; q < 4; ++q) { y[q] = (y[q] - mean) * rstd * g0[q] + b0[q]; y[4 + q] = (y[4 + q] - mean) * rstd * g1[q] + b1[q]; }
      *(v4u*)(lds + ((j >> 6) * 2 + (cc >> 7)) * SHM_V + v_st(j & 63, cc & 127)) = pack8(y); } }
  const int ib = wid & 3, ct = wid >> 2;
  bf16x8 wa[8];
  { const float* wr = Wg + (size_t)(32 * ib + r32) * 128 + hi * 8;
#pragma unroll
    for (int ks = 0; ks < 8; ++ks) { if (ks < 4 || ib >= 2) { const f32x4 a0 = *(const f32x4*)(wr + ks * 16), a1 = *(const f32x4*)(wr + ks * 16 + 4);
        v4u w; w.x = cvtpk(a0[0], a0[1]); w.y = cvtpk(a0[2], a0[3]); w.z = cvtpk(a1[0], a1[1]); w.w = cvtpk(a1[2], a1[3]); wa[ks] = __builtin_bit_cast(bf16x8, w); }
      else wa[ks] = (bf16x8){0, 0, 0, 0, 0, 0, 0, 0}; } }
  __syncthreads();
  f32x16 o[4] = {};
  pv_d0(o, (int)(uintptr_t)(lds + (0 * 2 + ct) * SHM_V) + v_rd_base(lane), wa[0], wa[1], wa[2], wa[3]);
  if (ib >= 2) pv_d0(o, (int)(uintptr_t)(lds + (1 * 2 + ct) * SHM_V) + v_rd_base(lane), wa[4], wa[5], wa[6], wa[7]);
  { bf16 uv[16][4];
#pragma unroll
    for (int r = 0; r < 16; ++r)
#pragma unroll
      for (int d0 = 0; d0 < 4; ++d0) uv[r][d0] = P[pblk(t0 + 32 * ib + crow(r, hi), 3072 + g * 256 + 128 * ct + 32 * d0 + r32)];
#pragma unroll
    for (int r = 0; r < 16; ++r) { const int i = 32 * ib + crow(r, hi); const float bi = bs[i]; const size_t row = t0 + i;
#pragma unroll
      for (int d0 = 0; d0 < 4; ++d0) { const int c = 128 * ct + 32 * d0 + r32;
        const float uu = gelu_tanh(bf2f(uv[r][d0]));
        O[row * LDO + 1024 + g * 256 + c] = (bf16)f2bf(uu * (o[d0][r] + bi)); } } }
  __syncthreads();
}
#undef SBAR
}

__device__ __forceinline__ f32x4 mma16(bf16x8 a, bf16x8 b, f32x4 c) { return __builtin_amdgcn_mfma_f32_16x16x32_bf16(a, b, c, 0, 0, 0); }

struct Args { const float* in[20]; float* out; unsigned char* ws; int ph_lo, ph_hi, sel, li; };

constexpr int N_PHASES = 17;

__global__ void __launch_bounds__(NWAVES * 64, 2) mega_fwd(Args args) {
    extern __shared__ __attribute__((aligned(16))) unsigned char lds[];
    LAS unsigned char* ldsl = (LAS unsigned char*)lds;
    const int G = gridDim.x; const int bx = blockIdx.x;
    const int vcu = (G % 8 == 0) ? (bx % 8) * (G / 8) + bx / 8 : bx;
#define PHASE_ENV() \
    const __attribute__((address_space(4))) Args* ap_ = (const __attribute__((address_space(4))) Args*)__builtin_amdgcn_kernarg_segment_ptr(); asm volatile("" : "+s"(ap_)); \
    int tid = threadIdx.x; asm volatile("" : "+v"(tid)); const int lane = tid & 63, wave = __builtin_amdgcn_readfirstlane(tid >> 6); (void)lane; \
    unsigned char* const ws = ap_->ws; const int gw = vcu * NWAVES + wave, NGW = G * NWAVES; const int gt = vcu * (NWAVES * 64) + tid, NGT = G * NWAVES * 64; \
    const float* const x_in = ap_->in[0]; \
    bf16* const W_ABIN = (bf16*)(ws + WS_W_ABIN); bf16* const W_ABOUT = (bf16*)(ws + WS_W_ABOUT); bf16* const W_CDIN = (bf16*)(ws + WS_W_CDIN); bf16* const W_CDOUT = (bf16*)(ws + WS_W_CDOUT); \
    bf16* const W_UP0 = (bf16*)(ws + WS_W_UP0); bf16* const W_UP1 = (bf16*)(ws + WS_W_UP1); bf16* const W_DN0 = (bf16*)(ws + WS_W_DN0); bf16* const W_DN1 = (bf16*)(ws + WS_W_DN1); \
    bf16* const XN = (bf16*)(ws + WS_XN); bf16* const OB16 = (bf16*)(ws + WS_O); float* const X = (float*)(ws + WS_X); bf16* const ACT = (bf16*)(ws + WS_ACT); \
    bf16* const P = (bf16*)(ws + WS_P); float* const OBF = (float*)(ws + WS_OB); bf16* const KV = (bf16*)(ws + WS_KV); bf16* const PREV = (bf16*)(ws + WS_PREV); bf16* const UP = (bf16*)(ws + WS_UP); \
    unsigned long long* const SS = (unsigned long long*)(ws + WS_SS); (void)SS; unsigned long long* const LNS = (unsigned long long*)(ws + WS_LNS); (void)LNS; bf16* const HALO = (bf16*)(ws + WS_HALO); (void)HALO; bf16* const SCR = (bf16*)(ws + WS_SCR); (void)SCR; float* const SCAL = (float*)(ws + WS_SCAL); float2* const ROPE = (float2*)(ws + WS_ROPE); \
    (void)gw; (void)NGW; (void)gt; (void)NGT; (void)x_in; (void)W_ABIN; (void)W_ABOUT; (void)W_CDIN; (void)W_CDOUT; (void)W_UP0; (void)W_UP1; (void)W_DN0; (void)W_DN1; (void)XN; (void)OB16; (void)X; (void)ACT; (void)P; (void)OBF; (void)KV; (void)PREV; (void)UP; (void)SCAL; (void)ROPE;
#define AIN(k) (ap_->in[k])

#if !MK_PER_PHASE
    for (int u = threadIdx.x; u < (LDS_BYTES - LDSCTL_OFF) / 4; u += NWAVES * 64) ((LAS unsigned*)(ldsl + LDSCTL_OFF))[u] = 0u;
    __syncthreads();
    XcdBarrier bar = xcd_barrier_post((unsigned*)(args.ws + WS_CTL) + 4096 + args.li * XCD_BAR_WORDS, (volatile LAS unsigned*)(ldsl + MISC_OFF) + 8);
#define GRID_BAR() xcd_barrier(bar)
#else
#define GRID_BAR() do {} while (0)
#endif
    const int lo = args.ph_lo, hi_ph = args.ph_hi;
#ifndef PH_MASK
#define PH_MASK 0xFFFFFFu
#endif
#define IN(k) (((PH_MASK >> (k)) & 1u) && lo <= (k) && (k) < hi_ph)
#define SEAM(k) do { if (IN(k) && IN((k) + 1)) GRID_BAR(); } while (0)
#ifndef REPEAT_MASK
#define REPEAT_MASK 0u
#endif
#define NREP(k) (((REPEAT_MASK >> (k)) & 1u) ? 2 : 1)

#define RAW_TO_XN(SRC, SSP) do { \
        for (int m = gw; m < MTOK; m += NGW) { const GAS f32x4* xr = (const GAS f32x4*)((SRC) + (size_t)m * DM) + lane; f32x4 v[8]; float s = 0.f; \
            _Pragma("unroll") for (int j = 0; j < 8; ++j) { v[j] = __builtin_nontemporal_load(xr + 64 * j); s += (v[j].x * v[j].x + v[j].y * v[j].y) + (v[j].z * v[j].z + v[j].w * v[j].w); } \
            s = wave_sum(s); if (lane == 0) (SSP)[m] = (unsigned long long)(s * 16777216.f); \
            GAS v2u* o8 = (GAS v2u*)(XN + (size_t)m * DM) + lane; \
            _Pragma("unroll") for (int j = 0; j < 8; ++j) { v2u w; w.x = pk2(v[j].x, v[j].y); w.y = pk2(v[j].z, v[j].w); o8[64 * j] = w; } } } while (0)

#ifndef CT_P5
#define CT_P5 3200
#endif
    constexpr int CT_ABIN = 32 * (AB_IN / 64), CT_SQ = 32 * (DM / 64), CT_CDIN = 32 * (CD_IN / 64), CT_UP = 32 * (DFF2 / 64), CT_DN = (DFF / 64) * (DM / 64);
    constexpr int CT_L0 = CT_ABIN + CT_SQ + CT_UP + CT_DN, CT_ALL = CT_L0 + CT_CDIN + CT_SQ + CT_UP + CT_DN, CT_S1 = CT_L0 + CT_P5, CT_S2 = CT_ALL - CT_DN, CT_PRO = CT_L0 - CT_DN;
#define CONVERT_TILES(FIRST, LAST, W_ID, N_W) do { \
        LAS unsigned* T = (LAS unsigned*)(ldsl + wave * 9216); \
        const int rp = lane >> 4, cq = lane & 15; \
        struct TileRef { const float* src; bf16* dst; const float* gk; int K, N, perm; }; \
        auto tile_ref = [&](int it, TileRef& t) -> int { \
            int r = it; \
            if (r < CT_ABIN) { t = TileRef{AIN(5), W_ABIN, AIN(1), DM, AB_IN, 0}; return r; } r -= CT_ABIN; \
            if (r < CT_SQ) { t = TileRef{AIN(6), W_ABOUT, nullptr, DM, DM, 0}; return r; } r -= CT_SQ; \
            if (r < CT_UP) { t = TileRef{AIN(16), W_UP0, AIN(2), DM, DFF2, 1}; return r; } r -= CT_UP; \
            if (r < CT_DN) { t = TileRef{AIN(19), W_DN0, nullptr, DFF, DM, 0}; return r; } r -= CT_DN; \
            if (r < CT_CDIN) { t = TileRef{AIN(9), W_CDIN, AIN(1) + DM, DM, CD_IN, 0}; return r; } r -= CT_CDIN; \
            if (r < CT_SQ) { t = TileRef{AIN(10), W_CDOUT, nullptr, DM, DM, 0}; return r; } r -= CT_SQ; \
            if (r < CT_UP) { t = TileRef{AIN(16) + (size_t)DM * DFF2, W_UP1, AIN(2) + DM, DM, DFF2, 1}; return r; } r -= CT_UP; \
            t = TileRef{AIN(19) + (size_t)DFF * DM, W_DN1, nullptr, DFF, DM, 0}; return r; \
        }; \
        f32x4 va[2][8], vb[2][8]; float ga[2][8], gb[2][8];                                 \
        auto tile_load = [&](int it, const int s_) __attribute__((always_inline)) { \
            TileRef t; const int r = tile_ref(it, t); const int nblk = t.N / 64, kb = r / nblk, nb = r % nblk; \
            const float* p = t.src + (size_t)(kb * 64 + 2 * rp) * t.N + nb * 64 + 4 * cq; \
            _Pragma("unroll") \
            for (int i = 0; i < 8; ++i) { va[s_][i] = __builtin_nontemporal_load((const f32x4*)(p + (size_t)(8 * i) * t.N)); vb[s_][i] = __builtin_nontemporal_load((const f32x4*)(p + (size_t)(8 * i + 1) * t.N)); \
                ga[s_][i] = t.gk ? t.gk[kb * 64 + 8 * i + 2 * rp] : 1.f; gb[s_][i] = t.gk ? t.gk[kb * 64 + 8 * i + 2 * rp + 1] : 1.f; } \
        }; \
        const int ct_last = (LAST), ct_step = (N_W); \
        auto tile_emit = [&](int it, const int s_, int nxt) __attribute__((always_inline)) {     \
            _Pragma("unroll") \
            for (int i = 0; i < 8; ++i) { \
                _Pragma("unroll") \
                for (int j = 0; j < 4; ++j) T[(4 * cq + j) * 32 + ((4 * i + rp) ^ ((cq & 7) << 2))] = pk2(va[s_][i][j] * ga[s_][i], vb[s_][i][j] * gb[s_][i]); }     \
            TileRef t; const int r = tile_ref(it, t); const int nblk = t.N / 64, kb = r / nblk, nb = r % nblk; \
            const int n0_ = nb * 64; const int drow0 = !t.perm ? n0_ : (n0_ < DFF ? (n0_ >> 7) * 256 + (n0_ & 127) : ((n0_ - DFF) >> 7) * 256 + 128 + ((n0_ - DFF) & 127)); \
            if (nxt < ct_last) tile_load(nxt, s_); \
            LDS_WAIT(); asm volatile("" ::: "memory"); \
            _Pragma("unroll") \
            for (int o = 0; o < 8; ++o) { const int idx = o * 64 + lane, n = idx >> 3, c = idx & 7; \
                const v4u w = *(const LAS v4u*)(T + n * 32 + 4 * (c ^ ((n >> 2) & 7))); \
                *(GAS v4u*)(t.dst + (size_t)(drow0 + n) * t.K + kb * 64 + 8 * c) = w; } \
            LDS_WAIT(); asm volatile("" ::: "memory"); \
        }; \
        int it = (FIRST) + (W_ID); \
        if (it < ct_last) tile_load(it, 0); \
        if (it + ct_step < ct_last) tile_load(it + ct_step, 1); \
        while (it < ct_last) { \
            tile_emit(it, 0, it + 2 * ct_step); \
            if (it + ct_step < ct_last) tile_emit(it + ct_step, 1, it + 3 * ct_step); \
            it += 2 * ct_step; \
        } \
    } while (0)

    for (int rep_ = 0; rep_ < NREP(0); ++rep_) if (IN(0)) { if (rep_) GRID_BAR(); PHASE_ENV();
        RAW_TO_XN(x_in, SS);
        if (G == 256) { CONVERT_TILES(CT_ABIN + CT_SQ, CT_PRO, gw, NGW); CONVERT_TILES(0, CT_ABIN + CT_SQ, gw, NGW); }
        else { CONVERT_TILES(0, CT_ALL, gw, NGW); }
        for (int e = gt; e < SEQ * 64; e += NGT) { const int pos = e >> 6, i = e & 63;
            double f = 1.0; for (int k = 0; k < i; ++k) f *= 0.8659643233600653;
            const float ang = (float)pos * (float)f;
            double rev = (double)ang * 0.15915494309189535; rev -= floor(rev);
            const float rv = (float)rev;
            ROPE[e] = make_float2(__builtin_amdgcn_cosf(rv), __builtin_amdgcn_sinf(rv)); }
        if (vcu == 0 && wave == 0) { const float* lv = AIN(7);
            float a = lv[lane] * lv[128 + lane] + lv[64 + lane] * lv[192 + lane]; float b = lv[256 + lane] * lv[384 + lane] + lv[320 + lane] * lv[448 + lane];
            a = wave_sum(a); b = wave_sum(b);
            if (lane == 0) SCAL[0] = expf(a) - expf(b) + 0.2f; }
    }
    SEAM(0);

    for (int rep_ = 0; rep_ < NREP(1); ++rep_) if (IN(1)) { if (rep_) GRID_BAR(); PHASE_ENV(); pg8::Gemm g{XN, W_ABIN, MTOK, AB_IN, DM}; pg8::StaticOrder S; S.init(MTOK, AB_IN, G, bx);
        pg8::EpiBf16 E{P, AB_IN, SS, nullptr, 0, 0}; pg8::gemm_phase<pg8::EpiBf16, pg8::StaticOrder, true, true>(ldsl, g, S, E, tid); }
    SEAM(1);

    for (int rep_ = 0; rep_ < NREP(2); ++rep_) if (IN(2)) { if (rep_) GRID_BAR(); PHASE_ENV();
#ifndef NO_B
        if (!(ap_->sel & 1)) { const int bh = vcu >> 5, comp = (vcu >> 4) & 1, s = vcu & 15, b = bh >> 2, h = bh & 3;
          float* tb = (float*)(lds + att::B2_TB);
          if (tid < 448) { const int rel = tid - 256 - 127, n = rel < 0 ? -rel : rel; int bucket = (n < 8) ? n : 8 + (31 - __clz((n * n) >> 6)); if (n >= 8 && bucket > 15) bucket = 15; if (rel > 0) bucket += 16;
              const float* rb = AIN(4); tb[tid] = (rel >= -127 && rel <= 63) ? (rb[bucket * 4 + h] - rb[15 * 4 + h]) * (1.f / att::SCALE) : 0.f; }
          __syncthreads();
          const bf16* Pb = P + (size_t)b * SEQ * AB_IN;
          for (int i = 0; i < 2; ++i) { const int q128 = i ? 31 - s : s;
              att::attnB2_unit<AB_IN, 1024>(Pb + (size_t)(128 * q128) * AB_IN + 3072 + h * 256 + comp * 128, Pb, 4096 + h * 256 + comp * 128, 5120 + h * 256,
                                            (bf16*)OBF + (size_t)comp * MTOK * 1024 + (size_t)(b * SEQ + 128 * q128) * 1024 + h * 256, q128, (char*)lds, ap_->sel); } }
#endif
#ifndef NO_A
#ifndef NREP_A
#define NREP_A 1
#endif
        for (int ra_ = 0; ra_ < NREP_A; ++ra_) if (!(ap_->sel & 2))
        { const int bh = vcu >> 4, qb = vcu & 15, b = bh >> 3, h = bh & 7;
          const bf16* Pb = P + (size_t)b * SEQ * AB_IN;
          att::attnA_unit<AB_IN, DM>(Pb + (size_t)(256 * qb) * AB_IN + h * 128, Pb, 1024 + h * 128, 2048 + h * 128, OB16 + (size_t)(b * SEQ + 256 * qb) * DM + h * 128, qb, (char*)lds); }
#endif
    }
    SEAM(2);

    for (int rep_ = 0; rep_ < NREP(3); ++rep_) if (IN(3)) { if (rep_) GRID_BAR(); PHASE_ENV();
        const float lam = SCAL[0]; const float* sg = AIN(8);
        f32x4 g4[4];
#pragma unroll
        for (int q = 0; q < 4; ++q) g4[q] = *(const f32x4*)(sg + (lane & 15) * 16 + q * 4);
        const bf16* OBH = (const bf16*)OBF;
        for (int row0 = gw * 2; row0 < MTOK; row0 += NGW * 2) { f32x4 a[2][4], c[2][4];
            v4u ra[2][2], rc[2][2];
#pragma unroll
            for (int rr = 0; rr < 2; ++rr)
#pragma unroll
                for (int q = 0; q < 2; ++q) { ra[rr][q] = *(const v4u*)(OBH + (size_t)(row0 + rr) * 1024 + lane * 16 + q * 8); rc[rr][q] = *(const v4u*)(OBH + (size_t)MTOK * 1024 + (size_t)(row0 + rr) * 1024 + lane * 16 + q * 8); }
#pragma unroll
            for (int rr = 0; rr < 2; ++rr)
#pragma unroll
                for (int q = 0; q < 2; ++q) {
                    a[rr][2 * q] = (f32x4){bflo(ra[rr][q].x), bfhi(ra[rr][q].x), bflo(ra[rr][q].y), bfhi(ra[rr][q].y)}; a[rr][2 * q + 1] = (f32x4){bflo(ra[rr][q].z), bfhi(ra[rr][q].z), bflo(ra[rr][q].w), bfhi(ra[rr][q].w)};
                    c[rr][2 * q] = (f32x4){bflo(rc[rr][q].x), bfhi(rc[rr][q].x), bflo(rc[rr][q].y), bfhi(rc[rr][q].y)}; c[rr][2 * q + 1] = (f32x4){bflo(rc[rr][q].z), bfhi(rc[rr][q].z), bflo(rc[rr][q].w), bfhi(rc[rr][q].w)}; }
#pragma unroll
            for (int rr = 0; rr < 2; ++rr) { float ss = 0.f;
#pragma unroll
                for (int q = 0; q < 4; ++q) { a[rr][q] = a[rr][q] - lam * c[rr][q]; ss += (a[rr][q].x * a[rr][q].x + a[rr][q].y * a[rr][q].y) + (a[rr][q].z * a[rr][q].z + a[rr][q].w * a[rr][q].w); }
                ss += __shfl_xor(ss, 1); ss += __shfl_xor(ss, 2); ss += __shfl_xor(ss, 4); ss += __shfl_xor(ss, 8);
                const float rs = rsqrtf(ss * (1.f / 256.f) + EPS) * 0.8f;
                v4u w0, w1;
                w0.x = pk2(a[rr][0].x * rs * g4[0].x, a[rr][0].y * rs * g4[0].y); w0.y = pk2(a[rr][0].z * rs * g4[0].z, a[rr][0].w * rs * g4[0].w);
                w0.z = pk2(a[rr][1].x * rs * g4[1].x, a[rr][1].y * rs * g4[1].y); w0.w = pk2(a[rr][1].z * rs * g4[1].z, a[rr][1].w * rs * g4[1].w);
                w1.x = pk2(a[rr][2].x * rs * g4[2].x, a[rr][2].y * rs * g4[2].y); w1.y = pk2(a[rr][2].z * rs * g4[2].z, a[rr][2].w * rs * g4[2].w);
                w1.z = pk2(a[rr][3].x * rs * g4[3].x, a[rr][3].y * rs * g4[3].y); w1.w = pk2(a[rr][3].z * rs * g4[3].z, a[rr][3].w * rs * g4[3].w);
                bf16* op = OB16 + (size_t)(row0 + rr) * DM + 1024 + lane * 16; *(v4u*)op = w0; *(v4u*)(op + 8) = w1; } }
    }
    SEAM(3);

    for (int rep_ = 0; rep_ < NREP(4); ++rep_) if (IN(4)) { if (rep_) GRID_BAR(); PHASE_ENV(); pg8::Gemm g{OB16, W_ABOUT, MTOK, DM, DM}; pg8::StaticOrder S; S.init(MTOK, DM, G, bx);
        pg8::EpiRes E{nullptr, XN, DM, SS + 1 * MTOK}; pg8::gemm_phase<pg8::EpiRes, pg8::StaticOrder, false, true>(ldsl, g, S, E, tid); }
    SEAM(4);

#ifndef FIX_IN_DOWN
#define FIX_IN_DOWN 1
#endif
#if FIX_IN_DOWN
#define FIX_PHASE(PB, L) if (IN(PB) && !IN(PB + 1) && IN(PB + 2)) GRID_BAR();
#define FIX_LOCAL(L) auto fix_hook = [&]() __attribute__((always_inline)) { pg8::Unit fu; for (int fi = 0; S.next(fi, fu); ++fi) conv_fix_panel(HALO, ACT, AIN(17) + (size_t)(L) * 3 * DFF2, AIN(18) + (size_t)(L) * DFF2, fu.pm, tid); \
          asm volatile("s_waitcnt vmcnt(0)" ::: "memory"); __syncthreads(); };
#else
#define FIX_PHASE(PB, L) \
    for (int rep_ = 0; rep_ < NREP(PB + 1); ++rep_) if (IN(PB + 1)) { if (rep_) GRID_BAR(); PHASE_ENV(); conv_fix(HALO, ACT, AIN(17) + (size_t)(L) * 3 * DFF2, AIN(18) + (size_t)(L) * DFF2, gt, NGT); } \
    SEAM(PB + 1);
#define FIX_LOCAL(L) pg8::NoHook fix_hook;
#endif
#define FFN_PHASES(PB, WUP, WDN, L, SSIN, SSOUT) \
    for (int rep_ = 0; rep_ < NREP(PB); ++rep_) if (IN(PB)) { if (rep_) GRID_BAR(); PHASE_ENV(); pg8::Gemm g{XN, WUP, MTOK, DFF2, DM}; pg8::StaticOrder S; S.init(MTOK, DFF2, G, bx); \
        pg8::EpiConv E{ACT, SS + (SSIN) * MTOK, AIN(17) + (size_t)(L) * 3 * DFF2, AIN(18) + (size_t)(L) * DFF2, HALO, ldsl}; \
        pg8::gemm_phase<pg8::EpiConv, pg8::StaticOrder, true, true>(ldsl, g, S, E, tid); \
        if (G == 256 && bx >= 128) { if ((PB) == 5) { CONVERT_TILES(CT_PRO, CT_S1, (bx - 128) * NWAVES + wave, 128 * NWAVES); } else { CONVERT_TILES(CT_S2, CT_ALL, (bx - 128) * NWAVES + wave, 128 * NWAVES); } } } \
    SEAM(PB); \
    FIX_PHASE(PB, L) \
    for (int rep_ = 0; rep_ < NREP(PB + 2); ++rep_) if (IN(PB + 2)) { if (rep_) GRID_BAR(); PHASE_ENV(); pg8::Gemm g{ACT, WDN, MTOK, DM, DFF}; pg8::StaticOrder S; S.init(MTOK, DM, G, bx); \
        FIX_LOCAL(L) \
        if ((L) == 1 && G == 256) { pg8::EpiFinal E{XN, DM, SS + (SSOUT) * MTOK, (unsigned*)(ws + WS_CNT), AIN(3), ap_->out}; pg8::gemm_phase<pg8::EpiFinal, pg8::StaticOrder, false, true>(ldsl, g, S, E, tid, fix_hook); } \
        else { pg8::EpiRes E{nullptr, XN, DM, SS + (SSOUT) * MTOK}; pg8::gemm_phase<pg8::EpiRes, pg8::StaticOrder, false, true>(ldsl, g, S, E, tid, fix_hook); } } \
    SEAM(PB + 2);

    auto conv_fix = [&](const bf16* halo, bf16* act, const float* cw, const float* cb, int gt_, int ngt_) {
        constexpr int NCH = DFF / 8;
        for (int task = gt_; task < NCH * 64; task += ngt_) { const int ch = task % NCH, rr = (task / NCH) & 1, pm = task / (2 * NCH), n0 = ch * 8;
            const int pca = (n0 >> 7) * 256 + (n0 & 127); const bool first = (pm & 15) == 0;
            const bf16* H = halo + (size_t)pm * 4 * DFF2; const bf16* Hp = H - (size_t)4 * DFF2;
            float cv[2][8];
#pragma unroll
            for (int bj = 0; bj < 2; ++bj) { const int pc = pca + bj * 128, cc = bj * DFF + n0; const v4u z = {0u, 0u, 0u, 0u};
                const v4u c0 = *(const v4u*)(H + pc), c1 = *(const v4u*)(H + DFF2 + pc);
                const v4u q254 = first ? z : *(const v4u*)(Hp + 2 * DFF2 + pc), q255 = first ? z : *(const v4u*)(Hp + 3 * DFF2 + pc);
                const v4u x2 = rr == 0 ? q254 : q255, x1 = rr == 0 ? q255 : c0, x0 = rr == 0 ? c0 : c1;
#pragma unroll
                for (int q = 0; q < 4; ++q) {
                    cv[bj][2 * q] = cb[cc + 2 * q] + cw[cc + 2 * q] * bflo(x2[q]) + cw[DFF2 + cc + 2 * q] * bflo(x1[q]) + cw[2 * DFF2 + cc + 2 * q] * bflo(x0[q]);
                    cv[bj][2 * q + 1] = cb[cc + 2 * q + 1] + cw[cc + 2 * q + 1] * bfhi(x2[q]) + cw[DFF2 + cc + 2 * q + 1] * bfhi(x1[q]) + cw[2 * DFF2 + cc + 2 * q + 1] * bfhi(x0[q]); } }
            float o[8];
#pragma unroll
            for (int q = 0; q < 8; ++q) o[q] = silu_f(cv[1][q]) * cv[0][q];
            v4u w; w.x = pk2(o[0], o[1]); w.y = pk2(o[2], o[3]); w.z = pk2(o[4], o[5]); w.w = pk2(o[6], o[7]);
            *(v4u*)(act + (size_t)(pm * 256 + rr) * DFF + n0) = w; }
    };

    auto conv_fix_panel = [&](const bf16* halo, bf16* act, const float* cw, const float* cb, int pm, int t_) __attribute__((always_inline)) {
        constexpr int NCH = DFF / 8; const bool first = (pm & 15) == 0;
        const bf16* H = halo + (size_t)pm * 4 * DFF2; const bf16* Hp = H - (size_t)4 * DFF2;
        for (int ch = t_; ch < NCH; ch += NWAVES * 64) { const int n0 = ch * 8, pca = (n0 >> 7) * 256 + (n0 & 127);
            float cv[2][2][8];
#pragma unroll
            for (int bj = 0; bj < 2; ++bj) { const int pc = pca + bj * 128, cc = bj * DFF + n0; const v4u z = {0u, 0u, 0u, 0u};
                const v4u c0 = *(const v4u*)(H + pc), c1 = *(const v4u*)(H + DFF2 + pc);
                const v4u q254 = first ? z : *(const v4u*)(Hp + 2 * DFF2 + pc), q255 = first ? z : *(const v4u*)(Hp + 3 * DFF2 + pc);
                float w0[8], w1[8], w2[8], bb[8];
#pragma unroll
                for (int hf = 0; hf < 2; ++hf) { const f32x4 a0 = *(const f32x4*)(cw + cc + 4 * hf), a1 = *(const f32x4*)(cw + DFF2 + cc + 4 * hf), a2 = *(const f32x4*)(cw + 2 * DFF2 + cc + 4 * hf), a3 = *(const f32x4*)(cb + cc + 4 * hf);
                    w0[4 * hf] = a0.x; w0[4 * hf + 1] = a0.y; w0[4 * hf + 2] = a0.z; w0[4 * hf + 3] = a0.w; w1[4 * hf] = a1.x; w1[4 * hf + 1] = a1.y; w1[4 * hf + 2] = a1.z; w1[4 * hf + 3] = a1.w;
                    w2[4 * hf] = a2.x; w2[4 * hf + 1] = a2.y; w2[4 * hf + 2] = a2.z; w2[4 * hf + 3] = a2.w; bb[4 * hf] = a3.x; bb[4 * hf + 1] = a3.y; bb[4 * hf + 2] = a3.z; bb[4 * hf + 3] = a3.w; }
#pragma unroll
                for (int q = 0; q < 4; ++q) { const int e0 = 2 * q, e1 = 2 * q + 1;
                    cv[0][bj][e0] = bb[e0] + w0[e0] * bflo(q254[q]) + w1[e0] * bflo(q255[q]) + w2[e0] * bflo(c0[q]);
                    cv[0][bj][e1] = bb[e1] + w0[e1] * bfhi(q254[q]) + w1[e1] * bfhi(q255[q]) + w2[e1] * bfhi(c0[q]);
                    cv[1][bj][e0] = bb[e0] + w0[e0] * bflo(q255[q]) + w1[e0] * bflo(c0[q]) + w2[e0] * bflo(c1[q]);
                    cv[1][bj][e1] = bb[e1] + w0[e1] * bfhi(q255[q]) + w1[e1] * bfhi(c0[q]) + w2[e1] * bfhi(c1[q]); } }
#pragma unroll
            for (int rr = 0; rr < 2; ++rr) { float o[8];
#pragma unroll
                for (int q = 0; q < 8; ++q) o[q] = silu_f(cv[rr][1][q]) * cv[rr][0][q];
                v4u w; w.x = pk2(o[0], o[1]); w.y = pk2(o[2], o[3]); w.z = pk2(o[4], o[5]); w.w = pk2(o[6], o[7]);
                *(v4u*)(act + (size_t)(pm * 256 + rr) * DFF + n0) = w; } }
    };

    FFN_PHASES(5, W_UP0, W_DN0, 0, 1, 2)

    for (int rep_ = 0; rep_ < NREP(8); ++rep_) if (IN(8)) { if (rep_) GRID_BAR(); PHASE_ENV(); pg8::Gemm g{XN, W_CDIN, MTOK, CD_IN, DM}; pg8::StaticOrder S; S.init(MTOK, CD_IN, G, bx);
        pg8::EpiBf16 E{P, CD_IN, SS + 2 * MTOK, LNS, 16, 20, MTOK}; pg8::gemm_phase<pg8::EpiBf16, pg8::StaticOrder, true, true>(ldsl, g, S, E, tid);
        if (G == 256 && bx >= 128) { CONVERT_TILES(CT_S1, CT_S2, (bx - 128) * NWAVES + wave, 128 * NWAVES); } }
    SEAM(8);

    for (int rep_ = 0; rep_ < NREP(9); ++rep_) if (IN(9)) { if (rep_) GRID_BAR(); PHASE_ENV();
        for (int u = vcu; u < 8 * 64; u += G) { const int bh = u >> 6, n = u & 63;
            att::ret_kv_unit<CD_IN>(P, ROPE, KV + ((size_t)bh * 64 + n) * 32768, bh >> 2, bh & 3, n, (char*)lds); }
        for (int u = vcu; u < 256; u += G) { const int g = u & 3, nbk = (u >> 2) & 31, b = u >> 7;
            att::sgu_unit<CD_IN, DM>(P, LNS, AIN(12), AIN(13), AIN(14) + (size_t)g * 128 * 128, AIN(15) + g * 128, OB16, (size_t)b * SEQ + 128 * nbk, g, (char*)lds); }
    }
    SEAM(9);

    for (int rep_ = 0; rep_ < NREP(10); ++rep_) if (IN(10)) { if (rep_) GRID_BAR(); PHASE_ENV();
        if (wave < 4) for (int e4 = (vcu * 4 + wave) * 64 + lane; e4 < 8 * 256 * 128 / 4; e4 += G * 4 * 64) { const int e = e4 * 4; const int bh = e >> 15, h = bh & 3; const int r = e & 32767;
            const float g64 = __expf(64.f * __logf(1.f - exp2f(-5.f - (float)h)));
            const bf16* src = KV + (size_t)bh * 64 * 32768 + r; bf16* dst = PREV + (size_t)bh * 64 * 32768 + r; float st[4] = {0.f, 0.f, 0.f, 0.f};
#pragma unroll 16
            for (int n = 0; n < 64; ++n) { const v2u kv = *(const v2u*)(src + (size_t)n * 32768);
                v2u w; w.x = pk2(st[0], st[1]); w.y = pk2(st[2], st[3]); *(v2u*)(dst + (size_t)n * 32768) = w;
                st[0] = g64 * st[0] + bflo(kv.x); st[1] = g64 * st[1] + bfhi(kv.x); st[2] = g64 * st[2] + bflo(kv.y); st[3] = g64 * st[3] + bfhi(kv.y); } }
    }
    SEAM(10);

    for (int rep_ = 0; rep_ < NREP(11); ++rep_) if (IN(11)) { if (rep_) GRID_BAR(); PHASE_ENV();
        for (int u = vcu; u < 256; u += G) { const int bh = u >> 5, np = u & 31;
            att::ret_out_unit<CD_IN, DM>(P, ROPE, PREV, AIN(11), OB16, bh >> 2, bh & 3, np, (char*)lds); }
    }
    SEAM(11);

    for (int rep_ = 0; rep_ < NREP(12); ++rep_) if (IN(12)) { if (rep_) GRID_BAR(); PHASE_ENV(); pg8::Gemm g{OB16, W_CDOUT, MTOK, DM, DM}; pg8::StaticOrder S; S.init(MTOK, DM, G, bx);
        pg8::EpiRes E{nullptr, XN, DM, SS + 3 * MTOK}; pg8::gemm_phase<pg8::EpiRes, pg8::StaticOrder, false, true>(ldsl, g, S, E, tid); }
    SEAM(12);

    FFN_PHASES(13, W_UP1, W_DN1, 1, 3, 4)

    for (int rep_ = 0; rep_ < NREP(16); ++rep_) if (IN(16) && G != 256) { if (rep_) GRID_BAR(); PHASE_ENV(); const float* fg = AIN(3); const unsigned long long* ss4 = SS + 4 * MTOK;
        for (int m0 = gw * 4; m0 < MTOK; m0 += NGW * 4) { v4u v[4][4]; float rstd[4];
#pragma unroll
            for (int rr = 0; rr < 4; ++rr) { const GAS v4u* xr = (const GAS v4u*)(XN + (size_t)(m0 + rr) * DM) + lane;
#pragma unroll
                for (int j = 0; j < 4; ++j) v[rr][j] = xr[64 * j];
                rstd[rr] = rsqrtf((float)ss4[m0 + rr] * (1.f / 16777216.f / DM) + EPS); }
#pragma unroll
            for (int rr = 0; rr < 4; ++rr) { float* orow = ap_->out + (size_t)(m0 + rr) * DM;
#pragma unroll
                for (int j = 0; j < 4; ++j) { const int c0 = (64 * j + lane) * 8; const f32x4 g0 = *(const f32x4*)(fg + c0), g1 = *(const f32x4*)(fg + c0 + 4); const float r_ = rstd[rr];
                    const f32x4 o0 = {bflo(v[rr][j].x) * r_ * g0.x, bfhi(v[rr][j].x) * r_ * g0.y, bflo(v[rr][j].y) * r_ * g0.z, bfhi(v[rr][j].y) * r_ * g0.w};
                    const f32x4 o1 = {bflo(v[rr][j].z) * r_ * g1.x, bfhi(v[rr][j].z) * r_ * g1.y, bflo(v[rr][j].w) * r_ * g1.z, bfhi(v[rr][j].w) * r_ * g1.w};
                    *(GAS f32x4*)(orow + c0) = o0; *(GAS f32x4*)(orow + c0 + 4) = o1; } } }
    }
#undef IN
#undef SEAM
}

extern "C" void kernel_launch(void* const* d_in, const int* in_sizes, int n_in, void* d_out, int out_size, void* d_ws, size_t ws_size, hipStream_t stream) {
    static int grid = 0;
    if (grid == 0) {
        if (n_in != 20 || in_sizes[0] != MTOK * DM || out_size != MTOK * DM || ws_size < WS_END) {
            fprintf(stderr, "kernel_launch: unexpected shapes: n_in %d in0 %d out %d ws %zu (need >= %zu)\n", n_in, n_in > 0 ? in_sizes[0] : -1, out_size, ws_size, (size_t)WS_END); grid = -1; return; }
        int dev = 0, cus = 0;
        if (hipGetDevice(&dev) != hipSuccess || hipDeviceGetAttribute(&cus, hipDeviceAttributeMultiprocessorCount, dev) != hipSuccess) { grid = -1; return; }
        if (hipFuncSetAttribute((const void*)mega_fwd, hipFuncAttributeMaxDynamicSharedMemorySize, LDS_BYTES) != hipSuccess) { fprintf(stderr, "kernel_launch: hipFuncSetAttribute failed\n"); grid = -1; return; }
        int per_cu = 0;
        if (hipOccupancyMaxActiveBlocksPerMultiprocessor(&per_cu, (const void*)mega_fwd, NWAVES * 64, LDS_BYTES) != hipSuccess || per_cu < 1) { fprintf(stderr, "kernel_launch: occupancy query says %d blocks per CU\n", per_cu); }
        (void)hipGetLastError();
        grid = cus;
    }
    if (grid < 0) return;
    const size_t ws_shift = ((ws_size - WS_END) >> 21) << 21; d_ws = (char*)d_ws + ws_shift;
    hipMemsetAsync((char*)d_ws + WS_CTL, 0, CTL_ZERO_BYTES, stream);
    Args a{};
    for (int i = 0; i < 20; ++i) a.in[i] = (const float*)d_in[i];
    a.out = (float*)d_out; a.ws = (unsigned char*)d_ws;
#if MK_PER_PHASE
    for (int p = 0; p < N_PHASES; ++p) { a.ph_lo = p; a.ph_hi = p + 1; hipLaunchKernelGGL(mega_fwd, dim3(grid), dim3(NWAVES * 64), LDS_BYTES, stream, a); }
#else
    a.ph_lo = 0; a.ph_hi = (grid == 256) ? N_PHASES - 1 : N_PHASES; hipLaunchKernelGGL         (mega_fwd, dim3(grid), dim3(NWAVES * 64), LDS_BYTES, stream, a);
#if PROBE_PHASE >= 0
    a.ph_lo = PROBE_PHASE; a.ph_hi = PROBE_PHASE + PROBE_NPH; a.sel = PROBE_SEL; a.li = 1; hipLaunchKernelGGL(mega_fwd, dim3(grid), dim3(NWAVES * 64), LDS_BYTES, stream, a);
#endif
#endif
    const hipError_t le = hipPeekAtLastError();
    if (le != hipSuccess) fprintf(stderr, "kernel_launch: launch failed: %s\n", hipGetErrorName(le));
}
```
